# Optimizing an MI355X kernel written in HIP

```python
import jax
import jax.numpy as jnp
from jax import lax
import numpy as np

D_MODEL = 1024
BATCH = 8
SEQ = 2048
DEPTH = 2

EPS = 1e-6
MIX_WIDTH = D_MODEL
A_WIDTH = D_MODEL // 2
A_HEAD_DIM = 64
A_HEADS = A_WIDTH // A_HEAD_DIM
A_LORA_W = 64
A_LORA_A = 64
A_LORA_G = 128
A_IN = 3 * A_WIDTH + A_LORA_W + A_LORA_A + A_LORA_G
A_GN_EPS = 64e-5
B_WIDTH = D_MODEL // 2
B_GROUPS = 4
B_GROUP_DIM = B_WIDTH // B_GROUPS
B_CHUNK = 128
EVEN_IN = A_IN + 2 * B_WIDTH
C_WIDTH = D_MODEL // 2
C_GROUP_CH = 16
C_GROUPS = C_WIDTH // C_GROUP_CH
C_STATE = 64
D_WIDTH = D_MODEL // 2
D_HEAD_DIM = 64
D_HEADS = D_WIDTH // D_HEAD_DIM
D_NGROUPS = 2
D_STATE = 128
D_CONV = 4
D_CHUNK = 128
D_XBC = D_WIDTH + 2 * D_NGROUPS * D_STATE
ODD_IN = C_WIDTH + D_WIDTH + D_XBC + D_HEADS
FFN_DENSE = 2816
N_EXPERTS = 8
TOP_K = 2
FFN_EXPERT = 3584
MOE_BLOCK = 256

kernel_name = 'hybrid_rwkv7_gmlp_s5_ssd_moe'


def rms_norm(z, g):
    zf = z.astype(jnp.float32)
    y = zf * lax.rsqrt(jnp.mean(zf * zf, axis=-1, keepdims=True) + EPS)
    return (y * g.astype(jnp.float32)).astype(z.dtype)


def layer_norm(z, w, b, eps):
    zf = z.astype(jnp.float32)
    mean = jnp.mean(zf, axis=-1, keepdims=True)
    var = jnp.mean(jnp.square(zf - mean), axis=-1, keepdims=True)
    return (zf - mean) * lax.rsqrt(var + eps) * w + b


def token_shift(z):
    return jnp.pad(z, ((0, 0), (1, 0), (0, 0)))[:, :-1]


def causal_dwconv(z, w, b):
    t = z.shape[1]
    zp = jnp.pad(z, ((0, 0), (D_CONV - 1, 0), (0, 0)))
    out = b
    for j in range(D_CONV):
        out = out + w[j] * zp[:, j:j + t]
    return out


def swiglu(h, w_gate, w_up, w_down):
    return (jax.nn.silu(h @ w_gate) * (h @ w_up)) @ w_down


def rwkv7_step(state, inp):
    r_t, w_t, k_t, v_t, a_t, b_t = inp
    sa = jnp.einsum('bhvk,bhk->bhv', state, a_t)
    state = (state * w_t[:, :, None, :] + sa[..., None] * b_t[:, :, None, :]
             + v_t[..., None] * k_t[:, :, None, :])
    return state, jnp.einsum('bhvk,bhk->bhv', state, r_t)


def rwkv7_mix(p, mu, w0, w2, a0, a2, g2, k_k, k_a, r_k, ln_w, ln_b):
    f32 = jnp.float32
    bsz, t, _ = p.shape
    p = p + (token_shift(p) - p) * mu
    i3 = 3 * A_WIDTH
    r, k, v, xw, xa, xg = jnp.split(
        p, [A_WIDTH, 2 * A_WIDTH, i3, i3 + A_LORA_W, i3 + A_LORA_W + A_LORA_A], axis=-1)
    w = -jax.nn.softplus(-(w0 + jnp.tanh(xw) @ w2).astype(f32)) - 0.5
    decay = jnp.exp(-jnp.exp(w))
    a = jax.nn.sigmoid((a0 + xa @ a2).astype(f32))
    g = jax.nn.sigmoid(xg) @ g2
    k = k.astype(f32)
    heads = lambda z: z.astype(f32).reshape(bsz, t, A_HEADS, A_HEAD_DIM)
    kk = heads(k * k_k)
    kk = kk / jnp.maximum(jnp.sqrt(jnp.sum(kk * kk, axis=-1, keepdims=True)), 1e-12)
    k = heads(k * (1.0 + (a - 1.0) * k_a))
    r, v, decay, a = heads(r), heads(v), heads(decay), heads(a)
    tm = lambda z: jnp.swapaxes(z, 0, 1)
    xs = (tm(r), tm(decay), tm(k), tm(v), tm(-kk), tm(kk * a))
    s0 = jnp.zeros((bsz, A_HEADS, A_HEAD_DIM, A_HEAD_DIM), f32)
    _, y = lax.scan(rwkv7_step, s0, xs)
    y = jnp.swapaxes(y, 0, 1)
    y = layer_norm(y, ln_w.reshape(A_HEADS, A_HEAD_DIM), ln_b.reshape(A_HEADS, A_HEAD_DIM), A_GN_EPS)
    y = y + jnp.sum(r * k * r_k, axis=-1, keepdims=True) * v
    y = y.reshape(bsz, t, A_WIDTH) * g
    return y.astype(p.dtype)


def gmlp_mix(p, ln_w, ln_b, ws, bs):
    bsz, t, _ = p.shape
    u, v = jnp.split(jax.nn.gelu(p), 2, axis=-1)
    nc = t // B_CHUNK
    v = v.reshape(bsz, nc, B_CHUNK, B_GROUPS, B_GROUP_DIM)
    v = layer_norm(v, ln_w, ln_b, EPS)
    causal = jnp.tril(jnp.ones((B_CHUNK, B_CHUNK), bool))
    ws_c = jnp.where(causal[None], ws, 0.0)
    s = jnp.einsum('gij,bcjgd->bcigd', ws_c, v) + bs.T[None, None, :, :, None]
    return (u * s.reshape(bsz, t, B_WIDTH).astype(u.dtype)).astype(p.dtype)


def s5_combine(e1, e2):
    a1r, a1i, b1r, b1i = e1
    a2r, a2i, b2r, b2i = e2
    return (a2r * a1r - a2i * a1i,
            a2r * a1i + a2i * a1r,
            a2r * b1r - a2i * b1i + b2r,
            a2r * b1i + a2i * b1r + b2i)


def s5_mix(u, a_re, a_im, log_dt, b_re, b_im, c_re, c_im, d_skip, glu_w, glu_b):
    f32 = jnp.float32
    bsz, t, _ = u.shape
    uf = u.astype(f32).reshape(bsz, t, C_GROUPS, C_GROUP_CH)
    lr, li = a_re.astype(f32), a_im.astype(f32)
    dt = jnp.exp(log_dt.astype(f32))[:, None]
    mag = jnp.exp(lr * dt)
    abar_r, abar_i = mag * jnp.cos(li * dt), mag * jnp.sin(li * dt)
    nr, ni = abar_r - 1.0, abar_i
    den = lr * lr + li * li
    fr, fi = (nr * lr + ni * li) / den, (ni * lr - nr * li) / den
    br, bi = b_re.astype(f32), b_im.astype(f32)
    bbar_r = fr[..., None] * br - fi[..., None] * bi
    bbar_i = fr[..., None] * bi + fi[..., None] * br
    bu_r = jnp.einsum('btgc,gpc->tbgp', uf, bbar_r)
    bu_i = jnp.einsum('btgc,gpc->tbgp', uf, bbar_i)
    shp = bu_r.shape
    a_r = jnp.broadcast_to(abar_r, shp)
    a_i = jnp.broadcast_to(abar_i, shp)
    _, _, xr, xi = lax.associative_scan(s5_combine, (a_r, a_i, bu_r, bu_i), axis=0)
    y = (jnp.einsum('tbgp,gcp->btgc', xr, c_re.astype(f32))
         - jnp.einsum('tbgp,gcp->btgc', xi, c_im.astype(f32)))
    y = y + d_skip.astype(f32).reshape(C_GROUPS, C_GROUP_CH) * uf
    y = jax.nn.gelu(y.reshape(bsz, t, C_WIDTH))
    y = y * jax.nn.sigmoid(y @ glu_w.astype(f32) + glu_b.astype(f32))
    return y.astype(u.dtype)


def segsum(a):
    l = a.shape[-1]
    z = jnp.broadcast_to(a[..., :, None], a.shape + (l,))
    z = jnp.where(jnp.tril(jnp.ones((l, l), bool), -1), z, 0.0)
    cs = jnp.cumsum(z, axis=-2)
    return jnp.where(jnp.tril(jnp.ones((l, l), bool)), cs, -jnp.inf)


def ssd_chunked(x, a, bm, cm):
    b, t, h, pd = x.shape
    g, n = bm.shape[2], bm.shape[3]
    r = h // g
    c, l = t // D_CHUNK, D_CHUNK
    x = x.reshape(b, c, l, g, r, pd)
    a = a.reshape(b, c, l, g, r).transpose(0, 3, 4, 1, 2)
    bm = bm.reshape(b, c, l, g, n)
    cm = cm.reshape(b, c, l, g, n)
    a_cs = jnp.cumsum(a, axis=-1)
    lmat = jnp.exp(segsum(a))
    cb = jnp.einsum('bclgn,bcsgn->bgcls', cm, bm)
    y_diag = jnp.einsum('bgcls,bgrcls,bcsgrp->bclgrp', cb, lmat, x)
    decay_states = jnp.exp(a_cs[..., -1:] - a_cs)
    states = jnp.einsum('bclgn,bgrcl,bclgrp->bcgrpn', bm, decay_states, x)
    states = jnp.concatenate([jnp.zeros_like(states[:, :1]), states], axis=1)
    chunk_tot = jnp.pad(a_cs[..., -1], ((0, 0), (0, 0), (0, 0), (1, 0)))
    decay_chunk = jnp.exp(segsum(chunk_tot))
    states = jnp.einsum('bgrzc,bcgrpn->bzgrpn', decay_chunk, states)[:, :-1]
    y_off = jnp.einsum('bclgn,bcgrpn,bgrcl->bclgrp', cm, states, jnp.exp(a_cs))
    return (y_diag + y_off).reshape(b, t, h, pd)


def mamba2_mix(p, conv_w, conv_b, dt_bias, a_log, d_skip, norm_w):
    f32 = jnp.float32
    bsz, t, _ = p.shape
    z, xbc, dt = jnp.split(p, [D_WIDTH, D_WIDTH + D_XBC], axis=-1)
    xbc = jax.nn.silu(causal_dwconv(xbc, conv_w, conv_b)).astype(f32)
    xh, bm, cm = jnp.split(xbc, [D_WIDTH, D_WIDTH + D_NGROUPS * D_STATE], axis=-1)
    dt = jax.nn.softplus((dt + dt_bias).astype(f32))
    a = -jnp.exp(a_log.astype(f32))
    xh = xh.reshape(bsz, t, D_HEADS, D_HEAD_DIM)
    bm = bm.reshape(bsz, t, D_NGROUPS, D_STATE)
    cm = cm.reshape(bsz, t, D_NGROUPS, D_STATE)
    y = ssd_chunked(xh * dt[..., None], a * dt, bm, cm)
    y = y + d_skip.astype(f32)[None, None, :, None] * xh
    y = y.reshape(bsz, t, D_WIDTH) * jax.nn.silu(z.astype(f32))
    yg = y.reshape(bsz, t, D_NGROUPS, D_WIDTH // D_NGROUPS)
    yg = yg * lax.rsqrt(jnp.mean(yg * yg, axis=-1, keepdims=True) + EPS)
    return (yg.reshape(bsz, t, D_WIDTH) * norm_w.astype(f32)).astype(p.dtype)


def moe_swiglu(h, w_router, w_gate, w_up, w_down):
    bsz, t, d = h.shape
    n = bsz * t
    hf = h.reshape(n, d)
    logits = (hf @ w_router).astype(jnp.float32)
    top_vals, top_idx = lax.top_k(logits, TOP_K)
    gates = jax.nn.softmax(top_vals, axis=-1).astype(h.dtype)
    flat_e = top_idx.reshape(-1).astype(jnp.int32)
    flat_tok = jnp.repeat(jnp.arange(n, dtype=jnp.int32), TOP_K)
    flat_gate = gates.reshape(-1)
    order = jnp.argsort(flat_e)
    sorted_e = flat_e[order]
    counts = jnp.bincount(flat_e, length=N_EXPERTS)
    padded = (counts + MOE_BLOCK - 1) // MOE_BLOCK * MOE_BLOCK
    start = jnp.cumsum(counts) - counts
    pend = jnp.cumsum(padded)
    pstart = pend - padded
    rank = jnp.arange(n * TOP_K, dtype=jnp.int32) - start[sorted_e]
    dest = pstart[sorted_e] + rank
    n_blocks = -(-(n * TOP_K + N_EXPERTS * MOE_BLOCK) // MOE_BLOCK)
    n_slots = n_blocks * MOE_BLOCK
    slot_tok = jnp.full((n_slots,), n, jnp.int32).at[dest].set(flat_tok[order])
    slot_gate = jnp.zeros((n_slots,), h.dtype).at[dest].set(flat_gate[order])
    block_start = jnp.arange(n_blocks, dtype=jnp.int32) * MOE_BLOCK
    block_expert = jnp.minimum(jnp.searchsorted(pend, block_start, side='right'), N_EXPERTS - 1)
    hpad = jnp.concatenate([hf, jnp.zeros((1, d), h.dtype)], axis=0)
    xs = hpad[slot_tok].reshape(n_blocks, MOE_BLOCK, d)

    def expert_block(args):
        xb, e = args
        return swiglu(xb, w_gate[e], w_up[e], w_down[e])

    ys = lax.map(expert_block, (xs, block_expert)).reshape(n_slots, d)
    out = jnp.zeros((n + 1, d), h.dtype).at[slot_tok].add(ys * slot_gate[:, None])
    return out[:n].reshape(bsz, t, d)


def even_layer(x, norm_pre_mix, w_in, rwkv_p, gmlp_p, w_out, norm_post_mix,
               norm_pre_ffn, ffn_p, norm_post_ffn):
    p = rms_norm(x, norm_pre_mix) @ w_in
    ya = rwkv7_mix(p[..., :A_IN], *rwkv_p)
    yb = gmlp_mix(p[..., A_IN:], *gmlp_p)
    y = jnp.concatenate([ya, yb], axis=-1) @ w_out
    x = x + rms_norm(y, norm_post_mix)
    x = x + rms_norm(swiglu(rms_norm(x, norm_pre_ffn), *ffn_p), norm_post_ffn)
    return x


def odd_layer(x, norm_pre_mix, w_in, s5_p, m2_p, w_out, norm_post_mix,
              norm_pre_ffn, moe_p, norm_post_ffn):
    p = rms_norm(x, norm_pre_mix) @ w_in
    yc = s5_mix(p[..., :C_WIDTH], *s5_p)
    yd = mamba2_mix(p[..., C_WIDTH:], *m2_p)
    y = jnp.concatenate([yc, yd], axis=-1) @ w_out
    x = x + rms_norm(y, norm_post_mix)
    x = x + rms_norm(moe_swiglu(rms_norm(x, norm_pre_ffn), *moe_p), norm_post_ffn)
    return x


def setup_inputs(seed: int = 0) -> dict:
    key = jax.random.key(seed)
    ks = iter(jax.random.split(key, 80))
    f32 = jnp.float32

    def nrm(shape, scale):
        return scale * jax.random.normal(next(ks), shape, f32)

    def unif(shape, lo, hi):
        return jax.random.uniform(next(ks), shape, f32, lo, hi)

    def gain(shape):
        return 1.0 + nrm(shape, 0.02)

    D = D_MODEL
    x = nrm((BATCH, SEQ, D), 1.0)
    l0_norm_pre_mix = gain((D,))
    l0_w_in = nrm((D, EVEN_IN), D ** -0.5)
    l0_rwkv_mu = unif((A_IN,), 0.0, 1.0)
    ramp = jnp.arange(A_WIDTH, dtype=f32) / (A_WIDTH - 1)
    l0_rwkv_w0 = -6.5 + 5.0 * ramp ** 0.9 + nrm((A_WIDTH,), 0.01)
    l0_rwkv_w2 = nrm((A_LORA_W, A_WIDTH), 0.1 * A_LORA_W ** -0.5)
    l0_rwkv_a0 = nrm((A_WIDTH,), 0.1)
    l0_rwkv_a2 = nrm((A_LORA_A, A_WIDTH), 0.1 * A_LORA_A ** -0.5)
    l0_rwkv_g2 = nrm((A_LORA_G, A_WIDTH), A_LORA_G ** -0.5)
    l0_rwkv_k_k = 0.85 + nrm((A_WIDTH,), 0.02)
    l0_rwkv_k_a = 1.0 + nrm((A_WIDTH,), 0.02)
    l0_rwkv_r_k = nrm((A_HEADS, A_HEAD_DIM), 0.1)
    l0_rwkv_ln_w = gain((A_WIDTH,))
    l0_rwkv_ln_b = nrm((A_WIDTH,), 0.01)
    l0_gmlp_ln_w = gain((B_GROUPS, B_GROUP_DIM))
    l0_gmlp_ln_b = nrm((B_GROUPS, B_GROUP_DIM), 0.01)
    l0_gmlp_ws = nrm((B_GROUPS, B_CHUNK, B_CHUNK), B_CHUNK ** -0.5)
    l0_gmlp_bs = 1.0 + nrm((B_GROUPS, B_CHUNK), 0.02)
    l0_w_out = nrm((MIX_WIDTH, D), MIX_WIDTH ** -0.5)
    l0_norm_post_mix = gain((D,))
    l0_norm_pre_ffn = gain((D,))
    l0_ffn_w_gate = nrm((D, FFN_DENSE), D ** -0.5)
    l0_ffn_w_up = nrm((D, FFN_DENSE), D ** -0.5)
    l0_ffn_w_down = nrm((FFN_DENSE, D), FFN_DENSE ** -0.5)
    l0_norm_post_ffn = gain((D,))
    l1_norm_pre_mix = gain((D,))
    l1_w_in = nrm((D, ODD_IN), D ** -0.5)
    l1_s5_a_re = -0.5 + nrm((C_GROUPS, C_STATE), 0.01)
    l1_s5_a_im = jnp.pi * jnp.arange(C_STATE, dtype=f32)[None, :] + nrm((C_GROUPS, C_STATE), 0.01)
    l1_s5_log_dt = unif((C_GROUPS,), float(np.log(1e-3)), float(np.log(1e-1)))
    l1_s5_b_re = nrm((C_GROUPS, C_STATE, C_GROUP_CH), (2 * C_GROUP_CH) ** -0.5)
    l1_s5_b_im = nrm((C_GROUPS, C_STATE, C_GROUP_CH), (2 * C_GROUP_CH) ** -0.5)
    l1_s5_c_re = nrm((C_GROUPS, C_GROUP_CH, C_STATE), C_STATE ** -0.5)
    l1_s5_c_im = nrm((C_GROUPS, C_GROUP_CH, C_STATE), C_STATE ** -0.5)
    l1_s5_d = nrm((C_WIDTH,), 0.5)
    l1_s5_glu_w = nrm((C_WIDTH, C_WIDTH), C_WIDTH ** -0.5)
    l1_s5_glu_b = nrm((C_WIDTH,), 0.01)
    l1_m2_conv_w = nrm((D_CONV, D_XBC), D_CONV ** -0.5)
    l1_m2_conv_b = nrm((D_XBC,), 0.01)
    dt0 = jnp.exp(unif((D_HEADS,), float(np.log(1e-3)), float(np.log(1e-1))))
    l1_m2_dt_bias = dt0 + jnp.log(-jnp.expm1(-dt0))
    l1_m2_a_log = jnp.log(unif((D_HEADS,), 1.0, 16.0))
    l1_m2_d = gain((D_HEADS,))
    l1_m2_norm_w = gain((D_WIDTH,))
    l1_w_out = nrm((MIX_WIDTH, D), MIX_WIDTH ** -0.5)
    l1_norm_post_mix = gain((D,))
    l1_norm_pre_ffn = gain((D,))
    l1_moe_router = nrm((D, N_EXPERTS), D ** -0.5)
    l1_moe_w_gate = nrm((N_EXPERTS, D, FFN_EXPERT), D ** -0.5)
    l1_moe_w_up = nrm((N_EXPERTS, D, FFN_EXPERT), D ** -0.5)
    l1_moe_w_down = nrm((N_EXPERTS, FFN_EXPERT, D), FFN_EXPERT ** -0.5)
    l1_norm_post_ffn = gain((D,))
    return {
        'x': x,
        'l0_norm_pre_mix': l0_norm_pre_mix, 'l0_w_in': l0_w_in,
        'l0_rwkv_mu': l0_rwkv_mu, 'l0_rwkv_w0': l0_rwkv_w0, 'l0_rwkv_w2': l0_rwkv_w2,
        'l0_rwkv_a0': l0_rwkv_a0, 'l0_rwkv_a2': l0_rwkv_a2, 'l0_rwkv_g2': l0_rwkv_g2,
        'l0_rwkv_k_k': l0_rwkv_k_k, 'l0_rwkv_k_a': l0_rwkv_k_a, 'l0_rwkv_r_k': l0_rwkv_r_k,
        'l0_rwkv_ln_w': l0_rwkv_ln_w, 'l0_rwkv_ln_b': l0_rwkv_ln_b,
        'l0_gmlp_ln_w': l0_gmlp_ln_w, 'l0_gmlp_ln_b': l0_gmlp_ln_b,
        'l0_gmlp_ws': l0_gmlp_ws, 'l0_gmlp_bs': l0_gmlp_bs,
        'l0_w_out': l0_w_out, 'l0_norm_post_mix': l0_norm_post_mix,
        'l0_norm_pre_ffn': l0_norm_pre_ffn, 'l0_ffn_w_gate': l0_ffn_w_gate,
        'l0_ffn_w_up': l0_ffn_w_up, 'l0_ffn_w_down': l0_ffn_w_down,
        'l0_norm_post_ffn': l0_norm_post_ffn,
        'l1_norm_pre_mix': l1_norm_pre_mix, 'l1_w_in': l1_w_in,
        'l1_s5_a_re': l1_s5_a_re, 'l1_s5_a_im': l1_s5_a_im, 'l1_s5_log_dt': l1_s5_log_dt,
        'l1_s5_b_re': l1_s5_b_re, 'l1_s5_b_im': l1_s5_b_im,
        'l1_s5_c_re': l1_s5_c_re, 'l1_s5_c_im': l1_s5_c_im, 'l1_s5_d': l1_s5_d,
        'l1_s5_glu_w': l1_s5_glu_w, 'l1_s5_glu_b': l1_s5_glu_b,
        'l1_m2_conv_w': l1_m2_conv_w, 'l1_m2_conv_b': l1_m2_conv_b,
        'l1_m2_dt_bias': l1_m2_dt_bias, 'l1_m2_a_log': l1_m2_a_log,
        'l1_m2_d': l1_m2_d, 'l1_m2_norm_w': l1_m2_norm_w,
        'l1_w_out': l1_w_out, 'l1_norm_post_mix': l1_norm_post_mix,
        'l1_norm_pre_ffn': l1_norm_pre_ffn, 'l1_moe_router': l1_moe_router,
        'l1_moe_w_gate': l1_moe_w_gate, 'l1_moe_w_up': l1_moe_w_up,
        'l1_moe_w_down': l1_moe_w_down, 'l1_norm_post_ffn': l1_norm_post_ffn,
    }


def reference(x,
              l0_norm_pre_mix, l0_w_in,
              l0_rwkv_mu, l0_rwkv_w0, l0_rwkv_w2, l0_rwkv_a0, l0_rwkv_a2, l0_rwkv_g2,
              l0_rwkv_k_k, l0_rwkv_k_a, l0_rwkv_r_k, l0_rwkv_ln_w, l0_rwkv_ln_b,
              l0_gmlp_ln_w, l0_gmlp_ln_b, l0_gmlp_ws, l0_gmlp_bs,
              l0_w_out, l0_norm_post_mix, l0_norm_pre_ffn,
              l0_ffn_w_gate, l0_ffn_w_up, l0_ffn_w_down, l0_norm_post_ffn,
              l1_norm_pre_mix, l1_w_in,
              l1_s5_a_re, l1_s5_a_im, l1_s5_log_dt, l1_s5_b_re, l1_s5_b_im,
              l1_s5_c_re, l1_s5_c_im, l1_s5_d, l1_s5_glu_w, l1_s5_glu_b,
              l1_m2_conv_w, l1_m2_conv_b, l1_m2_dt_bias, l1_m2_a_log, l1_m2_d, l1_m2_norm_w,
              l1_w_out, l1_norm_post_mix, l1_norm_pre_ffn,
              l1_moe_router, l1_moe_w_gate, l1_moe_w_up, l1_moe_w_down, l1_norm_post_ffn):
    layer_params = (
        (l0_norm_pre_mix, l0_w_in,
         (l0_rwkv_mu, l0_rwkv_w0, l0_rwkv_w2, l0_rwkv_a0, l0_rwkv_a2, l0_rwkv_g2,
          l0_rwkv_k_k, l0_rwkv_k_a, l0_rwkv_r_k, l0_rwkv_ln_w, l0_rwkv_ln_b),
         (l0_gmlp_ln_w, l0_gmlp_ln_b, l0_gmlp_ws, l0_gmlp_bs),
         l0_w_out, l0_norm_post_mix, l0_norm_pre_ffn,
         (l0_ffn_w_gate, l0_ffn_w_up, l0_ffn_w_down), l0_norm_post_ffn),
        (l1_norm_pre_mix, l1_w_in,
         (l1_s5_a_re, l1_s5_a_im, l1_s5_log_dt, l1_s5_b_re, l1_s5_b_im,
          l1_s5_c_re, l1_s5_c_im, l1_s5_d, l1_s5_glu_w, l1_s5_glu_b),
         (l1_m2_conv_w, l1_m2_conv_b, l1_m2_dt_bias, l1_m2_a_log, l1_m2_d, l1_m2_norm_w),
         l1_w_out, l1_norm_post_mix, l1_norm_pre_ffn,
         (l1_moe_router, l1_moe_w_gate, l1_moe_w_up, l1_moe_w_down), l1_norm_post_ffn),
    )
    for i in range(DEPTH):
        if i % 2 == 0:
            x = even_layer(x, *layer_params[i])
        else:
            x = odd_layer(x, *layer_params[i])
    return x
```

```cpp
#include <hip/hip_runtime.h>
#include <stdint.h>
#include <stdio.h>
#include <utility>

#ifndef ONE_LAUNCH
#define ONE_LAUNCH 0
#endif

constexpr int D = 1024, BATCH = 8, SEQ = 2048, M = BATCH * SEQ;
constexpr int A_W = 512, A_IN = 1792, EVEN_IN = 2816, FFN = 2816;
constexpr int ODD_IN = 2056, NE = 8, FE = 3584;
constexpr int MAXSLOT = 2 * M + NE * 256;
constexpr int NT = 512, NW = 8;

typedef unsigned short bf16;
typedef float f32x4 __attribute__((ext_vector_type(4)));
#define LAS __attribute__((address_space(3)))

enum {
  I_X = 0,
  I0_NPM, I0_WIN, I0_MU, I0_W0, I0_W2, I0_A0, I0_A2, I0_G2, I0_KK, I0_KA, I0_RK, I0_LNW, I0_LNB,
  I0_GLNW, I0_GLNB, I0_GWS, I0_GBS, I0_WOUT, I0_NPOM, I0_NPF, I0_FG, I0_FU, I0_FD, I0_NPOF,
  I1_NPM, I1_WIN, I1_ARE, I1_AIM, I1_LDT, I1_BRE, I1_BIM, I1_CRE, I1_CIM, I1_SD, I1_GLW, I1_GLB,
  I1_CW, I1_CB, I1_DTB, I1_ALOG, I1_MD, I1_MNW, I1_WOUT, I1_NPOM, I1_NPF, I1_RT, I1_MG, I1_MU, I1_MDN, I1_NPOF,
  N_IN
};
static_assert(N_IN == 51, "input count");

constexpr size_t MiB = 1ull << 20;
constexpr size_t WS_CTL = 0, CTL_BYTES = 1 * MiB;
constexpr size_t WS_XN = 1 * MiB;
constexpr size_t WS_YMIX = 33 * MiB;
constexpr size_t WS_Y = 65 * MiB;
constexpr size_t WS_BIG = 129 * MiB;
constexpr size_t WS_P0 = WS_BIG;
constexpr size_t WS_SR = WS_P0 + 88 * MiB;
constexpr size_t WS_SW = WS_SR + 32 * MiB, WS_SK = WS_SW + 32 * MiB, WS_SV = WS_SK + 32 * MiB, WS_SA = WS_SV + 32 * MiB, WS_SB = WS_SA + 32 * MiB;
constexpr size_t WS_G = WS_SB + 32 * MiB;
constexpr size_t WS_BON = WS_G + 32 * MiB;
constexpr size_t WS_L0END = WS_BON + 1 * MiB;
constexpr size_t WS_H = WS_BIG;
constexpr size_t WS_P1 = WS_BIG;
constexpr size_t WS_DT = WS_P1 + 64 * MiB;
constexpr size_t WS_CONV = WS_DT + 1 * MiB;
constexpr size_t WS_YC = WS_CONV + 64 * MiB;
constexpr size_t WS_YSSD = WS_YC + 16 * MiB;
constexpr size_t WS_HID = WS_BIG;
constexpr size_t WS_YS = WS_HID + 238 * MiB;
constexpr size_t WS_ROUTE = WS_YS + 68 * MiB;
constexpr size_t WS_END = WS_ROUTE + 1 * MiB;
static_assert(WS_L0END <= 462 * MiB && WS_END <= 462 * MiB, "workspace map");
static_assert((size_t)MAXSLOT * FE * 2 <= 238 * MiB && (size_t)MAXSLOT * D * 2 <= 68 * MiB, "moe buffers");
constexpr int CW_BAR = 4096;
constexpr int CW_CNT = 8192;
constexpr int CW_CUR = 8192 + 64 * 8;
constexpr int CW_SLOTTOK = 65536;
static_assert((CW_SLOTTOK + MAXSLOT) * 4 <= (int)CTL_BYTES, "ctl");

constexpr int LDS_BYTES = 147456;

__device__ __forceinline__ float bf2f(bf16 v) { return __uint_as_float(((unsigned)v) << 16); }
__device__ __forceinline__ bf16 f2bf(float f) { unsigned u = __float_as_uint(f); u += 0x7fffu + ((u >> 16) & 1u); return (bf16)(u >> 16); }
__device__ __forceinline__ float wave_sum(float v) {
#pragma unroll
  for (int o = 32; o > 0; o >>= 1) v += __shfl_xor(v, o);
  return v;
}
__device__ __forceinline__ float sigmoid_(float x) { return 1.f / (1.f + expf(-x)); }
__device__ __forceinline__ float silu_(float x) { return x / (1.f + expf(-x)); }
__device__ __forceinline__ float gelu_(float x) { const float u = 0.7978845608028654f * (x + 0.044715f * x * x * x); return 0.5f * x * (1.f + tanhf(u)); }
__device__ __forceinline__ float softplus_(float x) { return fmaxf(x, 0.f) + log1pf(expf(-fabsf(x))); }

#define XB_TMO      128
#define XB_XCNT(j)  (256  + 64 * (j))
#define XB_XSUB(j)  (1280 + 64 * (j))
#define XB_XGEN(j)  (2304 + 64 * (j))
#define XB_TOP      3328
#define XB_TOPGEN   3392
#define XCD_BAR_WORDS 3456
#define XB_SPIN_CAP (1u << 22)

__device__ __forceinline__ unsigned xb_ld(unsigned* p)              { return __hip_atomic_load(p, __ATOMIC_RELAXED, __HIP_MEMORY_SCOPE_AGENT); }
__device__ __forceinline__ unsigned xb_add(unsigned* p, unsigned v) { return __hip_atomic_fetch_add(p, v, __ATOMIC_RELAXED, __HIP_MEMORY_SCOPE_AGENT); }
__device__ __forceinline__ unsigned xb_xcc_id() { return (unsigned)__builtin_amdgcn_s_getreg((3 << 11) | 20) & 0xFu; }
#define XB_SPIN(cond, bar) do { unsigned _sp = 0; while (cond) { __builtin_amdgcn_s_sleep(1); \
    if ((++_sp & 255u) == 0u) { if (xb_ld(&(bar)[XB_TMO])) break; if (_sp > XB_SPIN_CAP) { atomicAdd(&(bar)[XB_TMO], 1u); break; } } } } while (0)

struct XcdBarrier { unsigned* bar; unsigned x; volatile LAS unsigned* st; };

__device__ __forceinline__ XcdBarrier xcd_barrier_post(unsigned* bar, volatile LAS unsigned* st) {
    XcdBarrier b; b.bar = bar; b.x = xb_xcc_id(); b.st = st;
    if (threadIdx.x == 0) (void)xb_add(&bar[XB_XCNT(b.x)], 1u);
    return b;
}
__device__ __forceinline__ void xcd_barrier_complete(unsigned* bar, unsigned x, unsigned& nloc, unsigned& nx) {
    const unsigned G = gridDim.x * gridDim.y * gridDim.z;
    unsigned sum, cnt, mine, sp = 0u;
    for (;;) {
        sum = 0u; cnt = 0u; mine = 0u;
#pragma unroll
        for (unsigned j = 0; j < 16; ++j) { const unsigned c = xb_ld(&bar[XB_XCNT(j)]); sum += c; cnt += (c > 0u) ? 1u : 0u; mine = (j == x) ? c : mine; }
        if (sum == G) break;
        __builtin_amdgcn_s_sleep(1);
        if ((++sp & 255u) == 0u) { if (xb_ld(&bar[XB_TMO])) break; if (sp > XB_SPIN_CAP) { atomicAdd(&bar[XB_TMO], 1u); break; } }
    }
    nloc = mine > 0u ? mine : 1u; nx = cnt > 0u ? cnt : 1u;
}
__device__ __forceinline__ void xcd_barrier(const XcdBarrier& b) {
    asm volatile("s_waitcnt vmcnt(0)" ::: "memory");
    __syncthreads();
    if (threadIdx.x == 0) {
        unsigned* bar = b.bar;
        __builtin_amdgcn_s_waitcnt(0);
        unsigned nloc = b.st[0], nx = b.st[1];
        if (nloc == 0u) { xcd_barrier_complete(bar, b.x, nloc, nx); b.st[0] = nloc; b.st[1] = nx; }
        const unsigned old = xb_add(&bar[XB_XSUB(b.x)], 1u);
        const unsigned gen = old / nloc;
        if (old + 1u == (gen + 1u) * nloc) {
            __builtin_amdgcn_fence(__ATOMIC_RELEASE, "agent");
            asm volatile("s_waitcnt vmcnt(0)" ::: "memory");
            const unsigned og = xb_add(&bar[XB_TOP], 1u);
            const unsigned tg = og / nx;
            if (og + 1u == (tg + 1u) * nx) xb_add(&bar[XB_TOPGEN], 1u);
            else XB_SPIN(xb_ld(&bar[XB_TOPGEN]) == tg, bar);
            __builtin_amdgcn_fence(__ATOMIC_ACQUIRE, "agent");
            xb_add(&bar[XB_XGEN(b.x)], 1u);
            asm volatile("s_waitcnt vmcnt(0)" ::: "memory");
        } else {
            XB_SPIN(xb_ld(&bar[XB_XGEN(b.x)]) == gen, bar);
            __builtin_amdgcn_fence(__ATOMIC_ACQUIRE, "agent");
            asm volatile("s_waitcnt vmcnt(0)" ::: "memory");
        }
    }
    __syncthreads();
}

struct Args { const float* in[N_IN]; float* out; unsigned char* ws; int lo, hi; };
struct Ctx {
  const float* const* in; float* out; unsigned char* ws; unsigned* ctl;
  unsigned char* lds;
  int tid, lane, wave, bid, G;
};


template <int YMODE, int PROJ>
__device__ __forceinline__ void norm_phase(const Ctx& c, const float* resin, float* resout, const float* Y, const float* gpost, const float* gpre, bf16* XN,
                                           const float* W8, int ldw8, int c0, float* out8) {
  float* w8s = (float*)c.lds;
  LAS unsigned* hist = (LAS unsigned*)(c.lds + 32768);
  if (PROJ) {
    for (int i = c.tid; i < 1024 * 8; i += NT) w8s[i] = W8[(size_t)(i >> 3) * ldw8 + c0 + (i & 7)];
    if (PROJ == 2 && c.tid < 8) hist[c.tid] = 0u;
    __syncthreads();
  }
  int* tok_e = (int*)(c.ws + WS_ROUTE); float* tok_g = (float*)(c.ws + WS_ROUTE + 128 * 1024);
  const int* tok_slot = (const int*)(c.ws + WS_ROUTE + 256 * 1024);
  const bf16* YS = (const bf16*)(c.ws + WS_YS);
  for (int m = c.wave * c.G + c.bid; m < M; m += NW * c.G) {
    f32x4 r[4];
#pragma unroll
    for (int j = 0; j < 4; ++j) r[j] = *(const f32x4*)(resin + (size_t)m * D + j * 256 + c.lane * 4);
    if (YMODE) {
      f32x4 y[4]; float ss = 0.f;
      if (YMODE == 1) {
#pragma unroll
        for (int j = 0; j < 4; ++j) y[j] = *(const f32x4*)(Y + (size_t)m * D + j * 256 + c.lane * 4);
      } else {
        const int s0 = tok_slot[2 * m], s1 = tok_slot[2 * m + 1]; const float g0 = tok_g[2 * m], g1 = tok_g[2 * m + 1];
#pragma unroll
        for (int j = 0; j < 4; ++j) {
          const uint2 a = *(const uint2*)(YS + (size_t)s0 * D + j * 256 + c.lane * 4), b = *(const uint2*)(YS + (size_t)s1 * D + j * 256 + c.lane * 4);
          y[j][0] = g0 * bf2f((bf16)(a.x & 0xffff)) + g1 * bf2f((bf16)(b.x & 0xffff));
          y[j][1] = g0 * bf2f((bf16)(a.x >> 16)) + g1 * bf2f((bf16)(b.x >> 16));
          y[j][2] = g0 * bf2f((bf16)(a.y & 0xffff)) + g1 * bf2f((bf16)(b.y & 0xffff));
          y[j][3] = g0 * bf2f((bf16)(a.y >> 16)) + g1 * bf2f((bf16)(b.y >> 16));
        }
      }
#pragma unroll
      for (int j = 0; j < 4; ++j) ss += y[j][0] * y[j][0] + y[j][1] * y[j][1] + y[j][2] * y[j][2] + y[j][3] * y[j][3];
      const float rs = rsqrtf(wave_sum(ss) * (1.f / D) + 1e-6f);
#pragma unroll
      for (int j = 0; j < 4; ++j) {
        const f32x4 g = *(const f32x4*)(gpost + j * 256 + c.lane * 4);
        r[j] = r[j] + y[j] * rs * g;
        *(f32x4*)(resout + (size_t)m * D + j * 256 + c.lane * 4) = r[j];
      }
    }
    if (gpre) {
      float ss = 0.f;
#pragma unroll
      for (int j = 0; j < 4; ++j) ss += r[j][0] * r[j][0] + r[j][1] * r[j][1] + r[j][2] * r[j][2] + r[j][3] * r[j][3];
      const float rs = rsqrtf(wave_sum(ss) * (1.f / D) + 1e-6f);
      float p8[8];
#pragma unroll
      for (int q = 0; q < 8; ++q) p8[q] = 0.f;
#pragma unroll
      for (int j = 0; j < 4; ++j) {
        const f32x4 g = *(const f32x4*)(gpre + j * 256 + c.lane * 4);
        const f32x4 xn = r[j] * rs * g;
        uint2 o; o.x = (unsigned)f2bf(xn[0]) | ((unsigned)f2bf(xn[1]) << 16); o.y = (unsigned)f2bf(xn[2]) | ((unsigned)f2bf(xn[3]) << 16);
        *(uint2*)(XN + (size_t)m * D + j * 256 + c.lane * 4) = o;
        if (PROJ) {
#pragma unroll
          for (int e = 0; e < 4; ++e) {
            const float* wr = w8s + (j * 256 + c.lane * 4 + e) * 8;
#pragma unroll
            for (int q = 0; q < 8; ++q) p8[q] += xn[e] * wr[q];
          }
        }
      }
      if (PROJ) {
#pragma unroll
        for (int q = 0; q < 8; ++q) p8[q] = wave_sum(p8[q]);
        if (PROJ == 1) { if (c.lane < 8) { float v = p8[0];
#pragma unroll
            for (int q = 1; q < 8; ++q) v = (c.lane == q) ? p8[q] : v;
            out8[(size_t)m * 8 + c.lane] = v; } }
        if (PROJ == 2 && c.lane == 0) {
          int e0 = 0; float v0 = p8[0];
#pragma unroll
          for (int q = 1; q < 8; ++q) if (p8[q] > v0) { v0 = p8[q]; e0 = q; }
          int e1 = -1; float v1 = -3.0e38f;
#pragma unroll
          for (int q = 0; q < 8; ++q) if (q != e0 && p8[q] > v1) { v1 = p8[q]; e1 = q; }
          const float g1 = 1.f / (1.f + expf(v0 - v1)), g0 = 1.f - g1;
          tok_e[2 * m] = e0; tok_e[2 * m + 1] = e1; tok_g[2 * m] = g0; tok_g[2 * m + 1] = g1;
          atomicAdd((unsigned*)&hist[e0], 1u); atomicAdd((unsigned*)&hist[e1], 1u);
        }
      }
    }
  }
  if (PROJ == 2) { __syncthreads(); if (c.tid < 8) atomicAdd(c.ctl + CW_CNT + 64 * c.tid, hist[c.tid]); }
  __syncthreads();
}

struct EpiStoreBf16 { bf16* O; int ldo; __device__ __forceinline__ void operator()(int row, int col, const float* a, const float*) const {
    uint2 o; o.x = (unsigned)f2bf(a[0]) | ((unsigned)f2bf(a[1]) << 16); o.y = (unsigned)f2bf(a[2]) | ((unsigned)f2bf(a[3]) << 16); *(uint2*)(O + (size_t)row * ldo + col) = o; } };
struct EpiStoreF32 { float* O; int ldo; __device__ __forceinline__ void operator()(int row, int col, const float* a, const float*) const {
    *(f32x4*)(O + (size_t)row * ldo + col) = (f32x4){a[0], a[1], a[2], a[3]}; } };
struct EpiSwiglu { bf16* O; int ldo; __device__ __forceinline__ void operator()(int row, int col, const float* a, const float* b) const {
    float h[4];
#pragma unroll
    for (int i = 0; i < 4; ++i) h[i] = silu_(a[i]) * b[i];
    uint2 o; o.x = (unsigned)f2bf(h[0]) | ((unsigned)f2bf(h[1]) << 16); o.y = (unsigned)f2bf(h[2]) | ((unsigned)f2bf(h[3]) << 16); *(uint2*)(O + (size_t)row * ldo + col) = o; } };
struct EpiGlu { bf16* O; int ldo; const bf16* Yc; const float* bias; __device__ __forceinline__ void operator()(int row, int col, const float* a, const float*) const {
    float h[4];
#pragma unroll
    for (int i = 0; i < 4; ++i) { const float y = bf2f(Yc[(size_t)row * 512 + col + i]); h[i] = y * sigmoid_(a[i] + bias[col + i]); }
    uint2 o; o.x = (unsigned)f2bf(h[0]) | ((unsigned)f2bf(h[1]) << 16); o.y = (unsigned)f2bf(h[2]) | ((unsigned)f2bf(h[3]) << 16); *(uint2*)(O + (size_t)row * ldo + col) = o; } };

template <bool DUAL, bool MOE, class Epi>
__device__ __forceinline__ void gemm_valu(const Ctx& c, const bf16* A, int lda, const int* rowidx, const float* B, const float* B2, int ldb, size_t bstride_e,
                                          int rows, int N, int K, const Epi& E) {
  float* As = (float*)c.lds;
  float* Bs = As + 16 * 132;
  float* Bs2 = Bs + 16 * 128;
  int pend[8];
  int nmt = rows / 128;
  if (MOE) {
    int acc = 0;
#pragma unroll
    for (int e = 0; e < 8; ++e) { const int cnt = (int)c.ctl[CW_CNT + 64 * e]; acc += (cnt + 255) / 256 * 256; pend[e] = acc; }
    nmt = acc / 128;
  }
  const int nnt = N / 128, nitems = nmt * nnt;
  const int ty = c.tid >> 5, tx = c.tid & 31;
  const int ar = c.tid >> 2, ak = (c.tid & 3) * 4;
  const int bk = c.tid >> 5, bn = (c.tid & 31) * 4;
  for (int it = c.bid; it < nitems; it += c.G) {
    const int tm = it / nnt, tn = it % nnt;
    const float* Bp = B; const float* Bp2 = B2;
    if (MOE) { int e = 0;
#pragma unroll
      for (int q = 0; q < 7; ++q) if (tm * 128 >= pend[q]) e = q + 1;
      Bp += (size_t)e * bstride_e; if (DUAL) Bp2 += (size_t)e * bstride_e; }
    const int grow = tm * 128 + ar;
    const size_t arow = rowidx ? (size_t)rowidx[grow] : (size_t)grow;
    const bf16* ap = A + arow * lda + ak;
    float acc[8][4], acc2[8][4];
#pragma unroll
    for (int i = 0; i < 8; ++i)
#pragma unroll
      for (int j = 0; j < 4; ++j) { acc[i][j] = 0.f; acc2[i][j] = 0.f; }
    for (int k0 = 0; k0 < K; k0 += 16) {
      const uint2 av = *(const uint2*)(ap + k0);
      const f32x4 bv = *(const f32x4*)(Bp + (size_t)(k0 + bk) * ldb + tn * 128 + bn);
      f32x4 bv2; if (DUAL) bv2 = *(const f32x4*)(Bp2 + (size_t)(k0 + bk) * ldb + tn * 128 + bn);
      __syncthreads();
      As[(ak + 0) * 132 + ar] = bf2f((bf16)(av.x & 0xffff)); As[(ak + 1) * 132 + ar] = bf2f((bf16)(av.x >> 16));
      As[(ak + 2) * 132 + ar] = bf2f((bf16)(av.y & 0xffff)); As[(ak + 3) * 132 + ar] = bf2f((bf16)(av.y >> 16));
      *(f32x4*)(Bs + bk * 128 + bn) = bv;
      if (DUAL) *(f32x4*)(Bs2 + bk * 128 + bn) = bv2;
      __syncthreads();
#pragma unroll
      for (int k = 0; k < 16; ++k) {
        const f32x4 a0 = *(const f32x4*)(As + k * 132 + ty * 8), a1 = *(const f32x4*)(As + k * 132 + ty * 8 + 4);
        const f32x4 b = *(const f32x4*)(Bs + k * 128 + tx * 4);
        const float a[8] = {a0[0], a0[1], a0[2], a0[3], a1[0], a1[1], a1[2], a1[3]};
#pragma unroll
        for (int i = 0; i < 8; ++i)
#pragma unroll
          for (int j = 0; j < 4; ++j) acc[i][j] += a[i] * b[j];
        if (DUAL) {
          const f32x4 b2 = *(const f32x4*)(Bs2 + k * 128 + tx * 4);
#pragma unroll
          for (int i = 0; i < 8; ++i)
#pragma unroll
            for (int j = 0; j < 4; ++j) acc2[i][j] += a[i] * b2[j];
        }
      }
    }
#pragma unroll
    for (int i = 0; i < 8; ++i) E(tm * 128 + ty * 8 + i, tn * 128 + tx * 4, acc[i], acc2[i]);
  }
  __syncthreads();
}

__device__ __forceinline__ void rwkv_prep(const Ctx& c) {
  const float* const* in = c.in;
  const bf16* P = (const bf16*)(c.ws + WS_P0);
  float* SR = (float*)(c.ws + WS_SR); float* SW = (float*)(c.ws + WS_SW); float* SK = (float*)(c.ws + WS_SK); float* SV = (float*)(c.ws + WS_SV);
  float* SA = (float*)(c.ws + WS_SA); float* SB = (float*)(c.ws + WS_SB); float* GG = (float*)(c.ws + WS_G); float* BON = (float*)(c.ws + WS_BON);
  float* ps = (float*)c.lds + c.wave * A_IN;
  const float* mu = in[I0_MU];
  for (int m = c.wave * c.G + c.bid; m < M; m += NW * c.G) {
    const int t = m % SEQ;
    for (int i = c.lane; i < A_IN; i += 64) {
      const float cur = bf2f(P[(size_t)m * EVEN_IN + i]);
      const float prev = t > 0 ? bf2f(P[(size_t)(m - 1) * EVEN_IN + i]) : 0.f;
      float v = cur + (prev - cur) * mu[i];
      if (i >= 1536 && i < 1600) v = tanhf(v);
      if (i >= 1664) v = sigmoid_(v);
      ps[i] = v;
    }
    __builtin_amdgcn_s_waitcnt(0); __builtin_amdgcn_wave_barrier();
    for (int j = 0; j < 8; ++j) {
      const int ch = j * 64 + c.lane;
      float aw = in[I0_W0][ch], aa = in[I0_A0][ch], ag = 0.f;
      for (int i = 0; i < 64; ++i) { aw += ps[1536 + i] * in[I0_W2][i * 512 + ch]; aa += ps[1600 + i] * in[I0_A2][i * 512 + ch]; }
      for (int i = 0; i < 128; ++i) ag += ps[1664 + i] * in[I0_G2][i * 512 + ch];
      const float wl = -softplus_(-aw) - 0.5f;
      const float decay = expf(-expf(wl));
      const float a = sigmoid_(aa);
      const float r = ps[ch], k = ps[512 + ch], v = ps[1024 + ch];
      float kk = k * in[I0_KK][ch];
      const float nrm = sqrtf(wave_sum(kk * kk));
      kk = kk / fmaxf(nrm, 1e-12f);
      const float k2 = k * (1.f + (a - 1.f) * in[I0_KA][ch]);
      const float bon = wave_sum(r * k2 * in[I0_RK][ch]);
      const size_t o = (size_t)m * 512 + ch;
      SR[o] = r; SW[o] = decay; SK[o] = k2; SV[o] = v; SA[o] = -kk; SB[o] = kk * a; GG[o] = ag;
      if (c.lane == 0) BON[(size_t)m * 8 + j] = bon;
    }
    __builtin_amdgcn_s_waitcnt(0); __builtin_amdgcn_wave_barrier();
  }
  __syncthreads();
}

__device__ __forceinline__ void rwkv_scan(const Ctx& c) {
  float* SR = (float*)(c.ws + WS_SR); const float* SW = (const float*)(c.ws + WS_SW); const float* SK = (const float*)(c.ws + WS_SK);
  const float* SV = (const float*)(c.ws + WS_SV); const float* SA = (const float*)(c.ws + WS_SA); const float* SB = (const float*)(c.ws + WS_SB);
  for (int it = c.wave * c.G + c.bid; it < BATCH * 8; it += NW * c.G) {
    const int b = it >> 3, h = it & 7;
    float S[64];
#pragma unroll
    for (int i = 0; i < 64; ++i) S[i] = 0.f;
    size_t o = ((size_t)b * SEQ) * 512 + h * 64 + c.lane;
    float r_l = SR[o], w_l = SW[o], k_l = SK[o], v_l = SV[o], a_l = SA[o], b_l = SB[o];
    for (int t = 0; t < SEQ; ++t) {
      const size_t on = (t + 1 < SEQ) ? o + 512 : o;
      const float r_n = SR[on], w_n = SW[on], k_n = SK[on], v_n = SV[on], a_n = SA[on], b_n = SB[on];
      float sa = 0.f;
#pragma unroll
      for (int i = 0; i < 64; ++i) sa += S[i] * __uint_as_float(__builtin_amdgcn_readlane(__float_as_uint(a_l), i));
      float y = 0.f;
#pragma unroll
      for (int i = 0; i < 64; ++i) {
        const float wi = __uint_as_float(__builtin_amdgcn_readlane(__float_as_uint(w_l), i));
        const float bi = __uint_as_float(__builtin_amdgcn_readlane(__float_as_uint(b_l), i));
        const float ki = __uint_as_float(__builtin_amdgcn_readlane(__float_as_uint(k_l), i));
        const float ri = __uint_as_float(__builtin_amdgcn_readlane(__float_as_uint(r_l), i));
        S[i] = S[i] * wi + sa * bi + v_l * ki;
        y += S[i] * ri;
      }
      SR[o] = y;
      o = on; r_l = r_n; w_l = w_n; k_l = k_n; v_l = v_n; a_l = a_n; b_l = b_n;
    }
  }
}

__device__ __forceinline__ void rwkv_post(const Ctx& c) {
  const float* YS = (const float*)(c.ws + WS_SR); const float* SV = (const float*)(c.ws + WS_SV); const float* GG = (const float*)(c.ws + WS_G);
  const float* BON = (const float*)(c.ws + WS_BON); bf16* YM = (bf16*)(c.ws + WS_YMIX);
  const float* lnw = c.in[I0_LNW]; const float* lnb = c.in[I0_LNB];
  for (int m = c.wave * c.G + c.bid; m < M; m += NW * c.G) {
#pragma unroll
    for (int j = 0; j < 8; ++j) {
      const int ch = j * 64 + c.lane; const size_t o = (size_t)m * 512 + ch;
      const float y = YS[o];
      const float mean = wave_sum(y) * (1.f / 64.f);
      const float d = y - mean;
      const float var = wave_sum(d * d) * (1.f / 64.f);
      float v = d * rsqrtf(var + 64e-5f) * lnw[ch] + lnb[ch];
      v += BON[(size_t)m * 8 + j] * SV[o];
      YM[(size_t)m * D + ch] = f2bf(v * GG[o]);
    }
  }
}

__device__ __forceinline__ void gmlp_phase(const Ctx& c) {
  const bf16* P = (const bf16*)(c.ws + WS_P0); bf16* YM = (bf16*)(c.ws + WS_YMIX);
  const float* lnw = c.in[I0_GLNW]; const float* lnb = c.in[I0_GLNB]; const float* ws = c.in[I0_GWS]; const float* bs = c.in[I0_GBS];
  float* vn = (float*)c.lds;
  for (int it = c.bid; it < BATCH * 16 * 4; it += c.G) {
    const int g = it & 3, ck = (it >> 2) & 15, b = it >> 6;
    const size_t m0 = (size_t)b * SEQ + ck * 128;
    __syncthreads();
    for (int j = c.wave; j < 128; j += NW) {
      const bf16* row = P + (m0 + j) * EVEN_IN + 2304 + g * 128;
      const float v0 = gelu_(bf2f(row[c.lane])), v1 = gelu_(bf2f(row[c.lane + 64]));
      const float mean = wave_sum(v0 + v1) * (1.f / 128.f);
      const float d0 = v0 - mean, d1 = v1 - mean;
      const float rs = rsqrtf(wave_sum(d0 * d0 + d1 * d1) * (1.f / 128.f) + 1e-6f);
      vn[j * 128 + c.lane] = d0 * rs * lnw[g * 128 + c.lane] + lnb[g * 128 + c.lane];
      vn[j * 128 + c.lane + 64] = d1 * rs * lnw[g * 128 + c.lane + 64] + lnb[g * 128 + c.lane + 64];
    }
    __syncthreads();
    const int d = c.tid & 127, iq = c.tid >> 7;
    for (int ii = 0; ii < 32; ++ii) {
      const int i = iq + 4 * ii;
      const float* wrow = ws + ((size_t)g * 128 + i) * 128;
      float acc = bs[g * 128 + i];
      for (int j = 0; j <= i; ++j) acc += wrow[j] * vn[j * 128 + d];
      const float u = gelu_(bf2f(P[(m0 + i) * EVEN_IN + 1792 + g * 128 + d]));
      YM[(m0 + i) * D + 512 + g * 128 + d] = f2bf(u * acc);
    }
  }
  __syncthreads();
}

__device__ __forceinline__ void s5_scan(const Ctx& c) {
  const float* const* in = c.in;
  const bf16* P1 = (const bf16*)(c.ws + WS_P1); bf16* YC = (bf16*)(c.ws + WS_YC);
  float* wl = (float*)c.lds + c.wave * 4096;
  float* XR = wl, *XI = wl + 1040, *CRE = wl + 2080, *CIM = wl + 3120;
  for (int it = c.wave * c.G + c.bid; it < BATCH * 32; it += NW * c.G) {
    const int b = it >> 5, g = it & 31, p = c.lane;
    const float lr = in[I1_ARE][g * 64 + p], li = in[I1_AIM][g * 64 + p], dt = expf(in[I1_LDT][g]);
    const float mag = expf(lr * dt), ar = mag * cosf(li * dt), ai = mag * sinf(li * dt);
    const float nr = ar - 1.f, ni = ai, den = lr * lr + li * li;
    const float fr = (nr * lr + ni * li) / den, fi = (ni * lr - nr * li) / den;
    float bbr[16], bbi[16];
#pragma unroll
    for (int q = 0; q < 16; ++q) { const float br = in[I1_BRE][(g * 64 + p) * 16 + q], bi = in[I1_BIM][(g * 64 + p) * 16 + q]; bbr[q] = fr * br - fi * bi; bbi[q] = fr * bi + fi * br; }
#pragma unroll
    for (int q = 0; q < 16; ++q) { CRE[q * 65 + p] = in[I1_CRE][(g * 16 + q) * 64 + p]; CIM[q * 65 + p] = in[I1_CIM][(g * 16 + q) * 64 + p]; }
    float xr = 0.f, xi = 0.f;
    const int tt = c.lane >> 2, cq = c.lane & 3;
    for (int t0 = 0; t0 < SEQ; t0 += 16) {
      const size_t m0 = (size_t)b * SEQ + t0;
#pragma unroll 4
      for (int s = 0; s < 16; ++s) {
        const uint4 u0 = *(const uint4*)(P1 + (m0 + s) * 2048 + g * 16), u1 = *(const uint4*)(P1 + (m0 + s) * 2048 + g * 16 + 8);
        const unsigned uw[8] = {u0.x, u0.y, u0.z, u0.w, u1.x, u1.y, u1.z, u1.w};
        float br = 0.f, bi = 0.f;
#pragma unroll
        for (int q = 0; q < 8; ++q) { const float ua = bf2f((bf16)(uw[q] & 0xffff)), ub = bf2f((bf16)(uw[q] >> 16));
          br += ua * bbr[2 * q] + ub * bbr[2 * q + 1]; bi += ua * bbi[2 * q] + ub * bbi[2 * q + 1]; }
        const float nxr = ar * xr - ai * xi + br, nxi = ar * xi + ai * xr + bi;
        xr = nxr; xi = nxi;
        XR[s * 65 + p] = xr; XI[s * 65 + p] = xi;
      }
      __builtin_amdgcn_s_waitcnt(0); __builtin_amdgcn_wave_barrier();
      float y[4] = {0.f, 0.f, 0.f, 0.f};
      for (int q = 0; q < 64; ++q) {
        const float a = XR[tt * 65 + q], bq = XI[tt * 65 + q];
#pragma unroll
        for (int e = 0; e < 4; ++e) y[e] += a * CRE[(cq * 4 + e) * 65 + q] - bq * CIM[(cq * 4 + e) * 65 + q];
      }
#pragma unroll
      for (int e = 0; e < 4; ++e) {
        const int ch = g * 16 + cq * 4 + e;
        const float u = bf2f(P1[(m0 + tt) * 2048 + ch]);
        YC[(m0 + tt) * 512 + ch] = f2bf(gelu_(y[e] + in[I1_SD][ch] * u));
      }
      __builtin_amdgcn_s_waitcnt(0); __builtin_amdgcn_wave_barrier();
    }
  }
  __syncthreads();
}

__device__ __forceinline__ void ssd_conv(const Ctx& c) {
  const bf16* P1 = (const bf16*)(c.ws + WS_P1); float* CV = (float*)(c.ws + WS_CONV);
  const float* cw = c.in[I1_CW]; const float* cb = c.in[I1_CB];
  for (size_t i = (size_t)c.bid * NT + c.tid; i < (size_t)M * 1024; i += (size_t)c.G * NT) {
    const int ch = (int)(i & 1023); const size_t m = i >> 10; const int t = (int)(m % SEQ);
    float acc = cb[ch];
#pragma unroll
    for (int j = 0; j < 4; ++j) { const int tt = t - 3 + j; if (tt >= 0) acc += cw[j * 1024 + ch] * bf2f(P1[(m - 3 + j) * 2048 + 1024 + ch]); }
    CV[i] = silu_(acc);
  }
}

__device__ __forceinline__ void ssd_scan(const Ctx& c) {
  const float* CV = (const float*)(c.ws + WS_CONV); const float* DT = (const float*)(c.ws + WS_DT); float* YO = (float*)(c.ws + WS_YSSD);
  for (int it = c.bid; it < BATCH * 8; it += c.G) {
    const int b = it >> 3, h = it & 7, grp = h >> 2, p = c.tid >> 3, ns = c.tid & 7;
    const float dtb = c.in[I1_DTB][h], av = -expf(c.in[I1_ALOG][h]), dsk = c.in[I1_MD][h];
    float H[16];
#pragma unroll
    for (int i = 0; i < 16; ++i) H[i] = 0.f;
    const size_t m0 = (size_t)b * SEQ;
    f32x4 Bn[4], Cn[4]; float xn, dn;
    {
      const float* row = CV + m0 * 1024;
#pragma unroll
      for (int q = 0; q < 4; ++q) { Bn[q] = *(const f32x4*)(row + 512 + grp * 128 + ns * 16 + q * 4); Cn[q] = *(const f32x4*)(row + 768 + grp * 128 + ns * 16 + q * 4); }
      xn = row[h * 64 + p]; dn = DT[m0 * 8 + h];
    }
    for (int t = 0; t < SEQ; ++t) {
      f32x4 Bc[4], Cc[4];
#pragma unroll
      for (int q = 0; q < 4; ++q) { Bc[q] = Bn[q]; Cc[q] = Cn[q]; }
      const float xc = xn, dc = dn;
      {
        const size_t mn = m0 + (t + 1 < SEQ ? t + 1 : t);
        const float* row = CV + mn * 1024;
#pragma unroll
        for (int q = 0; q < 4; ++q) { Bn[q] = *(const f32x4*)(row + 512 + grp * 128 + ns * 16 + q * 4); Cn[q] = *(const f32x4*)(row + 768 + grp * 128 + ns * 16 + q * 4); }
        xn = row[h * 64 + p]; dn = DT[mn * 8 + h];
      }
      const float dt = softplus_(dc + dtb), dA = expf(av * dt), xs = xc * dt;
      float y = 0.f;
#pragma unroll
      for (int q = 0; q < 4; ++q)
#pragma unroll
        for (int e = 0; e < 4; ++e) { H[q * 4 + e] = dA * H[q * 4 + e] + xs * Bc[q][e]; y += H[q * 4 + e] * Cc[q][e]; }
      y += __shfl_xor(y, 1); y += __shfl_xor(y, 2); y += __shfl_xor(y, 4);
      if (ns == 0) YO[(m0 + t) * 512 + h * 64 + p] = y + dsk * xc;
    }
  }
}

__device__ __forceinline__ void ssd_post(const Ctx& c) {
  const bf16* P1 = (const bf16*)(c.ws + WS_P1); const float* YO = (const float*)(c.ws + WS_YSSD); bf16* YM = (bf16*)(c.ws + WS_YMIX);
  const float* nw = c.in[I1_MNW];
  for (int m = c.wave * c.G + c.bid; m < M; m += NW * c.G) {
    float v[8]; float ss = 0.f;
#pragma unroll
    for (int e = 0; e < 8; ++e) { const int ch = c.lane * 8 + e; const float z = bf2f(P1[(size_t)m * 2048 + 512 + ch]); v[e] = YO[(size_t)m * 512 + ch] * silu_(z); ss += v[e] * v[e]; }
#pragma unroll
    for (int o = 16; o > 0; o >>= 1) ss += __shfl_xor(ss, o);
    const float rs = rsqrtf(ss * (1.f / 256.f) + 1e-6f);
#pragma unroll
    for (int e = 0; e < 8; ++e) { const int ch = c.lane * 8 + e; YM[(size_t)m * D + 512 + ch] = f2bf(v[e] * rs * nw[ch]); }
  }
}

__device__ __forceinline__ void moe_assign(const Ctx& c) {
  LAS unsigned* lcnt = (LAS unsigned*)c.lds; LAS unsigned* lbase = lcnt + 8;
  const int* tok_e = (const int*)(c.ws + WS_ROUTE); int* tok_slot = (int*)(c.ws + WS_ROUTE + 256 * 1024); int* slot_tok = (int*)(c.ctl + CW_SLOTTOK);
  int pstart[8]; { int acc = 0;
#pragma unroll
    for (int e = 0; e < 8; ++e) { pstart[e] = acc; acc += ((int)c.ctl[CW_CNT + 64 * e] + 255) / 256 * 256; } }
  for (int tb = c.bid; tb < M / 64; tb += c.G) {
    __syncthreads();
    if (c.tid < 8) lcnt[c.tid] = 0u;
    __syncthreads();
    int e = 0; unsigned rank = 0; const int pair = tb * 128 + c.tid;
    if (c.tid < 128) { e = tok_e[pair]; rank = atomicAdd((unsigned*)&lcnt[e], 1u); }
    __syncthreads();
    if (c.tid < 8) lbase[c.tid] = atomicAdd(c.ctl + CW_CUR + 64 * c.tid, lcnt[c.tid]);
    __syncthreads();
    if (c.tid < 128) {
      int ps = 0;
#pragma unroll
      for (int q = 0; q < 8; ++q) ps = (e == q) ? pstart[q] : ps;
      const int slot = ps + (int)lbase[e] + (int)rank;
      slot_tok[slot] = pair >> 1; tok_slot[pair] = slot;
    }
  }
  __syncthreads();
}


constexpr int LAST_PHASE = 20;
template <int LO, int HI>
__global__ void __launch_bounds__(NT, 2) fwd_kernel(Args args) {
  extern __shared__ __attribute__((aligned(16))) unsigned char lds[];
  Ctx c; c.in = args.in; c.out = args.out; c.ws = args.ws; c.ctl = (unsigned*)(args.ws + WS_CTL); c.lds = lds;
  c.tid = threadIdx.x; c.lane = c.tid & 63; c.wave = __builtin_amdgcn_readfirstlane(c.tid >> 6); c.bid = blockIdx.x; c.G = gridDim.x;
  volatile LAS unsigned* bst = (volatile LAS unsigned*)(LAS unsigned char*)(lds + LDS_BYTES - 16);
  constexpr int lo = LO, hi = HI;
  XcdBarrier bar; bar.bar = c.ctl + CW_BAR; bar.x = 0; bar.st = bst;
  if constexpr (hi - lo > 1) {
    if (c.tid == 0) { bst[0] = 0u; bst[1] = 0u; }
    __syncthreads();
    bar = xcd_barrier_post(c.ctl + CW_BAR, bst);
  }
#define IN(k) (lo <= (k) && (k) < hi)
#define SEAM(k) do { if constexpr (IN(k) && IN((k) + 1)) xcd_barrier(bar); } while (0)
  const float* const* in = args.in;
  unsigned char* ws = args.ws;
  bf16* XN = (bf16*)(ws + WS_XN); bf16* YM = (bf16*)(ws + WS_YMIX); float* Y = (float*)(ws + WS_Y);

  if constexpr (IN(0)) { norm_phase<0, 0>(c, in[I_X], nullptr, nullptr, nullptr, in[I0_NPM], XN, nullptr, 0, 0, nullptr); } SEAM(0);
  if constexpr (IN(1)) { EpiStoreBf16 E{(bf16*)(ws + WS_P0), EVEN_IN}; gemm_valu<false, false>(c, XN, D, nullptr, in[I0_WIN], nullptr, EVEN_IN, 0, M, EVEN_IN, D, E); } SEAM(1);
  if constexpr (IN(2)) { rwkv_prep(c); } SEAM(2);
  if constexpr (IN(3)) { rwkv_scan(c); gmlp_phase(c); } SEAM(3);
  if constexpr (IN(4)) { rwkv_post(c); } SEAM(4);
  if constexpr (IN(5)) { EpiStoreF32 E{Y, D}; gemm_valu<false, false>(c, YM, D, nullptr, in[I0_WOUT], nullptr, D, 0, M, D, D, E); } SEAM(5);
  if constexpr (IN(6)) { norm_phase<1, 0>(c, in[I_X], args.out, Y, in[I0_NPOM], in[I0_NPF], XN, nullptr, 0, 0, nullptr); } SEAM(6);
  if constexpr (IN(7)) { EpiSwiglu E{(bf16*)(ws + WS_H), FFN}; gemm_valu<true, false>(c, XN, D, nullptr, in[I0_FG], in[I0_FU], FFN, 0, M, FFN, D, E); } SEAM(7);
  if constexpr (IN(8)) { EpiStoreF32 E{Y, D}; gemm_valu<false, false>(c, (const bf16*)(ws + WS_H), FFN, nullptr, in[I0_FD], nullptr, D, 0, M, D, FFN, E); } SEAM(8);
  if constexpr (IN(9)) { norm_phase<1, 1>(c, args.out, args.out, Y, in[I0_NPOF], in[I1_NPM], XN, in[I1_WIN], ODD_IN, 2048, (float*)(ws + WS_DT)); } SEAM(9);
  if constexpr (IN(10)) { EpiStoreBf16 E{(bf16*)(ws + WS_P1), 2048}; gemm_valu<false, false>(c, XN, D, nullptr, in[I1_WIN], nullptr, ODD_IN, 0, M, 2048, D, E); } SEAM(10);
  if constexpr (IN(11)) { ssd_conv(c); s5_scan(c); } SEAM(11);
  if constexpr (IN(12)) { ssd_scan(c);
    EpiGlu E{YM, D, (const bf16*)(ws + WS_YC), in[I1_GLB]}; gemm_valu<false, false>(c, (const bf16*)(ws + WS_YC), 512, nullptr, in[I1_GLW], nullptr, 512, 0, M, 512, 512, E); } SEAM(12);
  if constexpr (IN(13)) { ssd_post(c); } SEAM(13);
  if constexpr (IN(14)) { EpiStoreF32 E{Y, D}; gemm_valu<false, false>(c, YM, D, nullptr, in[I1_WOUT], nullptr, D, 0, M, D, D, E); } SEAM(14);
  if constexpr (IN(15)) { norm_phase<1, 2>(c, args.out, args.out, Y, in[I1_NPOM], in[I1_NPF], XN, in[I1_RT], 8, 0, nullptr); } SEAM(15);
  if constexpr (IN(16)) { moe_assign(c); } SEAM(16);
  if constexpr (IN(17)) { EpiSwiglu E{(bf16*)(ws + WS_HID), FE};
    gemm_valu<true, true>(c, XN, D, (const int*)(c.ctl + CW_SLOTTOK), in[I1_MG], in[I1_MU], FE, (size_t)D * FE, 0, FE, D, E); } SEAM(17);
  if constexpr (IN(18)) { EpiStoreBf16 E{(bf16*)(ws + WS_YS), D};
    gemm_valu<false, true>(c, (const bf16*)(ws + WS_HID), FE, nullptr, in[I1_MDN], nullptr, D, (size_t)FE * D, 0, D, FE, E); } SEAM(18);
  if constexpr (IN(19)) { norm_phase<2, 0>(c, args.out, args.out, nullptr, in[I1_NPOF], nullptr, nullptr, nullptr, 0, 0, nullptr); }
#undef IN
#undef SEAM
}

template <int P> static void launch_one(const Args& a, hipStream_t stream) { hipLaunchKernelGGL((fwd_kernel<P, P + 1>), dim3(256), dim3(NT), LDS_BYTES, stream, a); }
template <int P> static bool set_attr_one() { return hipFuncSetAttribute((const void*)fwd_kernel<P, P + 1>, hipFuncAttributeMaxDynamicSharedMemorySize, LDS_BYTES) == hipSuccess; }
template <int... Ps> static void launch_all(const Args& a, hipStream_t stream, std::integer_sequence<int, Ps...>) { (launch_one<Ps>(a, stream), ...); }
template <int... Ps> static bool set_attr_all(std::integer_sequence<int, Ps...>) { return (set_attr_one<Ps>() && ...); }

extern "C" void kernel_launch(void* const* d_in, const int* in_sizes, int n_in, void* d_out, int out_size, void* d_ws, size_t ws_size, hipStream_t stream) {
  static int ready = 0;
  if (!ready) {
    bool ok = true;
    if (n_in != N_IN || out_size != M * D || ws_size < WS_END) { fprintf(stderr, "kernel_launch: unexpected problem: n_in %d out %d ws %zu (need %zu)\n", n_in, out_size, ws_size, (size_t)WS_END); ok = false; }
#if ONE_LAUNCH
    if (ok && hipFuncSetAttribute((const void*)fwd_kernel<0, LAST_PHASE>, hipFuncAttributeMaxDynamicSharedMemorySize, LDS_BYTES) != hipSuccess) ok = false;
#else
    if (ok && !set_attr_all(std::make_integer_sequence<int, LAST_PHASE>{})) ok = false;
#endif
    if (!ok) fprintf(stderr, "kernel_launch: setup failed\n");
    ready = ok ? 1 : -1;
  }
  if (ready < 0) return;
  (void)hipMemsetAsync((char*)d_ws + WS_CTL, 0, CTL_BYTES, stream);
  Args a{};
  for (int i = 0; i < N_IN; ++i) a.in[i] = (const float*)d_in[i];
  a.out = (float*)d_out; a.ws = (unsigned char*)d_ws;
#if ONE_LAUNCH
  hipLaunchKernelGGL((fwd_kernel<0, LAST_PHASE>), dim3(256), dim3(NT), LDS_BYTES, stream, a);
#else
  launch_all(a, stream, std::make_integer_sequence<int, LAST_PHASE>{});
#endif
}
```

```cpp
#include <hip/hip_runtime.h>
#include <stdint.h>
#include <stdio.h>
#include <utility>

#ifndef ONE_LAUNCH
#define ONE_LAUNCH 1
#endif

constexpr int D = 1024, BATCH = 8, SEQ = 2048, M = BATCH * SEQ;
constexpr int A_W = 512, A_IN = 1792, EVEN_IN = 2816, FFN = 2816;
constexpr int ODD_IN = 2056, NE = 8, FE = 3584;
constexpr int MAXSLOT = 2 * M + NE * 256;
constexpr int NT = 512, NW = 8;

typedef unsigned short bf16;
typedef float f32x4 __attribute__((ext_vector_type(4)));
#define LAS __attribute__((address_space(3)))

enum {
  I_X = 0,
  I0_NPM, I0_WIN, I0_MU, I0_W0, I0_W2, I0_A0, I0_A2, I0_G2, I0_KK, I0_KA, I0_RK, I0_LNW, I0_LNB,
  I0_GLNW, I0_GLNB, I0_GWS, I0_GBS, I0_WOUT, I0_NPOM, I0_NPF, I0_FG, I0_FU, I0_FD, I0_NPOF,
  I1_NPM, I1_WIN, I1_ARE, I1_AIM, I1_LDT, I1_BRE, I1_BIM, I1_CRE, I1_CIM, I1_SD, I1_GLW, I1_GLB,
  I1_CW, I1_CB, I1_DTB, I1_ALOG, I1_MD, I1_MNW, I1_WOUT, I1_NPOM, I1_NPF, I1_RT, I1_MG, I1_MU, I1_MDN, I1_NPOF,
  N_IN
};
static_assert(N_IN == 51, "input count");

constexpr size_t MiB = 1ull << 20;
constexpr size_t WS_CTL = 0, CTL_BYTES = 1 * MiB;
constexpr size_t WS_XN = 1 * MiB;
constexpr size_t WS_YMIX = 33 * MiB;
constexpr size_t WS_Y = 65 * MiB;
constexpr size_t WS_BIG = 129 * MiB;
constexpr size_t WS_P0 = WS_BIG;
constexpr size_t WS_SR = WS_P0 + 88 * MiB;
constexpr size_t WS_SW = WS_SR + 32 * MiB, WS_SK = WS_SW + 32 * MiB, WS_SV = WS_SK + 32 * MiB, WS_SA = WS_SV + 32 * MiB, WS_SB = WS_SA + 32 * MiB;
constexpr size_t WS_G = WS_SB + 32 * MiB;
constexpr size_t WS_BON = WS_G + 32 * MiB;
constexpr size_t WS_L0END = WS_BON + 1 * MiB;
constexpr size_t WS_H = WS_BIG;
constexpr size_t WS_P1 = WS_BIG;
constexpr size_t WS_DT = WS_P1 + 64 * MiB;
constexpr size_t WS_CONV = WS_DT + 1 * MiB;
constexpr size_t WS_YC = WS_CONV + 64 * MiB;
constexpr size_t WS_YSSD = WS_YC + 16 * MiB;
constexpr size_t WS_HID = WS_BIG;
constexpr size_t WS_YS = WS_HID + 238 * MiB;
constexpr size_t WS_ROUTE = WS_YS + 68 * MiB;
constexpr size_t WS_END = WS_ROUTE + 1 * MiB;
static_assert(WS_L0END <= 462 * MiB && WS_END <= 462 * MiB, "workspace map");
static_assert((size_t)MAXSLOT * FE * 2 <= 238 * MiB && (size_t)MAXSLOT * D * 2 <= 68 * MiB, "moe buffers");
constexpr int CW_BAR = 4096;
constexpr int CW_CNT = 8192;
constexpr int CW_CUR = 8192 + 64 * 8;
constexpr int CW_SLOTTOK = 65536;
static_assert((CW_SLOTTOK + MAXSLOT) * 4 <= (int)CTL_BYTES, "ctl");

constexpr int LDS_BYTES = 147456;

__device__ __forceinline__ float bf2f(bf16 v) { return __uint_as_float(((unsigned)v) << 16); }
__device__ __forceinline__ bf16 f2bf(float f) { unsigned u = __float_as_uint(f); u += 0x7fffu + ((u >> 16) & 1u); return (bf16)(u >> 16); }
__device__ __forceinline__ float wave_sum(float v) {
#pragma unroll
  for (int o = 32; o > 0; o >>= 1) v += __shfl_xor(v, o);
  return v;
}
__device__ __forceinline__ float sigmoid_(float x) { return 1.f / (1.f + expf(-x)); }
__device__ __forceinline__ float silu_(float x) { return x / (1.f + expf(-x)); }
__device__ __forceinline__ float gelu_(float x) { const float u = 0.7978845608028654f * (x + 0.044715f * x * x * x); return 0.5f * x * (1.f + tanhf(u)); }
__device__ __forceinline__ float softplus_(float x) { return fmaxf(x, 0.f) + log1pf(expf(-fabsf(x))); }

#define XB_TMO      128
#define XB_XCNT(j)  (256  + 64 * (j))
#define XB_XSUB(j)  (1280 + 64 * (j))
#define XB_XGEN(j)  (2304 + 64 * (j))
#define XB_TOP      3328
#define XB_TOPGEN   3392
#define XCD_BAR_WORDS 3456
#define XB_SPIN_CAP (1u << 22)

__device__ __forceinline__ unsigned xb_ld(unsigned* p)              { return __hip_atomic_load(p, __ATOMIC_RELAXED, __HIP_MEMORY_SCOPE_AGENT); }
__device__ __forceinline__ unsigned xb_add(unsigned* p, unsigned v) { return __hip_atomic_fetch_add(p, v, __ATOMIC_RELAXED, __HIP_MEMORY_SCOPE_AGENT); }
__device__ __forceinline__ unsigned xb_xcc_id() { return (unsigned)__builtin_amdgcn_s_getreg((3 << 11) | 20) & 0xFu; }
#define XB_SPIN(cond, bar) do { unsigned _sp = 0; while (cond) { __builtin_amdgcn_s_sleep(1); \
    if ((++_sp & 255u) == 0u) { if (xb_ld(&(bar)[XB_TMO])) break; if (_sp > XB_SPIN_CAP) { atomicAdd(&(bar)[XB_TMO], 1u); break; } } } } while (0)

struct XcdBarrier { unsigned* bar; unsigned x; volatile LAS unsigned* st; };

__device__ __forceinline__ XcdBarrier xcd_barrier_post(unsigned* bar, volatile LAS unsigned* st) {
    XcdBarrier b; b.bar = bar; b.x = xb_xcc_id(); b.st = st;
    if (threadIdx.x == 0) (void)xb_add(&bar[XB_XCNT(b.x)], 1u);
    return b;
}
__device__ __forceinline__ void xcd_barrier_complete(unsigned* bar, unsigned x, unsigned& nloc, unsigned& nx) {
    const unsigned G = gridDim.x * gridDim.y * gridDim.z;
    unsigned sum, cnt, mine, sp = 0u;
    for (;;) {
        sum = 0u; cnt = 0u; mine = 0u;
#pragma unroll
        for (unsigned j = 0; j < 16; ++j) { const unsigned c = xb_ld(&bar[XB_XCNT(j)]); sum += c; cnt += (c > 0u) ? 1u : 0u; mine = (j == x) ? c : mine; }
        if (sum == G) break;
        __builtin_amdgcn_s_sleep(1);
        if ((++sp & 255u) == 0u) { if (xb_ld(&bar[XB_TMO])) break; if (sp > XB_SPIN_CAP) { atomicAdd(&bar[XB_TMO], 1u); break; } }
    }
    nloc = mine > 0u ? mine : 1u; nx = cnt > 0u ? cnt : 1u;
}
__device__ __forceinline__ void xcd_barrier(const XcdBarrier& b) {
    asm volatile("s_waitcnt vmcnt(0)" ::: "memory");
    __syncthreads();
    if (threadIdx.x == 0) {
        unsigned* bar = b.bar;
        __builtin_amdgcn_s_waitcnt(0);
        unsigned nloc = b.st[0], nx = b.st[1];
        if (nloc == 0u) { xcd_barrier_complete(bar, b.x, nloc, nx); b.st[0] = nloc; b.st[1] = nx; }
        const unsigned old = xb_add(&bar[XB_XSUB(b.x)], 1u);
        const unsigned gen = old / nloc;
        if (old + 1u == (gen + 1u) * nloc) {
            __builtin_amdgcn_fence(__ATOMIC_RELEASE, "agent");
            asm volatile("s_waitcnt vmcnt(0)" ::: "memory");
            const unsigned og = xb_add(&bar[XB_TOP], 1u);
            const unsigned tg = og / nx;
            if (og + 1u == (tg + 1u) * nx) xb_add(&bar[XB_TOPGEN], 1u);
            else XB_SPIN(xb_ld(&bar[XB_TOPGEN]) == tg, bar);
            __builtin_amdgcn_fence(__ATOMIC_ACQUIRE, "agent");
            xb_add(&bar[XB_XGEN(b.x)], 1u);
            asm volatile("s_waitcnt vmcnt(0)" ::: "memory");
        } else {
            XB_SPIN(xb_ld(&bar[XB_XGEN(b.x)]) == gen, bar);
            __builtin_amdgcn_fence(__ATOMIC_ACQUIRE, "agent");
            asm volatile("s_waitcnt vmcnt(0)" ::: "memory");
        }
    }
    __syncthreads();
}

struct Args { const float* in[N_IN]; float* out; unsigned char* ws; int lo, hi; };
struct Ctx {
  float* out; unsigned char* ws; unsigned* ctl;
  unsigned char* lds;
  int tid, lane, wave, bid, G;
};
__device__ __forceinline__ Ctx launder(Ctx c) {
  asm volatile("" : "+v"(c.tid), "+v"(c.lane));
  asm volatile("" : "+s"(c.wave), "+s"(c.bid), "+s"(c.G));
  return c;
}
constexpr int LDS_PTAB = LDS_BYTES - 1024;
constexpr int LDS_BST = LDS_BYTES - 16;
__device__ __forceinline__ const float* inp(const Ctx& c, int k) {
  const LAS unsigned* pt = (const LAS unsigned*)(LAS unsigned char*)(c.lds + LDS_PTAB);
  const unsigned lo = __builtin_amdgcn_readfirstlane(pt[2 * k]), hi = __builtin_amdgcn_readfirstlane(pt[2 * k + 1]);
  return (const float*)(((unsigned long long)hi << 32) | lo);
}


template <int YMODE, int PROJ>
__device__ __forceinline__ void norm_phase(const Ctx& c, const float* resin, float* resout, const float* Y, const float* gpost, const float* gpre, bf16* XN,
                                           const float* W8, int ldw8, int c0, float* out8) {
  float* w8s = (float*)c.lds;
  LAS unsigned* hist = (LAS unsigned*)(c.lds + 32768);
  if (PROJ) {
    for (int i = c.tid; i < 1024 * 8; i += NT) w8s[i] = W8[(size_t)(i >> 3) * ldw8 + c0 + (i & 7)];
    if (PROJ == 2 && c.tid < 8) hist[c.tid] = 0u;
    __syncthreads();
  }
  int* tok_e = (int*)(c.ws + WS_ROUTE); float* tok_g = (float*)(c.ws + WS_ROUTE + 128 * 1024);
  const int* tok_slot = (const int*)(c.ws + WS_ROUTE + 256 * 1024);
  const bf16* YS = (const bf16*)(c.ws + WS_YS);
  for (int m = c.wave * c.G + c.bid; m < M; m += NW * c.G) {
    f32x4 r[4];
#pragma unroll
    for (int j = 0; j < 4; ++j) r[j] = *(const f32x4*)(resin + (size_t)m * D + j * 256 + c.lane * 4);
    if (YMODE) {
      f32x4 y[4]; float ss = 0.f;
      if (YMODE == 1) {
#pragma unroll
        for (int j = 0; j < 4; ++j) y[j] = *(const f32x4*)(Y + (size_t)m * D + j * 256 + c.lane * 4);
      } else {
        const int s0 = tok_slot[2 * m], s1 = tok_slot[2 * m + 1]; const float g0 = tok_g[2 * m], g1 = tok_g[2 * m + 1];
#pragma unroll
        for (int j = 0; j < 4; ++j) {
          const uint2 a = *(const uint2*)(YS + (size_t)s0 * D + j * 256 + c.lane * 4), b = *(const uint2*)(YS + (size_t)s1 * D + j * 256 + c.lane * 4);
          y[j][0] = g0 * bf2f((bf16)(a.x & 0xffff)) + g1 * bf2f((bf16)(b.x & 0xffff));
          y[j][1] = g0 * bf2f((bf16)(a.x >> 16)) + g1 * bf2f((bf16)(b.x >> 16));
          y[j][2] = g0 * bf2f((bf16)(a.y & 0xffff)) + g1 * bf2f((bf16)(b.y & 0xffff));
          y[j][3] = g0 * bf2f((bf16)(a.y >> 16)) + g1 * bf2f((bf16)(b.y >> 16));
        }
      }
#pragma unroll
      for (int j = 0; j < 4; ++j) ss += y[j][0] * y[j][0] + y[j][1] * y[j][1] + y[j][2] * y[j][2] + y[j][3] * y[j][3];
      const float rs = rsqrtf(wave_sum(ss) * (1.f / D) + 1e-6f);
#pragma unroll
      for (int j = 0; j < 4; ++j) {
        const f32x4 g = *(const f32x4*)(gpost + j * 256 + c.lane * 4);
        r[j] = r[j] + y[j] * rs * g;
        *(f32x4*)(resout + (size_t)m * D + j * 256 + c.lane * 4) = r[j];
      }
    }
    if (gpre) {
      float ss = 0.f;
#pragma unroll
      for (int j = 0; j < 4; ++j) ss += r[j][0] * r[j][0] + r[j][1] * r[j][1] + r[j][2] * r[j][2] + r[j][3] * r[j][3];
      const float rs = rsqrtf(wave_sum(ss) * (1.f / D) + 1e-6f);
      float p8[8];
#pragma unroll
      for (int q = 0; q < 8; ++q) p8[q] = 0.f;
#pragma unroll
      for (int j = 0; j < 4; ++j) {
        const f32x4 g = *(const f32x4*)(gpre + j * 256 + c.lane * 4);
        const f32x4 xn = r[j] * rs * g;
        uint2 o; o.x = (unsigned)f2bf(xn[0]) | ((unsigned)f2bf(xn[1]) << 16); o.y = (unsigned)f2bf(xn[2]) | ((unsigned)f2bf(xn[3]) << 16);
        *(uint2*)(XN + (size_t)m * D + j * 256 + c.lane * 4) = o;
        if (PROJ) {
#pragma unroll
          for (int e = 0; e < 4; ++e) {
            const float* wr = w8s + (j * 256 + c.lane * 4 + e) * 8;
#pragma unroll
            for (int q = 0; q < 8; ++q) p8[q] += xn[e] * wr[q];
          }
        }
      }
      if (PROJ) {
#pragma unroll
        for (int q = 0; q < 8; ++q) p8[q] = wave_sum(p8[q]);
        if (PROJ == 1) { if (c.lane < 8) { float v = p8[0];
#pragma unroll
            for (int q = 1; q < 8; ++q) v = (c.lane == q) ? p8[q] : v;
            out8[(size_t)m * 8 + c.lane] = v; } }
        if (PROJ == 2 && c.lane == 0) {
          int e0 = 0; float v0 = p8[0];
#pragma unroll
          for (int q = 1; q < 8; ++q) if (p8[q] > v0) { v0 = p8[q]; e0 = q; }
          int e1 = -1; float v1 = -3.0e38f;
#pragma unroll
          for (int q = 0; q < 8; ++q) if (q != e0 && p8[q] > v1) { v1 = p8[q]; e1 = q; }
          const float g1 = 1.f / (1.f + expf(v0 - v1)), g0 = 1.f - g1;
          tok_e[2 * m] = e0; tok_e[2 * m + 1] = e1; tok_g[2 * m] = g0; tok_g[2 * m + 1] = g1;
          atomicAdd((unsigned*)&hist[e0], 1u); atomicAdd((unsigned*)&hist[e1], 1u);
        }
      }
    }
  }
  if (PROJ == 2) { __syncthreads(); if (c.tid < 8) atomicAdd(c.ctl + CW_CNT + 64 * c.tid, hist[c.tid]); }
  __syncthreads();
}

struct EpiStoreBf16 { bf16* O; int ldo; __device__ __forceinline__ void operator()(int row, int col, const float* a, const float*) const {
    uint2 o; o.x = (unsigned)f2bf(a[0]) | ((unsigned)f2bf(a[1]) << 16); o.y = (unsigned)f2bf(a[2]) | ((unsigned)f2bf(a[3]) << 16); *(uint2*)(O + (size_t)row * ldo + col) = o; } };
struct EpiStoreF32 { float* O; int ldo; __device__ __forceinline__ void operator()(int row, int col, const float* a, const float*) const {
    *(f32x4*)(O + (size_t)row * ldo + col) = (f32x4){a[0], a[1], a[2], a[3]}; } };
struct EpiSwiglu { bf16* O; int ldo; __device__ __forceinline__ void operator()(int row, int col, const float* a, const float* b) const {
    float h[4];
#pragma unroll
    for (int i = 0; i < 4; ++i) h[i] = silu_(a[i]) * b[i];
    uint2 o; o.x = (unsigned)f2bf(h[0]) | ((unsigned)f2bf(h[1]) << 16); o.y = (unsigned)f2bf(h[2]) | ((unsigned)f2bf(h[3]) << 16); *(uint2*)(O + (size_t)row * ldo + col) = o; } };
struct EpiGlu { bf16* O; int ldo; const bf16* Yc; const float* bias; __device__ __forceinline__ void operator()(int row, int col, const float* a, const float*) const {
    float h[4];
#pragma unroll
    for (int i = 0; i < 4; ++i) { const float y = bf2f(Yc[(size_t)row * 512 + col + i]); h[i] = y * sigmoid_(a[i] + bias[col + i]); }
    uint2 o; o.x = (unsigned)f2bf(h[0]) | ((unsigned)f2bf(h[1]) << 16); o.y = (unsigned)f2bf(h[2]) | ((unsigned)f2bf(h[3]) << 16); *(uint2*)(O + (size_t)row * ldo + col) = o; } };

template <bool DUAL, bool MOE, class Epi>
__device__ __forceinline__ void gemm_valu(const Ctx& c, const bf16* A, int lda, const int* rowidx, const float* B, const float* B2, int ldb, size_t bstride_e,
                                          int rows, int N, int K, const Epi& E) {
  float* As = (float*)c.lds;
  float* Bs = As + 16 * 132;
  float* Bs2 = Bs + 16 * 128;
  int pend[8];
  int nmt = rows / 128;
  if (MOE) {
    int acc = 0;
#pragma unroll
    for (int e = 0; e < 8; ++e) { const int cnt = (int)c.ctl[CW_CNT + 64 * e]; acc += (cnt + 255) / 256 * 256; pend[e] = acc; }
    nmt = acc / 128;
  }
  const int nnt = N / 128, nitems = nmt * nnt;
  const int ty = c.tid >> 5, tx = c.tid & 31;
  const int ar = c.tid >> 2, ak = (c.tid & 3) * 4;
  const int bk = c.tid >> 5, bn = (c.tid & 31) * 4;
  for (int it = c.bid; it < nitems; it += c.G) {
    const int tm = it / nnt, tn = it % nnt;
    const float* Bp = B; const float* Bp2 = B2;
    if (MOE) { int e = 0;
#pragma unroll
      for (int q = 0; q < 7; ++q) if (tm * 128 >= pend[q]) e = q + 1;
      Bp += (size_t)e * bstride_e; if (DUAL) Bp2 += (size_t)e * bstride_e; }
    const int grow = tm * 128 + ar;
    const size_t arow = rowidx ? (size_t)rowidx[grow] : (size_t)grow;
    const bf16* ap = A + arow * lda + ak;
    float acc[8][4], acc2[8][4];
#pragma unroll
    for (int i = 0; i < 8; ++i)
#pragma unroll
      for (int j = 0; j < 4; ++j) { acc[i][j] = 0.f; acc2[i][j] = 0.f; }
    for (int k0 = 0; k0 < K; k0 += 16) {
      const uint2 av = *(const uint2*)(ap + k0);
      const f32x4 bv = *(const f32x4*)(Bp + (size_t)(k0 + bk) * ldb + tn * 128 + bn);
      f32x4 bv2; if (DUAL) bv2 = *(const f32x4*)(Bp2 + (size_t)(k0 + bk) * ldb + tn * 128 + bn);
      __syncthreads();
      As[(ak + 0) * 132 + ar] = bf2f((bf16)(av.x & 0xffff)); As[(ak + 1) * 132 + ar] = bf2f((bf16)(av.x >> 16));
      As[(ak + 2) * 132 + ar] = bf2f((bf16)(av.y & 0xffff)); As[(ak + 3) * 132 + ar] = bf2f((bf16)(av.y >> 16));
      *(f32x4*)(Bs + bk * 128 + bn) = bv;
      if (DUAL) *(f32x4*)(Bs2 + bk * 128 + bn) = bv2;
      __syncthreads();
#pragma unroll 2
      for (int k = 0; k < 16; ++k) {
        const f32x4 a0 = *(const f32x4*)(As + k * 132 + ty * 8), a1 = *(const f32x4*)(As + k * 132 + ty * 8 + 4);
        const f32x4 b = *(const f32x4*)(Bs + k * 128 + tx * 4);
        const float a[8] = {a0[0], a0[1], a0[2], a0[3], a1[0], a1[1], a1[2], a1[3]};
#pragma unroll
        for (int i = 0; i < 8; ++i)
#pragma unroll
          for (int j = 0; j < 4; ++j) acc[i][j] += a[i] * b[j];
        if (DUAL) {
          const f32x4 b2 = *(const f32x4*)(Bs2 + k * 128 + tx * 4);
#pragma unroll
          for (int i = 0; i < 8; ++i)
#pragma unroll
            for (int j = 0; j < 4; ++j) acc2[i][j] += a[i] * b2[j];
        }
      }
    }
#pragma unroll
    for (int i = 0; i < 8; ++i) E(tm * 128 + ty * 8 + i, tn * 128 + tx * 4, acc[i], acc2[i]);
  }
  __syncthreads();
}

__device__ __forceinline__ void rwkv_prep(const Ctx& c) {
  const float* mu = inp(c, I0_MU); const float* w0 = inp(c, I0_W0); const float* w2 = inp(c, I0_W2); const float* a0 = inp(c, I0_A0); const float* a2 = inp(c, I0_A2);
  const float* g2 = inp(c, I0_G2); const float* kkp = inp(c, I0_KK); const float* kap = inp(c, I0_KA); const float* rkp = inp(c, I0_RK);
  const bf16* P = (const bf16*)(c.ws + WS_P0);
  float* SR = (float*)(c.ws + WS_SR); float* SW = (float*)(c.ws + WS_SW); float* SK = (float*)(c.ws + WS_SK); float* SV = (float*)(c.ws + WS_SV);
  float* SA = (float*)(c.ws + WS_SA); float* SB = (float*)(c.ws + WS_SB); float* GG = (float*)(c.ws + WS_G); float* BON = (float*)(c.ws + WS_BON);
  float* ps = (float*)c.lds + c.wave * A_IN;
  for (int m = c.wave * c.G + c.bid; m < M; m += NW * c.G) {
    const int t = m % SEQ;
    for (int i = c.lane; i < A_IN; i += 64) {
      const float cur = bf2f(P[(size_t)m * EVEN_IN + i]);
      const float prev = t > 0 ? bf2f(P[(size_t)(m - 1) * EVEN_IN + i]) : 0.f;
      float v = cur + (prev - cur) * mu[i];
      if (i >= 1536 && i < 1600) v = tanhf(v);
      if (i >= 1664) v = sigmoid_(v);
      ps[i] = v;
    }
    __builtin_amdgcn_s_waitcnt(0); __builtin_amdgcn_wave_barrier();
    for (int j = 0; j < 8; ++j) {
      const int ch = j * 64 + c.lane;
      float aw = w0[ch], aa = a0[ch], ag = 0.f;
      for (int i = 0; i < 64; ++i) { aw += ps[1536 + i] * w2[i * 512 + ch]; aa += ps[1600 + i] * a2[i * 512 + ch]; }
      for (int i = 0; i < 128; ++i) ag += ps[1664 + i] * g2[i * 512 + ch];
      const float wl = -softplus_(-aw) - 0.5f;
      const float decay = expf(-expf(wl));
      const float a = sigmoid_(aa);
      const float r = ps[ch], k = ps[512 + ch], v = ps[1024 + ch];
      float kk = k * kkp[ch];
      const float nrm = sqrtf(wave_sum(kk * kk));
      kk = kk / fmaxf(nrm, 1e-12f);
      const float k2 = k * (1.f + (a - 1.f) * kap[ch]);
      const float bon = wave_sum(r * k2 * rkp[ch]);
      const size_t o = (size_t)m * 512 + ch;
      SR[o] = r; SW[o] = decay; SK[o] = k2; SV[o] = v; SA[o] = -kk; SB[o] = kk * a; GG[o] = ag;
      if (c.lane == 0) BON[(size_t)m * 8 + j] = bon;
    }
    __builtin_amdgcn_s_waitcnt(0); __builtin_amdgcn_wave_barrier();
  }
  __syncthreads();
}

__device__ __forceinline__ void rwkv_scan(const Ctx& c) {
  float* SR = (float*)(c.ws + WS_SR); const float* SW = (const float*)(c.ws + WS_SW); const float* SK = (const float*)(c.ws + WS_SK);
  const float* SV = (const float*)(c.ws + WS_SV); const float* SA = (const float*)(c.ws + WS_SA); const float* SB = (const float*)(c.ws + WS_SB);
  for (int it = c.wave * c.G + c.bid; it < BATCH * 8; it += NW * c.G) {
    const int b = it >> 3, h = it & 7;
    float S[64];
#pragma unroll
    for (int i = 0; i < 64; ++i) S[i] = 0.f;
    size_t o = ((size_t)b * SEQ) * 512 + h * 64 + c.lane;
    float r_l = SR[o], w_l = SW[o], k_l = SK[o], v_l = SV[o], a_l = SA[o], b_l = SB[o];
    for (int t = 0; t < SEQ; ++t) {
      const size_t on = (t + 1 < SEQ) ? o + 512 : o;
      const float r_n = SR[on], w_n = SW[on], k_n = SK[on], v_n = SV[on], a_n = SA[on], b_n = SB[on];
      float sa = 0.f;
#pragma unroll
      for (int i = 0; i < 64; ++i) sa += S[i] * __uint_as_float(__builtin_amdgcn_readlane(__float_as_uint(a_l), i));
      float y = 0.f;
#pragma unroll
      for (int i = 0; i < 64; ++i) {
        const float wi = __uint_as_float(__builtin_amdgcn_readlane(__float_as_uint(w_l), i));
        const float bi = __uint_as_float(__builtin_amdgcn_readlane(__float_as_uint(b_l), i));
        const float ki = __uint_as_float(__builtin_amdgcn_readlane(__float_as_uint(k_l), i));
        const float ri = __uint_as_float(__builtin_amdgcn_readlane(__float_as_uint(r_l), i));
        S[i] = S[i] * wi + sa * bi + v_l * ki;
        y += S[i] * ri;
      }
      SR[o] = y;
      o = on; r_l = r_n; w_l = w_n; k_l = k_n; v_l = v_n; a_l = a_n; b_l = b_n;
    }
  }
}

__device__ __forceinline__ void rwkv_post(const Ctx& c) {
  const float* YS = (const float*)(c.ws + WS_SR); const float* SV = (const float*)(c.ws + WS_SV); const float* GG = (const float*)(c.ws + WS_G);
  const float* BON = (const float*)(c.ws + WS_BON); bf16* YM = (bf16*)(c.ws + WS_YMIX);
  const float* lnw = inp(c, I0_LNW); const float* lnb = inp(c, I0_LNB);
  for (int m = c.wave * c.G + c.bid; m < M; m += NW * c.G) {
#pragma unroll
    for (int j = 0; j < 8; ++j) {
      const int ch = j * 64 + c.lane; const size_t o = (size_t)m * 512 + ch;
      const float y = YS[o];
      const float mean = wave_sum(y) * (1.f / 64.f);
      const float d = y - mean;
      const float var = wave_sum(d * d) * (1.f / 64.f);
      float v = d * rsqrtf(var + 64e-5f) * lnw[ch] + lnb[ch];
      v += BON[(size_t)m * 8 + j] * SV[o];
      YM[(size_t)m * D + ch] = f2bf(v * GG[o]);
    }
  }
}

__device__ __forceinline__ void gmlp_phase(const Ctx& c) {
  const bf16* P = (const bf16*)(c.ws + WS_P0); bf16* YM = (bf16*)(c.ws + WS_YMIX);
  const float* lnw = inp(c, I0_GLNW); const float* lnb = inp(c, I0_GLNB); const float* ws = inp(c, I0_GWS); const float* bs = inp(c, I0_GBS);
  float* vn = (float*)c.lds;
  for (int it = c.bid; it < BATCH * 16 * 4; it += c.G) {
    const int g = it & 3, ck = (it >> 2) & 15, b = it >> 6;
    const size_t m0 = (size_t)b * SEQ + ck * 128;
    __syncthreads();
    for (int j = c.wave; j < 128; j += NW) {
      const bf16* row = P + (m0 + j) * EVEN_IN + 2304 + g * 128;
      const float v0 = gelu_(bf2f(row[c.lane])), v1 = gelu_(bf2f(row[c.lane + 64]));
      const float mean = wave_sum(v0 + v1) * (1.f / 128.f);
      const float d0 = v0 - mean, d1 = v1 - mean;
      const float rs = rsqrtf(wave_sum(d0 * d0 + d1 * d1) * (1.f / 128.f) + 1e-6f);
      vn[j * 128 + c.lane] = d0 * rs * lnw[g * 128 + c.lane] + lnb[g * 128 + c.lane];
      vn[j * 128 + c.lane + 64] = d1 * rs * lnw[g * 128 + c.lane + 64] + lnb[g * 128 + c.lane + 64];
    }
    __syncthreads();
    const int d = c.tid & 127, iq = c.tid >> 7;
    for (int ii = 0; ii < 32; ++ii) {
      const int i = iq + 4 * ii;
      const float* wrow = ws + ((size_t)g * 128 + i) * 128;
      float acc = bs[g * 128 + i];
      for (int j = 0; j <= i; ++j) acc += wrow[j] * vn[j * 128 + d];
      const float u = gelu_(bf2f(P[(m0 + i) * EVEN_IN + 1792 + g * 128 + d]));
      YM[(m0 + i) * D + 512 + g * 128 + d] = f2bf(u * acc);
    }
  }
  __syncthreads();
}

__device__ __forceinline__ void s5_scan(const Ctx& c) {
  const float* p_are = inp(c, I1_ARE); const float* p_aim = inp(c, I1_AIM); const float* p_ldt = inp(c, I1_LDT); const float* p_bre = inp(c, I1_BRE); const float* p_bim = inp(c, I1_BIM);
  const float* p_cre = inp(c, I1_CRE); const float* p_cim = inp(c, I1_CIM); const float* p_sd = inp(c, I1_SD);
  const bf16* P1 = (const bf16*)(c.ws + WS_P1); bf16* YC = (bf16*)(c.ws + WS_YC);
  float* wl = (float*)c.lds + c.wave * 4096;
  float* XR = wl, *XI = wl + 1040, *CRE = wl + 2080, *CIM = wl + 3120;
  for (int it = c.wave * c.G + c.bid; it < BATCH * 32; it += NW * c.G) {
    const int b = it >> 5, g = it & 31, p = c.lane;
    const float lr = p_are[g * 64 + p], li = p_aim[g * 64 + p], dt = expf(p_ldt[g]);
    const float mag = expf(lr * dt), ar = mag * cosf(li * dt), ai = mag * sinf(li * dt);
    const float nr = ar - 1.f, ni = ai, den = lr * lr + li * li;
    const float fr = (nr * lr + ni * li) / den, fi = (ni * lr - nr * li) / den;
    float bbr[16], bbi[16];
#pragma unroll
    for (int q = 0; q < 16; ++q) { const float br = p_bre[(g * 64 + p) * 16 + q], bi = p_bim[(g * 64 + p) * 16 + q]; bbr[q] = fr * br - fi * bi; bbi[q] = fr * bi + fi * br; }
#pragma unroll
    for (int q = 0; q < 16; ++q) { CRE[q * 65 + p] = p_cre[(g * 16 + q) * 64 + p]; CIM[q * 65 + p] = p_cim[(g * 16 + q) * 64 + p]; }
    float xr = 0.f, xi = 0.f;
    const int tt = c.lane >> 2, cq = c.lane & 3;
    for (int t0 = 0; t0 < SEQ; t0 += 16) {
      const size_t m0 = (size_t)b * SEQ + t0;
#pragma unroll 4
      for (int s = 0; s < 16; ++s) {
        const uint4 u0 = *(const uint4*)(P1 + (m0 + s) * 2048 + g * 16), u1 = *(const uint4*)(P1 + (m0 + s) * 2048 + g * 16 + 8);
        const unsigned uw[8] = {u0.x, u0.y, u0.z, u0.w, u1.x, u1.y, u1.z, u1.w};
        float br = 0.f, bi = 0.f;
#pragma unroll
        for (int q = 0; q < 8; ++q) { const float ua = bf2f((bf16)(uw[q] & 0xffff)), ub = bf2f((bf16)(uw[q] >> 16));
          br += ua * bbr[2 * q] + ub * bbr[2 * q + 1]; bi += ua * bbi[2 * q] + ub * bbi[2 * q + 1]; }
        const float nxr = ar * xr - ai * xi + br, nxi = ar * xi + ai * xr + bi;
        xr = nxr; xi = nxi;
        XR[s * 65 + p] = xr; XI[s * 65 + p] = xi;
      }
      __builtin_amdgcn_s_waitcnt(0); __builtin_amdgcn_wave_barrier();
      float y[4] = {0.f, 0.f, 0.f, 0.f};
      for (int q = 0; q < 64; ++q) {
        const float a = XR[tt * 65 + q], bq = XI[tt * 65 + q];
#pragma unroll
        for (int e = 0; e < 4; ++e) y[e] += a * CRE[(cq * 4 + e) * 65 + q] - bq * CIM[(cq * 4 + e) * 65 + q];
      }
#pragma unroll
      for (int e = 0; e < 4; ++e) {
        const int ch = g * 16 + cq * 4 + e;
        const float u = bf2f(P1[(m0 + tt) * 2048 + ch]);
        YC[(m0 + tt) * 512 + ch] = f2bf(gelu_(y[e] + p_sd[ch] * u));
      }
      __builtin_amdgcn_s_waitcnt(0); __builtin_amdgcn_wave_barrier();
    }
  }
  __syncthreads();
}

__device__ __forceinline__ void ssd_conv(const Ctx& c) {
  const bf16* P1 = (const bf16*)(c.ws + WS_P1); float* CV = (float*)(c.ws + WS_CONV);
  const float* cw = inp(c, I1_CW); const float* cb = inp(c, I1_CB);
  for (size_t i = (size_t)c.bid * NT + c.tid; i < (size_t)M * 1024; i += (size_t)c.G * NT) {
    const int ch = (int)(i & 1023); const size_t m = i >> 10; const int t = (int)(m % SEQ);
    float acc = cb[ch];
#pragma unroll
    for (int j = 0; j < 4; ++j) { const int tt = t - 3 + j; if (tt >= 0) acc += cw[j * 1024 + ch] * bf2f(P1[(m - 3 + j) * 2048 + 1024 + ch]); }
    CV[i] = silu_(acc);
  }
}

__device__ __forceinline__ void ssd_scan(const Ctx& c) {
  const float* CV = (const float*)(c.ws + WS_CONV); const float* DT = (const float*)(c.ws + WS_DT); float* YO = (float*)(c.ws + WS_YSSD);
  const float* p_dtb = inp(c, I1_DTB); const float* p_alog = inp(c, I1_ALOG); const float* p_md = inp(c, I1_MD);
  for (int it = c.bid; it < BATCH * 8; it += c.G) {
    const int b = it >> 3, h = it & 7, grp = h >> 2, p = c.tid >> 3, ns = c.tid & 7;
    const float dtb = p_dtb[h], av = -expf(p_alog[h]), dsk = p_md[h];
    float H[16];
#pragma unroll
    for (int i = 0; i < 16; ++i) H[i] = 0.f;
    const size_t m0 = (size_t)b * SEQ;
    f32x4 Bn[4], Cn[4]; float xn, dn;
    {
      const float* row = CV + m0 * 1024;
#pragma unroll
      for (int q = 0; q < 4; ++q) { Bn[q] = *(const f32x4*)(row + 512 + grp * 128 + ns * 16 + q * 4); Cn[q] = *(const f32x4*)(row + 768 + grp * 128 + ns * 16 + q * 4); }
      xn = row[h * 64 + p]; dn = DT[m0 * 8 + h];
    }
    for (int t = 0; t < SEQ; ++t) {
      f32x4 Bc[4], Cc[4];
#pragma unroll
      for (int q = 0; q < 4; ++q) { Bc[q] = Bn[q]; Cc[q] = Cn[q]; }
      const float xc = xn, dc = dn;
      {
        const size_t mn = m0 + (t + 1 < SEQ ? t + 1 : t);
        const float* row = CV + mn * 1024;
#pragma unroll
        for (int q = 0; q < 4; ++q) { Bn[q] = *(const f32x4*)(row + 512 + grp * 128 + ns * 16 + q * 4); Cn[q] = *(const f32x4*)(row + 768 + grp * 128 + ns * 16 + q * 4); }
        xn = row[h * 64 + p]; dn = DT[mn * 8 + h];
      }
      const float dt = softplus_(dc + dtb), dA = expf(av * dt), xs = xc * dt;
      float y = 0.f;
#pragma unroll
      for (int q = 0; q < 4; ++q)
#pragma unroll
        for (int e = 0; e < 4; ++e) { H[q * 4 + e] = dA * H[q * 4 + e] + xs * Bc[q][e]; y += H[q * 4 + e] * Cc[q][e]; }
      y += __shfl_xor(y, 1); y += __shfl_xor(y, 2); y += __shfl_xor(y, 4);
      if (ns == 0) YO[(m0 + t) * 512 + h * 64 + p] = y + dsk * xc;
    }
  }
}

__device__ __forceinline__ void ssd_post(const Ctx& c) {
  const bf16* P1 = (const bf16*)(c.ws + WS_P1); const float* YO = (const float*)(c.ws + WS_YSSD); bf16* YM = (bf16*)(c.ws + WS_YMIX);
  const float* nw = inp(c, I1_MNW);
  for (int m = c.wave * c.G + c.bid; m < M; m += NW * c.G) {
    float v[8]; float ss = 0.f;
#pragma unroll
    for (int e = 0; e < 8; ++e) { const int ch = c.lane * 8 + e; const float z = bf2f(P1[(size_t)m * 2048 + 512 + ch]); v[e] = YO[(size_t)m * 512 + ch] * silu_(z); ss += v[e] * v[e]; }
#pragma unroll
    for (int o = 16; o > 0; o >>= 1) ss += __shfl_xor(ss, o);
    const float rs = rsqrtf(ss * (1.f / 256.f) + 1e-6f);
#pragma unroll
    for (int e = 0; e < 8; ++e) { const int ch = c.lane * 8 + e; YM[(size_t)m * D + 512 + ch] = f2bf(v[e] * rs * nw[ch]); }
  }
}

__device__ __forceinline__ void moe_assign(const Ctx& c) {
  LAS unsigned* lcnt = (LAS unsigned*)c.lds; LAS unsigned* lbase = lcnt + 8;
  const int* tok_e = (const int*)(c.ws + WS_ROUTE); int* tok_slot = (int*)(c.ws + WS_ROUTE + 256 * 1024); int* slot_tok = (int*)(c.ctl + CW_SLOTTOK);
  int pstart[8]; { int acc = 0;
#pragma unroll
    for (int e = 0; e < 8; ++e) { pstart[e] = acc; acc += ((int)c.ctl[CW_CNT + 64 * e] + 255) / 256 * 256; } }
  for (int tb = c.bid; tb < M / 64; tb += c.G) {
    __syncthreads();
    if (c.tid < 8) lcnt[c.tid] = 0u;
    __syncthreads();
    int e = 0; unsigned rank = 0; const int pair = tb * 128 + c.tid;
    if (c.tid < 128) { e = tok_e[pair]; rank = atomicAdd((unsigned*)&lcnt[e], 1u); }
    __syncthreads();
    if (c.tid < 8) lbase[c.tid] = atomicAdd(c.ctl + CW_CUR + 64 * c.tid, lcnt[c.tid]);
    __syncthreads();
    if (c.tid < 128) {
      int ps = 0;
#pragma unroll
      for (int q = 0; q < 8; ++q) ps = (e == q) ? pstart[q] : ps;
      const int slot = ps + (int)lbase[e] + (int)rank;
      slot_tok[slot] = pair >> 1; tok_slot[pair] = slot;
    }
  }
  __syncthreads();
}


constexpr int LAST_PHASE = 20;
template <int LO, int HI>
__global__ void __launch_bounds__(NT, 2) fwd_kernel(Args args) {
  extern __shared__ __attribute__((aligned(16))) unsigned char lds[];
  Ctx c0; c0.out = args.out; c0.ws = args.ws; c0.ctl = (unsigned*)(args.ws + WS_CTL); c0.lds = lds;
  c0.tid = threadIdx.x; c0.lane = c0.tid & 63; c0.wave = __builtin_amdgcn_readfirstlane(c0.tid >> 6); c0.bid = blockIdx.x; c0.G = gridDim.x;
  volatile LAS unsigned* bst = (volatile LAS unsigned*)(LAS unsigned char*)(lds + LDS_BST);
  if (c0.tid == 0) { LAS unsigned long long* pt = (LAS unsigned long long*)(LAS unsigned char*)(lds + LDS_PTAB);
#pragma unroll
    for (int i = 0; i < N_IN; ++i) pt[i] = (unsigned long long)args.in[i];
    bst[0] = 0u; bst[1] = 0u; }
  __syncthreads();
  constexpr int lo = LO, hi = HI;
  XcdBarrier bar; bar.bar = c0.ctl + CW_BAR; bar.x = 0; bar.st = bst;
  if constexpr (hi - lo > 1) bar = xcd_barrier_post(c0.ctl + CW_BAR, bst);
#define IN(k) (lo <= (k) && (k) < hi)
#define SEAM(k) do { if constexpr (IN(k) && IN((k) + 1)) xcd_barrier(bar); } while (0)
  unsigned char* ws = args.ws;
  bf16* XN = (bf16*)(ws + WS_XN); bf16* YM = (bf16*)(ws + WS_YMIX); float* Y = (float*)(ws + WS_Y);

  if constexpr (IN(0)) { const Ctx c = launder(c0); norm_phase<0, 0>(c, inp(c, I_X), nullptr, nullptr, nullptr, inp(c, I0_NPM), XN, nullptr, 0, 0, nullptr); } SEAM(0);
  if constexpr (IN(1)) { const Ctx c = launder(c0); EpiStoreBf16 E{(bf16*)(ws + WS_P0), EVEN_IN}; gemm_valu<false, false>(c, XN, D, nullptr, inp(c, I0_WIN), nullptr, EVEN_IN, 0, M, EVEN_IN, D, E); } SEAM(1);
  if constexpr (IN(2)) { const Ctx c = launder(c0); rwkv_prep(c); } SEAM(2);
  if constexpr (IN(3)) { const Ctx c = launder(c0); rwkv_scan(c); gmlp_phase(c); } SEAM(3);
  if constexpr (IN(4)) { const Ctx c = launder(c0); rwkv_post(c); } SEAM(4);
  if constexpr (IN(5)) { const Ctx c = launder(c0); EpiStoreF32 E{Y, D}; gemm_valu<false, false>(c, YM, D, nullptr, inp(c, I0_WOUT), nullptr, D, 0, M, D, D, E); } SEAM(5);
  if constexpr (IN(6)) { const Ctx c = launder(c0); norm_phase<1, 0>(c, inp(c, I_X), args.out, Y, inp(c, I0_NPOM), inp(c, I0_NPF), XN, nullptr, 0, 0, nullptr); } SEAM(6);
  if constexpr (IN(7)) { const Ctx c = launder(c0); EpiSwiglu E{(bf16*)(ws + WS_H), FFN}; gemm_valu<true, false>(c, XN, D, nullptr, inp(c, I0_FG), inp(c, I0_FU), FFN, 0, M, FFN, D, E); } SEAM(7);
  if constexpr (IN(8)) { const Ctx c = launder(c0); EpiStoreF32 E{Y, D}; gemm_valu<false, false>(c, (const bf16*)(ws + WS_H), FFN, nullptr, inp(c, I0_FD), nullptr, D, 0, M, D, FFN, E); } SEAM(8);
  if constexpr (IN(9)) { const Ctx c = launder(c0); norm_phase<1, 1>(c, args.out, args.out, Y, inp(c, I0_NPOF), inp(c, I1_NPM), XN, inp(c, I1_WIN), ODD_IN, 2048, (float*)(ws + WS_DT)); } SEAM(9);
  if constexpr (IN(10)) { const Ctx c = launder(c0); EpiStoreBf16 E{(bf16*)(ws + WS_P1), 2048}; gemm_valu<false, false>(c, XN, D, nullptr, inp(c, I1_WIN), nullptr, ODD_IN, 0, M, 2048, D, E); } SEAM(10);
  if constexpr (IN(11)) { const Ctx c = launder(c0); ssd_conv(c); s5_scan(c); } SEAM(11);
  if constexpr (IN(12)) { const Ctx c = launder(c0); ssd_scan(c);
    EpiGlu E{YM, D, (const bf16*)(ws + WS_YC), inp(c, I1_GLB)}; gemm_valu<false, false>(c, (const bf16*)(ws + WS_YC), 512, nullptr, inp(c, I1_GLW), nullptr, 512, 0, M, 512, 512, E); } SEAM(12);
  if constexpr (IN(13)) { const Ctx c = launder(c0); ssd_post(c); } SEAM(13);
  if constexpr (IN(14)) { const Ctx c = launder(c0); EpiStoreF32 E{Y, D}; gemm_valu<false, false>(c, YM, D, nullptr, inp(c, I1_WOUT), nullptr, D, 0, M, D, D, E); } SEAM(14);
  if constexpr (IN(15)) { const Ctx c = launder(c0); norm_phase<1, 2>(c, args.out, args.out, Y, inp(c, I1_NPOM), inp(c, I1_NPF), XN, inp(c, I1_RT), 8, 0, nullptr); } SEAM(15);
  if constexpr (IN(16)) { const Ctx c = launder(c0); moe_assign(c); } SEAM(16);
  if constexpr (IN(17)) { const Ctx c = launder(c0); EpiSwiglu E{(bf16*)(ws + WS_HID), FE};
    gemm_valu<true, true>(c, XN, D, (const int*)(c.ctl + CW_SLOTTOK), inp(c, I1_MG), inp(c, I1_MU), FE, (size_t)D * FE, 0, FE, D, E); } SEAM(17);
  if constexpr (IN(18)) { const Ctx c = launder(c0); EpiStoreBf16 E{(bf16*)(ws + WS_YS), D};
    gemm_valu<false, true>(c, (const bf16*)(ws + WS_HID), FE, nullptr, inp(c, I1_MDN), nullptr, D, (size_t)FE * D, 0, D, FE, E); } SEAM(18);
  if constexpr (IN(19)) { const Ctx c = launder(c0); norm_phase<2, 0>(c, args.out, args.out, nullptr, inp(c, I1_NPOF), nullptr, nullptr, nullptr, 0, 0, nullptr); }
#undef IN
#undef SEAM
}

template <int P> static void launch_one(const Args& a, hipStream_t stream) { hipLaunchKernelGGL((fwd_kernel<P, P + 1>), dim3(256), dim3(NT), LDS_BYTES, stream, a); }
template <int P> static bool set_attr_one() { return hipFuncSetAttribute((const void*)fwd_kernel<P, P + 1>, hipFuncAttributeMaxDynamicSharedMemorySize, LDS_BYTES) == hipSuccess; }
template <int... Ps> static void launch_all(const Args& a, hipStream_t stream, std::integer_sequence<int, Ps...>) { (launch_one<Ps>(a, stream), ...); }
template <int... Ps> static bool set_attr_all(std::integer_sequence<int, Ps...>) { return (set_attr_one<Ps>() && ...); }

extern "C" void kernel_launch(void* const* d_in, const int* in_sizes, int n_in, void* d_out, int out_size, void* d_ws, size_t ws_size, hipStream_t stream) {
  static int ready = 0;
  if (!ready) {
    bool ok = true;
    if (n_in != N_IN || out_size != M * D || ws_size < WS_END) { fprintf(stderr, "kernel_launch: unexpected problem: n_in %d out %d ws %zu (need %zu)\n", n_in, out_size, ws_size, (size_t)WS_END); ok = false; }
#if ONE_LAUNCH
    if (ok && hipFuncSetAttribute((const void*)fwd_kernel<0, LAST_PHASE>, hipFuncAttributeMaxDynamicSharedMemorySize, LDS_BYTES) != hipSuccess) ok = false;
#else
    if (ok && !set_attr_all(std::make_integer_sequence<int, LAST_PHASE>{})) ok = false;
#endif
    if (!ok) fprintf(stderr, "kernel_launch: setup failed\n");
    ready = ok ? 1 : -1;
  }
  if (ready < 0) return;
  (void)hipMemsetAsync((char*)d_ws + WS_CTL, 0, CTL_BYTES, stream);
  Args a{};
  for (int i = 0; i < N_IN; ++i) a.in[i] = (const float*)d_in[i];
  a.out = (float*)d_out; a.ws = (unsigned char*)d_ws;
#if ONE_LAUNCH
  hipLaunchKernelGGL((fwd_kernel<0, LAST_PHASE>), dim3(256), dim3(NT), LDS_BYTES, stream, a);
#else
  launch_all(a, stream, std::make_integer_sequence<int, LAST_PHASE>{});
#endif
}
```

```cpp
#include <hip/hip_runtime.h>
#include <stdint.h>
#include <stdio.h>
#include <utility>

#ifndef ONE_LAUNCH
#define ONE_LAUNCH 1
#endif

constexpr int D = 1024, BATCH = 8, SEQ = 2048, M = BATCH * SEQ;
constexpr int A_W = 512, A_IN = 1792, EVEN_IN = 2816, FFN = 2816;
constexpr int ODD_IN = 2056, NE = 8, FE = 3584;
constexpr int MAXSLOT = 2 * M + NE * 256;
constexpr int NT = 512, NW = 8;

typedef unsigned short bf16;
typedef float f32x4 __attribute__((ext_vector_type(4)));
#define LAS __attribute__((address_space(3)))

enum {
  I_X = 0,
  I0_NPM, I0_WIN, I0_MU, I0_W0, I0_W2, I0_A0, I0_A2, I0_G2, I0_KK, I0_KA, I0_RK, I0_LNW, I0_LNB,
  I0_GLNW, I0_GLNB, I0_GWS, I0_GBS, I0_WOUT, I0_NPOM, I0_NPF, I0_FG, I0_FU, I0_FD, I0_NPOF,
  I1_NPM, I1_WIN, I1_ARE, I1_AIM, I1_LDT, I1_BRE, I1_BIM, I1_CRE, I1_CIM, I1_SD, I1_GLW, I1_GLB,
  I1_CW, I1_CB, I1_DTB, I1_ALOG, I1_MD, I1_MNW, I1_WOUT, I1_NPOM, I1_NPF, I1_RT, I1_MG, I1_MU, I1_MDN, I1_NPOF,
  N_IN
};
static_assert(N_IN == 51, "input count");

constexpr size_t MiB = 1ull << 20;
constexpr size_t WS_CTL = 0, CTL_BYTES = 1 * MiB;
constexpr size_t WS_WIN0 = 1 * MiB;
constexpr size_t WS_WOUT0 = 7 * MiB;
constexpr size_t WS_FGU = 9 * MiB;
constexpr size_t WS_FD = 20 * MiB;
constexpr size_t WS_WIN1 = 26 * MiB;
constexpr size_t WS_GLU = 30 * MiB;
constexpr size_t WS_WOUT1 = 31 * MiB;
constexpr size_t WS_MGU = 33 * MiB;
constexpr size_t WS_MD = 145 * MiB;
constexpr size_t WS_XN = 201 * MiB;
constexpr size_t WS_YMIX = 233 * MiB;
constexpr size_t WS_Y = 265 * MiB;
constexpr size_t WS_BIG = 329 * MiB;
constexpr size_t WS_P0 = WS_BIG;
constexpr size_t WS_SR = WS_MGU;
constexpr size_t WS_SW = WS_SR + 32 * MiB, WS_SK = WS_SW + 32 * MiB, WS_SV = WS_SK + 32 * MiB, WS_SA = WS_SV + 32 * MiB, WS_SB = WS_Y;
constexpr size_t WS_G = WS_P0 + 88 * MiB;
constexpr size_t WS_BON = WS_G + 32 * MiB;
constexpr size_t WS_L0END = WS_BON + 1 * MiB;
static_assert(WS_SA + 32 * MiB <= WS_XN, "streams inside the MoE weight region");
constexpr size_t WS_H = WS_BIG;
constexpr size_t WS_P1 = WS_BIG;
constexpr size_t WS_DT = WS_P1 + 64 * MiB;
constexpr size_t WS_CONV = WS_DT + 1 * MiB;
constexpr size_t WS_YC = WS_Y;
constexpr size_t WS_YSSD = WS_Y + 16 * MiB;
constexpr int FH = FE / 2;
constexpr size_t WS_HID = WS_BIG;
constexpr size_t WS_YS = WS_YMIX;
constexpr size_t WS_ROUTE = WS_BIG + 120 * MiB;
constexpr size_t WS_END = 462 * MiB;
static_assert(WS_L0END <= WS_END && WS_CONV + 64 * MiB <= WS_END && WS_ROUTE + 1 * MiB <= WS_END, "workspace map");
static_assert((size_t)MAXSLOT * FH * 2 <= 120 * MiB && (size_t)MAXSLOT * D * 2 <= 96 * MiB, "moe buffers");
constexpr int CW_BAR = 4096;
constexpr int CW_CNT = 8192;
constexpr int CW_CUR = 8192 + 64 * 8;
constexpr int CW_SLOTTOK = 65536;
static_assert((CW_SLOTTOK + MAXSLOT) * 4 <= (int)CTL_BYTES, "ctl");

constexpr int LDS_BYTES = 147456;

__device__ __forceinline__ float bf2f(bf16 v) { return __uint_as_float(((unsigned)v) << 16); }
__device__ __forceinline__ bf16 f2bf(float f) { unsigned u = __float_as_uint(f); u += 0x7fffu + ((u >> 16) & 1u); return (bf16)(u >> 16); }
__device__ __forceinline__ float wave_sum(float v) {
#pragma unroll
  for (int o = 32; o > 0; o >>= 1) v += __shfl_xor(v, o);
  return v;
}
__device__ __forceinline__ float sigmoid_(float x) { return 1.f / (1.f + expf(-x)); }
__device__ __forceinline__ float silu_(float x) { return x / (1.f + expf(-x)); }
__device__ __forceinline__ float gelu_(float x) { const float u = 0.7978845608028654f * (x + 0.044715f * x * x * x); return 0.5f * x * (1.f + tanhf(u)); }
__device__ __forceinline__ float softplus_(float x) { return fmaxf(x, 0.f) + log1pf(expf(-fabsf(x))); }

#define XB_TMO      128
#define XB_XCNT(j)  (256  + 64 * (j))
#define XB_XSUB(j)  (1280 + 64 * (j))
#define XB_XGEN(j)  (2304 + 64 * (j))
#define XB_TOP      3328
#define XB_TOPGEN   3392
#define XCD_BAR_WORDS 3456
#define XB_SPIN_CAP (1u << 22)

__device__ __forceinline__ unsigned xb_ld(unsigned* p)              { return __hip_atomic_load(p, __ATOMIC_RELAXED, __HIP_MEMORY_SCOPE_AGENT); }
__device__ __forceinline__ unsigned xb_add(unsigned* p, unsigned v) { return __hip_atomic_fetch_add(p, v, __ATOMIC_RELAXED, __HIP_MEMORY_SCOPE_AGENT); }
__device__ __forceinline__ unsigned xb_xcc_id() { return (unsigned)__builtin_amdgcn_s_getreg((3 << 11) | 20) & 0xFu; }
#define XB_SPIN(cond, bar) do { unsigned _sp = 0; while (cond) { __builtin_amdgcn_s_sleep(1); \
    if ((++_sp & 255u) == 0u) { if (xb_ld(&(bar)[XB_TMO])) break; if (_sp > XB_SPIN_CAP) { atomicAdd(&(bar)[XB_TMO], 1u); break; } } } } while (0)

struct XcdBarrier { unsigned* bar; unsigned x; volatile LAS unsigned* st; };

__device__ __forceinline__ XcdBarrier xcd_barrier_post(unsigned* bar, volatile LAS unsigned* st) {
    XcdBarrier b; b.bar = bar; b.x = xb_xcc_id(); b.st = st;
    if (threadIdx.x == 0) (void)xb_add(&bar[XB_XCNT(b.x)], 1u);
    return b;
}
__device__ __forceinline__ void xcd_barrier_complete(unsigned* bar, unsigned x, unsigned& nloc, unsigned& nx) {
    const unsigned G = gridDim.x * gridDim.y * gridDim.z;
    unsigned sum, cnt, mine, sp = 0u;
    for (;;) {
        sum = 0u; cnt = 0u; mine = 0u;
#pragma unroll
        for (unsigned j = 0; j < 16; ++j) { const unsigned c = xb_ld(&bar[XB_XCNT(j)]); sum += c; cnt += (c > 0u) ? 1u : 0u; mine = (j == x) ? c : mine; }
        if (sum == G) break;
        __builtin_amdgcn_s_sleep(1);
        if ((++sp & 255u) == 0u) { if (xb_ld(&bar[XB_TMO])) break; if (sp > XB_SPIN_CAP) { atomicAdd(&bar[XB_TMO], 1u); break; } }
    }
    nloc = mine > 0u ? mine : 1u; nx = cnt > 0u ? cnt : 1u;
}
__device__ __forceinline__ void xcd_barrier(const XcdBarrier& b) {
    asm volatile("s_waitcnt vmcnt(0)" ::: "memory");
    __syncthreads();
    if (threadIdx.x == 0) {
        unsigned* bar = b.bar;
        __builtin_amdgcn_s_waitcnt(0);
        unsigned nloc = b.st[0], nx = b.st[1];
        if (nloc == 0u) { xcd_barrier_complete(bar, b.x, nloc, nx); b.st[0] = nloc; b.st[1] = nx; }
        const unsigned old = xb_add(&bar[XB_XSUB(b.x)], 1u);
        const unsigned gen = old / nloc;
        if (old + 1u == (gen + 1u) * nloc) {
            __builtin_amdgcn_fence(__ATOMIC_RELEASE, "agent");
            asm volatile("s_waitcnt vmcnt(0)" ::: "memory");
            const unsigned og = xb_add(&bar[XB_TOP], 1u);
            const unsigned tg = og / nx;
            if (og + 1u == (tg + 1u) * nx) xb_add(&bar[XB_TOPGEN], 1u);
            else XB_SPIN(xb_ld(&bar[XB_TOPGEN]) == tg, bar);
            __builtin_amdgcn_fence(__ATOMIC_ACQUIRE, "agent");
            xb_add(&bar[XB_XGEN(b.x)], 1u);
            asm volatile("s_waitcnt vmcnt(0)" ::: "memory");
        } else {
            XB_SPIN(xb_ld(&bar[XB_XGEN(b.x)]) == gen, bar);
            __builtin_amdgcn_fence(__ATOMIC_ACQUIRE, "agent");
            asm volatile("s_waitcnt vmcnt(0)" ::: "memory");
        }
    }
    __syncthreads();
}

struct Args { const float* in[N_IN]; float* out; unsigned char* ws; int lo, hi; };
struct Ctx {
  float* out; unsigned char* ws; unsigned* ctl;
  unsigned char* lds;
  int tid, lane, wave, bid, G;
};
__device__ __forceinline__ Ctx launder(Ctx c) {
  asm volatile("" : "+v"(c.tid), "+v"(c.lane));
  asm volatile("" : "+s"(c.wave), "+s"(c.bid), "+s"(c.G));
  return c;
}
constexpr int LDS_PTAB = LDS_BYTES - 1024;
constexpr int LDS_BST = LDS_BYTES - 16;
__device__ __forceinline__ const float* inp(const Ctx& c, int k) {
  const LAS unsigned* pt = (const LAS unsigned*)(LAS unsigned char*)(c.lds + LDS_PTAB);
  const unsigned lo = __builtin_amdgcn_readfirstlane(pt[2 * k]), hi = __builtin_amdgcn_readfirstlane(pt[2 * k + 1]);
  return (const float*)(((unsigned long long)hi << 32) | lo);
}


namespace mg {
typedef short bf16x8 __attribute__((ext_vector_type(8)));
typedef unsigned u32x4 __attribute__((ext_vector_type(4)));
constexpr int BM = 256, BK = 64, HALF = 128, HTB = HALF * BK * 2, STAGE_BYTES = 8 * HTB, NXCD = 8, WGM = 8;
constexpr int LDS_IDX = STAGE_BYTES;
__host__ __device__ __forceinline__ int lds_byte(int r, int c) { const int st = (r >> 4) * 2 + (c >> 5), rr = r & 15, cc = c & 31, ob = rr * 64 + cc * 2; return st * 1024 + (ob ^ (((ob >> 9) & 1) << 5)); }
__host__ __device__ __forceinline__ void stage_rc(int b, int& R, int& C) { const int st = b / 1024, sb = b % 1024, swz = sb ^ (((sb >> 9) & 1) << 5); R = (st >> 1) * 16 + swz / 64; C = (st & 1) * 32 + (swz % 64) / 2; }
__host__ __device__ __forceinline__ int perm32(int rho) { const int n = rho >> 4, i = rho & 15; return 8 * (i >> 2) + 4 * n + (i & 3); }
struct Unit { int pm, pn; };
struct Gemm { const bf16* A; const bf16* Bt; int lda, ldb, K; };

struct Tiles {
  int nM, nN, nwg, G, c;
  __device__ __forceinline__ void init(int nM_, int nN_, int G_, int c_) { nM = nM_; nN = nN_; nwg = nM * nN; G = G_; c = c_; }
  __device__ __forceinline__ bool next(int i, Unit& u) const {
    const long L = (long)i * G + c; if (L >= nwg) return false;
    int wgid = (int)L; { const int q = nwg / NXCD, r = nwg % NXCD, xcd = wgid % NXCD, off = wgid / NXCD; wgid = (xcd < r ? xcd * (q + 1) : r * (q + 1) + (xcd - r) * q) + off; }
    const int nig = WGM * nN, gid = wgid / nig, fm = gid * WGM, gsz = (nM - fm) < WGM ? (nM - fm) : WGM;
    u.pm = fm + ((wgid % nig) % gsz); u.pn = (wgid % nig) / gsz; return true;
  }
};
struct DenseOrder : Tiles {
  static constexpr bool GATHER = false;
  const int* rowidx;
  __device__ __forceinline__ const char* a_tile(const Gemm& g, const Unit& u) const { return (const char*)g.A + (size_t)u.pm * BM * g.lda * 2; }
  __device__ __forceinline__ const char* b_tile(const Gemm& g, const Unit& u) const { return (const char*)g.Bt + (size_t)u.pn * BM * g.ldb * 2; }
};
template <bool GATHER_> struct MoeOrder : Tiles {
  static constexpr bool GATHER = GATHER_;
  int pend[8]; size_t bstride_e, boff; const int* rowidx;
  __device__ __forceinline__ int expert(int pm) const { int e = 0;
#pragma unroll
    for (int q = 0; q < 7; ++q) e += (pm * BM >= pend[q]) ? 1 : 0;
    return e; }
  __device__ __forceinline__ const char* a_tile(const Gemm& g, const Unit& u) const { return (const char*)g.A + (size_t)u.pm * BM * g.lda * 2; }
  __device__ __forceinline__ const char* b_tile(const Gemm& g, const Unit& u) const { return (const char*)g.Bt + (size_t)expert(u.pm) * bstride_e + boff + (size_t)u.pn * BM * g.ldb * 2; }
};

__device__ __forceinline__ unsigned cvt_pk_bf16(float lo, float hi) { unsigned r; asm volatile("v_cvt_pk_bf16_f32 %0, %1, %2" : "=v"(r) : "v"(lo), "v"(hi)); return r; }

struct EpiF32 { static constexpr bool PERM = false; float* C; int ldc;
  __device__ __forceinline__ void operator()(const f32x4 (&acc)[2][2][4][2], const Unit& u, int wr, int wc, int fr, int fq) const {
    const int row0 = u.pm * BM + wr * 64 + fr, col0 = u.pn * BM + wc * 32 + 4 * fq;
#pragma unroll
    for (int ai = 0; ai < 2; ++ai)
#pragma unroll
      for (int m = 0; m < 4; ++m) { float* rowp = C + (size_t)(row0 + ai * HALF + m * 16) * ldc + col0;
#pragma unroll
        for (int bj = 0; bj < 2; ++bj)
#pragma unroll
          for (int n = 0; n < 2; ++n) *(f32x4*)(rowp + bj * HALF + n * 16) = acc[ai][bj][m][n]; }
  } };
template <bool ACCUM> struct EpiBf16 { static constexpr bool PERM = true; bf16* O; int ldc;
  __device__ __forceinline__ void operator()(const f32x4 (&acc)[2][2][4][2], const Unit& u, int wr, int wc, int fr, int fq) const {
    const int row0 = u.pm * BM + wr * 64 + fr, col0 = u.pn * BM + wc * 32 + 8 * fq;
#pragma unroll
    for (int ai = 0; ai < 2; ++ai)
#pragma unroll
      for (int m = 0; m < 4; ++m) { bf16* rowp = O + (size_t)(row0 + ai * HALF + m * 16) * ldc + col0;
#pragma unroll
        for (int bj = 0; bj < 2; ++bj) { f32x4 v0 = acc[ai][bj][m][0], v1 = acc[ai][bj][m][1];
          if (ACCUM) { const u32x4 o = *(const u32x4*)(rowp + bj * HALF);
            v0[0] += __uint_as_float(o.x << 16); v0[1] += __uint_as_float(o.x & 0xffff0000u); v0[2] += __uint_as_float(o.y << 16); v0[3] += __uint_as_float(o.y & 0xffff0000u);
            v1[0] += __uint_as_float(o.z << 16); v1[1] += __uint_as_float(o.z & 0xffff0000u); v1[2] += __uint_as_float(o.w << 16); v1[3] += __uint_as_float(o.w & 0xffff0000u); }
          u32x4 w; w.x = cvt_pk_bf16(v0[0], v0[1]); w.y = cvt_pk_bf16(v0[2], v0[3]); w.z = cvt_pk_bf16(v1[0], v1[1]); w.w = cvt_pk_bf16(v1[2], v1[3]);
          *(u32x4*)(rowp + bj * HALF) = w; } }
  } };
struct EpiSwigluT { static constexpr bool PERM = true; bf16* O; int ldc;
  __device__ __forceinline__ void operator()(const f32x4 (&acc)[2][2][4][2], const Unit& u, int wr, int wc, int fr, int fq) const {
    const int row0 = u.pm * BM + wr * 64 + fr, col0 = u.pn * HALF + wc * 32 + 8 * fq;
#pragma unroll
    for (int ai = 0; ai < 2; ++ai)
#pragma unroll
      for (int m = 0; m < 4; ++m) { bf16* rowp = O + (size_t)(row0 + ai * HALF + m * 16) * ldc + col0;
        float h[8];
#pragma unroll
        for (int n = 0; n < 2; ++n)
#pragma unroll
          for (int e = 0; e < 4; ++e) { const float gte = acc[ai][0][m][n][e], up = acc[ai][1][m][n][e]; h[n * 4 + e] = gte * __builtin_amdgcn_rcpf(1.f + __expf(-gte)) * up; }
        u32x4 w; w.x = cvt_pk_bf16(h[0], h[1]); w.y = cvt_pk_bf16(h[2], h[3]); w.z = cvt_pk_bf16(h[4], h[5]); w.w = cvt_pk_bf16(h[6], h[7]);
        *(u32x4*)rowp = w; }
  } };
struct EpiGluT { static constexpr bool PERM = true; bf16* O; int ldc; const bf16* Yc; const float* bias;
  __device__ __forceinline__ void operator()(const f32x4 (&acc)[2][2][4][2], const Unit& u, int wr, int wc, int fr, int fq) const {
    const int row0 = u.pm * BM + wr * 64 + fr, col0 = u.pn * BM + wc * 32 + 8 * fq;
#pragma unroll
    for (int ai = 0; ai < 2; ++ai)
#pragma unroll
      for (int m = 0; m < 4; ++m) { const int row = row0 + ai * HALF + m * 16;
#pragma unroll
        for (int bj = 0; bj < 2; ++bj) { const int col = col0 + bj * HALF;
          const u32x4 yv = *(const u32x4*)(Yc + (size_t)row * 512 + col);
          const f32x4 b0 = *(const f32x4*)(bias + col), b1 = *(const f32x4*)(bias + col + 4);
          const float y[8] = {__uint_as_float(yv.x << 16), __uint_as_float(yv.x & 0xffff0000u), __uint_as_float(yv.y << 16), __uint_as_float(yv.y & 0xffff0000u),
                              __uint_as_float(yv.z << 16), __uint_as_float(yv.z & 0xffff0000u), __uint_as_float(yv.w << 16), __uint_as_float(yv.w & 0xffff0000u)};
          float h[8];
#pragma unroll
          for (int e = 0; e < 4; ++e) { h[e] = y[e] * __builtin_amdgcn_rcpf(1.f + __expf(-(acc[ai][bj][m][0][e] + b0[e]))); h[4 + e] = y[4 + e] * __builtin_amdgcn_rcpf(1.f + __expf(-(acc[ai][bj][m][1][e] + b1[e]))); }
          u32x4 w; w.x = cvt_pk_bf16(h[0], h[1]); w.y = cvt_pk_bf16(h[2], h[3]); w.z = cvt_pk_bf16(h[4], h[5]); w.w = cvt_pk_bf16(h[6], h[7]);
          *(u32x4*)(O + (size_t)row * ldc + col) = w; } }
  } };

template <class Epi, class Sched>
__device__ __forceinline__ void gemm_phase(LAS unsigned char* lds, const Gemm g, const Sched& S, const Epi& E) {
  const int tid = threadIdx.x, wid = __builtin_amdgcn_readfirstlane(tid >> 6), lane = tid & 63, wr = wid >> 2, wc = wid & 3, fr = lane & 15, fq = lane >> 4;
  const int K = g.K, nt = K / BK;
  unsigned voffA[2], voffB[2]; int gR[2], gC[2];
#pragma unroll
  for (int i = 0; i < 2; ++i) { int R, C; stage_rc(tid * 16 + i * 8192, R, C); const int Rb = Epi::PERM ? ((R & ~31) + perm32(R & 31)) : R;
    voffA[i] = (unsigned)(R * g.lda + C) * 2u; voffB[i] = (unsigned)(Rb * g.ldb + C) * 2u; gR[i] = R; gC[i] = C * 2; }
  const size_t kstep = (size_t)(BK * 2);
  const size_t hstepA = (size_t)HALF * g.lda * 2, hstepB = (size_t)HALF * g.ldb * 2;
  const unsigned ldsw = (unsigned)wid * 1024u;
  const unsigned rowb = (unsigned)g.lda * 2u;
  const int aoff = lds_byte(wr * 64 + fr, fq * 8), boff = lds_byte(wc * 32 + fr, fq * 8);
#define PG8_SA(b, h) (((b) * 2 + (h)) * HTB)
#define PG8_SB(b, h) ((4 + (b) * 2 + (h)) * HTB)
#define PG8_STAGE(bufoff, gbase, voff) do { _Pragma("unroll") for (int _i = 0; _i < 2; ++_i) \
    __builtin_amdgcn_global_load_lds((const unsigned*)((const char*)(gbase) + (voff)[_i]), (LAS unsigned*)(lds + (bufoff) + ldsw + _i * 8192), 16, 0, 0); } while (0)
#define PG8_STAGE_A(bufoff, p, h, goff) do { if constexpr (Sched::GATHER) PG8_STAGE(bufoff, p, (goff)[h]); else PG8_STAGE(bufoff, (p) + (h) * hstepA, voffA); } while (0)
#define PG8_LDA(dst, b, h) do { _Pragma("unroll") for (int m = 0; m < 4; ++m) _Pragma("unroll") for (int k = 0; k < 2; ++k) dst[m][k] = *(const LAS bf16x8*)(lds + PG8_SA(b, h) + aoff + m * 2048 + k * 1024); } while (0)
#define PG8_LDB(dst, b, h) do { _Pragma("unroll") for (int n = 0; n < 2; ++n) _Pragma("unroll") for (int k = 0; k < 2; ++k) dst[n][k] = *(const LAS bf16x8*)(lds + PG8_SB(b, h) + boff + n * 2048 + k * 1024); } while (0)
#define PG8_MMA(ai, bj, At, Bt) do { __builtin_amdgcn_s_setprio(1); _Pragma("unroll") for (int m = 0; m < 4; ++m) _Pragma("unroll") for (int n = 0; n < 2; ++n) _Pragma("unroll") for (int k = 0; k < 2; ++k) \
    acc[ai][bj][m][n] = __builtin_amdgcn_mfma_f32_16x16x32_bf16(Bt[n][k], At[m][k], acc[ai][bj][m][n], 0, 0, 0); __builtin_amdgcn_s_setprio(0); } while (0)
#define PG8_WAIT_V(n) asm volatile("s_waitcnt vmcnt(" #n ")" ::: "memory")
#define PG8_WAIT_L(n) asm volatile("s_waitcnt lgkmcnt(" #n ")" ::: "memory")
#define PG8_BAR __builtin_amdgcn_s_barrier()
#define PG8_SCHED __builtin_amdgcn_sched_barrier(0)
  Unit cur, nxt; int ui = 0;
  if (!S.next(0, cur)) return;
  f32x4 acc[2][2][4][2];
#pragma unroll
  for (int a = 0; a < 2; ++a)
#pragma unroll
    for (int b = 0; b < 2; ++b)
#pragma unroll
      for (int m = 0; m < 4; ++m)
#pragma unroll
        for (int n = 0; n < 2; ++n) acc[a][b][m][n] = (f32x4){0.f, 0.f, 0.f, 0.f};
  bf16x8 At[4][2], B0[2][2], B1[2][2];
  unsigned gcu[2][2] = {{0u, 0u}, {0u, 0u}};
  const char* cA = Sched::GATHER ? (const char*)g.A : S.a_tile(g, cur); const char* cB = S.b_tile(g, cur);
  if constexpr (Sched::GATHER) {
#pragma unroll
    for (int h = 0; h < 2; ++h)
#pragma unroll
      for (int i = 0; i < 2; ++i) gcu[h][i] = (unsigned)S.rowidx[cur.pm * BM + h * HALF + gR[i]] * rowb + (unsigned)gC[i];
  }
  PG8_STAGE(PG8_SB(0, 0), cB, voffB); PG8_STAGE(PG8_SB(0, 1), cB + hstepB, voffB); PG8_STAGE_A(PG8_SA(0, 0), cA, 0, gcu); PG8_STAGE_A(PG8_SA(0, 1), cA, 1, gcu);
  if (wr == 1) PG8_BAR;
  PG8_WAIT_V(2); PG8_BAR;
  PG8_STAGE(PG8_SB(1, 0), cB + kstep, voffB); PG8_STAGE_A(PG8_SA(1, 0), cA + kstep, 0, gcu); PG8_STAGE(PG8_SB(1, 1), cB + hstepB + kstep, voffB);
  PG8_WAIT_V(6); PG8_BAR;
  for (;;) {
    const bool has_next = S.next(ui + 1, nxt);
    const char* nA = Sched::GATHER ? (const char*)g.A : (has_next ? S.a_tile(g, nxt) : cA); const char* nB = has_next ? S.b_tile(g, nxt) : cB;
    if constexpr (Sched::GATHER) {
      if (has_next && wid < 4) __builtin_amdgcn_global_load_lds((const unsigned*)(S.rowidx + nxt.pm * BM + wid * 64 + lane), (LAS unsigned*)(lds + LDS_IDX + ((ui + 1) & 1) * 1024 + wid * 256), 4, 0, 0);
    }
    for (int t = 0; t < nt; t += 2) {
      const bool last = (t == nt - 2);
      const char* a1 = cA + (size_t)(t + 1) * kstep;
      const char* a2 = last ? nA : cA + (size_t)(t + 2) * kstep; const char* b2 = last ? nB : cB + (size_t)(t + 2) * kstep;
      const char* a3 = a2 + kstep; const char* b3 = b2 + kstep;
      unsigned g2[2][2];
#pragma unroll
      for (int h = 0; h < 2; ++h)
#pragma unroll
        for (int i = 0; i < 2; ++i) g2[h][i] = gcu[h][i];
      if constexpr (Sched::GATHER) {
        if (last && has_next) {
          const LAS unsigned* ix = (const LAS unsigned*)(lds + LDS_IDX + ((ui + 1) & 1) * 1024);
#pragma unroll
          for (int h = 0; h < 2; ++h)
#pragma unroll
            for (int i = 0; i < 2; ++i) g2[h][i] = ix[h * HALF + gR[i]] * rowb + (unsigned)gC[i];
        }
      }
      PG8_LDB(B0, 0, 0); PG8_LDB(B1, 0, 1); PG8_SCHED; PG8_LDA(At, 0, 0); PG8_STAGE_A(PG8_SA(1, 1), a1, 1, gcu);
      PG8_WAIT_V(8); PG8_WAIT_L(0); PG8_BAR; PG8_MMA(0, 0, At, B0); PG8_MMA(0, 1, At, B1); PG8_BAR; PG8_SCHED;
      PG8_LDA(At, 0, 1); PG8_STAGE(PG8_SB(0, 0), b2, voffB); PG8_STAGE(PG8_SB(0, 1), b2 + hstepB, voffB); PG8_STAGE_A(PG8_SA(0, 0), a2, 0, g2);
      PG8_WAIT_V(8); PG8_WAIT_L(0); PG8_BAR; PG8_MMA(1, 0, At, B0); PG8_MMA(1, 1, At, B1); PG8_BAR; PG8_SCHED;
      PG8_LDB(B0, 1, 0); PG8_LDB(B1, 1, 1); PG8_SCHED; PG8_LDA(At, 1, 0); PG8_STAGE_A(PG8_SA(0, 1), a2, 1, g2);
      PG8_WAIT_V(8); PG8_WAIT_L(0); PG8_BAR; PG8_MMA(0, 0, At, B0); PG8_MMA(0, 1, At, B1); PG8_BAR; PG8_SCHED;
      PG8_LDA(At, 1, 1); PG8_STAGE(PG8_SB(1, 0), b3, voffB); PG8_STAGE(PG8_SB(1, 1), b3 + hstepB, voffB); PG8_STAGE_A(PG8_SA(1, 0), a3, 0, g2);
      PG8_WAIT_V(8); PG8_WAIT_L(0); PG8_BAR; PG8_MMA(1, 0, At, B0); PG8_MMA(1, 1, At, B1); PG8_BAR; PG8_SCHED;
      if constexpr (Sched::GATHER) { if (last) {
#pragma unroll
        for (int h = 0; h < 2; ++h)
#pragma unroll
          for (int i = 0; i < 2; ++i) gcu[h][i] = g2[h][i]; } }
    }
    if (wr == 0) PG8_BAR;
    E(acc, cur, wr, wc, fr, fq);
    if (!has_next) break;
#pragma unroll
    for (int a = 0; a < 2; ++a)
#pragma unroll
      for (int b = 0; b < 2; ++b)
#pragma unroll
        for (int m = 0; m < 4; ++m)
#pragma unroll
          for (int n = 0; n < 2; ++n) acc[a][b][m][n] = (f32x4){0.f, 0.f, 0.f, 0.f};
    cur = nxt; cA = nA; cB = nB; ++ui;
    if (wr == 1) PG8_BAR;
  }
  PG8_WAIT_V(0);
  PG8_BAR;
#undef PG8_SA
#undef PG8_SB
#undef PG8_STAGE
#undef PG8_STAGE_A
#undef PG8_LDA
#undef PG8_LDB
#undef PG8_MMA
#undef PG8_WAIT_V
#undef PG8_WAIT_L
#undef PG8_BAR
#undef PG8_SCHED
}
}

__device__ __forceinline__ void cvt_item(const float* W, int ldw, bf16* WT, int Kd, int dst_row0, int k0, int n0, float* scr, int lane) {
#pragma unroll 8
  for (int i = 0; i < 32; ++i) { const int kk = 2 * i + (lane >> 5); scr[kk * 33 + (lane & 31)] = W[(size_t)(k0 + kk) * ldw + n0 + (lane & 31)]; }
  __builtin_amdgcn_s_waitcnt(0); __builtin_amdgcn_wave_barrier();
  const int cch = lane & 7;
#pragma unroll
  for (int j = 0; j < 4; ++j) { const int n = (lane >> 3) + 8 * j; const float* sp = scr + (8 * cch) * 33 + n;
    mg::u32x4 o; o.x = mg::cvt_pk_bf16(sp[0 * 33], sp[1 * 33]); o.y = mg::cvt_pk_bf16(sp[2 * 33], sp[3 * 33]); o.z = mg::cvt_pk_bf16(sp[4 * 33], sp[5 * 33]); o.w = mg::cvt_pk_bf16(sp[6 * 33], sp[7 * 33]);
    *(mg::u32x4*)(WT + (size_t)(dst_row0 + n) * Kd + k0 + 8 * cch) = o; }
  __builtin_amdgcn_s_waitcnt(0); __builtin_amdgcn_wave_barrier();
}
__device__ __forceinline__ void cvt_mat_item(const float* W, int K, int N, int ldw, bf16* WT, int mode, int it, float* scr, int lane) {
  const int nblk = N / 32, kb = it / nblk, nb = it % nblk, n0 = nb * 32;
  const int dst = mode == 0 ? n0 : ((n0 >> 7) * 256 + (n0 & 127) + (mode == 2 ? 128 : 0));
  cvt_item(W, ldw, WT, K, dst, kb * 64, n0, scr, lane);
}
__device__ __forceinline__ void cvt_dense(const Ctx& c) {
  float* scr = (float*)c.lds + c.wave * 4096;
  const float* win0 = inp(c, I0_WIN); const float* wout0 = inp(c, I0_WOUT); const float* fg = inp(c, I0_FG); const float* fu = inp(c, I0_FU); const float* fd = inp(c, I0_FD);
  const float* win1 = inp(c, I1_WIN); const float* glw = inp(c, I1_GLW); const float* wout1 = inp(c, I1_WOUT);
  unsigned char* ws = c.ws;
  for (int it = c.wave * c.G + c.bid; it < 7808; it += NW * c.G) {
    int r = it;
    if (r < 1408) { cvt_mat_item(win0, D, EVEN_IN, EVEN_IN, (bf16*)(ws + WS_WIN0), 0, r, scr, c.lane); continue; } r -= 1408;
    if (r < 512) { cvt_mat_item(wout0, D, D, D, (bf16*)(ws + WS_WOUT0), 0, r, scr, c.lane); continue; } r -= 512;
    if (r < 1408) { cvt_mat_item(fg, D, FFN, FFN, (bf16*)(ws + WS_FGU), 1, r, scr, c.lane); continue; } r -= 1408;
    if (r < 1408) { cvt_mat_item(fu, D, FFN, FFN, (bf16*)(ws + WS_FGU), 2, r, scr, c.lane); continue; } r -= 1408;
    if (r < 1408) { cvt_mat_item(fd, FFN, D, D, (bf16*)(ws + WS_FD), 0, r, scr, c.lane); continue; } r -= 1408;
    if (r < 1024) { cvt_mat_item(win1, D, 2048, ODD_IN, (bf16*)(ws + WS_WIN1), 0, r, scr, c.lane); continue; } r -= 1024;
    if (r < 128) { cvt_mat_item(glw, 512, 512, 512, (bf16*)(ws + WS_GLU), 0, r, scr, c.lane); continue; } r -= 128;
    cvt_mat_item(wout1, D, D, D, (bf16*)(ws + WS_WOUT1), 0, r, scr, c.lane);
  }
}
__device__ __forceinline__ void cvt_moe(const Ctx& c, int vb, int vG) {
  float* scr = (float*)c.lds + c.wave * 4096;
  const float* mgp = inp(c, I1_MG); const float* mup = inp(c, I1_MU); const float* mdp = inp(c, I1_MDN);
  for (int it = c.wave * vG + vb; it < 8 * 5376; it += NW * vG) {
    const int e = it / 5376, r = it % 5376, which = r / 1792, idx = r % 1792;
    if (which == 0) cvt_mat_item(mgp + (size_t)e * D * FE, D, FE, FE, (bf16*)(c.ws + WS_MGU) + (size_t)e * 2 * FE * D, 1, idx, scr, c.lane);
    else if (which == 1) cvt_mat_item(mup + (size_t)e * D * FE, D, FE, FE, (bf16*)(c.ws + WS_MGU) + (size_t)e * 2 * FE * D, 2, idx, scr, c.lane);
    else cvt_mat_item(mdp + (size_t)e * FE * D, FE, D, D, (bf16*)(c.ws + WS_MD) + (size_t)e * D * FE, 0, idx, scr, c.lane);
  }
}


template <int YMODE, int PROJ>
__device__ __forceinline__ void norm_phase(const Ctx& c, const float* resin, float* resout, const float* Y, const float* gpost, const float* gpre, bf16* XN,
                                           const float* W8, int ldw8, int c0, float* out8) {
  float* w8s = (float*)c.lds;
  LAS unsigned* hist = (LAS unsigned*)(c.lds + 32768);
  if (PROJ) {
    for (int i = c.tid; i < 1024 * 8; i += NT) w8s[i] = W8[(size_t)(i >> 3) * ldw8 + c0 + (i & 7)];
    if (PROJ == 2 && c.tid < 8) hist[c.tid] = 0u;
    __syncthreads();
  }
  int* tok_e = (int*)(c.ws + WS_ROUTE); float* tok_g = (float*)(c.ws + WS_ROUTE + 128 * 1024);
  const int* tok_slot = (const int*)(c.ws + WS_ROUTE + 256 * 1024);
  const bf16* YS = (const bf16*)(c.ws + WS_YS);
  for (int m = c.wave * c.G + c.bid; m < M; m += NW * c.G) {
    f32x4 r[4];
#pragma unroll
    for (int j = 0; j < 4; ++j) r[j] = *(const f32x4*)(resin + (size_t)m * D + j * 256 + c.lane * 4);
    if (YMODE) {
      f32x4 y[4]; float ss = 0.f;
      if (YMODE == 1) {
#pragma unroll
        for (int j = 0; j < 4; ++j) y[j] = *(const f32x4*)(Y + (size_t)m * D + j * 256 + c.lane * 4);
      } else {
        const int s0 = tok_slot[2 * m], s1 = tok_slot[2 * m + 1]; const float g0 = tok_g[2 * m], g1 = tok_g[2 * m + 1];
#pragma unroll
        for (int j = 0; j < 4; ++j) {
          const uint2 a = *(const uint2*)(YS + (size_t)s0 * D + j * 256 + c.lane * 4), b = *(const uint2*)(YS + (size_t)s1 * D + j * 256 + c.lane * 4);
          y[j][0] = g0 * bf2f((bf16)(a.x & 0xffff)) + g1 * bf2f((bf16)(b.x & 0xffff));
          y[j][1] = g0 * bf2f((bf16)(a.x >> 16)) + g1 * bf2f((bf16)(b.x >> 16));
          y[j][2] = g0 * bf2f((bf16)(a.y & 0xffff)) + g1 * bf2f((bf16)(b.y & 0xffff));
          y[j][3] = g0 * bf2f((bf16)(a.y >> 16)) + g1 * bf2f((bf16)(b.y >> 16));
        }
      }
#pragma unroll
      for (int j = 0; j < 4; ++j) ss += y[j][0] * y[j][0] + y[j][1] * y[j][1] + y[j][2] * y[j][2] + y[j][3] * y[j][3];
      const float rs = rsqrtf(wave_sum(ss) * (1.f / D) + 1e-6f);
#pragma unroll
      for (int j = 0; j < 4; ++j) {
        const f32x4 g = *(const f32x4*)(gpost + j * 256 + c.lane * 4);
        r[j] = r[j] + y[j] * rs * g;
        *(f32x4*)(resout + (size_t)m * D + j * 256 + c.lane * 4) = r[j];
      }
    }
    if (gpre) {
      float ss = 0.f;
#pragma unroll
      for (int j = 0; j < 4; ++j) ss += r[j][0] * r[j][0] + r[j][1] * r[j][1] + r[j][2] * r[j][2] + r[j][3] * r[j][3];
      const float rs = rsqrtf(wave_sum(ss) * (1.f / D) + 1e-6f);
      float p8[8];
#pragma unroll
      for (int q = 0; q < 8; ++q) p8[q] = 0.f;
#pragma unroll
      for (int j = 0; j < 4; ++j) {
        const f32x4 g = *(const f32x4*)(gpre + j * 256 + c.lane * 4);
        const f32x4 xn = r[j] * rs * g;
        uint2 o; o.x = (unsigned)f2bf(xn[0]) | ((unsigned)f2bf(xn[1]) << 16); o.y = (unsigned)f2bf(xn[2]) | ((unsigned)f2bf(xn[3]) << 16);
        *(uint2*)(XN + (size_t)m * D + j * 256 + c.lane * 4) = o;
        if (PROJ) {
#pragma unroll
          for (int e = 0; e < 4; ++e) {
            const float* wr = w8s + (j * 256 + c.lane * 4 + e) * 8;
#pragma unroll
            for (int q = 0; q < 8; ++q) p8[q] += xn[e] * wr[q];
          }
        }
      }
      if (PROJ) {
#pragma unroll
        for (int q = 0; q < 8; ++q) p8[q] = wave_sum(p8[q]);
        if (PROJ == 1) { if (c.lane < 8) { float v = p8[0];
#pragma unroll
            for (int q = 1; q < 8; ++q) v = (c.lane == q) ? p8[q] : v;
            out8[(size_t)m * 8 + c.lane] = v; } }
        if (PROJ == 2 && c.lane == 0) {
          int e0 = 0; float v0 = p8[0];
#pragma unroll
          for (int q = 1; q < 8; ++q) if (p8[q] > v0) { v0 = p8[q]; e0 = q; }
          int e1 = -1; float v1 = -3.0e38f;
#pragma unroll
          for (int q = 0; q < 8; ++q) if (q != e0 && p8[q] > v1) { v1 = p8[q]; e1 = q; }
          const float g1 = 1.f / (1.f + expf(v0 - v1)), g0 = 1.f - g1;
          tok_e[2 * m] = e0; tok_e[2 * m + 1] = e1; tok_g[2 * m] = g0; tok_g[2 * m + 1] = g1;
          atomicAdd((unsigned*)&hist[e0], 1u); atomicAdd((unsigned*)&hist[e1], 1u);
        }
      }
    }
  }
  if (PROJ == 2) { __syncthreads(); if (c.tid < 8) atomicAdd(c.ctl + CW_CNT + 64 * c.tid, hist[c.tid]); }
  __syncthreads();
}

__device__ __forceinline__ void rwkv_prep(const Ctx& c) {
  const float* mu = inp(c, I0_MU); const float* w0 = inp(c, I0_W0); const float* w2 = inp(c, I0_W2); const float* a0 = inp(c, I0_A0); const float* a2 = inp(c, I0_A2);
  const float* g2 = inp(c, I0_G2); const float* kkp = inp(c, I0_KK); const float* kap = inp(c, I0_KA); const float* rkp = inp(c, I0_RK);
  const bf16* P = (const bf16*)(c.ws + WS_P0);
  float* SR = (float*)(c.ws + WS_SR); float* SW = (float*)(c.ws + WS_SW); float* SK = (float*)(c.ws + WS_SK); float* SV = (float*)(c.ws + WS_SV);
  float* SA = (float*)(c.ws + WS_SA); float* SB = (float*)(c.ws + WS_SB); float* GG = (float*)(c.ws + WS_G); float* BON = (float*)(c.ws + WS_BON);
  float* ps = (float*)c.lds + c.wave * A_IN;
  for (int m = c.wave * c.G + c.bid; m < M; m += NW * c.G) {
    const int t = m % SEQ;
    for (int i = c.lane; i < A_IN; i += 64) {
      const float cur = bf2f(P[(size_t)m * EVEN_IN + i]);
      const float prev = t > 0 ? bf2f(P[(size_t)(m - 1) * EVEN_IN + i]) : 0.f;
      float v = cur + (prev - cur) * mu[i];
      if (i >= 1536 && i < 1600) v = tanhf(v);
      if (i >= 1664) v = sigmoid_(v);
      ps[i] = v;
    }
    __builtin_amdgcn_s_waitcnt(0); __builtin_amdgcn_wave_barrier();
    for (int j = 0; j < 8; ++j) {
      const int ch = j * 64 + c.lane;
      float aw = w0[ch], aa = a0[ch], ag = 0.f;
      for (int i = 0; i < 64; ++i) { aw += ps[1536 + i] * w2[i * 512 + ch]; aa += ps[1600 + i] * a2[i * 512 + ch]; }
      for (int i = 0; i < 128; ++i) ag += ps[1664 + i] * g2[i * 512 + ch];
      const float wl = -softplus_(-aw) - 0.5f;
      const float decay = expf(-expf(wl));
      const float a = sigmoid_(aa);
      const float r = ps[ch], k = ps[512 + ch], v = ps[1024 + ch];
      float kk = k * kkp[ch];
      const float nrm = sqrtf(wave_sum(kk * kk));
      kk = kk / fmaxf(nrm, 1e-12f);
      const float k2 = k * (1.f + (a - 1.f) * kap[ch]);
      const float bon = wave_sum(r * k2 * rkp[ch]);
      const size_t o = (size_t)m * 512 + ch;
      SR[o] = r; SW[o] = decay; SK[o] = k2; SV[o] = v; SA[o] = -kk; SB[o] = kk * a; GG[o] = ag;
      if (c.lane == 0) BON[(size_t)m * 8 + j] = bon;
    }
    __builtin_amdgcn_s_waitcnt(0); __builtin_amdgcn_wave_barrier();
  }
  __syncthreads();
}

__device__ __forceinline__ void rwkv_scan(const Ctx& c) {
  float* SR = (float*)(c.ws + WS_SR); const float* SW = (const float*)(c.ws + WS_SW); const float* SK = (const float*)(c.ws + WS_SK);
  const float* SV = (const float*)(c.ws + WS_SV); const float* SA = (const float*)(c.ws + WS_SA); const float* SB = (const float*)(c.ws + WS_SB);
  for (int it = c.wave * c.G + c.bid; it < BATCH * 8; it += NW * c.G) {
    const int b = it >> 3, h = it & 7;
    float S[64];
#pragma unroll
    for (int i = 0; i < 64; ++i) S[i] = 0.f;
    size_t o = ((size_t)b * SEQ) * 512 + h * 64 + c.lane;
    float r_l = SR[o], w_l = SW[o], k_l = SK[o], v_l = SV[o], a_l = SA[o], b_l = SB[o];
    for (int t = 0; t < SEQ; ++t) {
      const size_t on = (t + 1 < SEQ) ? o + 512 : o;
      const float r_n = SR[on], w_n = SW[on], k_n = SK[on], v_n = SV[on], a_n = SA[on], b_n = SB[on];
      float sa = 0.f;
#pragma unroll
      for (int i = 0; i < 64; ++i) sa += S[i] * __uint_as_float(__builtin_amdgcn_readlane(__float_as_uint(a_l), i));
      float y = 0.f;
#pragma unroll
      for (int i = 0; i < 64; ++i) {
        const float wi = __uint_as_float(__builtin_amdgcn_readlane(__float_as_uint(w_l), i));
        const float bi = __uint_as_float(__builtin_amdgcn_readlane(__float_as_uint(b_l), i));
        const float ki = __uint_as_float(__builtin_amdgcn_readlane(__float_as_uint(k_l), i));
        const float ri = __uint_as_float(__builtin_amdgcn_readlane(__float_as_uint(r_l), i));
        S[i] = S[i] * wi + sa * bi + v_l * ki;
        y += S[i] * ri;
      }
      SR[o] = y;
      o = on; r_l = r_n; w_l = w_n; k_l = k_n; v_l = v_n; a_l = a_n; b_l = b_n;
    }
  }
}

__device__ __forceinline__ void rwkv_post(const Ctx& c) {
  const float* YS = (const float*)(c.ws + WS_SR); const float* SV = (const float*)(c.ws + WS_SV); const float* GG = (const float*)(c.ws + WS_G);
  const float* BON = (const float*)(c.ws + WS_BON); bf16* YM = (bf16*)(c.ws + WS_YMIX);
  const float* lnw = inp(c, I0_LNW); const float* lnb = inp(c, I0_LNB);
  for (int m = c.wave * c.G + c.bid; m < M; m += NW * c.G) {
#pragma unroll
    for (int j = 0; j < 8; ++j) {
      const int ch = j * 64 + c.lane; const size_t o = (size_t)m * 512 + ch;
      const float y = YS[o];
      const float mean = wave_sum(y) * (1.f / 64.f);
      const float d = y - mean;
      const float var = wave_sum(d * d) * (1.f / 64.f);
      float v = d * rsqrtf(var + 64e-5f) * lnw[ch] + lnb[ch];
      v += BON[(size_t)m * 8 + j] * SV[o];
      YM[(size_t)m * D + ch] = f2bf(v * GG[o]);
    }
  }
}

__device__ __forceinline__ void gmlp_phase(const Ctx& c) {
  const bf16* P = (const bf16*)(c.ws + WS_P0); bf16* YM = (bf16*)(c.ws + WS_YMIX);
  const float* lnw = inp(c, I0_GLNW); const float* lnb = inp(c, I0_GLNB); const float* ws = inp(c, I0_GWS); const float* bs = inp(c, I0_GBS);
  float* vn = (float*)c.lds;
  for (int it = c.bid; it < BATCH * 16 * 4; it += c.G) {
    const int g = it & 3, ck = (it >> 2) & 15, b = it >> 6;
    const size_t m0 = (size_t)b * SEQ + ck * 128;
    __syncthreads();
    for (int j = c.wave; j < 128; j += NW) {
      const bf16* row = P + (m0 + j) * EVEN_IN + 2304 + g * 128;
      const float v0 = gelu_(bf2f(row[c.lane])), v1 = gelu_(bf2f(row[c.lane + 64]));
      const float mean = wave_sum(v0 + v1) * (1.f / 128.f);
      const float d0 = v0 - mean, d1 = v1 - mean;
      const float rs = rsqrtf(wave_sum(d0 * d0 + d1 * d1) * (1.f / 128.f) + 1e-6f);
      vn[j * 128 + c.lane] = d0 * rs * lnw[g * 128 + c.lane] + lnb[g * 128 + c.lane];
      vn[j * 128 + c.lane + 64] = d1 * rs * lnw[g * 128 + c.lane + 64] + lnb[g * 128 + c.lane + 64];
    }
    __syncthreads();
    const int d = c.tid & 127, iq = c.tid >> 7;
    for (int ii = 0; ii < 32; ++ii) {
      const int i = iq + 4 * ii;
      const float* wrow = ws + ((size_t)g * 128 + i) * 128;
      float acc = bs[g * 128 + i];
      for (int j = 0; j <= i; ++j) acc += wrow[j] * vn[j * 128 + d];
      const float u = gelu_(bf2f(P[(m0 + i) * EVEN_IN + 1792 + g * 128 + d]));
      YM[(m0 + i) * D + 512 + g * 128 + d] = f2bf(u * acc);
    }
  }
  __syncthreads();
}

__device__ __forceinline__ void s5_scan(const Ctx& c) {
  const float* p_are = inp(c, I1_ARE); const float* p_aim = inp(c, I1_AIM); const float* p_ldt = inp(c, I1_LDT); const float* p_bre = inp(c, I1_BRE); const float* p_bim = inp(c, I1_BIM);
  const float* p_cre = inp(c, I1_CRE); const float* p_cim = inp(c, I1_CIM); const float* p_sd = inp(c, I1_SD);
  const bf16* P1 = (const bf16*)(c.ws + WS_P1); bf16* YC = (bf16*)(c.ws + WS_YC);
  float* wl = (float*)c.lds + c.wave * 4096;
  float* XR = wl, *XI = wl + 1040, *CRE = wl + 2080, *CIM = wl + 3120;
  for (int it = c.wave * c.G + c.bid; it < BATCH * 32; it += NW * c.G) {
    const int b = it >> 5, g = it & 31, p = c.lane;
    const float lr = p_are[g * 64 + p], li = p_aim[g * 64 + p], dt = expf(p_ldt[g]);
    const float mag = expf(lr * dt), ar = mag * cosf(li * dt), ai = mag * sinf(li * dt);
    const float nr = ar - 1.f, ni = ai, den = lr * lr + li * li;
    const float fr = (nr * lr + ni * li) / den, fi = (ni * lr - nr * li) / den;
    float bbr[16], bbi[16];
#pragma unroll
    for (int q = 0; q < 16; ++q) { const float br = p_bre[(g * 64 + p) * 16 + q], bi = p_bim[(g * 64 + p) * 16 + q]; bbr[q] = fr * br - fi * bi; bbi[q] = fr * bi + fi * br; }
#pragma unroll
    for (int q = 0; q < 16; ++q) { CRE[q * 65 + p] = p_cre[(g * 16 + q) * 64 + p]; CIM[q * 65 + p] = p_cim[(g * 16 + q) * 64 + p]; }
    float xr = 0.f, xi = 0.f;
    const int tt = c.lane >> 2, cq = c.lane & 3;
    for (int t0 = 0; t0 < SEQ; t0 += 16) {
      const size_t m0 = (size_t)b * SEQ + t0;
#pragma unroll 4
      for (int s = 0; s < 16; ++s) {
        const uint4 u0 = *(const uint4*)(P1 + (m0 + s) * 2048 + g * 16), u1 = *(const uint4*)(P1 + (m0 + s) * 2048 + g * 16 + 8);
        const unsigned uw[8] = {u0.x, u0.y, u0.z, u0.w, u1.x, u1.y, u1.z, u1.w};
        float br = 0.f, bi = 0.f;
#pragma unroll
        for (int q = 0; q < 8; ++q) { const float ua = bf2f((bf16)(uw[q] & 0xffff)), ub = bf2f((bf16)(uw[q] >> 16));
          br += ua * bbr[2 * q] + ub * bbr[2 * q + 1]; bi += ua * bbi[2 * q] + ub * bbi[2 * q + 1]; }
        const float nxr = ar * xr - ai * xi + br, nxi = ar * xi + ai * xr + bi;
        xr = nxr; xi = nxi;
        XR[s * 65 + p] = xr; XI[s * 65 + p] = xi;
      }
      __builtin_amdgcn_s_waitcnt(0); __builtin_amdgcn_wave_barrier();
      float y[4] = {0.f, 0.f, 0.f, 0.f};
      for (int q = 0; q < 64; ++q) {
        const float a = XR[tt * 65 + q], bq = XI[tt * 65 + q];
#pragma unroll
        for (int e = 0; e < 4; ++e) y[e] += a * CRE[(cq * 4 + e) * 65 + q] - bq * CIM[(cq * 4 + e) * 65 + q];
      }
#pragma unroll
      for (int e = 0; e < 4; ++e) {
        const int ch = g * 16 + cq * 4 + e;
        const float u = bf2f(P1[(m0 + tt) * 2048 + ch]);
        YC[(m0 + tt) * 512 + ch] = f2bf(gelu_(y[e] + p_sd[ch] * u));
      }
      __builtin_amdgcn_s_waitcnt(0); __builtin_amdgcn_wave_barrier();
    }
  }
  __syncthreads();
}

__device__ __forceinline__ void ssd_conv(const Ctx& c) {
  const bf16* P1 = (const bf16*)(c.ws + WS_P1); float* CV = (float*)(c.ws + WS_CONV);
  const float* cw = inp(c, I1_CW); const float* cb = inp(c, I1_CB);
  for (size_t i = (size_t)c.bid * NT + c.tid; i < (size_t)M * 1024; i += (size_t)c.G * NT) {
    const int ch = (int)(i & 1023); const size_t m = i >> 10; const int t = (int)(m % SEQ);
    float acc = cb[ch];
#pragma unroll
    for (int j = 0; j < 4; ++j) { const int tt = t - 3 + j; if (tt >= 0) acc += cw[j * 1024 + ch] * bf2f(P1[(m - 3 + j) * 2048 + 1024 + ch]); }
    CV[i] = silu_(acc);
  }
}

__device__ __forceinline__ void ssd_scan(const Ctx& c) {
  const float* CV = (const float*)(c.ws + WS_CONV); const float* DT = (const float*)(c.ws + WS_DT); float* YO = (float*)(c.ws + WS_YSSD);
  const float* p_dtb = inp(c, I1_DTB); const float* p_alog = inp(c, I1_ALOG); const float* p_md = inp(c, I1_MD);
  for (int it = c.bid; it < BATCH * 8; it += c.G) {
    const int b = it >> 3, h = it & 7, grp = h >> 2, p = c.tid >> 3, ns = c.tid & 7;
    const float dtb = p_dtb[h], av = -expf(p_alog[h]), dsk = p_md[h];
    float H[16];
#pragma unroll
    for (int i = 0; i < 16; ++i) H[i] = 0.f;
    const size_t m0 = (size_t)b * SEQ;
    f32x4 Bn[4], Cn[4]; float xn, dn;
    {
      const float* row = CV + m0 * 1024;
#pragma unroll
      for (int q = 0; q < 4; ++q) { Bn[q] = *(const f32x4*)(row + 512 + grp * 128 + ns * 16 + q * 4); Cn[q] = *(const f32x4*)(row + 768 + grp * 128 + ns * 16 + q * 4); }
      xn = row[h * 64 + p]; dn = DT[m0 * 8 + h];
    }
    for (int t = 0; t < SEQ; ++t) {
      f32x4 Bc[4], Cc[4];
#pragma unroll
      for (int q = 0; q < 4; ++q) { Bc[q] = Bn[q]; Cc[q] = Cn[q]; }
      const float xc = xn, dc = dn;
      {
        const size_t mn = m0 + (t + 1 < SEQ ? t + 1 : t);
        const float* row = CV + mn * 1024;
#pragma unroll
        for (int q = 0; q < 4; ++q) { Bn[q] = *(const f32x4*)(row + 512 + grp * 128 + ns * 16 + q * 4); Cn[q] = *(const f32x4*)(row + 768 + grp * 128 + ns * 16 + q * 4); }
        xn = row[h * 64 + p]; dn = DT[mn * 8 + h];
      }
      const float dt = softplus_(dc + dtb), dA = expf(av * dt), xs = xc * dt;
      float y = 0.f;
#pragma unroll
      for (int q = 0; q < 4; ++q)
#pragma unroll
        for (int e = 0; e < 4; ++e) { H[q * 4 + e] = dA * H[q * 4 + e] + xs * Bc[q][e]; y += H[q * 4 + e] * Cc[q][e]; }
      y += __shfl_xor(y, 1); y += __shfl_xor(y, 2); y += __shfl_xor(y, 4);
      if (ns == 0) YO[(m0 + t) * 512 + h * 64 + p] = y + dsk * xc;
    }
  }
}

__device__ __forceinline__ void ssd_post(const Ctx& c) {
  const bf16* P1 = (const bf16*)(c.ws + WS_P1); const float* YO = (const float*)(c.ws + WS_YSSD); bf16* YM = (bf16*)(c.ws + WS_YMIX);
  const float* nw = inp(c, I1_MNW);
  for (int m = c.wave * c.G + c.bid; m < M; m += NW * c.G) {
    float v[8]; float ss = 0.f;
#pragma unroll
    for (int e = 0; e < 8; ++e) { const int ch = c.lane * 8 + e; const float z = bf2f(P1[(size_t)m * 2048 + 512 + ch]); v[e] = YO[(size_t)m * 512 + ch] * silu_(z); ss += v[e] * v[e]; }
#pragma unroll
    for (int o = 16; o > 0; o >>= 1) ss += __shfl_xor(ss, o);
    const float rs = rsqrtf(ss * (1.f / 256.f) + 1e-6f);
#pragma unroll
    for (int e = 0; e < 8; ++e) { const int ch = c.lane * 8 + e; YM[(size_t)m * D + 512 + ch] = f2bf(v[e] * rs * nw[ch]); }
  }
}

__device__ __forceinline__ void moe_assign(const Ctx& c) {
  LAS unsigned* lcnt = (LAS unsigned*)c.lds; LAS unsigned* lbase = lcnt + 8;
  const int* tok_e = (const int*)(c.ws + WS_ROUTE); int* tok_slot = (int*)(c.ws + WS_ROUTE + 256 * 1024); int* slot_tok = (int*)(c.ctl + CW_SLOTTOK);
  int pstart[8]; { int acc = 0;
#pragma unroll
    for (int e = 0; e < 8; ++e) { pstart[e] = acc; acc += ((int)c.ctl[CW_CNT + 64 * e] + 255) / 256 * 256; } }
  for (int tb = c.bid; tb < M / 64; tb += c.G) {
    __syncthreads();
    if (c.tid < 8) lcnt[c.tid] = 0u;
    __syncthreads();
    int e = 0; unsigned rank = 0; const int pair = tb * 128 + c.tid;
    if (c.tid < 128) { e = tok_e[pair]; rank = atomicAdd((unsigned*)&lcnt[e], 1u); }
    __syncthreads();
    if (c.tid < 8) lbase[c.tid] = atomicAdd(c.ctl + CW_CUR + 64 * c.tid, lcnt[c.tid]);
    __syncthreads();
    if (c.tid < 128) {
      int ps = 0;
#pragma unroll
      for (int q = 0; q < 8; ++q) ps = (e == q) ? pstart[q] : ps;
      const int slot = ps + (int)lbase[e] + (int)rank;
      slot_tok[slot] = pair >> 1; tok_slot[pair] = slot;
    }
  }
  __syncthreads();
}


constexpr int LAST_PHASE = 22;
template <int LO, int HI>
__global__ void __launch_bounds__(NT, 2) fwd_kernel(Args args) {
  extern __shared__ __attribute__((aligned(16))) unsigned char lds[];
  Ctx c0; c0.out = args.out; c0.ws = args.ws; c0.ctl = (unsigned*)(args.ws + WS_CTL); c0.lds = lds;
  c0.tid = threadIdx.x; c0.lane = c0.tid & 63; c0.wave = __builtin_amdgcn_readfirstlane(c0.tid >> 6); c0.bid = blockIdx.x; c0.G = gridDim.x;
  volatile LAS unsigned* bst = (volatile LAS unsigned*)(LAS unsigned char*)(lds + LDS_BST);
  if (c0.tid == 0) { LAS unsigned long long* pt = (LAS unsigned long long*)(LAS unsigned char*)(lds + LDS_PTAB);
#pragma unroll
    for (int i = 0; i < N_IN; ++i) pt[i] = (unsigned long long)args.in[i];
    bst[0] = 0u; bst[1] = 0u; }
  __syncthreads();
  constexpr int lo = LO, hi = HI;
  XcdBarrier bar; bar.bar = c0.ctl + CW_BAR; bar.x = 0; bar.st = bst;
  if constexpr (hi - lo > 1) bar = xcd_barrier_post(c0.ctl + CW_BAR, bst);
#define IN(k) (lo <= (k) && (k) < hi)
#define SEAM(k) do { if constexpr (IN(k) && IN((k) + 1)) xcd_barrier(bar); } while (0)
  unsigned char* ws = args.ws;
  bf16* XN = (bf16*)(ws + WS_XN); bf16* YM = (bf16*)(ws + WS_YMIX); float* Y = (float*)(ws + WS_Y);

  LAS unsigned char* const ldsl = (LAS unsigned char*)lds;
  if constexpr (IN(0)) { const Ctx c = launder(c0); cvt_dense(c); norm_phase<0, 0>(c, inp(c, I_X), nullptr, nullptr, nullptr, inp(c, I0_NPM), XN, nullptr, 0, 0, nullptr); } SEAM(0);
  if constexpr (IN(1)) { const Ctx c = launder(c0); mg::Gemm g{XN, (const bf16*)(ws + WS_WIN0), D, D, D}; mg::DenseOrder S; S.init(M / 256, EVEN_IN / 256, c.G, c.bid);
    mg::EpiBf16<false> E{(bf16*)(ws + WS_P0), EVEN_IN}; mg::gemm_phase(ldsl, g, S, E); } SEAM(1);
  if constexpr (IN(2)) { const Ctx c = launder(c0); rwkv_prep(c); } SEAM(2);
  if constexpr (IN(3)) { const Ctx c = launder(c0); rwkv_scan(c); gmlp_phase(c); } SEAM(3);
  if constexpr (IN(4)) { const Ctx c = launder(c0); rwkv_post(c); } SEAM(4);
  if constexpr (IN(5)) { const Ctx c = launder(c0); mg::Gemm g{YM, (const bf16*)(ws + WS_WOUT0), D, D, D}; mg::DenseOrder S; S.init(M / 256, D / 256, c.G, c.bid);
    mg::EpiF32 E{Y, D}; mg::gemm_phase(ldsl, g, S, E); } SEAM(5);
  if constexpr (IN(6)) { const Ctx c = launder(c0); norm_phase<1, 0>(c, inp(c, I_X), args.out, Y, inp(c, I0_NPOM), inp(c, I0_NPF), XN, nullptr, 0, 0, nullptr); } SEAM(6);
  if constexpr (IN(7)) { const Ctx c = launder(c0); mg::Gemm g{XN, (const bf16*)(ws + WS_FGU), D, D, D}; mg::DenseOrder S; S.init(M / 256, 2 * FFN / 256, c.G, c.bid);
    mg::EpiSwigluT E{(bf16*)(ws + WS_H), FFN}; mg::gemm_phase(ldsl, g, S, E); } SEAM(7);
  if constexpr (IN(8)) { const Ctx c = launder(c0); mg::Gemm g{(const bf16*)(ws + WS_H), (const bf16*)(ws + WS_FD), FFN, FFN, FFN}; mg::DenseOrder S; S.init(M / 256, D / 256, c.G, c.bid);
    mg::EpiF32 E{Y, D}; mg::gemm_phase(ldsl, g, S, E); } SEAM(8);
  if constexpr (IN(9)) { const Ctx c = launder(c0); norm_phase<1, 1>(c, args.out, args.out, Y, inp(c, I0_NPOF), inp(c, I1_NPM), XN, inp(c, I1_WIN), ODD_IN, 2048, (float*)(ws + WS_DT)); } SEAM(9);
  if constexpr (IN(10)) { const Ctx c = launder(c0); mg::Gemm g{XN, (const bf16*)(ws + WS_WIN1), D, D, D}; mg::DenseOrder S; S.init(M / 256, 2048 / 256, c.G, c.bid);
    mg::EpiBf16<false> E{(bf16*)(ws + WS_P1), 2048}; mg::gemm_phase(ldsl, g, S, E); } SEAM(10);
  if constexpr (IN(11)) { const Ctx c = launder(c0); ssd_conv(c); s5_scan(c); cvt_moe(c, c.bid, c.G); } SEAM(11);
  if constexpr (IN(12)) { const Ctx c = launder(c0); ssd_scan(c);
    mg::Gemm g{(const bf16*)(ws + WS_YC), (const bf16*)(ws + WS_GLU), 512, 512, 512}; mg::DenseOrder S; S.init(M / 256, 512 / 256, c.G, c.G - 1 - c.bid);
    mg::EpiGluT E{YM, D, (const bf16*)(ws + WS_YC), inp(c, I1_GLB)}; mg::gemm_phase(ldsl, g, S, E); } SEAM(12);
  if constexpr (IN(13)) { const Ctx c = launder(c0); ssd_post(c); } SEAM(13);
  if constexpr (IN(14)) { const Ctx c = launder(c0); mg::Gemm g{YM, (const bf16*)(ws + WS_WOUT1), D, D, D}; mg::DenseOrder S; S.init(M / 256, D / 256, c.G, c.bid);
    mg::EpiF32 E{Y, D}; mg::gemm_phase(ldsl, g, S, E); } SEAM(14);
  if constexpr (IN(15)) { const Ctx c = launder(c0); norm_phase<1, 2>(c, args.out, args.out, Y, inp(c, I1_NPOM), inp(c, I1_NPF), XN, inp(c, I1_RT), 8, 0, nullptr); } SEAM(15);
  if constexpr (IN(16)) { const Ctx c = launder(c0); moe_assign(c); } SEAM(16);
#define MOE_SCHED(S, nn, bse, bof) do { int acc_ = 0; \
    _Pragma("unroll") for (int e = 0; e < 8; ++e) { acc_ += ((int)c.ctl[CW_CNT + 64 * e] + 255) / 256 * 256; S.pend[e] = acc_; } \
    S.init(acc_ / 256, nn, c.G, c.bid); S.bstride_e = (bse); S.boff = (bof); S.rowidx = (const int*)(c.ctl + CW_SLOTTOK); } while (0)
  if constexpr (IN(17)) { const Ctx c = launder(c0); mg::Gemm g{XN, (const bf16*)(ws + WS_MGU), D, D, D}; mg::MoeOrder<true> S; MOE_SCHED(S, FH / 128, (size_t)2 * FE * D * 2, 0);
    mg::EpiSwigluT E{(bf16*)(ws + WS_HID), FH}; mg::gemm_phase(ldsl, g, S, E); } SEAM(17);
  if constexpr (IN(18)) { const Ctx c = launder(c0); mg::Gemm g{(const bf16*)(ws + WS_HID), (const bf16*)(ws + WS_MD), FH, FE, FH}; mg::MoeOrder<false> S; MOE_SCHED(S, D / 256, (size_t)D * FE * 2, 0);
    mg::EpiBf16<false> E{(bf16*)(ws + WS_YS), D}; mg::gemm_phase(ldsl, g, S, E); } SEAM(18);
  if constexpr (IN(19)) { const Ctx c = launder(c0); mg::Gemm g{XN, (const bf16*)(ws + WS_MGU), D, D, D}; mg::MoeOrder<true> S; MOE_SCHED(S, FH / 128, (size_t)2 * FE * D * 2, (size_t)(FH / 128) * 256 * D * 2);
    mg::EpiSwigluT E{(bf16*)(ws + WS_HID), FH}; mg::gemm_phase(ldsl, g, S, E); } SEAM(19);
  if constexpr (IN(20)) { const Ctx c = launder(c0); mg::Gemm g{(const bf16*)(ws + WS_HID), (const bf16*)(ws + WS_MD), FH, FE, FH}; mg::MoeOrder<false> S; MOE_SCHED(S, D / 256, (size_t)D * FE * 2, (size_t)FH * 2);
    mg::EpiBf16<true> E{(bf16*)(ws + WS_YS), D}; mg::gemm_phase(ldsl, g, S, E); } SEAM(20);
  if constexpr (IN(21)) { const Ctx c = launder(c0); norm_phase<2, 0>(c, args.out, args.out, nullptr, inp(c, I1_NPOF), nullptr, nullptr, nullptr, 0, 0, nullptr); }
#undef MOE_SCHED
#undef IN
#undef SEAM
}

template <int P> static void launch_one(const Args& a, hipStream_t stream) { hipLaunchKernelGGL((fwd_kernel<P, P + 1>), dim3(256), dim3(NT), LDS_BYTES, stream, a); }
template <int P> static bool set_attr_one() { return hipFuncSetAttribute((const void*)fwd_kernel<P, P + 1>, hipFuncAttributeMaxDynamicSharedMemorySize, LDS_BYTES) == hipSuccess; }
template <int... Ps> static void launch_all(const Args& a, hipStream_t stream, std::integer_sequence<int, Ps...>) { (launch_one<Ps>(a, stream), ...); }
template <int... Ps> static bool set_attr_all(std::integer_sequence<int, Ps...>) { return (set_attr_one<Ps>() && ...); }

extern "C" void kernel_launch(void* const* d_in, const int* in_sizes, int n_in, void* d_out, int out_size, void* d_ws, size_t ws_size, hipStream_t stream) {
  static int ready = 0;
  if (!ready) {
    bool ok = true;
    if (n_in != N_IN || out_size != M * D || ws_size < WS_END) { fprintf(stderr, "kernel_launch: unexpected problem: n_in %d out %d ws %zu (need %zu)\n", n_in, out_size, ws_size, (size_t)WS_END); ok = false; }
#if ONE_LAUNCH
    if (ok && hipFuncSetAttribute((const void*)fwd_kernel<0, LAST_PHASE>, hipFuncAttributeMaxDynamicSharedMemorySize, LDS_BYTES) != hipSuccess) ok = false;
#else
    if (ok && !set_attr_all(std::make_integer_sequence<int, LAST_PHASE>{})) ok = false;
#endif
    if (!ok) fprintf(stderr, "kernel_launch: setup failed\n");
    ready = ok ? 1 : -1;
  }
  if (ready < 0) return;
  (void)hipMemsetAsync((char*)d_ws + WS_CTL, 0, CTL_BYTES, stream);
  Args a{};
  for (int i = 0; i < N_IN; ++i) a.in[i] = (const float*)d_in[i];
  a.out = (float*)d_out; a.ws = (unsigned char*)d_ws;
#if ONE_LAUNCH
  hipLaunchKernelGGL((fwd_kernel<0, LAST_PHASE>), dim3(256), dim3(NT), LDS_BYTES, stream, a);
#else
  launch_all(a, stream, std::make_integer_sequence<int, LAST_PHASE>{});
#endif
}
```

```cpp
#include <hip/hip_runtime.h>
#include <stdint.h>
#include <stdio.h>
#include <utility>

#ifndef ONE_LAUNCH
#define ONE_LAUNCH 1
#endif

constexpr int D = 1024, BATCH = 8, SEQ = 2048, M = BATCH * SEQ;
constexpr int A_W = 512, A_IN = 1792, EVEN_IN = 2816, FFN = 2816;
constexpr int ODD_IN = 2056, NE = 8, FE = 3584;
constexpr int MAXSLOT = 2 * M + NE * 256;
constexpr int NT = 512, NW = 8;

typedef unsigned short bf16;
typedef float f32x4 __attribute__((ext_vector_type(4)));
#define LAS __attribute__((address_space(3)))

enum {
  I_X = 0,
  I0_NPM, I0_WIN, I0_MU, I0_W0, I0_W2, I0_A0, I0_A2, I0_G2, I0_KK, I0_KA, I0_RK, I0_LNW, I0_LNB,
  I0_GLNW, I0_GLNB, I0_GWS, I0_GBS, I0_WOUT, I0_NPOM, I0_NPF, I0_FG, I0_FU, I0_FD, I0_NPOF,
  I1_NPM, I1_WIN, I1_ARE, I1_AIM, I1_LDT, I1_BRE, I1_BIM, I1_CRE, I1_CIM, I1_SD, I1_GLW, I1_GLB,
  I1_CW, I1_CB, I1_DTB, I1_ALOG, I1_MD, I1_MNW, I1_WOUT, I1_NPOM, I1_NPF, I1_RT, I1_MG, I1_MU, I1_MDN, I1_NPOF,
  N_IN
};
static_assert(N_IN == 51, "input count");

constexpr size_t MiB = 1ull << 20;
constexpr size_t WS_CTL = 0, CTL_BYTES = 1 * MiB;
constexpr size_t WS_WIN0 = 1 * MiB;
constexpr size_t WS_WOUT0 = 7 * MiB;
constexpr size_t WS_FGU = 9 * MiB;
constexpr size_t WS_FD = 20 * MiB;
constexpr size_t WS_WIN1 = 26 * MiB;
constexpr size_t WS_GLU = 30 * MiB;
constexpr size_t WS_WOUT1 = 31 * MiB;
constexpr size_t WS_MGU = 33 * MiB;
constexpr size_t WS_MD = 145 * MiB;
constexpr size_t WS_XN = 201 * MiB;
constexpr size_t WS_YMIX = 233 * MiB;
constexpr size_t WS_Y = 265 * MiB;
constexpr size_t WS_BIG = 329 * MiB;
constexpr size_t WS_P0 = WS_BIG;
constexpr size_t WS_SR = WS_MGU;
constexpr size_t WS_SW = WS_SR + 32 * MiB, WS_SK = WS_SW + 32 * MiB, WS_SV = WS_SK + 32 * MiB, WS_SA = WS_SV + 32 * MiB, WS_SB = WS_Y;
constexpr size_t WS_G = WS_P0 + 88 * MiB;
constexpr size_t WS_BON = WS_G + 32 * MiB;
constexpr size_t WS_L0END = WS_BON + 1 * MiB;
static_assert(WS_SA + 32 * MiB <= WS_XN, "streams inside the MoE weight region");
constexpr size_t WS_H = WS_BIG;
constexpr size_t WS_P1 = WS_BIG;
constexpr size_t WS_DT = WS_P1 + 64 * MiB;
constexpr size_t WS_CONV = WS_DT + 1 * MiB;
constexpr size_t WS_YC = WS_Y;
constexpr size_t WS_YSSD = WS_Y + 16 * MiB;
constexpr int FH = FE / 2;
constexpr size_t WS_HID = WS_BIG;
constexpr size_t WS_YS = WS_YMIX;
constexpr size_t WS_ROUTE = WS_BIG + 120 * MiB;
constexpr size_t WS_END = 462 * MiB;
static_assert(WS_L0END <= WS_END && WS_CONV + 64 * MiB <= WS_END && WS_ROUTE + 1 * MiB <= WS_END, "workspace map");
static_assert((size_t)MAXSLOT * FH * 2 <= 120 * MiB && (size_t)MAXSLOT * D * 2 <= 96 * MiB, "moe buffers");
constexpr int CW_BAR = 4096;
constexpr int CW_CNT = 8192;
constexpr int CW_CUR = 8192 + 64 * 8;
constexpr int CW_SLOTTOK = 65536;
static_assert((CW_SLOTTOK + MAXSLOT) * 4 <= (int)CTL_BYTES, "ctl");

constexpr int LDS_BYTES = 147456;

__device__ __forceinline__ float bf2f(bf16 v) { return __uint_as_float(((unsigned)v) << 16); }
__device__ __forceinline__ bf16 f2bf(float f) { unsigned u = __float_as_uint(f); u += 0x7fffu + ((u >> 16) & 1u); return (bf16)(u >> 16); }
__device__ __forceinline__ float wave_sum(float v) {
#pragma unroll
  for (int o = 32; o > 0; o >>= 1) v += __shfl_xor(v, o);
  return v;
}
__device__ __forceinline__ float sigmoid_(float x) { return 1.f / (1.f + expf(-x)); }
__device__ __forceinline__ float silu_(float x) { return x / (1.f + expf(-x)); }
__device__ __forceinline__ float gelu_(float x) { const float u = 0.7978845608028654f * (x + 0.044715f * x * x * x); return 0.5f * x * (1.f + tanhf(u)); }
__device__ __forceinline__ float softplus_(float x) { return fmaxf(x, 0.f) + log1pf(expf(-fabsf(x))); }

#define XB_TMO      128
#define XB_XCNT(j)  (256  + 64 * (j))
#define XB_XSUB(j)  (1280 + 64 * (j))
#define XB_XGEN(j)  (2304 + 64 * (j))
#define XB_TOP      3328
#define XB_TOPGEN   3392
#define XCD_BAR_WORDS 3456
#define XB_SPIN_CAP (1u << 22)

__device__ __forceinline__ unsigned xb_ld(unsigned* p)              { return __hip_atomic_load(p, __ATOMIC_RELAXED, __HIP_MEMORY_SCOPE_AGENT); }
__device__ __forceinline__ unsigned xb_add(unsigned* p, unsigned v) { return __hip_atomic_fetch_add(p, v, __ATOMIC_RELAXED, __HIP_MEMORY_SCOPE_AGENT); }
__device__ __forceinline__ unsigned xb_xcc_id() { return (unsigned)__builtin_amdgcn_s_getreg((3 << 11) | 20) & 0xFu; }
#define XB_SPIN(cond, bar) do { unsigned _sp = 0; while (cond) { __builtin_amdgcn_s_sleep(1); \
    if ((++_sp & 255u) == 0u) { if (xb_ld(&(bar)[XB_TMO])) break; if (_sp > XB_SPIN_CAP) { atomicAdd(&(bar)[XB_TMO], 1u); break; } } } } while (0)

struct XcdBarrier { unsigned* bar; unsigned x; volatile LAS unsigned* st; };

__device__ __forceinline__ XcdBarrier xcd_barrier_post(unsigned* bar, volatile LAS unsigned* st) {
    XcdBarrier b; b.bar = bar; b.x = xb_xcc_id(); b.st = st;
    if (threadIdx.x == 0) (void)xb_add(&bar[XB_XCNT(b.x)], 1u);
    return b;
}
__device__ __forceinline__ void xcd_barrier_complete(unsigned* bar, unsigned x, unsigned& nloc, unsigned& nx) {
    const unsigned G = gridDim.x * gridDim.y * gridDim.z;
    unsigned sum, cnt, mine, sp = 0u;
    for (;;) {
        sum = 0u; cnt = 0u; mine = 0u;
#pragma unroll
        for (unsigned j = 0; j < 16; ++j) { const unsigned c = xb_ld(&bar[XB_XCNT(j)]); sum += c; cnt += (c > 0u) ? 1u : 0u; mine = (j == x) ? c : mine; }
        if (sum == G) break;
        __builtin_amdgcn_s_sleep(1);
        if ((++sp & 255u) == 0u) { if (xb_ld(&bar[XB_TMO])) break; if (sp > XB_SPIN_CAP) { atomicAdd(&bar[XB_TMO], 1u); break; } }
    }
    nloc = mine > 0u ? mine : 1u; nx = cnt > 0u ? cnt : 1u;
}
__device__ __forceinline__ void xcd_barrier(const XcdBarrier& b) {
    asm volatile("s_waitcnt vmcnt(0)" ::: "memory");
    __syncthreads();
    if (threadIdx.x == 0) {
        unsigned* bar = b.bar;
        __builtin_amdgcn_s_waitcnt(0);
        unsigned nloc = b.st[0], nx = b.st[1];
        if (nloc == 0u) { xcd_barrier_complete(bar, b.x, nloc, nx); b.st[0] = nloc; b.st[1] = nx; }
        const unsigned old = xb_add(&bar[XB_XSUB(b.x)], 1u);
        const unsigned gen = old / nloc;
        if (old + 1u == (gen + 1u) * nloc) {
            __builtin_amdgcn_fence(__ATOMIC_RELEASE, "agent");
            asm volatile("s_waitcnt vmcnt(0)" ::: "memory");
            const unsigned og = xb_add(&bar[XB_TOP], 1u);
            const unsigned tg = og / nx;
            if (og + 1u == (tg + 1u) * nx) xb_add(&bar[XB_TOPGEN], 1u);
            else XB_SPIN(xb_ld(&bar[XB_TOPGEN]) == tg, bar);
            __builtin_amdgcn_fence(__ATOMIC_ACQUIRE, "agent");
            xb_add(&bar[XB_XGEN(b.x)], 1u);
            asm volatile("s_waitcnt vmcnt(0)" ::: "memory");
        } else {
            XB_SPIN(xb_ld(&bar[XB_XGEN(b.x)]) == gen, bar);
            __builtin_amdgcn_fence(__ATOMIC_ACQUIRE, "agent");
            asm volatile("s_waitcnt vmcnt(0)" ::: "memory");
        }
    }
    __syncthreads();
}

struct Args { const float* in[N_IN]; float* out; unsigned char* ws; int lo, hi; };
struct Ctx {
  float* out; unsigned char* ws; unsigned* ctl;
  unsigned char* lds;
  int tid, lane, wave, bid, G;
};
__device__ __forceinline__ Ctx launder(Ctx c) {
  asm volatile("" : "+v"(c.tid), "+v"(c.lane));
  asm volatile("" : "+s"(c.wave), "+s"(c.bid), "+s"(c.G));
  return c;
}
constexpr int LDS_PTAB = LDS_BYTES - 1024;
constexpr int LDS_BST = LDS_BYTES - 16;
__device__ __forceinline__ const float* inp(const Ctx& c, int k) {
  const LAS unsigned* pt = (const LAS unsigned*)(LAS unsigned char*)(c.lds + LDS_PTAB);
  const unsigned lo = __builtin_amdgcn_readfirstlane(pt[2 * k]), hi = __builtin_amdgcn_readfirstlane(pt[2 * k + 1]);
  return (const float*)(((unsigned long long)hi << 32) | lo);
}


namespace mg {
typedef short bf16x8 __attribute__((ext_vector_type(8)));
typedef unsigned u32x4 __attribute__((ext_vector_type(4)));
constexpr int BM = 256, BK = 64, HALF = 128, HTB = HALF * BK * 2, STAGE_BYTES = 8 * HTB, NXCD = 8, WGM = 8;
constexpr int LDS_IDX = STAGE_BYTES;
__host__ __device__ __forceinline__ int lds_byte(int r, int c) { const int st = (r >> 4) * 2 + (c >> 5), rr = r & 15, cc = c & 31, ob = rr * 64 + cc * 2; return st * 1024 + (ob ^ (((ob >> 9) & 1) << 5)); }
__host__ __device__ __forceinline__ void stage_rc(int b, int& R, int& C) { const int st = b / 1024, sb = b % 1024, swz = sb ^ (((sb >> 9) & 1) << 5); R = (st >> 1) * 16 + swz / 64; C = (st & 1) * 32 + (swz % 64) / 2; }
__host__ __device__ __forceinline__ int perm32(int rho) { const int n = rho >> 4, i = rho & 15; return 8 * (i >> 2) + 4 * n + (i & 3); }
struct Unit { int pm, pn; };
struct Gemm { const bf16* A; const bf16* Bt; int lda, ldb, K; };

struct Tiles {
  int nM, nN, nwg, G, c;
  __device__ __forceinline__ void init(int nM_, int nN_, int G_, int c_) { nM = nM_; nN = nN_; nwg = nM * nN; G = G_; c = c_; }
  __device__ __forceinline__ bool next(int i, Unit& u) const {
    const long L = (long)i * G + c; if (L >= nwg) return false;
    int wgid = (int)L; { const int q = nwg / NXCD, r = nwg % NXCD, xcd = wgid % NXCD, off = wgid / NXCD; wgid = (xcd < r ? xcd * (q + 1) : r * (q + 1) + (xcd - r) * q) + off; }
    const int nig = WGM * nN, gid = wgid / nig, fm = gid * WGM, gsz = (nM - fm) < WGM ? (nM - fm) : WGM;
    u.pm = fm + ((wgid % nig) % gsz); u.pn = (wgid % nig) / gsz; return true;
  }
};
struct DenseOrder : Tiles {
  static constexpr bool GATHER = false;
  const int* rowidx;
  __device__ __forceinline__ const char* a_tile(const Gemm& g, const Unit& u) const { return (const char*)g.A + (size_t)u.pm * BM * g.lda * 2; }
  __device__ __forceinline__ const char* b_tile(const Gemm& g, const Unit& u) const { return (const char*)g.Bt + (size_t)u.pn * BM * g.ldb * 2; }
};
template <bool GATHER_> struct MoeOrder : Tiles {
  static constexpr bool GATHER = GATHER_;
  int pend[8]; size_t bstride_e, boff; const int* rowidx;
  __device__ __forceinline__ int expert(int pm) const { int e = 0;
#pragma unroll
    for (int q = 0; q < 7; ++q) e += (pm * BM >= pend[q]) ? 1 : 0;
    return e; }
  __device__ __forceinline__ const char* a_tile(const Gemm& g, const Unit& u) const { return (const char*)g.A + (size_t)u.pm * BM * g.lda * 2; }
  __device__ __forceinline__ const char* b_tile(const Gemm& g, const Unit& u) const { return (const char*)g.Bt + (size_t)expert(u.pm) * bstride_e + boff + (size_t)u.pn * BM * g.ldb * 2; }
};

__device__ __forceinline__ unsigned cvt_pk_bf16(float lo, float hi) { unsigned r; asm volatile("v_cvt_pk_bf16_f32 %0, %1, %2" : "=v"(r) : "v"(lo), "v"(hi)); return r; }

struct EpiF32 { static constexpr bool PERM = false; float* C; int ldc;
  __device__ __forceinline__ void operator()(const f32x4 (&acc)[2][2][4][2], const Unit& u, int wr, int wc, int fr, int fq) const {
    const int row0 = u.pm * BM + wr * 64 + fr, col0 = u.pn * BM + wc * 32 + 4 * fq;
#pragma unroll
    for (int ai = 0; ai < 2; ++ai)
#pragma unroll
      for (int m = 0; m < 4; ++m) { float* rowp = C + (size_t)(row0 + ai * HALF + m * 16) * ldc + col0;
#pragma unroll
        for (int bj = 0; bj < 2; ++bj)
#pragma unroll
          for (int n = 0; n < 2; ++n) *(f32x4*)(rowp + bj * HALF + n * 16) = acc[ai][bj][m][n]; }
  } };
template <bool ACCUM> struct EpiBf16 { static constexpr bool PERM = true; bf16* O; int ldc;
  __device__ __forceinline__ void operator()(const f32x4 (&acc)[2][2][4][2], const Unit& u, int wr, int wc, int fr, int fq) const {
    const int row0 = u.pm * BM + wr * 64 + fr, col0 = u.pn * BM + wc * 32 + 8 * fq;
#pragma unroll
    for (int ai = 0; ai < 2; ++ai)
#pragma unroll
      for (int m = 0; m < 4; ++m) { bf16* rowp = O + (size_t)(row0 + ai * HALF + m * 16) * ldc + col0;
#pragma unroll
        for (int bj = 0; bj < 2; ++bj) { f32x4 v0 = acc[ai][bj][m][0], v1 = acc[ai][bj][m][1];
          if (ACCUM) { const u32x4 o = *(const u32x4*)(rowp + bj * HALF);
            v0[0] += __uint_as_float(o.x << 16); v0[1] += __uint_as_float(o.x & 0xffff0000u); v0[2] += __uint_as_float(o.y << 16); v0[3] += __uint_as_float(o.y & 0xffff0000u);
            v1[0] += __uint_as_float(o.z << 16); v1[1] += __uint_as_float(o.z & 0xffff0000u); v1[2] += __uint_as_float(o.w << 16); v1[3] += __uint_as_float(o.w & 0xffff0000u); }
          u32x4 w; w.x = cvt_pk_bf16(v0[0], v0[1]); w.y = cvt_pk_bf16(v0[2], v0[3]); w.z = cvt_pk_bf16(v1[0], v1[1]); w.w = cvt_pk_bf16(v1[2], v1[3]);
          *(u32x4*)(rowp + bj * HALF) = w; } }
  } };
struct EpiSwigluT { static constexpr bool PERM = true; bf16* O; int ldc;
  __device__ __forceinline__ void operator()(const f32x4 (&acc)[2][2][4][2], const Unit& u, int wr, int wc, int fr, int fq) const {
    const int row0 = u.pm * BM + wr * 64 + fr, col0 = u.pn * HALF + wc * 32 + 8 * fq;
#pragma unroll
    for (int ai = 0; ai < 2; ++ai)
#pragma unroll
      for (int m = 0; m < 4; ++m) { bf16* rowp = O + (size_t)(row0 + ai * HALF + m * 16) * ldc + col0;
        float h[8];
#pragma unroll
        for (int n = 0; n < 2; ++n)
#pragma unroll
          for (int e = 0; e < 4; ++e) { const float gte = acc[ai][0][m][n][e], up = acc[ai][1][m][n][e]; h[n * 4 + e] = gte * __builtin_amdgcn_rcpf(1.f + __expf(-gte)) * up; }
        u32x4 w; w.x = cvt_pk_bf16(h[0], h[1]); w.y = cvt_pk_bf16(h[2], h[3]); w.z = cvt_pk_bf16(h[4], h[5]); w.w = cvt_pk_bf16(h[6], h[7]);
        *(u32x4*)rowp = w; }
  } };
struct EpiGluT { static constexpr bool PERM = true; bf16* O; int ldc; const bf16* Yc; const float* bias;
  __device__ __forceinline__ void operator()(const f32x4 (&acc)[2][2][4][2], const Unit& u, int wr, int wc, int fr, int fq) const {
    const int row0 = u.pm * BM + wr * 64 + fr, col0 = u.pn * BM + wc * 32 + 8 * fq;
#pragma unroll
    for (int ai = 0; ai < 2; ++ai)
#pragma unroll
      for (int m = 0; m < 4; ++m) { const int row = row0 + ai * HALF + m * 16;
#pragma unroll
        for (int bj = 0; bj < 2; ++bj) { const int col = col0 + bj * HALF;
          const u32x4 yv = *(const u32x4*)(Yc + (size_t)row * 512 + col);
          const f32x4 b0 = *(const f32x4*)(bias + col), b1 = *(const f32x4*)(bias + col + 4);
          const float y[8] = {__uint_as_float(yv.x << 16), __uint_as_float(yv.x & 0xffff0000u), __uint_as_float(yv.y << 16), __uint_as_float(yv.y & 0xffff0000u),
                              __uint_as_float(yv.z << 16), __uint_as_float(yv.z & 0xffff0000u), __uint_as_float(yv.w << 16), __uint_as_float(yv.w & 0xffff0000u)};
          float h[8];
#pragma unroll
          for (int e = 0; e < 4; ++e) { h[e] = y[e] * __builtin_amdgcn_rcpf(1.f + __expf(-(acc[ai][bj][m][0][e] + b0[e]))); h[4 + e] = y[4 + e] * __builtin_amdgcn_rcpf(1.f + __expf(-(acc[ai][bj][m][1][e] + b1[e]))); }
          u32x4 w; w.x = cvt_pk_bf16(h[0], h[1]); w.y = cvt_pk_bf16(h[2], h[3]); w.z = cvt_pk_bf16(h[4], h[5]); w.w = cvt_pk_bf16(h[6], h[7]);
          *(u32x4*)(O + (size_t)row * ldc + col) = w; } }
  } };

template <class Epi, class Sched>
__device__ __forceinline__ void gemm_phase(LAS unsigned char* lds, const Gemm g, const Sched& S, const Epi& E) {
  const int tid = threadIdx.x, wid = __builtin_amdgcn_readfirstlane(tid >> 6), lane = tid & 63, wr = wid >> 2, wc = wid & 3, fr = lane & 15, fq = lane >> 4;
  const int K = g.K, nt = K / BK;
  unsigned voffA[2], voffB[2]; int gR[2], gC[2];
#pragma unroll
  for (int i = 0; i < 2; ++i) { int R, C; stage_rc(tid * 16 + i * 8192, R, C); const int Rb = Epi::PERM ? ((R & ~31) + perm32(R & 31)) : R;
    voffA[i] = (unsigned)(R * g.lda + C) * 2u; voffB[i] = (unsigned)(Rb * g.ldb + C) * 2u; gR[i] = R; gC[i] = C * 2; }
  const size_t kstep = (size_t)(BK * 2);
  const size_t hstepA = (size_t)HALF * g.lda * 2, hstepB = (size_t)HALF * g.ldb * 2;
  const unsigned ldsw = (unsigned)wid * 1024u;
  const unsigned rowb = (unsigned)g.lda * 2u;
  const int aoff = lds_byte(wr * 64 + fr, fq * 8), boff = lds_byte(wc * 32 + fr, fq * 8);
#define PG8_SA(b, h) (((b) * 2 + (h)) * HTB)
#define PG8_SB(b, h) ((4 + (b) * 2 + (h)) * HTB)
#define PG8_STAGE(bufoff, gbase, voff) do { _Pragma("unroll") for (int _i = 0; _i < 2; ++_i) \
    __builtin_amdgcn_global_load_lds((const unsigned*)((const char*)(gbase) + (voff)[_i]), (LAS unsigned*)(lds + (bufoff) + ldsw + _i * 8192), 16, 0, 0); } while (0)
#define PG8_STAGE_A(bufoff, p, h, goff) do { if constexpr (Sched::GATHER) PG8_STAGE(bufoff, p, (goff)[h]); else PG8_STAGE(bufoff, (p) + (h) * hstepA, voffA); } while (0)
#define PG8_LDA(dst, b, h) do { _Pragma("unroll") for (int m = 0; m < 4; ++m) _Pragma("unroll") for (int k = 0; k < 2; ++k) dst[m][k] = *(const LAS bf16x8*)(lds + PG8_SA(b, h) + aoff + m * 2048 + k * 1024); } while (0)
#define PG8_LDB(dst, b, h) do { _Pragma("unroll") for (int n = 0; n < 2; ++n) _Pragma("unroll") for (int k = 0; k < 2; ++k) dst[n][k] = *(const LAS bf16x8*)(lds + PG8_SB(b, h) + boff + n * 2048 + k * 1024); } while (0)
#define PG8_MMA(ai, bj, At, Bt) do { __builtin_amdgcn_s_setprio(1); _Pragma("unroll") for (int m = 0; m < 4; ++m) _Pragma("unroll") for (int n = 0; n < 2; ++n) _Pragma("unroll") for (int k = 0; k < 2; ++k) \
    acc[ai][bj][m][n] = __builtin_amdgcn_mfma_f32_16x16x32_bf16(Bt[n][k], At[m][k], acc[ai][bj][m][n], 0, 0, 0); __builtin_amdgcn_s_setprio(0); } while (0)
#define PG8_WAIT_V(n) asm volatile("s_waitcnt vmcnt(" #n ")" ::: "memory")
#define PG8_WAIT_L(n) asm volatile("s_waitcnt lgkmcnt(" #n ")" ::: "memory")
#define PG8_BAR __builtin_amdgcn_s_barrier()
#define PG8_SCHED __builtin_amdgcn_sched_barrier(0)
  Unit cur, nxt; int ui = 0;
  if (!S.next(0, cur)) return;
  f32x4 acc[2][2][4][2];
#pragma unroll
  for (int a = 0; a < 2; ++a)
#pragma unroll
    for (int b = 0; b < 2; ++b)
#pragma unroll
      for (int m = 0; m < 4; ++m)
#pragma unroll
        for (int n = 0; n < 2; ++n) acc[a][b][m][n] = (f32x4){0.f, 0.f, 0.f, 0.f};
  bf16x8 At[4][2], B0[2][2], B1[2][2];
  unsigned gcu[2][2] = {{0u, 0u}, {0u, 0u}};
  const char* cA = Sched::GATHER ? (const char*)g.A : S.a_tile(g, cur); const char* cB = S.b_tile(g, cur);
  if constexpr (Sched::GATHER) {
#pragma unroll
    for (int h = 0; h < 2; ++h)
#pragma unroll
      for (int i = 0; i < 2; ++i) gcu[h][i] = (unsigned)S.rowidx[cur.pm * BM + h * HALF + gR[i]] * rowb + (unsigned)gC[i];
  }
  PG8_STAGE(PG8_SB(0, 0), cB, voffB); PG8_STAGE(PG8_SB(0, 1), cB + hstepB, voffB); PG8_STAGE_A(PG8_SA(0, 0), cA, 0, gcu); PG8_STAGE_A(PG8_SA(0, 1), cA, 1, gcu);
  if (wr == 1) PG8_BAR;
  PG8_WAIT_V(2); PG8_BAR;
  PG8_STAGE(PG8_SB(1, 0), cB + kstep, voffB); PG8_STAGE_A(PG8_SA(1, 0), cA + kstep, 0, gcu); PG8_STAGE(PG8_SB(1, 1), cB + hstepB + kstep, voffB);
  PG8_WAIT_V(6); PG8_BAR;
  for (;;) {
    const bool has_next = S.next(ui + 1, nxt);
    const char* nA = Sched::GATHER ? (const char*)g.A : (has_next ? S.a_tile(g, nxt) : cA); const char* nB = has_next ? S.b_tile(g, nxt) : cB;
    if constexpr (Sched::GATHER) {
      if (has_next && wid < 4) __builtin_amdgcn_global_load_lds((const unsigned*)(S.rowidx + nxt.pm * BM + wid * 64 + lane), (LAS unsigned*)(lds + LDS_IDX + ((ui + 1) & 1) * 1024 + wid * 256), 4, 0, 0);
    }
    for (int t = 0; t < nt; t += 2) {
      const bool last = (t == nt - 2);
      const char* a1 = cA + (size_t)(t + 1) * kstep;
      const char* a2 = last ? nA : cA + (size_t)(t + 2) * kstep; const char* b2 = last ? nB : cB + (size_t)(t + 2) * kstep;
      const char* a3 = a2 + kstep; const char* b3 = b2 + kstep;
      unsigned g2[2][2];
#pragma unroll
      for (int h = 0; h < 2; ++h)
#pragma unroll
        for (int i = 0; i < 2; ++i) g2[h][i] = gcu[h][i];
      if constexpr (Sched::GATHER) {
        if (last && has_next) {
          const LAS unsigned* ix = (const LAS unsigned*)(lds + LDS_IDX + ((ui + 1) & 1) * 1024);
#pragma unroll
          for (int h = 0; h < 2; ++h)
#pragma unroll
            for (int i = 0; i < 2; ++i) g2[h][i] = ix[h * HALF + gR[i]] * rowb + (unsigned)gC[i];
        }
      }
      PG8_LDB(B0, 0, 0); PG8_LDB(B1, 0, 1); PG8_SCHED; PG8_LDA(At, 0, 0); PG8_STAGE_A(PG8_SA(1, 1), a1, 1, gcu);
      PG8_WAIT_V(8); PG8_WAIT_L(0); PG8_BAR; PG8_MMA(0, 0, At, B0); PG8_MMA(0, 1, At, B1); PG8_BAR; PG8_SCHED;
      PG8_LDA(At, 0, 1); PG8_STAGE(PG8_SB(0, 0), b2, voffB); PG8_STAGE(PG8_SB(0, 1), b2 + hstepB, voffB); PG8_STAGE_A(PG8_SA(0, 0), a2, 0, g2);
      PG8_WAIT_V(8); PG8_WAIT_L(0); PG8_BAR; PG8_MMA(1, 0, At, B0); PG8_MMA(1, 1, At, B1); PG8_BAR; PG8_SCHED;
      PG8_LDB(B0, 1, 0); PG8_LDB(B1, 1, 1); PG8_SCHED; PG8_LDA(At, 1, 0); PG8_STAGE_A(PG8_SA(0, 1), a2, 1, g2);
      PG8_WAIT_V(8); PG8_WAIT_L(0); PG8_BAR; PG8_MMA(0, 0, At, B0); PG8_MMA(0, 1, At, B1); PG8_BAR; PG8_SCHED;
      PG8_LDA(At, 1, 1); PG8_STAGE(PG8_SB(1, 0), b3, voffB); PG8_STAGE(PG8_SB(1, 1), b3 + hstepB, voffB); PG8_STAGE_A(PG8_SA(1, 0), a3, 0, g2);
      PG8_WAIT_V(8); PG8_WAIT_L(0); PG8_BAR; PG8_MMA(1, 0, At, B0); PG8_MMA(1, 1, At, B1); PG8_BAR; PG8_SCHED;
      if constexpr (Sched::GATHER) { if (last) {
#pragma unroll
        for (int h = 0; h < 2; ++h)
#pragma unroll
          for (int i = 0; i < 2; ++i) gcu[h][i] = g2[h][i]; } }
    }
    if (wr == 0) PG8_BAR;
    E(acc, cur, wr, wc, fr, fq);
    if (!has_next) break;
#pragma unroll
    for (int a = 0; a < 2; ++a)
#pragma unroll
      for (int b = 0; b < 2; ++b)
#pragma unroll
        for (int m = 0; m < 4; ++m)
#pragma unroll
          for (int n = 0; n < 2; ++n) acc[a][b][m][n] = (f32x4){0.f, 0.f, 0.f, 0.f};
    cur = nxt; cA = nA; cB = nB; ++ui;
    if (wr == 1) PG8_BAR;
  }
  PG8_WAIT_V(0);
  PG8_BAR;
#undef PG8_SA
#undef PG8_SB
#undef PG8_STAGE
#undef PG8_STAGE_A
#undef PG8_LDA
#undef PG8_LDB
#undef PG8_MMA
#undef PG8_WAIT_V
#undef PG8_WAIT_L
#undef PG8_BAR
#undef PG8_SCHED
}
}

__device__ __forceinline__ void cvt_item(const float* W, int ldw, bf16* WT, int Kd, int dst_row0, int k0, int n0, float* scr, int lane) {
#pragma unroll 8
  for (int i = 0; i < 32; ++i) { const int kk = 2 * i + (lane >> 5); scr[kk * 33 + (lane & 31)] = W[(size_t)(k0 + kk) * ldw + n0 + (lane & 31)]; }
  __builtin_amdgcn_s_waitcnt(0); __builtin_amdgcn_wave_barrier();
  const int cch = lane & 7;
#pragma unroll
  for (int j = 0; j < 4; ++j) { const int n = (lane >> 3) + 8 * j; const float* sp = scr + (8 * cch) * 33 + n;
    mg::u32x4 o; o.x = mg::cvt_pk_bf16(sp[0 * 33], sp[1 * 33]); o.y = mg::cvt_pk_bf16(sp[2 * 33], sp[3 * 33]); o.z = mg::cvt_pk_bf16(sp[4 * 33], sp[5 * 33]); o.w = mg::cvt_pk_bf16(sp[6 * 33], sp[7 * 33]);
    *(mg::u32x4*)(WT + (size_t)(dst_row0 + n) * Kd + k0 + 8 * cch) = o; }
  __builtin_amdgcn_s_waitcnt(0); __builtin_amdgcn_wave_barrier();
}
__device__ __forceinline__ void cvt_mat_item(const float* W, int K, int N, int ldw, bf16* WT, int mode, int it, float* scr, int lane) {
  const int nblk = N / 32, kb = it / nblk, nb = it % nblk, n0 = nb * 32;
  const int dst = mode == 0 ? n0 : ((n0 >> 7) * 256 + (n0 & 127) + (mode == 2 ? 128 : 0));
  cvt_item(W, ldw, WT, K, dst, kb * 64, n0, scr, lane);
}
__device__ __forceinline__ void cvt_dense(const Ctx& c) {
  float* scr = (float*)c.lds + c.wave * 4096;
  const float* win0 = inp(c, I0_WIN); const float* wout0 = inp(c, I0_WOUT); const float* fg = inp(c, I0_FG); const float* fu = inp(c, I0_FU); const float* fd = inp(c, I0_FD);
  const float* win1 = inp(c, I1_WIN); const float* glw = inp(c, I1_GLW); const float* wout1 = inp(c, I1_WOUT);
  unsigned char* ws = c.ws;
  for (int it = c.wave * c.G + c.bid; it < 7808; it += NW * c.G) {
    int r = it;
    if (r < 1408) { cvt_mat_item(win0, D, EVEN_IN, EVEN_IN, (bf16*)(ws + WS_WIN0), 0, r, scr, c.lane); continue; } r -= 1408;
    if (r < 512) { cvt_mat_item(wout0, D, D, D, (bf16*)(ws + WS_WOUT0), 0, r, scr, c.lane); continue; } r -= 512;
    if (r < 1408) { cvt_mat_item(fg, D, FFN, FFN, (bf16*)(ws + WS_FGU), 1, r, scr, c.lane); continue; } r -= 1408;
    if (r < 1408) { cvt_mat_item(fu, D, FFN, FFN, (bf16*)(ws + WS_FGU), 2, r, scr, c.lane); continue; } r -= 1408;
    if (r < 1408) { cvt_mat_item(fd, FFN, D, D, (bf16*)(ws + WS_FD), 0, r, scr, c.lane); continue; } r -= 1408;
    if (r < 1024) { cvt_mat_item(win1, D, 2048, ODD_IN, (bf16*)(ws + WS_WIN1), 0, r, scr, c.lane); continue; } r -= 1024;
    if (r < 128) { cvt_mat_item(glw, 512, 512, 512, (bf16*)(ws + WS_GLU), 0, r, scr, c.lane); continue; } r -= 128;
    cvt_mat_item(wout1, D, D, D, (bf16*)(ws + WS_WOUT1), 0, r, scr, c.lane);
  }
}
__device__ __forceinline__ void cvt_moe(const Ctx& c, int vb, int vG) {
  float* scr = (float*)c.lds + c.wave * 4096;
  const float* mgp = inp(c, I1_MG); const float* mup = inp(c, I1_MU); const float* mdp = inp(c, I1_MDN);
  for (int it = c.wave * vG + vb; it < 8 * 5376; it += NW * vG) {
    const int e = it / 5376, r = it % 5376, which = r / 1792, idx = r % 1792;
    if (which == 0) cvt_mat_item(mgp + (size_t)e * D * FE, D, FE, FE, (bf16*)(c.ws + WS_MGU) + (size_t)e * 2 * FE * D, 1, idx, scr, c.lane);
    else if (which == 1) cvt_mat_item(mup + (size_t)e * D * FE, D, FE, FE, (bf16*)(c.ws + WS_MGU) + (size_t)e * 2 * FE * D, 2, idx, scr, c.lane);
    else cvt_mat_item(mdp + (size_t)e * FE * D, FE, D, D, (bf16*)(c.ws + WS_MD) + (size_t)e * D * FE, 0, idx, scr, c.lane);
  }
}


template <int YMODE, int PROJ>
__device__ __forceinline__ void norm_phase(const Ctx& c, const float* resin, float* resout, const float* Y, const float* gpost, const float* gpre, bf16* XN,
                                           const float* W8, int ldw8, int c0, float* out8) {
  float* w8s = (float*)c.lds;
  LAS unsigned* hist = (LAS unsigned*)(c.lds + 32768);
  if (PROJ) {
    for (int i = c.tid; i < 1024 * 8; i += NT) w8s[i] = W8[(size_t)(i >> 3) * ldw8 + c0 + (i & 7)];
    if (PROJ == 2 && c.tid < 8) hist[c.tid] = 0u;
    __syncthreads();
  }
  int* tok_e = (int*)(c.ws + WS_ROUTE); float* tok_g = (float*)(c.ws + WS_ROUTE + 128 * 1024);
  const int* tok_slot = (const int*)(c.ws + WS_ROUTE + 256 * 1024);
  const bf16* YS = (const bf16*)(c.ws + WS_YS);
  for (int m = c.wave * c.G + c.bid; m < M; m += NW * c.G) {
    f32x4 r[4];
#pragma unroll
    for (int j = 0; j < 4; ++j) r[j] = *(const f32x4*)(resin + (size_t)m * D + j * 256 + c.lane * 4);
    if (YMODE) {
      f32x4 y[4]; float ss = 0.f;
      if (YMODE == 1) {
#pragma unroll
        for (int j = 0; j < 4; ++j) y[j] = *(const f32x4*)(Y + (size_t)m * D + j * 256 + c.lane * 4);
      } else {
        const int s0 = tok_slot[2 * m], s1 = tok_slot[2 * m + 1]; const float g0 = tok_g[2 * m], g1 = tok_g[2 * m + 1];
#pragma unroll
        for (int j = 0; j < 4; ++j) {
          const uint2 a = *(const uint2*)(YS + (size_t)s0 * D + j * 256 + c.lane * 4), b = *(const uint2*)(YS + (size_t)s1 * D + j * 256 + c.lane * 4);
          y[j][0] = g0 * bf2f((bf16)(a.x & 0xffff)) + g1 * bf2f((bf16)(b.x & 0xffff));
          y[j][1] = g0 * bf2f((bf16)(a.x >> 16)) + g1 * bf2f((bf16)(b.x >> 16));
          y[j][2] = g0 * bf2f((bf16)(a.y & 0xffff)) + g1 * bf2f((bf16)(b.y & 0xffff));
          y[j][3] = g0 * bf2f((bf16)(a.y >> 16)) + g1 * bf2f((bf16)(b.y >> 16));
        }
      }
#pragma unroll
      for (int j = 0; j < 4; ++j) ss += y[j][0] * y[j][0] + y[j][1] * y[j][1] + y[j][2] * y[j][2] + y[j][3] * y[j][3];
      const float rs = rsqrtf(wave_sum(ss) * (1.f / D) + 1e-6f);
#pragma unroll
      for (int j = 0; j < 4; ++j) {
        const f32x4 g = *(const f32x4*)(gpost + j * 256 + c.lane * 4);
        r[j] = r[j] + y[j] * rs * g;
        *(f32x4*)(resout + (size_t)m * D + j * 256 + c.lane * 4) = r[j];
      }
    }
    if (gpre) {
      float ss = 0.f;
#pragma unroll
      for (int j = 0; j < 4; ++j) ss += r[j][0] * r[j][0] + r[j][1] * r[j][1] + r[j][2] * r[j][2] + r[j][3] * r[j][3];
      const float rs = rsqrtf(wave_sum(ss) * (1.f / D) + 1e-6f);
      float p8[8];
#pragma unroll
      for (int q = 0; q < 8; ++q) p8[q] = 0.f;
#pragma unroll
      for (int j = 0; j < 4; ++j) {
        const f32x4 g = *(const f32x4*)(gpre + j * 256 + c.lane * 4);
        const f32x4 xn = r[j] * rs * g;
        uint2 o; o.x = (unsigned)f2bf(xn[0]) | ((unsigned)f2bf(xn[1]) << 16); o.y = (unsigned)f2bf(xn[2]) | ((unsigned)f2bf(xn[3]) << 16);
        *(uint2*)(XN + (size_t)m * D + j * 256 + c.lane * 4) = o;
        if (PROJ) {
#pragma unroll
          for (int e = 0; e < 4; ++e) {
            const float* wr = w8s + (j * 256 + c.lane * 4 + e) * 8;
#pragma unroll
            for (int q = 0; q < 8; ++q) p8[q] += xn[e] * wr[q];
          }
        }
      }
      if (PROJ) {
#pragma unroll
        for (int q = 0; q < 8; ++q) p8[q] = wave_sum(p8[q]);
        if (PROJ == 1) { if (c.lane < 8) { float v = p8[0];
#pragma unroll
            for (int q = 1; q < 8; ++q) v = (c.lane == q) ? p8[q] : v;
            out8[(size_t)m * 8 + c.lane] = v; } }
        if (PROJ == 2 && c.lane == 0) {
          int e0 = 0; float v0 = p8[0];
#pragma unroll
          for (int q = 1; q < 8; ++q) if (p8[q] > v0) { v0 = p8[q]; e0 = q; }
          int e1 = -1; float v1 = -3.0e38f;
#pragma unroll
          for (int q = 0; q < 8; ++q) if (q != e0 && p8[q] > v1) { v1 = p8[q]; e1 = q; }
          const float g1 = 1.f / (1.f + expf(v0 - v1)), g0 = 1.f - g1;
          tok_e[2 * m] = e0; tok_e[2 * m + 1] = e1; tok_g[2 * m] = g0; tok_g[2 * m + 1] = g1;
          atomicAdd((unsigned*)&hist[e0], 1u); atomicAdd((unsigned*)&hist[e1], 1u);
        }
      }
    }
  }
  if (PROJ == 2) { __syncthreads(); if (c.tid < 8) atomicAdd(c.ctl + CW_CNT + 64 * c.tid, hist[c.tid]); }
  __syncthreads();
}

__device__ __forceinline__ void rwkv_prep(const Ctx& c) {
  const float* mu = inp(c, I0_MU); const float* w0 = inp(c, I0_W0); const float* w2 = inp(c, I0_W2); const float* a0 = inp(c, I0_A0); const float* a2 = inp(c, I0_A2);
  const float* g2 = inp(c, I0_G2); const float* kkp = inp(c, I0_KK); const float* kap = inp(c, I0_KA); const float* rkp = inp(c, I0_RK);
  const bf16* P = (const bf16*)(c.ws + WS_P0);
  float* SR = (float*)(c.ws + WS_SR); float* SW = (float*)(c.ws + WS_SW); float* SK = (float*)(c.ws + WS_SK); float* SV = (float*)(c.ws + WS_SV);
  float* SA = (float*)(c.ws + WS_SA); float* SB = (float*)(c.ws + WS_SB); float* GG = (float*)(c.ws + WS_G); float* BON = (float*)(c.ws + WS_BON);
  float* ps = (float*)c.lds + c.wave * A_IN;
  for (int m = c.wave * c.G + c.bid; m < M; m += NW * c.G) {
    const int t = m % SEQ;
    for (int i = c.lane; i < A_IN; i += 64) {
      const float cur = bf2f(P[(size_t)m * EVEN_IN + i]);
      const float prev = t > 0 ? bf2f(P[(size_t)(m - 1) * EVEN_IN + i]) : 0.f;
      float v = cur + (prev - cur) * mu[i];
      if (i >= 1536 && i < 1600) v = tanhf(v);
      if (i >= 1664) v = sigmoid_(v);
      ps[i] = v;
    }
    __builtin_amdgcn_s_waitcnt(0); __builtin_amdgcn_wave_barrier();
    for (int j = 0; j < 8; ++j) {
      const int ch = j * 64 + c.lane;
      float aw = w0[ch], aa = a0[ch], ag = 0.f;
      for (int i = 0; i < 64; ++i) { aw += ps[1536 + i] * w2[i * 512 + ch]; aa += ps[1600 + i] * a2[i * 512 + ch]; }
      for (int i = 0; i < 128; ++i) ag += ps[1664 + i] * g2[i * 512 + ch];
      const float wl = -softplus_(-aw) - 0.5f;
      const float decay = expf(-expf(wl));
      const float a = sigmoid_(aa);
      const float r = ps[ch], k = ps[512 + ch], v = ps[1024 + ch];
      float kk = k * kkp[ch];
      const float nrm = sqrtf(wave_sum(kk * kk));
      kk = kk / fmaxf(nrm, 1e-12f);
      const float k2 = k * (1.f + (a - 1.f) * kap[ch]);
      const float bon = wave_sum(r * k2 * rkp[ch]);
      const size_t o = (size_t)m * 512 + ch;
      SR[o] = r; SW[o] = decay; SK[o] = k2; SV[o] = v; SA[o] = -kk; SB[o] = kk * a; GG[o] = ag;
      if (c.lane == 0) BON[(size_t)m * 8 + j] = bon;
    }
    __builtin_amdgcn_s_waitcnt(0); __builtin_amdgcn_wave_barrier();
  }
  __syncthreads();
}

template <int CTRL> __device__ __forceinline__ float dpp_f(float v) { return __int_as_float(__builtin_amdgcn_update_dpp(0, __float_as_int(v), CTRL, 0xf, 0xf, true)); }
__device__ __forceinline__ float row16_sum(float v) { v += dpp_f<0xB1>(v); v += dpp_f<0x4E>(v); v += dpp_f<0x141>(v); v += dpp_f<0x140>(v); return v; }
constexpr size_t WS_YSC = WS_XN;
__device__ __forceinline__ void rwkv_scan(const Ctx& c) {
  const float* ST[6] = {(const float*)(c.ws + WS_SR), (const float*)(c.ws + WS_SW), (const float*)(c.ws + WS_SK), (const float*)(c.ws + WS_SV), (const float*)(c.ws + WS_SA), (const float*)(c.ws + WS_SB)};
  float* YO = (float*)(c.ws + WS_YSC);
  float* buf = (float*)c.lds;
  float* ysm = (float*)c.lds + 2 * 6 * 32 * 64;
  const int ltt = c.tid >> 4, lq = c.tid & 15;
  const int rr = c.lane >> 4, kq = c.lane & 15, rloc = c.wave * 4 + rr;
  for (int it = c.bid; it < BATCH * 8 * 2; it += c.G) {
    const int b = it >> 4, h = (it >> 1) & 7, half = it & 1;
    const size_t m0 = (size_t)b * SEQ;
    const int row = half * 32 + rloc;
    f32x4 S = {0.f, 0.f, 0.f, 0.f};
    f32x4 ld[6];
    __syncthreads();
#pragma unroll
    for (int s6 = 0; s6 < 6; ++s6) ld[s6] = *(const f32x4*)(ST[s6] + (m0 + ltt) * 512 + h * 64 + lq * 4);
#pragma unroll
    for (int s6 = 0; s6 < 6; ++s6) *(f32x4*)(buf + ((0 * 6 + s6) * 32 + ltt) * 64 + lq * 4) = ld[s6];
    __syncthreads();
    for (int ck = 0; ck < SEQ / 32; ++ck) {
      const int cur = ck & 1;
      if (ck + 1 < SEQ / 32) {
#pragma unroll
        for (int s6 = 0; s6 < 6; ++s6) ld[s6] = *(const f32x4*)(ST[s6] + (m0 + (ck + 1) * 32 + ltt) * 512 + h * 64 + lq * 4);
      }
      const float* bb = buf + cur * 6 * 32 * 64;
#pragma unroll 4
      for (int tt = 0; tt < 32; ++tt) {
        const f32x4 r4 = *(const f32x4*)(bb + (0 * 32 + tt) * 64 + kq * 4), w4 = *(const f32x4*)(bb + (1 * 32 + tt) * 64 + kq * 4), k4 = *(const f32x4*)(bb + (2 * 32 + tt) * 64 + kq * 4);
        const f32x4 a4 = *(const f32x4*)(bb + (4 * 32 + tt) * 64 + kq * 4), b4 = *(const f32x4*)(bb + (5 * 32 + tt) * 64 + kq * 4);
        const float v = bb[(3 * 32 + tt) * 64 + row];
        const float sa = row16_sum((S[0] * a4[0] + S[1] * a4[1]) + (S[2] * a4[2] + S[3] * a4[3]));
        S = S * w4 + sa * b4 + v * k4;
        const float y = row16_sum((S[0] * r4[0] + S[1] * r4[1]) + (S[2] * r4[2] + S[3] * r4[3]));
        if (kq == 0) ysm[tt * 32 + rloc] = y;
      }
      __syncthreads();
      if (ck + 1 < SEQ / 32) {
#pragma unroll
        for (int s6 = 0; s6 < 6; ++s6) *(f32x4*)(buf + (((cur ^ 1) * 6 + s6) * 32 + ltt) * 64 + lq * 4) = ld[s6];
      }
      if (c.tid < 256) { const int tt = c.tid >> 3, q = c.tid & 7; *(f32x4*)(YO + (m0 + ck * 32 + tt) * 512 + h * 64 + half * 32 + q * 4) = *(const f32x4*)(ysm + tt * 32 + q * 4); }
      __syncthreads();
    }
  }
  __syncthreads();
}

__device__ __forceinline__ void rwkv_post(const Ctx& c) {
  const float* YS = (const float*)(c.ws + WS_YSC); const float* SV = (const float*)(c.ws + WS_SV); const float* GG = (const float*)(c.ws + WS_G);
  const float* BON = (const float*)(c.ws + WS_BON); bf16* YM = (bf16*)(c.ws + WS_YMIX);
  const float* lnw = inp(c, I0_LNW); const float* lnb = inp(c, I0_LNB);
  for (int m = c.wave * c.G + c.bid; m < M; m += NW * c.G) {
#pragma unroll
    for (int j = 0; j < 8; ++j) {
      const int ch = j * 64 + c.lane; const size_t o = (size_t)m * 512 + ch;
      const float y = YS[o];
      const float mean = wave_sum(y) * (1.f / 64.f);
      const float d = y - mean;
      const float var = wave_sum(d * d) * (1.f / 64.f);
      float v = d * rsqrtf(var + 64e-5f) * lnw[ch] + lnb[ch];
      v += BON[(size_t)m * 8 + j] * SV[o];
      YM[(size_t)m * D + ch] = f2bf(v * GG[o]);
    }
  }
}

__device__ __forceinline__ void gmlp_phase(const Ctx& c, int vb, int vG) {
  const bf16* P = (const bf16*)(c.ws + WS_P0); bf16* YM = (bf16*)(c.ws + WS_YMIX);
  const float* lnw = inp(c, I0_GLNW); const float* lnb = inp(c, I0_GLNB); const float* ws = inp(c, I0_GWS); const float* bs = inp(c, I0_GBS);
  float* vn = (float*)c.lds;
  for (int it = vb; it < BATCH * 16 * 4; it += vG) {
    const int g = it & 3, ck = (it >> 2) & 15, b = it >> 6;
    const size_t m0 = (size_t)b * SEQ + ck * 128;
    __syncthreads();
    for (int j = c.wave; j < 128; j += NW) {
      const bf16* row = P + (m0 + j) * EVEN_IN + 2304 + g * 128;
      const float v0 = gelu_(bf2f(row[c.lane])), v1 = gelu_(bf2f(row[c.lane + 64]));
      const float mean = wave_sum(v0 + v1) * (1.f / 128.f);
      const float d0 = v0 - mean, d1 = v1 - mean;
      const float rs = rsqrtf(wave_sum(d0 * d0 + d1 * d1) * (1.f / 128.f) + 1e-6f);
      vn[j * 128 + c.lane] = d0 * rs * lnw[g * 128 + c.lane] + lnb[g * 128 + c.lane];
      vn[j * 128 + c.lane + 64] = d1 * rs * lnw[g * 128 + c.lane + 64] + lnb[g * 128 + c.lane + 64];
    }
    __syncthreads();
    const int d = c.tid & 127, iq = c.tid >> 7;
    for (int ii = 0; ii < 32; ++ii) {
      const int i = iq + 4 * ii;
      const float* wrow = ws + ((size_t)g * 128 + i) * 128;
      float acc = bs[g * 128 + i];
      for (int j = 0; j <= i; ++j) acc += wrow[j] * vn[j * 128 + d];
      const float u = gelu_(bf2f(P[(m0 + i) * EVEN_IN + 1792 + g * 128 + d]));
      YM[(m0 + i) * D + 512 + g * 128 + d] = f2bf(u * acc);
    }
  }
  __syncthreads();
}

__device__ __forceinline__ void s5_scan(const Ctx& c) {
  const float* p_are = inp(c, I1_ARE); const float* p_aim = inp(c, I1_AIM); const float* p_ldt = inp(c, I1_LDT); const float* p_bre = inp(c, I1_BRE); const float* p_bim = inp(c, I1_BIM);
  const float* p_cre = inp(c, I1_CRE); const float* p_cim = inp(c, I1_CIM); const float* p_sd = inp(c, I1_SD);
  const bf16* P1 = (const bf16*)(c.ws + WS_P1); bf16* YC = (bf16*)(c.ws + WS_YC);
  float* wl = (float*)c.lds + c.wave * 4096;
  float* XR = wl, *XI = wl + 1040, *CRE = wl + 2080, *CIM = wl + 3120;
  for (int it = c.wave * c.G + c.bid; it < BATCH * 32; it += NW * c.G) {
    const int b = it >> 5, g = it & 31, p = c.lane;
    const float lr = p_are[g * 64 + p], li = p_aim[g * 64 + p], dt = expf(p_ldt[g]);
    const float mag = expf(lr * dt), ar = mag * cosf(li * dt), ai = mag * sinf(li * dt);
    const float nr = ar - 1.f, ni = ai, den = lr * lr + li * li;
    const float fr = (nr * lr + ni * li) / den, fi = (ni * lr - nr * li) / den;
    float bbr[16], bbi[16];
#pragma unroll
    for (int q = 0; q < 16; ++q) { const float br = p_bre[(g * 64 + p) * 16 + q], bi = p_bim[(g * 64 + p) * 16 + q]; bbr[q] = fr * br - fi * bi; bbi[q] = fr * bi + fi * br; }
#pragma unroll
    for (int q = 0; q < 16; ++q) { CRE[q * 65 + p] = p_cre[(g * 16 + q) * 64 + p]; CIM[q * 65 + p] = p_cim[(g * 16 + q) * 64 + p]; }
    float xr = 0.f, xi = 0.f;
    const int tt = c.lane >> 2, cq = c.lane & 3;
    for (int t0 = 0; t0 < SEQ; t0 += 16) {
      const size_t m0 = (size_t)b * SEQ + t0;
#pragma unroll 4
      for (int s = 0; s < 16; ++s) {
        const uint4 u0 = *(const uint4*)(P1 + (m0 + s) * 2048 + g * 16), u1 = *(const uint4*)(P1 + (m0 + s) * 2048 + g * 16 + 8);
        const unsigned uw[8] = {u0.x, u0.y, u0.z, u0.w, u1.x, u1.y, u1.z, u1.w};
        float br = 0.f, bi = 0.f;
#pragma unroll
        for (int q = 0; q < 8; ++q) { const float ua = bf2f((bf16)(uw[q] & 0xffff)), ub = bf2f((bf16)(uw[q] >> 16));
          br += ua * bbr[2 * q] + ub * bbr[2 * q + 1]; bi += ua * bbi[2 * q] + ub * bbi[2 * q + 1]; }
        const float nxr = ar * xr - ai * xi + br, nxi = ar * xi + ai * xr + bi;
        xr = nxr; xi = nxi;
        XR[s * 65 + p] = xr; XI[s * 65 + p] = xi;
      }
      __builtin_amdgcn_s_waitcnt(0); __builtin_amdgcn_wave_barrier();
      float y[4] = {0.f, 0.f, 0.f, 0.f};
      for (int q = 0; q < 64; ++q) {
        const float a = XR[tt * 65 + q], bq = XI[tt * 65 + q];
#pragma unroll
        for (int e = 0; e < 4; ++e) y[e] += a * CRE[(cq * 4 + e) * 65 + q] - bq * CIM[(cq * 4 + e) * 65 + q];
      }
#pragma unroll
      for (int e = 0; e < 4; ++e) {
        const int ch = g * 16 + cq * 4 + e;
        const float u = bf2f(P1[(m0 + tt) * 2048 + ch]);
        YC[(m0 + tt) * 512 + ch] = f2bf(gelu_(y[e] + p_sd[ch] * u));
      }
      __builtin_amdgcn_s_waitcnt(0); __builtin_amdgcn_wave_barrier();
    }
  }
  __syncthreads();
}

__device__ __forceinline__ void ssd_conv(const Ctx& c) {
  const bf16* P1 = (const bf16*)(c.ws + WS_P1); float* CV = (float*)(c.ws + WS_CONV);
  const float* cw = inp(c, I1_CW); const float* cb = inp(c, I1_CB);
  for (size_t i = (size_t)c.bid * NT + c.tid; i < (size_t)M * 1024; i += (size_t)c.G * NT) {
    const int ch = (int)(i & 1023); const size_t m = i >> 10; const int t = (int)(m % SEQ);
    float acc = cb[ch];
#pragma unroll
    for (int j = 0; j < 4; ++j) { const int tt = t - 3 + j; if (tt >= 0) acc += cw[j * 1024 + ch] * bf2f(P1[(m - 3 + j) * 2048 + 1024 + ch]); }
    CV[i] = silu_(acc);
  }
}

__device__ __forceinline__ void ssd_scan(const Ctx& c) {
  const float* CV = (const float*)(c.ws + WS_CONV); const float* DT = (const float*)(c.ws + WS_DT); float* YO = (float*)(c.ws + WS_YSSD);
  const float* p_dtb = inp(c, I1_DTB); const float* p_alog = inp(c, I1_ALOG); const float* p_md = inp(c, I1_MD);
  for (int it = c.bid; it < BATCH * 8; it += c.G) {
    const int b = it >> 3, h = it & 7, grp = h >> 2, p = c.tid >> 3, ns = c.tid & 7;
    const float dtb = p_dtb[h], av = -expf(p_alog[h]), dsk = p_md[h];
    float H[16];
#pragma unroll
    for (int i = 0; i < 16; ++i) H[i] = 0.f;
    const size_t m0 = (size_t)b * SEQ;
    f32x4 Bn[4], Cn[4]; float xn, dn;
    {
      const float* row = CV + m0 * 1024;
#pragma unroll
      for (int q = 0; q < 4; ++q) { Bn[q] = *(const f32x4*)(row + 512 + grp * 128 + ns * 16 + q * 4); Cn[q] = *(const f32x4*)(row + 768 + grp * 128 + ns * 16 + q * 4); }
      xn = row[h * 64 + p]; dn = DT[m0 * 8 + h];
    }
    for (int t = 0; t < SEQ; ++t) {
      f32x4 Bc[4], Cc[4];
#pragma unroll
      for (int q = 0; q < 4; ++q) { Bc[q] = Bn[q]; Cc[q] = Cn[q]; }
      const float xc = xn, dc = dn;
      {
        const size_t mn = m0 + (t + 1 < SEQ ? t + 1 : t);
        const float* row = CV + mn * 1024;
#pragma unroll
        for (int q = 0; q < 4; ++q) { Bn[q] = *(const f32x4*)(row + 512 + grp * 128 + ns * 16 + q * 4); Cn[q] = *(const f32x4*)(row + 768 + grp * 128 + ns * 16 + q * 4); }
        xn = row[h * 64 + p]; dn = DT[mn * 8 + h];
      }
      const float dt = softplus_(dc + dtb), dA = expf(av * dt), xs = xc * dt;
      float y = 0.f;
#pragma unroll
      for (int q = 0; q < 4; ++q)
#pragma unroll
        for (int e = 0; e < 4; ++e) { H[q * 4 + e] = dA * H[q * 4 + e] + xs * Bc[q][e]; y += H[q * 4 + e] * Cc[q][e]; }
      y += __shfl_xor(y, 1); y += __shfl_xor(y, 2); y += __shfl_xor(y, 4);
      if (ns == 0) YO[(m0 + t) * 512 + h * 64 + p] = y + dsk * xc;
    }
  }
}

__device__ __forceinline__ void ssd_post(const Ctx& c) {
  const bf16* P1 = (const bf16*)(c.ws + WS_P1); const float* YO = (const float*)(c.ws + WS_YSSD); bf16* YM = (bf16*)(c.ws + WS_YMIX);
  const float* nw = inp(c, I1_MNW);
  for (int m = c.wave * c.G + c.bid; m < M; m += NW * c.G) {
    float v[8]; float ss = 0.f;
#pragma unroll
    for (int e = 0; e < 8; ++e) { const int ch = c.lane * 8 + e; const float z = bf2f(P1[(size_t)m * 2048 + 512 + ch]); v[e] = YO[(size_t)m * 512 + ch] * silu_(z); ss += v[e] * v[e]; }
#pragma unroll
    for (int o = 16; o > 0; o >>= 1) ss += __shfl_xor(ss, o);
    const float rs = rsqrtf(ss * (1.f / 256.f) + 1e-6f);
#pragma unroll
    for (int e = 0; e < 8; ++e) { const int ch = c.lane * 8 + e; YM[(size_t)m * D + 512 + ch] = f2bf(v[e] * rs * nw[ch]); }
  }
}

__device__ __forceinline__ void moe_assign(const Ctx& c) {
  LAS unsigned* lcnt = (LAS unsigned*)c.lds; LAS unsigned* lbase = lcnt + 8;
  const int* tok_e = (const int*)(c.ws + WS_ROUTE); int* tok_slot = (int*)(c.ws + WS_ROUTE + 256 * 1024); int* slot_tok = (int*)(c.ctl + CW_SLOTTOK);
  int pstart[8]; { int acc = 0;
#pragma unroll
    for (int e = 0; e < 8; ++e) { pstart[e] = acc; acc += ((int)c.ctl[CW_CNT + 64 * e] + 255) / 256 * 256; } }
  for (int tb = c.bid; tb < M / 64; tb += c.G) {
    __syncthreads();
    if (c.tid < 8) lcnt[c.tid] = 0u;
    __syncthreads();
    int e = 0; unsigned rank = 0; const int pair = tb * 128 + c.tid;
    if (c.tid < 128) { e = tok_e[pair]; rank = atomicAdd((unsigned*)&lcnt[e], 1u); }
    __syncthreads();
    if (c.tid < 8) lbase[c.tid] = atomicAdd(c.ctl + CW_CUR + 64 * c.tid, lcnt[c.tid]);
    __syncthreads();
    if (c.tid < 128) {
      int ps = 0;
#pragma unroll
      for (int q = 0; q < 8; ++q) ps = (e == q) ? pstart[q] : ps;
      const int slot = ps + (int)lbase[e] + (int)rank;
      slot_tok[slot] = pair >> 1; tok_slot[pair] = slot;
    }
  }
  __syncthreads();
}


constexpr int LAST_PHASE = 22;
template <int LO, int HI>
__global__ void __launch_bounds__(NT, 2) fwd_kernel(Args args) {
  extern __shared__ __attribute__((aligned(16))) unsigned char lds[];
  Ctx c0; c0.out = args.out; c0.ws = args.ws; c0.ctl = (unsigned*)(args.ws + WS_CTL); c0.lds = lds;
  c0.tid = threadIdx.x; c0.lane = c0.tid & 63; c0.wave = __builtin_amdgcn_readfirstlane(c0.tid >> 6); c0.bid = blockIdx.x; c0.G = gridDim.x;
  volatile LAS unsigned* bst = (volatile LAS unsigned*)(LAS unsigned char*)(lds + LDS_BST);
  if (c0.tid == 0) { LAS unsigned long long* pt = (LAS unsigned long long*)(LAS unsigned char*)(lds + LDS_PTAB);
#pragma unroll
    for (int i = 0; i < N_IN; ++i) pt[i] = (unsigned long long)args.in[i];
    bst[0] = 0u; bst[1] = 0u; }
  __syncthreads();
  constexpr int lo = LO, hi = HI;
  XcdBarrier bar; bar.bar = c0.ctl + CW_BAR; bar.x = 0; bar.st = bst;
  if constexpr (hi - lo > 1) bar = xcd_barrier_post(c0.ctl + CW_BAR, bst);
#define IN(k) (lo <= (k) && (k) < hi)
#define SEAM(k) do { if constexpr (IN(k) && IN((k) + 1)) xcd_barrier(bar); } while (0)
  unsigned char* ws = args.ws;
  bf16* XN = (bf16*)(ws + WS_XN); bf16* YM = (bf16*)(ws + WS_YMIX); float* Y = (float*)(ws + WS_Y);

  LAS unsigned char* const ldsl = (LAS unsigned char*)lds;
  if constexpr (IN(0)) { const Ctx c = launder(c0); cvt_dense(c); norm_phase<0, 0>(c, inp(c, I_X), nullptr, nullptr, nullptr, inp(c, I0_NPM), XN, nullptr, 0, 0, nullptr); } SEAM(0);
  if constexpr (IN(1)) { const Ctx c = launder(c0); mg::Gemm g{XN, (const bf16*)(ws + WS_WIN0), D, D, D}; mg::DenseOrder S; S.init(M / 256, EVEN_IN / 256, c.G, c.bid);
    mg::EpiBf16<false> E{(bf16*)(ws + WS_P0), EVEN_IN}; mg::gemm_phase(ldsl, g, S, E); } SEAM(1);
  if constexpr (IN(2)) { const Ctx c = launder(c0); rwkv_prep(c); } SEAM(2);
  if constexpr (IN(3)) { const Ctx c = launder(c0); if (c.G >= 256) { if (c.bid < 128) rwkv_scan(c); else gmlp_phase(c, c.bid - 128, c.G - 128); } else { rwkv_scan(c); gmlp_phase(c, c.bid, c.G); } } SEAM(3);
  if constexpr (IN(4)) { const Ctx c = launder(c0); rwkv_post(c); } SEAM(4);
  if constexpr (IN(5)) { const Ctx c = launder(c0); mg::Gemm g{YM, (const bf16*)(ws + WS_WOUT0), D, D, D}; mg::DenseOrder S; S.init(M / 256, D / 256, c.G, c.bid);
    mg::EpiF32 E{Y, D}; mg::gemm_phase(ldsl, g, S, E); } SEAM(5);
  if constexpr (IN(6)) { const Ctx c = launder(c0); norm_phase<1, 0>(c, inp(c, I_X), args.out, Y, inp(c, I0_NPOM), inp(c, I0_NPF), XN, nullptr, 0, 0, nullptr); } SEAM(6);
  if constexpr (IN(7)) { const Ctx c = launder(c0); mg::Gemm g{XN, (const bf16*)(ws + WS_FGU), D, D, D}; mg::DenseOrder S; S.init(M / 256, 2 * FFN / 256, c.G, c.bid);
    mg::EpiSwigluT E{(bf16*)(ws + WS_H), FFN}; mg::gemm_phase(ldsl, g, S, E); } SEAM(7);
  if constexpr (IN(8)) { const Ctx c = launder(c0); mg::Gemm g{(const bf16*)(ws + WS_H), (const bf16*)(ws + WS_FD), FFN, FFN, FFN}; mg::DenseOrder S; S.init(M / 256, D / 256, c.G, c.bid);
    mg::EpiF32 E{Y, D}; mg::gemm_phase(ldsl, g, S, E); } SEAM(8);
  if constexpr (IN(9)) { const Ctx c = launder(c0); norm_phase<1, 1>(c, args.out, args.out, Y, inp(c, I0_NPOF), inp(c, I1_NPM), XN, inp(c, I1_WIN), ODD_IN, 2048, (float*)(ws + WS_DT)); } SEAM(9);
  if constexpr (IN(10)) { const Ctx c = launder(c0); mg::Gemm g{XN, (const bf16*)(ws + WS_WIN1), D, D, D}; mg::DenseOrder S; S.init(M / 256, 2048 / 256, c.G, c.bid);
    mg::EpiBf16<false> E{(bf16*)(ws + WS_P1), 2048}; mg::gemm_phase(ldsl, g, S, E); } SEAM(10);
  if constexpr (IN(11)) { const Ctx c = launder(c0); ssd_conv(c); s5_scan(c); cvt_moe(c, c.bid, c.G); } SEAM(11);
  if constexpr (IN(12)) { const Ctx c = launder(c0); ssd_scan(c);
    mg::Gemm g{(const bf16*)(ws + WS_YC), (const bf16*)(ws + WS_GLU), 512, 512, 512}; mg::DenseOrder S; S.init(M / 256, 512 / 256, c.G, c.G - 1 - c.bid);
    mg::EpiGluT E{YM, D, (const bf16*)(ws + WS_YC), inp(c, I1_GLB)}; mg::gemm_phase(ldsl, g, S, E); } SEAM(12);
  if constexpr (IN(13)) { const Ctx c = launder(c0); ssd_post(c); } SEAM(13);
  if constexpr (IN(14)) { const Ctx c = launder(c0); mg::Gemm g{YM, (const bf16*)(ws + WS_WOUT1), D, D, D}; mg::DenseOrder S; S.init(M / 256, D / 256, c.G, c.bid);
    mg::EpiF32 E{Y, D}; mg::gemm_phase(ldsl, g, S, E); } SEAM(14);
  if constexpr (IN(15)) { const Ctx c = launder(c0); norm_phase<1, 2>(c, args.out, args.out, Y, inp(c, I1_NPOM), inp(c, I1_NPF), XN, inp(c, I1_RT), 8, 0, nullptr); } SEAM(15);
  if constexpr (IN(16)) { const Ctx c = launder(c0); moe_assign(c); } SEAM(16);
#define MOE_SCHED(S, nn, bse, bof) do { int acc_ = 0; \
    _Pragma("unroll") for (int e = 0; e < 8; ++e) { acc_ += ((int)c.ctl[CW_CNT + 64 * e] + 255) / 256 * 256; S.pend[e] = acc_; } \
    S.init(acc_ / 256, nn, c.G, c.bid); S.bstride_e = (bse); S.boff = (bof); S.rowidx = (const int*)(c.ctl + CW_SLOTTOK); } while (0)
  if constexpr (IN(17)) { const Ctx c = launder(c0); mg::Gemm g{XN, (const bf16*)(ws + WS_MGU), D, D, D}; mg::MoeOrder<true> S; MOE_SCHED(S, FH / 128, (size_t)2 * FE * D * 2, 0);
    mg::EpiSwigluT E{(bf16*)(ws + WS_HID), FH}; mg::gemm_phase(ldsl, g, S, E); } SEAM(17);
  if constexpr (IN(18)) { const Ctx c = launder(c0); mg::Gemm g{(const bf16*)(ws + WS_HID), (const bf16*)(ws + WS_MD), FH, FE, FH}; mg::MoeOrder<false> S; MOE_SCHED(S, D / 256, (size_t)D * FE * 2, 0);
    mg::EpiBf16<false> E{(bf16*)(ws + WS_YS), D}; mg::gemm_phase(ldsl, g, S, E); } SEAM(18);
  if constexpr (IN(19)) { const Ctx c = launder(c0); mg::Gemm g{XN, (const bf16*)(ws + WS_MGU), D, D, D}; mg::MoeOrder<true> S; MOE_SCHED(S, FH / 128, (size_t)2 * FE * D * 2, (size_t)(FH / 128) * 256 * D * 2);
    mg::EpiSwigluT E{(bf16*)(ws + WS_HID), FH}; mg::gemm_phase(ldsl, g, S, E); } SEAM(19);
  if constexpr (IN(20)) { const Ctx c = launder(c0); mg::Gemm g{(const bf16*)(ws + WS_HID), (const bf16*)(ws + WS_MD), FH, FE, FH}; mg::MoeOrder<false> S; MOE_SCHED(S, D / 256, (size_t)D * FE * 2, (size_t)FH * 2);
    mg::EpiBf16<true> E{(bf16*)(ws + WS_YS), D}; mg::gemm_phase(ldsl, g, S, E); } SEAM(20);
  if constexpr (IN(21)) { const Ctx c = launder(c0); norm_phase<2, 0>(c, args.out, args.out, nullptr, inp(c, I1_NPOF), nullptr, nullptr, nullptr, 0, 0, nullptr); }
#undef MOE_SCHED
#undef IN
#undef SEAM
}

template <int P> static void launch_one(const Args& a, hipStream_t stream) { hipLaunchKernelGGL((fwd_kernel<P, P + 1>), dim3(256), dim3(NT), LDS_BYTES, stream, a); }
template <int P> static bool set_attr_one() { return hipFuncSetAttribute((const void*)fwd_kernel<P, P + 1>, hipFuncAttributeMaxDynamicSharedMemorySize, LDS_BYTES) == hipSuccess; }
template <int... Ps> static void launch_all(const Args& a, hipStream_t stream, std::integer_sequence<int, Ps...>) { (launch_one<Ps>(a, stream), ...); }
template <int... Ps> static bool set_attr_all(std::integer_sequence<int, Ps...>) { return (set_attr_one<Ps>() && ...); }

extern "C" void kernel_launch(void* const* d_in, const int* in_sizes, int n_in, void* d_out, int out_size, void* d_ws, size_t ws_size, hipStream_t stream) {
  static int ready = 0;
  if (!ready) {
    bool ok = true;
    if (n_in != N_IN || out_size != M * D || ws_size < WS_END) { fprintf(stderr, "kernel_launch: unexpected problem: n_in %d out %d ws %zu (need %zu)\n", n_in, out_size, ws_size, (size_t)WS_END); ok = false; }
#if ONE_LAUNCH
    if (ok && hipFuncSetAttribute((const void*)fwd_kernel<0, LAST_PHASE>, hipFuncAttributeMaxDynamicSharedMemorySize, LDS_BYTES) != hipSuccess) ok = false;
#else
    if (ok && !set_attr_all(std::make_integer_sequence<int, LAST_PHASE>{})) ok = false;
#endif
    if (!ok) fprintf(stderr, "kernel_launch: setup failed\n");
    ready = ok ? 1 : -1;
  }
  if (ready < 0) return;
  (void)hipMemsetAsync((char*)d_ws + WS_CTL, 0, CTL_BYTES, stream);
  Args a{};
  for (int i = 0; i < N_IN; ++i) a.in[i] = (const float*)d_in[i];
  a.out = (float*)d_out; a.ws = (unsigned char*)d_ws;
#if ONE_LAUNCH
  hipLaunchKernelGGL((fwd_kernel<0, LAST_PHASE>), dim3(256), dim3(NT), LDS_BYTES, stream, a);
#else
  launch_all(a, stream, std::make_integer_sequence<int, LAST_PHASE>{});
#endif
}
```

```cpp
#include <hip/hip_runtime.h>
#include <stdint.h>
#include <stdio.h>
#include <utility>

#ifndef ONE_LAUNCH
#define ONE_LAUNCH 1
#endif

constexpr int D = 1024, BATCH = 8, SEQ = 2048, M = BATCH * SEQ;
constexpr int A_W = 512, A_IN = 1792, EVEN_IN = 2816, FFN = 2816;
constexpr int ODD_IN = 2056, NE = 8, FE = 3584;
constexpr int MAXSLOT = 2 * M + NE * 256;
constexpr int NT = 512, NW = 8;

typedef unsigned short bf16;
typedef float f32x4 __attribute__((ext_vector_type(4)));
#define LAS __attribute__((address_space(3)))

enum {
  I_X = 0,
  I0_NPM, I0_WIN, I0_MU, I0_W0, I0_W2, I0_A0, I0_A2, I0_G2, I0_KK, I0_KA, I0_RK, I0_LNW, I0_LNB,
  I0_GLNW, I0_GLNB, I0_GWS, I0_GBS, I0_WOUT, I0_NPOM, I0_NPF, I0_FG, I0_FU, I0_FD, I0_NPOF,
  I1_NPM, I1_WIN, I1_ARE, I1_AIM, I1_LDT, I1_BRE, I1_BIM, I1_CRE, I1_CIM, I1_SD, I1_GLW, I1_GLB,
  I1_CW, I1_CB, I1_DTB, I1_ALOG, I1_MD, I1_MNW, I1_WOUT, I1_NPOM, I1_NPF, I1_RT, I1_MG, I1_MU, I1_MDN, I1_NPOF,
  N_IN
};
static_assert(N_IN == 51, "input count");

constexpr size_t MiB = 1ull << 20;
constexpr size_t WS_CTL = 0, CTL_BYTES = 1 * MiB;
constexpr size_t KiB = 1024;
constexpr size_t WS_WIN0 = 1 * MiB;
constexpr size_t WS_WOUT0 = WS_WIN0 + 5632 * KiB;
constexpr size_t WS_FGU = WS_WOUT0 + 2048 * KiB;
constexpr size_t WS_FD = WS_FGU + 11264 * KiB;
constexpr size_t WS_WIN1 = WS_FD + 5632 * KiB;
constexpr size_t WS_GLU = WS_WIN1 + 4096 * KiB;
constexpr size_t WS_WOUT1 = WS_GLU + 512 * KiB;
constexpr size_t WS_WLORA = WS_WOUT1 + 2048 * KiB;
constexpr size_t WS_DENSE_END = WS_WLORA + 768 * KiB;
constexpr size_t WS_MGU = 33 * MiB;
constexpr size_t WS_MD = 145 * MiB;
constexpr size_t WS_XN = 201 * MiB;
constexpr size_t WS_YMIX = 233 * MiB;
constexpr size_t WS_Y = 265 * MiB;
constexpr size_t WS_BIG = 329 * MiB;
constexpr size_t WS_P0 = WS_BIG;
constexpr size_t WS_SR = WS_MGU;
constexpr size_t WS_SW = WS_SR + 32 * MiB, WS_SK = WS_SW + 32 * MiB, WS_SV = WS_SK + 32 * MiB, WS_SA = WS_SV + 32 * MiB, WS_SB = WS_Y;
constexpr size_t WS_LOG = WS_P0 + 88 * MiB;
constexpr size_t WS_BON = WS_LOG + 32 * MiB;
constexpr size_t WS_L0END = WS_BON + 1 * MiB;
constexpr size_t WS_ALORA = WS_MGU + 160 * MiB;
constexpr size_t WS_LOWA = WS_XN;
static_assert(WS_DENSE_END <= WS_MGU && WS_ALORA + 8 * MiB <= WS_XN, "lora buffers");
static_assert(WS_SA + 32 * MiB <= WS_XN, "streams inside the MoE weight region");
constexpr size_t WS_H = WS_BIG;
constexpr size_t WS_P1 = WS_BIG;
constexpr size_t WS_DT = WS_P1 + 64 * MiB;
constexpr size_t WS_ATOT = WS_DT + 768 * KiB;
constexpr size_t WS_CONV = WS_DT + 1 * MiB;
constexpr size_t WS_YD = WS_CONV + 32 * MiB;
constexpr size_t WS_YC = WS_Y;
constexpr size_t WS_SE = WS_Y + 16 * MiB;
constexpr size_t WS_SPV = WS_SE + 32 * MiB;
constexpr int FH = FE / 2;
constexpr size_t WS_HID = WS_BIG;
constexpr size_t WS_YS = WS_YMIX;
constexpr size_t WS_ROUTE = WS_BIG + 120 * MiB;
constexpr size_t WS_END = 462 * MiB;
static_assert(WS_L0END <= WS_END && WS_YD + 32 * MiB <= WS_END && WS_ROUTE + 1 * MiB <= WS_END && WS_SPV + 16 * MiB <= WS_BIG, "workspace map");
static_assert((size_t)MAXSLOT * FH * 2 <= 120 * MiB && (size_t)MAXSLOT * D * 2 <= 96 * MiB, "moe buffers");
constexpr int CW_BAR = 4096;
constexpr int CW_CNT = 8192;
constexpr int CW_CUR = 8192 + 64 * 8;
constexpr int CW_SLOTTOK = 65536;
static_assert((CW_SLOTTOK + MAXSLOT) * 4 <= (int)CTL_BYTES, "ctl");

constexpr int LDS_BYTES = 147456;

__device__ __forceinline__ float bf2f(bf16 v) { return __uint_as_float(((unsigned)v) << 16); }
__device__ __forceinline__ bf16 f2bf(float f) { unsigned u = __float_as_uint(f); u += 0x7fffu + ((u >> 16) & 1u); return (bf16)(u >> 16); }
__device__ __forceinline__ float wave_sum(float v) {
#pragma unroll
  for (int o = 32; o > 0; o >>= 1) v += __shfl_xor(v, o);
  return v;
}
__device__ __forceinline__ float sigmoid_(float x) { return 1.f / (1.f + expf(-x)); }
__device__ __forceinline__ float silu_(float x) { return x / (1.f + expf(-x)); }
__device__ __forceinline__ float gelu_(float x) { const float u = 0.7978845608028654f * (x + 0.044715f * x * x * x); return 0.5f * x * (1.f + tanhf(u)); }
__device__ __forceinline__ float softplus_(float x) { return fmaxf(x, 0.f) + log1pf(expf(-fabsf(x))); }

#define XB_TMO      128
#define XB_XCNT(j)  (256  + 64 * (j))
#define XB_XSUB(j)  (1280 + 64 * (j))
#define XB_XGEN(j)  (2304 + 64 * (j))
#define XB_TOP      3328
#define XB_TOPGEN   3392
#define XCD_BAR_WORDS 3456
#define XB_SPIN_CAP (1u << 22)

__device__ __forceinline__ unsigned xb_ld(unsigned* p)              { return __hip_atomic_load(p, __ATOMIC_RELAXED, __HIP_MEMORY_SCOPE_AGENT); }
__device__ __forceinline__ unsigned xb_add(unsigned* p, unsigned v) { return __hip_atomic_fetch_add(p, v, __ATOMIC_RELAXED, __HIP_MEMORY_SCOPE_AGENT); }
__device__ __forceinline__ unsigned xb_xcc_id() { return (unsigned)__builtin_amdgcn_s_getreg((3 << 11) | 20) & 0xFu; }
#define XB_SPIN(cond, bar) do { unsigned _sp = 0; while (cond) { __builtin_amdgcn_s_sleep(1); \
    if ((++_sp & 255u) == 0u) { if (xb_ld(&(bar)[XB_TMO])) break; if (_sp > XB_SPIN_CAP) { atomicAdd(&(bar)[XB_TMO], 1u); break; } } } } while (0)

struct XcdBarrier { unsigned* bar; unsigned x; volatile LAS unsigned* st; };

__device__ __forceinline__ XcdBarrier xcd_barrier_post(unsigned* bar, volatile LAS unsigned* st) {
    XcdBarrier b; b.bar = bar; b.x = xb_xcc_id(); b.st = st;
    if (threadIdx.x == 0) (void)xb_add(&bar[XB_XCNT(b.x)], 1u);
    return b;
}
__device__ __forceinline__ void xcd_barrier_complete(unsigned* bar, unsigned x, unsigned& nloc, unsigned& nx) {
    const unsigned G = gridDim.x * gridDim.y * gridDim.z;
    unsigned sum, cnt, mine, sp = 0u;
    for (;;) {
        sum = 0u; cnt = 0u; mine = 0u;
#pragma unroll
        for (unsigned j = 0; j < 16; ++j) { const unsigned c = xb_ld(&bar[XB_XCNT(j)]); sum += c; cnt += (c > 0u) ? 1u : 0u; mine = (j == x) ? c : mine; }
        if (sum == G) break;
        __builtin_amdgcn_s_sleep(1);
        if ((++sp & 255u) == 0u) { if (xb_ld(&bar[XB_TMO])) break; if (sp > XB_SPIN_CAP) { atomicAdd(&bar[XB_TMO], 1u); break; } }
    }
    nloc = mine > 0u ? mine : 1u; nx = cnt > 0u ? cnt : 1u;
}
__device__ __forceinline__ void xcd_barrier(const XcdBarrier& b) {
    asm volatile("s_waitcnt vmcnt(0)" ::: "memory");
    __syncthreads();
    if (threadIdx.x == 0) {
        unsigned* bar = b.bar;
        __builtin_amdgcn_s_waitcnt(0);
        unsigned nloc = b.st[0], nx = b.st[1];
        if (nloc == 0u) { xcd_barrier_complete(bar, b.x, nloc, nx); b.st[0] = nloc; b.st[1] = nx; }
        const unsigned old = xb_add(&bar[XB_XSUB(b.x)], 1u);
        const unsigned gen = old / nloc;
        if (old + 1u == (gen + 1u) * nloc) {
            __builtin_amdgcn_fence(__ATOMIC_RELEASE, "agent");
            asm volatile("s_waitcnt vmcnt(0)" ::: "memory");
            const unsigned og = xb_add(&bar[XB_TOP], 1u);
            const unsigned tg = og / nx;
            if (og + 1u == (tg + 1u) * nx) xb_add(&bar[XB_TOPGEN], 1u);
            else XB_SPIN(xb_ld(&bar[XB_TOPGEN]) == tg, bar);
            __builtin_amdgcn_fence(__ATOMIC_ACQUIRE, "agent");
            xb_add(&bar[XB_XGEN(b.x)], 1u);
            asm volatile("s_waitcnt vmcnt(0)" ::: "memory");
        } else {
            XB_SPIN(xb_ld(&bar[XB_XGEN(b.x)]) == gen, bar);
            __builtin_amdgcn_fence(__ATOMIC_ACQUIRE, "agent");
            asm volatile("s_waitcnt vmcnt(0)" ::: "memory");
        }
    }
    __syncthreads();
}

struct Args { const float* in[N_IN]; float* out; unsigned char* ws; int lo, hi; };
struct Ctx {
  float* out; unsigned char* ws; unsigned* ctl;
  unsigned char* lds;
  int tid, lane, wave, bid, G;
};
__device__ __forceinline__ Ctx launder(Ctx c) {
  asm volatile("" : "+v"(c.tid), "+v"(c.lane));
  asm volatile("" : "+s"(c.wave), "+s"(c.bid), "+s"(c.G));
  return c;
}
constexpr int LDS_PTAB = LDS_BYTES - 1024;
constexpr int LDS_BST = LDS_BYTES - 16;
__device__ __forceinline__ const float* inp(const Ctx& c, int k) {
  const LAS unsigned* pt = (const LAS unsigned*)(LAS unsigned char*)(c.lds + LDS_PTAB);
  const unsigned lo = __builtin_amdgcn_readfirstlane(pt[2 * k]), hi = __builtin_amdgcn_readfirstlane(pt[2 * k + 1]);
  return (const float*)(((unsigned long long)hi << 32) | lo);
}


namespace mg {
typedef short bf16x8 __attribute__((ext_vector_type(8)));
typedef unsigned u32x4 __attribute__((ext_vector_type(4)));
constexpr int BM = 256, BK = 64, HALF = 128, HTB = HALF * BK * 2, STAGE_BYTES = 8 * HTB, NXCD = 8, WGM = 8;
constexpr int LDS_IDX = STAGE_BYTES;
__host__ __device__ __forceinline__ int lds_byte(int r, int c) { const int st = (r >> 4) * 2 + (c >> 5), rr = r & 15, cc = c & 31, ob = rr * 64 + cc * 2; return st * 1024 + (ob ^ (((ob >> 9) & 1) << 5)); }
__host__ __device__ __forceinline__ void stage_rc(int b, int& R, int& C) { const int st = b / 1024, sb = b % 1024, swz = sb ^ (((sb >> 9) & 1) << 5); R = (st >> 1) * 16 + swz / 64; C = (st & 1) * 32 + (swz % 64) / 2; }
__host__ __device__ __forceinline__ int perm32(int rho) { const int n = rho >> 4, i = rho & 15; return 8 * (i >> 2) + 4 * n + (i & 3); }
struct Unit { int pm, pn; };
struct Gemm { const bf16* A; const bf16* Bt; int lda, ldb, K; };

struct Tiles {
  int nM, nN, nwg, G, c;
  __device__ __forceinline__ void init(int nM_, int nN_, int G_, int c_) { nM = nM_; nN = nN_; nwg = nM * nN; G = G_; c = c_; }
  __device__ __forceinline__ bool next(int i, Unit& u) const {
    const long L = (long)i * G + c; if (L >= nwg) return false;
    int wgid = (int)L; { const int q = nwg / NXCD, r = nwg % NXCD, xcd = wgid % NXCD, off = wgid / NXCD; wgid = (xcd < r ? xcd * (q + 1) : r * (q + 1) + (xcd - r) * q) + off; }
    const int nig = WGM * nN, gid = wgid / nig, fm = gid * WGM, gsz = (nM - fm) < WGM ? (nM - fm) : WGM;
    u.pm = fm + ((wgid % nig) % gsz); u.pn = (wgid % nig) / gsz; return true;
  }
};
struct DenseOrder : Tiles {
  static constexpr bool GATHER = false;
  const int* rowidx;
  __device__ __forceinline__ const char* a_tile(const Gemm& g, const Unit& u) const { return (const char*)g.A + (size_t)u.pm * BM * g.lda * 2; }
  __device__ __forceinline__ const char* b_tile(const Gemm& g, const Unit& u) const { return (const char*)g.Bt + (size_t)u.pn * BM * g.ldb * 2; }
};
template <bool GATHER_> struct MoeOrder : Tiles {
  static constexpr bool GATHER = GATHER_;
  int pend[8]; size_t bstride_e, boff; const int* rowidx;
  __device__ __forceinline__ int expert(int pm) const { int e = 0;
#pragma unroll
    for (int q = 0; q < 7; ++q) e += (pm * BM >= pend[q]) ? 1 : 0;
    return e; }
  __device__ __forceinline__ const char* a_tile(const Gemm& g, const Unit& u) const { return (const char*)g.A + (size_t)u.pm * BM * g.lda * 2; }
  __device__ __forceinline__ const char* b_tile(const Gemm& g, const Unit& u) const { return (const char*)g.Bt + (size_t)expert(u.pm) * bstride_e + boff + (size_t)u.pn * BM * g.ldb * 2; }
};

__device__ __forceinline__ unsigned cvt_pk_bf16(float lo, float hi) { unsigned r; asm volatile("v_cvt_pk_bf16_f32 %0, %1, %2" : "=v"(r) : "v"(lo), "v"(hi)); return r; }

struct EpiF32 { static constexpr bool PERM = false; float* C; int ldc;
  __device__ __forceinline__ void operator()(const f32x4 (&acc)[2][2][4][2], const Unit& u, int wr, int wc, int fr, int fq) const {
    const int row0 = u.pm * BM + wr * 64 + fr, col0 = u.pn * BM + wc * 32 + 4 * fq;
#pragma unroll
    for (int ai = 0; ai < 2; ++ai)
#pragma unroll
      for (int m = 0; m < 4; ++m) { float* rowp = C + (size_t)(row0 + ai * HALF + m * 16) * ldc + col0;
#pragma unroll
        for (int bj = 0; bj < 2; ++bj)
#pragma unroll
          for (int n = 0; n < 2; ++n) *(f32x4*)(rowp + bj * HALF + n * 16) = acc[ai][bj][m][n]; }
  } };
template <bool ACCUM> struct EpiBf16 { static constexpr bool PERM = true; bf16* O; int ldc;
  __device__ __forceinline__ void operator()(const f32x4 (&acc)[2][2][4][2], const Unit& u, int wr, int wc, int fr, int fq) const {
    const int row0 = u.pm * BM + wr * 64 + fr, col0 = u.pn * BM + wc * 32 + 8 * fq;
#pragma unroll
    for (int ai = 0; ai < 2; ++ai)
#pragma unroll
      for (int m = 0; m < 4; ++m) { bf16* rowp = O + (size_t)(row0 + ai * HALF + m * 16) * ldc + col0;
#pragma unroll
        for (int bj = 0; bj < 2; ++bj) { f32x4 v0 = acc[ai][bj][m][0], v1 = acc[ai][bj][m][1];
          if (ACCUM) { const u32x4 o = *(const u32x4*)(rowp + bj * HALF);
            v0[0] += __uint_as_float(o.x << 16); v0[1] += __uint_as_float(o.x & 0xffff0000u); v0[2] += __uint_as_float(o.y << 16); v0[3] += __uint_as_float(o.y & 0xffff0000u);
            v1[0] += __uint_as_float(o.z << 16); v1[1] += __uint_as_float(o.z & 0xffff0000u); v1[2] += __uint_as_float(o.w << 16); v1[3] += __uint_as_float(o.w & 0xffff0000u); }
          u32x4 w; w.x = cvt_pk_bf16(v0[0], v0[1]); w.y = cvt_pk_bf16(v0[2], v0[3]); w.z = cvt_pk_bf16(v1[0], v1[1]); w.w = cvt_pk_bf16(v1[2], v1[3]);
          *(u32x4*)(rowp + bj * HALF) = w; } }
  } };
struct EpiLora { static constexpr bool PERM = true; bf16* O0; bf16* O1;
  __device__ __forceinline__ void operator()(const f32x4 (&acc)[2][2][4][2], const Unit& u, int wr, int wc, int fr, int fq) const {
    bf16* base = (u.pn < 4) ? O0 : O1; constexpr int ldc = 1024;
    const int row0 = u.pm * BM + wr * 64 + fr, col0 = (u.pn & 3) * BM + wc * 32 + 8 * fq;
#pragma unroll
    for (int ai = 0; ai < 2; ++ai)
#pragma unroll
      for (int m = 0; m < 4; ++m) { bf16* rowp = base + (size_t)(row0 + ai * HALF + m * 16) * ldc + col0;
#pragma unroll
        for (int bj = 0; bj < 2; ++bj) { const f32x4 v0 = acc[ai][bj][m][0], v1 = acc[ai][bj][m][1];
          u32x4 w; w.x = cvt_pk_bf16(v0[0], v0[1]); w.y = cvt_pk_bf16(v0[2], v0[3]); w.z = cvt_pk_bf16(v1[0], v1[1]); w.w = cvt_pk_bf16(v1[2], v1[3]);
          *(u32x4*)(rowp + bj * HALF) = w; } }
  } };
struct EpiSwigluT { static constexpr bool PERM = true; bf16* O; int ldc;
  __device__ __forceinline__ void operator()(const f32x4 (&acc)[2][2][4][2], const Unit& u, int wr, int wc, int fr, int fq) const {
    const int row0 = u.pm * BM + wr * 64 + fr, col0 = u.pn * HALF + wc * 32 + 8 * fq;
#pragma unroll
    for (int ai = 0; ai < 2; ++ai)
#pragma unroll
      for (int m = 0; m < 4; ++m) { bf16* rowp = O + (size_t)(row0 + ai * HALF + m * 16) * ldc + col0;
        float h[8];
#pragma unroll
        for (int n = 0; n < 2; ++n)
#pragma unroll
          for (int e = 0; e < 4; ++e) { const float gte = acc[ai][0][m][n][e], up = acc[ai][1][m][n][e]; h[n * 4 + e] = gte * __builtin_amdgcn_rcpf(1.f + __expf(-gte)) * up; }
        u32x4 w; w.x = cvt_pk_bf16(h[0], h[1]); w.y = cvt_pk_bf16(h[2], h[3]); w.z = cvt_pk_bf16(h[4], h[5]); w.w = cvt_pk_bf16(h[6], h[7]);
        *(u32x4*)rowp = w; }
  } };
struct EpiGluT { static constexpr bool PERM = true; bf16* O; int ldc; const bf16* Yc; const float* bias;
  __device__ __forceinline__ void operator()(const f32x4 (&acc)[2][2][4][2], const Unit& u, int wr, int wc, int fr, int fq) const {
    const int row0 = u.pm * BM + wr * 64 + fr, col0 = u.pn * BM + wc * 32 + 8 * fq;
#pragma unroll
    for (int ai = 0; ai < 2; ++ai)
#pragma unroll
      for (int m = 0; m < 4; ++m) { const int row = row0 + ai * HALF + m * 16;
#pragma unroll
        for (int bj = 0; bj < 2; ++bj) { const int col = col0 + bj * HALF;
          const u32x4 yv = *(const u32x4*)(Yc + (size_t)row * 512 + col);
          const f32x4 b0 = *(const f32x4*)(bias + col), b1 = *(const f32x4*)(bias + col + 4);
          const float y[8] = {__uint_as_float(yv.x << 16), __uint_as_float(yv.x & 0xffff0000u), __uint_as_float(yv.y << 16), __uint_as_float(yv.y & 0xffff0000u),
                              __uint_as_float(yv.z << 16), __uint_as_float(yv.z & 0xffff0000u), __uint_as_float(yv.w << 16), __uint_as_float(yv.w & 0xffff0000u)};
          float h[8];
#pragma unroll
          for (int e = 0; e < 4; ++e) { h[e] = y[e] * __builtin_amdgcn_rcpf(1.f + __expf(-(acc[ai][bj][m][0][e] + b0[e]))); h[4 + e] = y[4 + e] * __builtin_amdgcn_rcpf(1.f + __expf(-(acc[ai][bj][m][1][e] + b1[e]))); }
          u32x4 w; w.x = cvt_pk_bf16(h[0], h[1]); w.y = cvt_pk_bf16(h[2], h[3]); w.z = cvt_pk_bf16(h[4], h[5]); w.w = cvt_pk_bf16(h[6], h[7]);
          *(u32x4*)(O + (size_t)row * ldc + col) = w; } }
  } };

template <class Epi, class Sched>
__device__ __forceinline__ void gemm_phase(LAS unsigned char* lds, const Gemm g, const Sched& S, const Epi& E) {
  const int tid = threadIdx.x, wid = __builtin_amdgcn_readfirstlane(tid >> 6), lane = tid & 63, wr = wid >> 2, wc = wid & 3, fr = lane & 15, fq = lane >> 4;
  const int K = g.K, nt = K / BK;
  unsigned voffA[2], voffB[2]; int gR[2], gC[2];
#pragma unroll
  for (int i = 0; i < 2; ++i) { int R, C; stage_rc(tid * 16 + i * 8192, R, C); const int Rb = Epi::PERM ? ((R & ~31) + perm32(R & 31)) : R;
    voffA[i] = (unsigned)(R * g.lda + C) * 2u; voffB[i] = (unsigned)(Rb * g.ldb + C) * 2u; gR[i] = R; gC[i] = C * 2; }
  const size_t kstep = (size_t)(BK * 2);
  const size_t hstepA = (size_t)HALF * g.lda * 2, hstepB = (size_t)HALF * g.ldb * 2;
  const unsigned ldsw = (unsigned)wid * 1024u;
  const unsigned rowb = (unsigned)g.lda * 2u;
  const int aoff = lds_byte(wr * 64 + fr, fq * 8), boff = lds_byte(wc * 32 + fr, fq * 8);
#define PG8_SA(b, h) (((b) * 2 + (h)) * HTB)
#define PG8_SB(b, h) ((4 + (b) * 2 + (h)) * HTB)
#define PG8_STAGE(bufoff, gbase, voff) do { _Pragma("unroll") for (int _i = 0; _i < 2; ++_i) \
    __builtin_amdgcn_global_load_lds((const unsigned*)((const char*)(gbase) + (voff)[_i]), (LAS unsigned*)(lds + (bufoff) + ldsw + _i * 8192), 16, 0, 0); } while (0)
#define PG8_STAGE_A(bufoff, p, h, goff) do { if constexpr (Sched::GATHER) PG8_STAGE(bufoff, p, (goff)[h]); else PG8_STAGE(bufoff, (p) + (h) * hstepA, voffA); } while (0)
#define PG8_LDA(dst, b, h) do { _Pragma("unroll") for (int m = 0; m < 4; ++m) _Pragma("unroll") for (int k = 0; k < 2; ++k) dst[m][k] = *(const LAS bf16x8*)(lds + PG8_SA(b, h) + aoff + m * 2048 + k * 1024); } while (0)
#define PG8_LDB(dst, b, h) do { _Pragma("unroll") for (int n = 0; n < 2; ++n) _Pragma("unroll") for (int k = 0; k < 2; ++k) dst[n][k] = *(const LAS bf16x8*)(lds + PG8_SB(b, h) + boff + n * 2048 + k * 1024); } while (0)
#define PG8_MMA(ai, bj, At, Bt) do { __builtin_amdgcn_s_setprio(1); _Pragma("unroll") for (int m = 0; m < 4; ++m) _Pragma("unroll") for (int n = 0; n < 2; ++n) _Pragma("unroll") for (int k = 0; k < 2; ++k) \
    acc[ai][bj][m][n] = __builtin_amdgcn_mfma_f32_16x16x32_bf16(Bt[n][k], At[m][k], acc[ai][bj][m][n], 0, 0, 0); __builtin_amdgcn_s_setprio(0); } while (0)
#define PG8_WAIT_V(n) asm volatile("s_waitcnt vmcnt(" #n ")" ::: "memory")
#define PG8_WAIT_L(n) asm volatile("s_waitcnt lgkmcnt(" #n ")" ::: "memory")
#define PG8_BAR __builtin_amdgcn_s_barrier()
#define PG8_SCHED __builtin_amdgcn_sched_barrier(0)
  Unit cur, nxt; int ui = 0;
  if (!S.next(0, cur)) return;
  f32x4 acc[2][2][4][2];
#pragma unroll
  for (int a = 0; a < 2; ++a)
#pragma unroll
    for (int b = 0; b < 2; ++b)
#pragma unroll
      for (int m = 0; m < 4; ++m)
#pragma unroll
        for (int n = 0; n < 2; ++n) acc[a][b][m][n] = (f32x4){0.f, 0.f, 0.f, 0.f};
  bf16x8 At[4][2], B0[2][2], B1[2][2];
  unsigned gcu[2][2] = {{0u, 0u}, {0u, 0u}};
  const char* cA = Sched::GATHER ? (const char*)g.A : S.a_tile(g, cur); const char* cB = S.b_tile(g, cur);
  if constexpr (Sched::GATHER) {
#pragma unroll
    for (int h = 0; h < 2; ++h)
#pragma unroll
      for (int i = 0; i < 2; ++i) gcu[h][i] = (unsigned)S.rowidx[cur.pm * BM + h * HALF + gR[i]] * rowb + (unsigned)gC[i];
  }
  PG8_STAGE(PG8_SB(0, 0), cB, voffB); PG8_STAGE(PG8_SB(0, 1), cB + hstepB, voffB); PG8_STAGE_A(PG8_SA(0, 0), cA, 0, gcu); PG8_STAGE_A(PG8_SA(0, 1), cA, 1, gcu);
  if (wr == 1) PG8_BAR;
  PG8_WAIT_V(2); PG8_BAR;
  PG8_STAGE(PG8_SB(1, 0), cB + kstep, voffB); PG8_STAGE_A(PG8_SA(1, 0), cA + kstep, 0, gcu); PG8_STAGE(PG8_SB(1, 1), cB + hstepB + kstep, voffB);
  PG8_WAIT_V(6); PG8_BAR;
  for (;;) {
    const bool has_next = S.next(ui + 1, nxt);
    const char* nA = Sched::GATHER ? (const char*)g.A : (has_next ? S.a_tile(g, nxt) : cA); const char* nB = has_next ? S.b_tile(g, nxt) : cB;
    if constexpr (Sched::GATHER) {
      if (has_next && wid < 4) __builtin_amdgcn_global_load_lds((const unsigned*)(S.rowidx + nxt.pm * BM + wid * 64 + lane), (LAS unsigned*)(lds + LDS_IDX + ((ui + 1) & 1) * 1024 + wid * 256), 4, 0, 0);
    }
#pragma nounroll
    for (int t = 0; t < nt; t += 2) {
      const bool last = (t == nt - 2);
      const char* a1 = cA + (size_t)(t + 1) * kstep;
      const char* a2 = last ? nA : cA + (size_t)(t + 2) * kstep; const char* b2 = last ? nB : cB + (size_t)(t + 2) * kstep;
      const char* a3 = a2 + kstep; const char* b3 = b2 + kstep;
      unsigned g2[2][2];
#pragma unroll
      for (int h = 0; h < 2; ++h)
#pragma unroll
        for (int i = 0; i < 2; ++i) g2[h][i] = gcu[h][i];
      if constexpr (Sched::GATHER) {
        if (last && has_next) {
          const LAS unsigned* ix = (const LAS unsigned*)(lds + LDS_IDX + ((ui + 1) & 1) * 1024);
#pragma unroll
          for (int h = 0; h < 2; ++h)
#pragma unroll
            for (int i = 0; i < 2; ++i) g2[h][i] = ix[h * HALF + gR[i]] * rowb + (unsigned)gC[i];
        }
      }
      PG8_LDB(B0, 0, 0); PG8_LDB(B1, 0, 1); PG8_SCHED; PG8_LDA(At, 0, 0); PG8_STAGE_A(PG8_SA(1, 1), a1, 1, gcu);
      PG8_WAIT_V(8); PG8_WAIT_L(0); PG8_BAR; PG8_MMA(0, 0, At, B0); PG8_MMA(0, 1, At, B1); PG8_BAR; PG8_SCHED;
      PG8_LDA(At, 0, 1); PG8_STAGE(PG8_SB(0, 0), b2, voffB); PG8_STAGE(PG8_SB(0, 1), b2 + hstepB, voffB); PG8_STAGE_A(PG8_SA(0, 0), a2, 0, g2);
      PG8_WAIT_V(8); PG8_WAIT_L(0); PG8_BAR; PG8_MMA(1, 0, At, B0); PG8_MMA(1, 1, At, B1); PG8_BAR; PG8_SCHED;
      PG8_LDB(B0, 1, 0); PG8_LDB(B1, 1, 1); PG8_SCHED; PG8_LDA(At, 1, 0); PG8_STAGE_A(PG8_SA(0, 1), a2, 1, g2);
      PG8_WAIT_V(8); PG8_WAIT_L(0); PG8_BAR; PG8_MMA(0, 0, At, B0); PG8_MMA(0, 1, At, B1); PG8_BAR; PG8_SCHED;
      PG8_LDA(At, 1, 1); PG8_STAGE(PG8_SB(1, 0), b3, voffB); PG8_STAGE(PG8_SB(1, 1), b3 + hstepB, voffB); PG8_STAGE_A(PG8_SA(1, 0), a3, 0, g2);
      PG8_WAIT_V(8); PG8_WAIT_L(0); PG8_BAR; PG8_MMA(1, 0, At, B0); PG8_MMA(1, 1, At, B1); PG8_BAR; PG8_SCHED;
      if constexpr (Sched::GATHER) { if (last) {
#pragma unroll
        for (int h = 0; h < 2; ++h)
#pragma unroll
          for (int i = 0; i < 2; ++i) gcu[h][i] = g2[h][i]; } }
    }
    if (wr == 0) PG8_BAR;
    E(acc, cur, wr, wc, fr, fq);
    if (!has_next) break;
#pragma unroll
    for (int a = 0; a < 2; ++a)
#pragma unroll
      for (int b = 0; b < 2; ++b)
#pragma unroll
        for (int m = 0; m < 4; ++m)
#pragma unroll
          for (int n = 0; n < 2; ++n) acc[a][b][m][n] = (f32x4){0.f, 0.f, 0.f, 0.f};
    cur = nxt; cA = nA; cB = nB; ++ui;
    if (wr == 1) PG8_BAR;
  }
  PG8_WAIT_V(0);
  PG8_BAR;
#undef PG8_SA
#undef PG8_SB
#undef PG8_STAGE
#undef PG8_STAGE_A
#undef PG8_LDA
#undef PG8_LDB
#undef PG8_MMA
#undef PG8_WAIT_V
#undef PG8_WAIT_L
#undef PG8_BAR
#undef PG8_SCHED
}
}

__device__ __forceinline__ void cvt_item(const float* W, int ldw, bf16* WT, int Kd, int dst_row0, int k0, int n0, float* scr, int lane) {
#pragma unroll 8
  for (int i = 0; i < 32; ++i) { const int kk = 2 * i + (lane >> 5); scr[kk * 33 + (lane & 31)] = W[(size_t)(k0 + kk) * ldw + n0 + (lane & 31)]; }
  __builtin_amdgcn_s_waitcnt(0); __builtin_amdgcn_wave_barrier();
  const int cch = lane & 7;
#pragma unroll
  for (int j = 0; j < 4; ++j) { const int n = (lane >> 3) + 8 * j; const float* sp = scr + (8 * cch) * 33 + n;
    mg::u32x4 o; o.x = mg::cvt_pk_bf16(sp[0 * 33], sp[1 * 33]); o.y = mg::cvt_pk_bf16(sp[2 * 33], sp[3 * 33]); o.z = mg::cvt_pk_bf16(sp[4 * 33], sp[5 * 33]); o.w = mg::cvt_pk_bf16(sp[6 * 33], sp[7 * 33]);
    *(mg::u32x4*)(WT + (size_t)(dst_row0 + n) * Kd + k0 + 8 * cch) = o; }
  __builtin_amdgcn_s_waitcnt(0); __builtin_amdgcn_wave_barrier();
}
__device__ __forceinline__ void cvt_mat_item(const float* W, int K, int N, int ldw, bf16* WT, int mode, int it, float* scr, int lane) {
  const int nblk = N / 32, kb = it / nblk, nb = it % nblk, n0 = nb * 32;
  const int dst = mode == 0 ? n0 : ((n0 >> 7) * 256 + (n0 & 127) + (mode == 2 ? 128 : 0));
  cvt_item(W, ldw, WT, K, dst, kb * 64, n0, scr, lane);
}
__device__ __forceinline__ void cvt_dense(const Ctx& c) {
  float* scr = (float*)c.lds + c.wave * 4096;
  const float* win0 = inp(c, I0_WIN); const float* wout0 = inp(c, I0_WOUT); const float* fg = inp(c, I0_FG); const float* fu = inp(c, I0_FU); const float* fd = inp(c, I0_FD);
  const float* win1 = inp(c, I1_WIN); const float* glw = inp(c, I1_GLW); const float* wout1 = inp(c, I1_WOUT);
  unsigned char* ws = c.ws;
  for (int it = c.wave * c.G + c.bid; it < 7808; it += NW * c.G) {
    int r = it;
    if (r < 1408) { cvt_mat_item(win0, D, EVEN_IN, EVEN_IN, (bf16*)(ws + WS_WIN0), 0, r, scr, c.lane); continue; } r -= 1408;
    if (r < 512) { cvt_mat_item(wout0, D, D, D, (bf16*)(ws + WS_WOUT0), 0, r, scr, c.lane); continue; } r -= 512;
    if (r < 1408) { cvt_mat_item(fg, D, FFN, FFN, (bf16*)(ws + WS_FGU), 1, r, scr, c.lane); continue; } r -= 1408;
    if (r < 1408) { cvt_mat_item(fu, D, FFN, FFN, (bf16*)(ws + WS_FGU), 2, r, scr, c.lane); continue; } r -= 1408;
    if (r < 1408) { cvt_mat_item(fd, FFN, D, D, (bf16*)(ws + WS_FD), 0, r, scr, c.lane); continue; } r -= 1408;
    if (r < 1024) { cvt_mat_item(win1, D, 2048, ODD_IN, (bf16*)(ws + WS_WIN1), 0, r, scr, c.lane); continue; } r -= 1024;
    if (r < 128) { cvt_mat_item(glw, 512, 512, 512, (bf16*)(ws + WS_GLU), 0, r, scr, c.lane); continue; } r -= 128;
    cvt_mat_item(wout1, D, D, D, (bf16*)(ws + WS_WOUT1), 0, r, scr, c.lane);
  }
}
__device__ __forceinline__ void cvt_moe(const Ctx& c, int vb, int vG) {
  float* scr = (float*)c.lds + c.wave * 4096;
  const float* mgp = inp(c, I1_MG); const float* mup = inp(c, I1_MU); const float* mdp = inp(c, I1_MDN);
  for (int it = c.wave * vG + vb; it < 8 * 5376; it += NW * vG) {
    const int e = it / 5376, r = it % 5376, which = r / 1792, idx = r % 1792;
    if (which == 0) cvt_mat_item(mgp + (size_t)e * D * FE, D, FE, FE, (bf16*)(c.ws + WS_MGU) + (size_t)e * 2 * FE * D, 1, idx, scr, c.lane);
    else if (which == 1) cvt_mat_item(mup + (size_t)e * D * FE, D, FE, FE, (bf16*)(c.ws + WS_MGU) + (size_t)e * 2 * FE * D, 2, idx, scr, c.lane);
    else cvt_mat_item(mdp + (size_t)e * FE * D, FE, D, D, (bf16*)(c.ws + WS_MD) + (size_t)e * D * FE, 0, idx, scr, c.lane);
  }
}


template <int YMODE, int PROJ>
__device__ __forceinline__ void norm_phase(const Ctx& c, const float* resin, float* resout, const float* Y, const float* gpost, const float* gpre, bf16* XN,
                                           const float* W8, int ldw8, int c0, float* out8) {
  float* w8s = (float*)c.lds;
  LAS unsigned* hist = (LAS unsigned*)(c.lds + 32768);
  if (PROJ) {
    for (int i = c.tid; i < 1024 * 8; i += NT) w8s[i] = W8[(size_t)(i >> 3) * ldw8 + c0 + (i & 7)];
    if (PROJ == 2 && c.tid < 8) hist[c.tid] = 0u;
    __syncthreads();
  }
  int* tok_e = (int*)(c.ws + WS_ROUTE); float* tok_g = (float*)(c.ws + WS_ROUTE + 128 * 1024);
  const int* tok_slot = (const int*)(c.ws + WS_ROUTE + 256 * 1024);
  const bf16* YS = (const bf16*)(c.ws + WS_YS);
  for (int m = c.wave * c.G + c.bid; m < M; m += NW * c.G) {
    f32x4 r[4];
#pragma unroll
    for (int j = 0; j < 4; ++j) r[j] = *(const f32x4*)(resin + (size_t)m * D + j * 256 + c.lane * 4);
    if (YMODE) {
      f32x4 y[4]; float ss = 0.f;
      if (YMODE == 1) {
#pragma unroll
        for (int j = 0; j < 4; ++j) y[j] = *(const f32x4*)(Y + (size_t)m * D + j * 256 + c.lane * 4);
      } else {
        const int s0 = tok_slot[2 * m], s1 = tok_slot[2 * m + 1]; const float g0 = tok_g[2 * m], g1 = tok_g[2 * m + 1];
#pragma unroll
        for (int j = 0; j < 4; ++j) {
          const uint2 a = *(const uint2*)(YS + (size_t)s0 * D + j * 256 + c.lane * 4), b = *(const uint2*)(YS + (size_t)s1 * D + j * 256 + c.lane * 4);
          y[j][0] = g0 * bf2f((bf16)(a.x & 0xffff)) + g1 * bf2f((bf16)(b.x & 0xffff));
          y[j][1] = g0 * bf2f((bf16)(a.x >> 16)) + g1 * bf2f((bf16)(b.x >> 16));
          y[j][2] = g0 * bf2f((bf16)(a.y & 0xffff)) + g1 * bf2f((bf16)(b.y & 0xffff));
          y[j][3] = g0 * bf2f((bf16)(a.y >> 16)) + g1 * bf2f((bf16)(b.y >> 16));
        }
      }
#pragma unroll
      for (int j = 0; j < 4; ++j) ss += y[j][0] * y[j][0] + y[j][1] * y[j][1] + y[j][2] * y[j][2] + y[j][3] * y[j][3];
      const float rs = rsqrtf(wave_sum(ss) * (1.f / D) + 1e-6f);
#pragma unroll
      for (int j = 0; j < 4; ++j) {
        const f32x4 g = *(const f32x4*)(gpost + j * 256 + c.lane * 4);
        r[j] = r[j] + y[j] * rs * g;
        *(f32x4*)(resout + (size_t)m * D + j * 256 + c.lane * 4) = r[j];
      }
    }
    if (gpre) {
      float ss = 0.f;
#pragma unroll
      for (int j = 0; j < 4; ++j) ss += r[j][0] * r[j][0] + r[j][1] * r[j][1] + r[j][2] * r[j][2] + r[j][3] * r[j][3];
      const float rs = rsqrtf(wave_sum(ss) * (1.f / D) + 1e-6f);
      float p8[8];
#pragma unroll
      for (int q = 0; q < 8; ++q) p8[q] = 0.f;
#pragma unroll
      for (int j = 0; j < 4; ++j) {
        const f32x4 g = *(const f32x4*)(gpre + j * 256 + c.lane * 4);
        const f32x4 xn = r[j] * rs * g;
        uint2 o; o.x = (unsigned)f2bf(xn[0]) | ((unsigned)f2bf(xn[1]) << 16); o.y = (unsigned)f2bf(xn[2]) | ((unsigned)f2bf(xn[3]) << 16);
        *(uint2*)(XN + (size_t)m * D + j * 256 + c.lane * 4) = o;
        if (PROJ) {
#pragma unroll
          for (int e = 0; e < 4; ++e) {
            const float* wr = w8s + (j * 256 + c.lane * 4 + e) * 8;
#pragma unroll
            for (int q = 0; q < 8; ++q) p8[q] += xn[e] * wr[q];
          }
        }
      }
      if (PROJ) {
#pragma unroll
        for (int q = 0; q < 8; ++q) p8[q] = wave_sum(p8[q]);
        if (PROJ == 1) { if (c.lane < 8) { float v = p8[0];
#pragma unroll
            for (int q = 1; q < 8; ++q) v = (c.lane == q) ? p8[q] : v;
            out8[(size_t)m * 8 + c.lane] = v; } }
        if (PROJ == 2 && c.lane == 0) {
          int e0 = 0; float v0 = p8[0];
#pragma unroll
          for (int q = 1; q < 8; ++q) if (p8[q] > v0) { v0 = p8[q]; e0 = q; }
          int e1 = -1; float v1 = -3.0e38f;
#pragma unroll
          for (int q = 0; q < 8; ++q) if (q != e0 && p8[q] > v1) { v1 = p8[q]; e1 = q; }
          const float g1 = 1.f / (1.f + expf(v0 - v1)), g0 = 1.f - g1;
          tok_e[2 * m] = e0; tok_e[2 * m + 1] = e1; tok_g[2 * m] = g0; tok_g[2 * m + 1] = g1;
          atomicAdd((unsigned*)&hist[e0], 1u); atomicAdd((unsigned*)&hist[e1], 1u);
        }
      }
    }
  }
  if (PROJ == 2) { __syncthreads(); if (c.tid < 8) atomicAdd(c.ctl + CW_CNT + 64 * c.tid, hist[c.tid]); }
  __syncthreads();
}

__device__ __forceinline__ void rwkv_prep_a(const Ctx& c) {
  const float* mu = inp(c, I0_MU);
  const bf16* P = (const bf16*)(c.ws + WS_P0); bf16* AL = (bf16*)(c.ws + WS_ALORA);
  const f32x4 mu4 = *(const f32x4*)(mu + 1536 + c.lane * 4);
  for (int m = c.wave * c.G + c.bid; m < M; m += NW * c.G) {
    const int t = m % SEQ;
    const uint2 cu = *(const uint2*)(P + (size_t)m * EVEN_IN + 1536 + c.lane * 4);
    uint2 pv = {0u, 0u}; if (t > 0) pv = *(const uint2*)(P + (size_t)(m - 1) * EVEN_IN + 1536 + c.lane * 4);
    const float cv[4] = {__uint_as_float(cu.x << 16), __uint_as_float(cu.x & 0xffff0000u), __uint_as_float(cu.y << 16), __uint_as_float(cu.y & 0xffff0000u)};
    const float pp[4] = {__uint_as_float(pv.x << 16), __uint_as_float(pv.x & 0xffff0000u), __uint_as_float(pv.y << 16), __uint_as_float(pv.y & 0xffff0000u)};
    float o[4];
#pragma unroll
    for (int e = 0; e < 4; ++e) { float v = cv[e] + (pp[e] - cv[e]) * mu4[e]; if (c.lane < 16) v = tanhf(v); else if (c.lane >= 32) v = sigmoid_(v); o[e] = v; }
    uint2 w; w.x = (unsigned)f2bf(o[0]) | ((unsigned)f2bf(o[1]) << 16); w.y = (unsigned)f2bf(o[2]) | ((unsigned)f2bf(o[3]) << 16);
    *(uint2*)(AL + (size_t)m * 256 + c.lane * 4) = w;
  }
}
__device__ __forceinline__ void build_wlora(const Ctx& c) {
  const float* w2 = inp(c, I0_W2); const float* a2 = inp(c, I0_A2); const float* g2 = inp(c, I0_G2);
  bf16* WL = (bf16*)(c.ws + WS_WLORA);
  for (int i = c.bid * NT + c.tid; i < 1536 * 256; i += c.G * NT) {
    const int n = i >> 8, k = i & 255; float v = 0.f;
    if (n < 512) { if (k < 64) v = w2[k * 512 + n]; }
    else if (n < 1024) { if (k >= 64 && k < 128) v = a2[(k - 64) * 512 + (n - 512)]; }
    else { if (k >= 128) v = g2[(k - 128) * 512 + (n - 1024)]; }
    WL[i] = f2bf(v);
  }
}
__device__ __forceinline__ void rwkv_prep_c(const Ctx& c) {
  const float* mu = inp(c, I0_MU); const float* w0 = inp(c, I0_W0); const float* a0 = inp(c, I0_A0);
  const float* kkp = inp(c, I0_KK); const float* kap = inp(c, I0_KA); const float* rkp = inp(c, I0_RK);
  const bf16* P = (const bf16*)(c.ws + WS_P0); const bf16* LW = (const bf16*)(c.ws + WS_LOWA);
  float* SR = (float*)(c.ws + WS_SR); float* SW = (float*)(c.ws + WS_SW); float* SK = (float*)(c.ws + WS_SK); float* SV = (float*)(c.ws + WS_SV);
  float* SA = (float*)(c.ws + WS_SA); float* SB = (float*)(c.ws + WS_SB); float* BON = (float*)(c.ws + WS_BON);
  for (int m = c.wave * c.G + c.bid; m < M; m += NW * c.G) {
    const int t = m % SEQ;
    const bf16* pc = P + (size_t)m * EVEN_IN; const bf16* pp = P + (size_t)(m - 1) * EVEN_IN;
#pragma unroll 2
    for (int j = 0; j < 8; ++j) {
      const int ch = j * 64 + c.lane;
      const float rc = bf2f(pc[ch]), kc = bf2f(pc[512 + ch]), vc = bf2f(pc[1024 + ch]);
      float rp = 0.f, kp = 0.f, vp = 0.f; if (t > 0) { rp = bf2f(pp[ch]); kp = bf2f(pp[512 + ch]); vp = bf2f(pp[1024 + ch]); }
      const float r = rc + (rp - rc) * mu[ch], k = kc + (kp - kc) * mu[512 + ch], v = vc + (vp - vc) * mu[1024 + ch];
      const float aw = w0[ch] + bf2f(LW[(size_t)m * 1024 + ch]), aa = a0[ch] + bf2f(LW[(size_t)m * 1024 + 512 + ch]);
      const float wl = -softplus_(-aw) - 0.5f;
      const float decay = expf(-expf(wl));
      const float a = sigmoid_(aa);
      float kk = k * kkp[ch];
      const float nrm = sqrtf(wave_sum(kk * kk));
      kk = kk / fmaxf(nrm, 1e-12f);
      const float k2 = k * (1.f + (a - 1.f) * kap[ch]);
      const float bon = wave_sum(r * k2 * rkp[ch]);
      const size_t o = (size_t)m * 512 + ch;
      SR[o] = r; SW[o] = decay; SK[o] = k2; SV[o] = v; SA[o] = -kk; SB[o] = kk * a;
      if (c.lane == 0) BON[(size_t)m * 8 + j] = bon;
    }
  }
}

template <int CTRL> __device__ __forceinline__ float dpp_f(float v) { return __int_as_float(__builtin_amdgcn_update_dpp(0, __float_as_int(v), CTRL, 0xf, 0xf, true)); }
__device__ __forceinline__ float row16_sum(float v) { v += dpp_f<0xB1>(v); v += dpp_f<0x4E>(v); v += dpp_f<0x141>(v); v += dpp_f<0x140>(v); return v; }
constexpr size_t WS_YSC = WS_XN;
__device__ __forceinline__ void rwkv_scan(const Ctx& c) {
  const float* ST[6] = {(const float*)(c.ws + WS_SR), (const float*)(c.ws + WS_SW), (const float*)(c.ws + WS_SK), (const float*)(c.ws + WS_SV), (const float*)(c.ws + WS_SA), (const float*)(c.ws + WS_SB)};
  float* YO = (float*)(c.ws + WS_YSC);
  float* buf = (float*)c.lds;
  float* ysm = (float*)c.lds + 2 * 6 * 32 * 64;
  const int ltt = c.tid >> 4, lq = c.tid & 15;
  const int rr = c.lane >> 4, kq = c.lane & 15, rloc = c.wave * 4 + rr;
  for (int it = c.bid; it < BATCH * 8 * 2; it += c.G) {
    const int b = it >> 4, h = (it >> 1) & 7, half = it & 1;
    const size_t m0 = (size_t)b * SEQ;
    const int row = half * 32 + rloc;
    f32x4 S = {0.f, 0.f, 0.f, 0.f};
    f32x4 ld[6];
    __syncthreads();
#pragma unroll
    for (int s6 = 0; s6 < 6; ++s6) ld[s6] = *(const f32x4*)(ST[s6] + (m0 + ltt) * 512 + h * 64 + lq * 4);
#pragma unroll
    for (int s6 = 0; s6 < 6; ++s6) *(f32x4*)(buf + ((0 * 6 + s6) * 32 + ltt) * 64 + lq * 4) = ld[s6];
    __syncthreads();
    for (int ck = 0; ck < SEQ / 32; ++ck) {
      const int cur = ck & 1;
      if (ck + 1 < SEQ / 32) {
#pragma unroll
        for (int s6 = 0; s6 < 6; ++s6) ld[s6] = *(const f32x4*)(ST[s6] + (m0 + (ck + 1) * 32 + ltt) * 512 + h * 64 + lq * 4);
      }
      const float* bb = buf + cur * 6 * 32 * 64;
#pragma unroll 4
      for (int tt = 0; tt < 32; ++tt) {
        const f32x4 r4 = *(const f32x4*)(bb + (0 * 32 + tt) * 64 + kq * 4), w4 = *(const f32x4*)(bb + (1 * 32 + tt) * 64 + kq * 4), k4 = *(const f32x4*)(bb + (2 * 32 + tt) * 64 + kq * 4);
        const f32x4 a4 = *(const f32x4*)(bb + (4 * 32 + tt) * 64 + kq * 4), b4 = *(const f32x4*)(bb + (5 * 32 + tt) * 64 + kq * 4);
        const float v = bb[(3 * 32 + tt) * 64 + row];
        const float sa = row16_sum((S[0] * a4[0] + S[1] * a4[1]) + (S[2] * a4[2] + S[3] * a4[3]));
        S = S * w4 + sa * b4 + v * k4;
        const float y = row16_sum((S[0] * r4[0] + S[1] * r4[1]) + (S[2] * r4[2] + S[3] * r4[3]));
        if (kq == 0) ysm[tt * 32 + rloc] = y;
      }
      __syncthreads();
      if (ck + 1 < SEQ / 32) {
#pragma unroll
        for (int s6 = 0; s6 < 6; ++s6) *(f32x4*)(buf + (((cur ^ 1) * 6 + s6) * 32 + ltt) * 64 + lq * 4) = ld[s6];
      }
      if (c.tid < 256) { const int tt = c.tid >> 3, q = c.tid & 7; *(f32x4*)(YO + (m0 + ck * 32 + tt) * 512 + h * 64 + half * 32 + q * 4) = *(const f32x4*)(ysm + tt * 32 + q * 4); }
      __syncthreads();
    }
  }
  __syncthreads();
}

__device__ __forceinline__ void rwkv_post(const Ctx& c) {
  const float* YS = (const float*)(c.ws + WS_YSC); const float* SV = (const float*)(c.ws + WS_SV); const bf16* GG = (const bf16*)(c.ws + WS_LOG);
  const float* BON = (const float*)(c.ws + WS_BON); bf16* YM = (bf16*)(c.ws + WS_YMIX);
  const float* lnw = inp(c, I0_LNW); const float* lnb = inp(c, I0_LNB);
  for (int m = c.wave * c.G + c.bid; m < M; m += NW * c.G) {
#pragma unroll
    for (int j = 0; j < 8; ++j) {
      const int ch = j * 64 + c.lane; const size_t o = (size_t)m * 512 + ch;
      const float y = YS[o];
      const float mean = wave_sum(y) * (1.f / 64.f);
      const float d = y - mean;
      const float var = wave_sum(d * d) * (1.f / 64.f);
      float v = d * rsqrtf(var + 64e-5f) * lnw[ch] + lnb[ch];
      v += BON[(size_t)m * 8 + j] * SV[o];
      YM[(size_t)m * D + ch] = f2bf(v * bf2f(GG[(size_t)m * 1024 + ch]));
    }
  }
}

__device__ __forceinline__ void gmlp_phase(const Ctx& c, int vb, int vG) {
  const bf16* P = (const bf16*)(c.ws + WS_P0); bf16* YM = (bf16*)(c.ws + WS_YMIX);
  const float* lnw = inp(c, I0_GLNW); const float* lnb = inp(c, I0_GLNB); const float* ws = inp(c, I0_GWS); const float* bs = inp(c, I0_GBS);
  float* vn = (float*)c.lds;
  for (int it = vb; it < BATCH * 16 * 4; it += vG) {
    const int g = it & 3, ck = (it >> 2) & 15, b = it >> 6;
    const size_t m0 = (size_t)b * SEQ + ck * 128;
    __syncthreads();
    for (int j = c.wave; j < 128; j += NW) {
      const bf16* row = P + (m0 + j) * EVEN_IN + 2304 + g * 128;
      const float v0 = gelu_(bf2f(row[c.lane])), v1 = gelu_(bf2f(row[c.lane + 64]));
      const float mean = wave_sum(v0 + v1) * (1.f / 128.f);
      const float d0 = v0 - mean, d1 = v1 - mean;
      const float rs = rsqrtf(wave_sum(d0 * d0 + d1 * d1) * (1.f / 128.f) + 1e-6f);
      vn[j * 128 + c.lane] = d0 * rs * lnw[g * 128 + c.lane] + lnb[g * 128 + c.lane];
      vn[j * 128 + c.lane + 64] = d1 * rs * lnw[g * 128 + c.lane + 64] + lnb[g * 128 + c.lane + 64];
    }
    __syncthreads();
    const int d = c.tid & 127, iq = c.tid >> 7;
    for (int ii = 0; ii < 32; ++ii) {
      const int i = iq + 4 * ii;
      const float* wrow = ws + ((size_t)g * 128 + i) * 128;
      float acc = bs[g * 128 + i];
      for (int j = 0; j <= i; ++j) acc += wrow[j] * vn[j * 128 + d];
      const float u = gelu_(bf2f(P[(m0 + i) * EVEN_IN + 1792 + g * 128 + d]));
      YM[(m0 + i) * D + 512 + g * 128 + d] = f2bf(u * acc);
    }
  }
  __syncthreads();
}

__device__ __forceinline__ void s5_scan(const Ctx& c) {
  const float* p_are = inp(c, I1_ARE); const float* p_aim = inp(c, I1_AIM); const float* p_ldt = inp(c, I1_LDT); const float* p_bre = inp(c, I1_BRE); const float* p_bim = inp(c, I1_BIM);
  const float* p_cre = inp(c, I1_CRE); const float* p_cim = inp(c, I1_CIM); const float* p_sd = inp(c, I1_SD);
  const bf16* P1 = (const bf16*)(c.ws + WS_P1); bf16* YC = (bf16*)(c.ws + WS_YC);
  float* wl = (float*)c.lds + c.wave * 4096;
  float* XR = wl, *XI = wl + 1040, *CRE = wl + 2080, *CIM = wl + 3120;
  for (int it = c.wave * c.G + c.bid; it < BATCH * 32; it += NW * c.G) {
    const int b = it >> 5, g = it & 31, p = c.lane;
    const float lr = p_are[g * 64 + p], li = p_aim[g * 64 + p], dt = expf(p_ldt[g]);
    const float mag = expf(lr * dt), ar = mag * cosf(li * dt), ai = mag * sinf(li * dt);
    const float nr = ar - 1.f, ni = ai, den = lr * lr + li * li;
    const float fr = (nr * lr + ni * li) / den, fi = (ni * lr - nr * li) / den;
    float bbr[16], bbi[16];
#pragma unroll
    for (int q = 0; q < 16; ++q) { const float br = p_bre[(g * 64 + p) * 16 + q], bi = p_bim[(g * 64 + p) * 16 + q]; bbr[q] = fr * br - fi * bi; bbi[q] = fr * bi + fi * br; }
#pragma unroll
    for (int q = 0; q < 16; ++q) { CRE[q * 65 + p] = p_cre[(g * 16 + q) * 64 + p]; CIM[q * 65 + p] = p_cim[(g * 16 + q) * 64 + p]; }
    float xr = 0.f, xi = 0.f;
    const int tt = c.lane >> 2, cq = c.lane & 3;
    for (int t0 = 0; t0 < SEQ; t0 += 16) {
      const size_t m0 = (size_t)b * SEQ + t0;
#pragma unroll 4
      for (int s = 0; s < 16; ++s) {
        const uint4 u0 = *(const uint4*)(P1 + (m0 + s) * 2048 + g * 16), u1 = *(const uint4*)(P1 + (m0 + s) * 2048 + g * 16 + 8);
        const unsigned uw[8] = {u0.x, u0.y, u0.z, u0.w, u1.x, u1.y, u1.z, u1.w};
        float br = 0.f, bi = 0.f;
#pragma unroll
        for (int q = 0; q < 8; ++q) { const float ua = bf2f((bf16)(uw[q] & 0xffff)), ub = bf2f((bf16)(uw[q] >> 16));
          br += ua * bbr[2 * q] + ub * bbr[2 * q + 1]; bi += ua * bbi[2 * q] + ub * bbi[2 * q + 1]; }
        const float nxr = ar * xr - ai * xi + br, nxi = ar * xi + ai * xr + bi;
        xr = nxr; xi = nxi;
        XR[s * 65 + p] = xr; XI[s * 65 + p] = xi;
      }
      __builtin_amdgcn_s_waitcnt(0); __builtin_amdgcn_wave_barrier();
      float y[4] = {0.f, 0.f, 0.f, 0.f};
      for (int q = 0; q < 64; ++q) {
        const float a = XR[tt * 65 + q], bq = XI[tt * 65 + q];
#pragma unroll
        for (int e = 0; e < 4; ++e) y[e] += a * CRE[(cq * 4 + e) * 65 + q] - bq * CIM[(cq * 4 + e) * 65 + q];
      }
#pragma unroll
      for (int e = 0; e < 4; ++e) {
        const int ch = g * 16 + cq * 4 + e;
        const float u = bf2f(P1[(m0 + tt) * 2048 + ch]);
        YC[(m0 + tt) * 512 + ch] = f2bf(gelu_(y[e] + p_sd[ch] * u));
      }
      __builtin_amdgcn_s_waitcnt(0); __builtin_amdgcn_wave_barrier();
    }
  }
  __syncthreads();
}

__device__ __forceinline__ void ssd_conv(const Ctx& c) {
  const bf16* P1 = (const bf16*)(c.ws + WS_P1); bf16* CV = (bf16*)(c.ws + WS_CONV);
  const float* cw = inp(c, I1_CW); const float* cb = inp(c, I1_CB);
  for (size_t i = (size_t)c.bid * NT + c.tid; i < (size_t)M * 128; i += (size_t)c.G * NT) {
    const int ch = (int)(i & 127) * 8; const size_t m = i >> 7; const int t = (int)(m % SEQ);
    float acc[8];
#pragma unroll
    for (int e = 0; e < 8; ++e) acc[e] = cb[ch + e];
#pragma unroll
    for (int j = 0; j < 4; ++j) { const int tt = t - 3 + j; if (tt >= 0) {
        const uint4 v = *(const uint4*)(P1 + (m - 3 + j) * 2048 + 1024 + ch); const unsigned vw[4] = {v.x, v.y, v.z, v.w};
#pragma unroll
        for (int e = 0; e < 4; ++e) { acc[2 * e] += cw[j * 1024 + ch + 2 * e] * __uint_as_float(vw[e] << 16); acc[2 * e + 1] += cw[j * 1024 + ch + 2 * e + 1] * __uint_as_float(vw[e] & 0xffff0000u); } } }
    uint4 o; o.x = mg::cvt_pk_bf16(silu_(acc[0]), silu_(acc[1])); o.y = mg::cvt_pk_bf16(silu_(acc[2]), silu_(acc[3])); o.z = mg::cvt_pk_bf16(silu_(acc[4]), silu_(acc[5])); o.w = mg::cvt_pk_bf16(silu_(acc[6]), silu_(acc[7]));
    *(uint4*)(CV + m * 1024 + ch) = o;
  }
}

constexpr int SPI = 136;
constexpr int SL_C = 0, SL_B = 34816, SL_BT = 69632, SL_XT = 104448, SL_DT = 121856, SL_ACS = 123904;
__device__ __forceinline__ void ssd_dt_acs(const Ctx& c, size_t m0, int g, const float* DT, const float* dtb, const float* alog, float* sdt, float* sacs) {
  if (c.wave < 4) {
    const int h = g * 4 + c.wave; const float av = -expf(alog[h]), bias = dtb[h];
    const float d0 = softplus_(DT[(m0 + 2 * c.lane) * 8 + h] + bias), d1 = softplus_(DT[(m0 + 2 * c.lane + 1) * 8 + h] + bias);
    const float a0 = av * d0, a1 = av * d1;
    float sc = a0 + a1;
#pragma unroll
    for (int o = 1; o < 64; o <<= 1) { const float t = __shfl_up(sc, o); if (c.lane >= o) sc += t; }
    sdt[c.wave * 128 + 2 * c.lane] = d0; sdt[c.wave * 128 + 2 * c.lane + 1] = d1;
    sacs[c.wave * 128 + 2 * c.lane] = sc - a1; sacs[c.wave * 128 + 2 * c.lane + 1] = sc;
  }
}
__device__ __forceinline__ void ssd_pass1(const Ctx& c) {
  const bf16* CV = (const bf16*)(c.ws + WS_CONV); const float* DT = (const float*)(c.ws + WS_DT);
  float* YD = (float*)(c.ws + WS_YD); float* SE = (float*)(c.ws + WS_SE); float* ATOT = (float*)(c.ws + WS_ATOT);
  const float* dtb = inp(c, I1_DTB); const float* alog = inp(c, I1_ALOG);
  bf16* Cs = (bf16*)(c.lds + SL_C); bf16* Bs = (bf16*)(c.lds + SL_B); bf16* BTs = (bf16*)(c.lds + SL_BT); bf16* XT = (bf16*)(c.lds + SL_XT);
  float* sdt = (float*)(c.lds + SL_DT); float* sacs = (float*)(c.lds + SL_ACS);
  const int w = c.wave, q = c.lane >> 4, lr = c.lane & 15;
  for (int unit = c.bid; unit < BATCH * 16 * 2; unit += c.G) {
    const int g = unit & 1, ck = (unit >> 1) & 15, b = unit >> 5;
    const size_t m0 = (size_t)b * SEQ + ck * 128;
    __syncthreads();
#pragma unroll
    for (int i = 0; i < 8; ++i) { const int idx = c.tid + NT * i, mat = idx >> 11, r = (idx >> 4) & 127, qq = idx & 15;
      const uint4 v = *(const uint4*)(CV + (m0 + r) * 1024 + 512 + mat * 256 + g * 128 + qq * 8);
      *(uint4*)((mat ? Cs : Bs) + r * SPI + qq * 8) = v; }
#pragma unroll
    for (int i = 0; i < 4; ++i) { const int task = c.tid + NT * i, n = task & 127, l0 = (task >> 7) * 8;
      unsigned short e[8];
#pragma unroll
      for (int j = 0; j < 8; ++j) e[j] = CV[(m0 + l0 + j) * 1024 + 512 + g * 128 + n];
      uint4 o; o.x = e[0] | ((unsigned)e[1] << 16); o.y = e[2] | ((unsigned)e[3] << 16); o.z = e[4] | ((unsigned)e[5] << 16); o.w = e[6] | ((unsigned)e[7] << 16);
      *(uint4*)(BTs + n * SPI + l0) = o; }
    ssd_dt_acs(c, m0, g, DT, dtb, alog, sdt, sacs);
    __syncthreads();
    mg::bf16x8 cf[4];
#pragma unroll
    for (int ks = 0; ks < 4; ++ks) cf[ks] = *(const mg::bf16x8*)(Cs + (16 * w + lr) * SPI + 32 * ks + 8 * q);
    f32x4 cb[8];
#pragma unroll
    for (int j = 0; j < 8; ++j) { cb[j] = (f32x4){0.f, 0.f, 0.f, 0.f};
#pragma unroll
      for (int ks = 0; ks < 4; ++ks) { const mg::bf16x8 bf = *(const mg::bf16x8*)(Bs + (16 * j + lr) * SPI + 32 * ks + 8 * q); cb[j] = __builtin_amdgcn_mfma_f32_16x16x32_bf16(cf[ks], bf, cb[j], 0, 0, 0); } }
    __syncthreads();
    bf16* Ms = Bs;
    for (int r = 0; r < 4; ++r) {
      const int h = g * 4 + r;
#pragma unroll
      for (int i = 0; i < 2; ++i) { const int task = c.tid + NT * i, p = task & 63, l0 = (task >> 6) * 8;
        unsigned short e[8];
#pragma unroll
        for (int j = 0; j < 8; ++j) e[j] = CV[(m0 + l0 + j) * 1024 + h * 64 + p];
        uint4 o; o.x = e[0] | ((unsigned)e[1] << 16); o.y = e[2] | ((unsigned)e[3] << 16); o.z = e[4] | ((unsigned)e[5] << 16); o.w = e[6] | ((unsigned)e[7] << 16);
        *(uint4*)(XT + p * SPI + l0) = o; }
      const float* ac = sacs + r * 128; const float* dl = sdt + r * 128;
#pragma unroll
      for (int j = 0; j < 8; ++j) { const int sidx = 16 * j + lr; const float as = ac[sidx], ds = dl[sidx];
#pragma unroll
        for (int i = 0; i < 4; ++i) { const int l = 16 * w + 4 * q + i;
          const float v = (sidx <= l) ? cb[j][i] * __expf(fminf(ac[l] - as, 0.f)) * ds : 0.f;
          Ms[l * SPI + sidx] = f2bf(v); } }
      __syncthreads();
      { f32x4 ya[4];
#pragma unroll
        for (int pt = 0; pt < 4; ++pt) ya[pt] = (f32x4){0.f, 0.f, 0.f, 0.f};
        const int kmax = (16 * w + 15) >> 5;
        for (int ks = 0; ks <= kmax; ++ks) { const mg::bf16x8 mf = *(const mg::bf16x8*)(Ms + (16 * w + lr) * SPI + 32 * ks + 8 * q);
#pragma unroll
          for (int pt = 0; pt < 4; ++pt) { const mg::bf16x8 xf = *(const mg::bf16x8*)(XT + (16 * pt + lr) * SPI + 32 * ks + 8 * q); ya[pt] = __builtin_amdgcn_mfma_f32_16x16x32_bf16(mf, xf, ya[pt], 0, 0, 0); } }
#pragma unroll
        for (int pt = 0; pt < 4; ++pt)
#pragma unroll
          for (int i = 0; i < 4; ++i) YD[(m0 + 16 * w + 4 * q + i) * 512 + h * 64 + 16 * pt + lr] = ya[pt][i]; }
      { const int pt = w & 3, ntb = (w >> 2) * 4; const float aend = ac[127];
        f32x4 sa[4];
#pragma unroll
        for (int nt = 0; nt < 4; ++nt) sa[nt] = (f32x4){0.f, 0.f, 0.f, 0.f};
#pragma unroll
        for (int ks = 0; ks < 4; ++ks) { const uint4 xr = *(const uint4*)(XT + (16 * pt + lr) * SPI + 32 * ks + 8 * q); const unsigned xw[4] = {xr.x, xr.y, xr.z, xr.w};
          float xv[8];
#pragma unroll
          for (int e = 0; e < 4; ++e) { const int l = 32 * ks + 8 * q + 2 * e;
            xv[2 * e] = __uint_as_float(xw[e] << 16) * dl[l] * __expf(aend - ac[l]); xv[2 * e + 1] = __uint_as_float(xw[e] & 0xffff0000u) * dl[l + 1] * __expf(aend - ac[l + 1]); }
          union { uint4 u; mg::bf16x8 v; } xs; xs.u.x = mg::cvt_pk_bf16(xv[0], xv[1]); xs.u.y = mg::cvt_pk_bf16(xv[2], xv[3]); xs.u.z = mg::cvt_pk_bf16(xv[4], xv[5]); xs.u.w = mg::cvt_pk_bf16(xv[6], xv[7]);
#pragma unroll
          for (int nt = 0; nt < 4; ++nt) { const mg::bf16x8 bt = *(const mg::bf16x8*)(BTs + (16 * (ntb + nt) + lr) * SPI + 32 * ks + 8 * q); sa[nt] = __builtin_amdgcn_mfma_f32_16x16x32_bf16(xs.v, bt, sa[nt], 0, 0, 0); } }
        float* Eo = SE + ((size_t)(b * 8 + h) * 16 + ck) * 8192;
#pragma unroll
        for (int nt = 0; nt < 4; ++nt)
#pragma unroll
          for (int i = 0; i < 4; ++i) Eo[(16 * pt + 4 * q + i) * 128 + 16 * (ntb + nt) + lr] = sa[nt][i];
        if (c.tid == 0) ATOT[(b * 8 + h) * 16 + ck] = aend; }
      __syncthreads();
    }
  }
  __syncthreads();
}
__device__ __forceinline__ void ssd_carry(const Ctx& c) {
  const float* SE = (const float*)(c.ws + WS_SE); const float* ATOT = (const float*)(c.ws + WS_ATOT); bf16* SPV = (bf16*)(c.ws + WS_SPV);
  for (int i = c.bid * NT + c.tid; i < BATCH * 8 * 2048; i += c.G * NT) {
    const int bh = i >> 11, e4 = (i & 2047) * 4;
    f32x4 S = {0.f, 0.f, 0.f, 0.f};
    for (int ck = 0; ck < 16; ++ck) {
      const size_t o = ((size_t)bh * 16 + ck) * 8192 + e4;
      uint2 pk; pk.x = mg::cvt_pk_bf16(S[0], S[1]); pk.y = mg::cvt_pk_bf16(S[2], S[3]);
      *(uint2*)(SPV + o) = pk;
      const float d = __expf(ATOT[bh * 16 + ck]); const f32x4 e = *(const f32x4*)(SE + o);
      S = S * d + e;
    }
  }
}
__device__ __forceinline__ void ssd_pass2(const Ctx& c) {
  const bf16* CV = (const bf16*)(c.ws + WS_CONV); const float* DT = (const float*)(c.ws + WS_DT); const bf16* P1 = (const bf16*)(c.ws + WS_P1);
  const float* YD = (const float*)(c.ws + WS_YD); const bf16* SPV = (const bf16*)(c.ws + WS_SPV); bf16* YM = (bf16*)(c.ws + WS_YMIX);
  const float* dtb = inp(c, I1_DTB); const float* alog = inp(c, I1_ALOG); const float* dsk = inp(c, I1_MD); const float* nw = inp(c, I1_MNW);
  bf16* Cs = (bf16*)(c.lds + SL_C); bf16* SPs = (bf16*)(c.lds + SL_B);
  float* sdt = (float*)(c.lds + SL_DT); float* sacs = (float*)(c.lds + SL_ACS);
  const int w = c.wave, q = c.lane >> 4, lr = c.lane & 15;
  for (int unit = c.bid; unit < BATCH * 16 * 2; unit += c.G) {
    const int g = unit & 1, ck = (unit >> 1) & 15, b = unit >> 5;
    const size_t m0 = (size_t)b * SEQ + ck * 128;
    __syncthreads();
#pragma unroll
    for (int i = 0; i < 4; ++i) { const int idx = c.tid + NT * i, r = idx >> 4, qq = idx & 15;
      *(uint4*)(Cs + r * SPI + qq * 8) = *(const uint4*)(CV + (m0 + r) * 1024 + 768 + g * 128 + qq * 8); }
#pragma unroll
    for (int i = 0; i < 8; ++i) { const int idx = c.tid + NT * i, r = idx >> 10, p = (idx >> 4) & 63, qq = idx & 15;
      *(uint4*)(SPs + (r * 64 + p) * SPI + qq * 8) = *(const uint4*)(SPV + ((size_t)(b * 8 + g * 4 + r) * 16 + ck) * 8192 + p * 128 + qq * 8); }
    ssd_dt_acs(c, m0, g, DT, dtb, alog, sdt, sacs);
    __syncthreads();
    mg::bf16x8 cf[4];
#pragma unroll
    for (int ks = 0; ks < 4; ++ks) cf[ks] = *(const mg::bf16x8*)(Cs + (16 * w + lr) * SPI + 32 * ks + 8 * q);
    f32x4 yo[4][4];
#pragma unroll
    for (int r = 0; r < 4; ++r)
#pragma unroll
      for (int pt = 0; pt < 4; ++pt) { yo[r][pt] = (f32x4){0.f, 0.f, 0.f, 0.f};
#pragma unroll
        for (int ks = 0; ks < 4; ++ks) { const mg::bf16x8 sf = *(const mg::bf16x8*)(SPs + (r * 64 + 16 * pt + lr) * SPI + 32 * ks + 8 * q); yo[r][pt] = __builtin_amdgcn_mfma_f32_16x16x32_bf16(cf[ks], sf, yo[r][pt], 0, 0, 0); } }
    float dh[4];
#pragma unroll
    for (int r = 0; r < 4; ++r) dh[r] = dsk[g * 4 + r];
    float ss[4];
#pragma unroll
    for (int i = 0; i < 4; ++i) {
      const int l = 16 * w + 4 * q + i; const size_t m = m0 + l;
      const float* ydp = YD + m * 512 + g * 256 + lr; const bf16* cvp = CV + m * 1024 + g * 256 + lr; const bf16* zp = P1 + m * 2048 + 512 + g * 256 + lr;
      float sq = 0.f;
#pragma unroll
      for (int r = 0; r < 4; ++r) { const float ea = __expf(sacs[r * 128 + l]);
#pragma unroll
        for (int pt = 0; pt < 4; ++pt) { const int o = r * 64 + 16 * pt;
          const float y = ydp[o] + ea * yo[r][pt][i] + dh[r] * bf2f(cvp[o]);
          const float vv = y * silu_(bf2f(zp[o]));
          yo[r][pt][i] = vv; sq += vv * vv; } }
      ss[i] = rsqrtf(row16_sum(sq) * (1.f / 256.f) + 1e-6f);
      asm volatile("" ::: "memory");
    }
#pragma unroll
    for (int i = 0; i < 4; ++i) { const int l = 16 * w + 4 * q + i;
      bf16* ymp = YM + (m0 + l) * D + 512 + g * 256 + lr; const float* nwp = nw + g * 256 + lr;
#pragma unroll
      for (int r = 0; r < 4; ++r)
#pragma unroll
        for (int pt = 0; pt < 4; ++pt) { const int o = r * 64 + 16 * pt; ymp[o] = f2bf(yo[r][pt][i] * ss[i] * nwp[o]); }
      asm volatile("" ::: "memory");
    }
  }
  __syncthreads();
}

__device__ __forceinline__ void moe_assign(const Ctx& c) {
  LAS unsigned* lcnt = (LAS unsigned*)c.lds; LAS unsigned* lbase = lcnt + 8;
  const int* tok_e = (const int*)(c.ws + WS_ROUTE); int* tok_slot = (int*)(c.ws + WS_ROUTE + 256 * 1024); int* slot_tok = (int*)(c.ctl + CW_SLOTTOK);
  int pstart[8]; { int acc = 0;
#pragma unroll
    for (int e = 0; e < 8; ++e) { pstart[e] = acc; acc += ((int)c.ctl[CW_CNT + 64 * e] + 255) / 256 * 256; } }
  for (int tb = c.bid; tb < M / 64; tb += c.G) {
    __syncthreads();
    if (c.tid < 8) lcnt[c.tid] = 0u;
    __syncthreads();
    int e = 0; unsigned rank = 0; const int pair = tb * 128 + c.tid;
    if (c.tid < 128) { e = tok_e[pair]; rank = atomicAdd((unsigned*)&lcnt[e], 1u); }
    __syncthreads();
    if (c.tid < 8) lbase[c.tid] = atomicAdd(c.ctl + CW_CUR + 64 * c.tid, lcnt[c.tid]);
    __syncthreads();
    if (c.tid < 128) {
      int ps = 0;
#pragma unroll
      for (int q = 0; q < 8; ++q) ps = (e == q) ? pstart[q] : ps;
      const int slot = ps + (int)lbase[e] + (int)rank;
      slot_tok[slot] = pair >> 1; tok_slot[pair] = slot;
    }
  }
  __syncthreads();
}


enum { PH_PRO, PH_WIN0, PH_PREPA, PH_LORA, PH_PREPC, PH_SCAN, PH_POST, PH_WOUT0, PH_NORM0, PH_FGU, PH_FD, PH_NORM1, PH_WIN1, PH_L1A, PH_L1B, PH_L1CARRY, PH_L1C, PH_WOUT1, PH_NORM2, PH_ASSIGN, PH_MGU0, PH_MD0, PH_MGU1, PH_MD1, PH_FINAL, PH_COUNT };
constexpr int LAST_PHASE = PH_COUNT;
template <int LO, int HI>
__global__ void __launch_bounds__(NT, 2) fwd_kernel(Args args) {
  extern __shared__ __attribute__((aligned(16))) unsigned char lds[];
  Ctx c0; c0.out = args.out; c0.ws = args.ws; c0.ctl = (unsigned*)(args.ws + WS_CTL); c0.lds = lds;
  c0.tid = threadIdx.x; c0.lane = c0.tid & 63; c0.wave = __builtin_amdgcn_readfirstlane(c0.tid >> 6); c0.bid = blockIdx.x; c0.G = gridDim.x;
  volatile LAS unsigned* bst = (volatile LAS unsigned*)(LAS unsigned char*)(lds + LDS_BST);
  if (c0.tid == 0) { LAS unsigned long long* pt = (LAS unsigned long long*)(LAS unsigned char*)(lds + LDS_PTAB);
#pragma unroll
    for (int i = 0; i < N_IN; ++i) pt[i] = (unsigned long long)args.in[i];
    bst[0] = 0u; bst[1] = 0u; }
  __syncthreads();
  constexpr int lo = LO, hi = HI;
  XcdBarrier bar; bar.bar = c0.ctl + CW_BAR; bar.x = 0; bar.st = bst;
  if constexpr (hi - lo > 1) bar = xcd_barrier_post(c0.ctl + CW_BAR, bst);
#define IN(k) (lo <= (k) && (k) < hi)
#define SEAM(k) do { if constexpr (IN(k) && IN((k) + 1)) xcd_barrier(bar); } while (0)
  unsigned char* ws = args.ws;
  bf16* XN = (bf16*)(ws + WS_XN); bf16* YM = (bf16*)(ws + WS_YMIX); float* Y = (float*)(ws + WS_Y);

  LAS unsigned char* const ldsl = (LAS unsigned char*)lds;
  if constexpr (IN(PH_PRO)) { const Ctx c = launder(c0); cvt_dense(c); build_wlora(c); norm_phase<0, 0>(c, inp(c, I_X), nullptr, nullptr, nullptr, inp(c, I0_NPM), XN, nullptr, 0, 0, nullptr); } SEAM(PH_PRO);
  if constexpr (IN(PH_WIN0)) { const Ctx c = launder(c0); mg::Gemm g{XN, (const bf16*)(ws + WS_WIN0), D, D, D}; mg::DenseOrder S; S.init(M / 256, EVEN_IN / 256, c.G, c.bid);
    mg::EpiBf16<false> E{(bf16*)(ws + WS_P0), EVEN_IN}; mg::gemm_phase(ldsl, g, S, E); } SEAM(PH_WIN0);
  if constexpr (IN(PH_PREPA)) { const Ctx c = launder(c0); rwkv_prep_a(c); } SEAM(PH_PREPA);
  if constexpr (IN(PH_LORA)) { const Ctx c = launder(c0); mg::Gemm g{(const bf16*)(ws + WS_ALORA), (const bf16*)(ws + WS_WLORA), 256, 256, 256}; mg::DenseOrder S; S.init(M / 256, 1536 / 256, c.G, c.bid);
    mg::EpiLora E{(bf16*)(ws + WS_LOWA), (bf16*)(ws + WS_LOG)}; mg::gemm_phase(ldsl, g, S, E); } SEAM(PH_LORA);
  if constexpr (IN(PH_PREPC)) { const Ctx c = launder(c0); rwkv_prep_c(c); } SEAM(PH_PREPC);
  if constexpr (IN(PH_SCAN)) { const Ctx c = launder(c0); if (c.G >= 256) { if (c.bid < 128) rwkv_scan(c); else gmlp_phase(c, c.bid - 128, c.G - 128); } else { rwkv_scan(c); gmlp_phase(c, c.bid, c.G); } } SEAM(PH_SCAN);
  if constexpr (IN(PH_POST)) { const Ctx c = launder(c0); rwkv_post(c); } SEAM(PH_POST);
  if constexpr (IN(PH_WOUT0)) { const Ctx c = launder(c0); mg::Gemm g{YM, (const bf16*)(ws + WS_WOUT0), D, D, D}; mg::DenseOrder S; S.init(M / 256, D / 256, c.G, c.bid);
    mg::EpiF32 E{Y, D}; mg::gemm_phase(ldsl, g, S, E); } SEAM(PH_WOUT0);
  if constexpr (IN(PH_NORM0)) { const Ctx c = launder(c0); norm_phase<1, 0>(c, inp(c, I_X), args.out, Y, inp(c, I0_NPOM), inp(c, I0_NPF), XN, nullptr, 0, 0, nullptr); } SEAM(PH_NORM0);
  if constexpr (IN(PH_FGU)) { const Ctx c = launder(c0); mg::Gemm g{XN, (const bf16*)(ws + WS_FGU), D, D, D}; mg::DenseOrder S; S.init(M / 256, 2 * FFN / 256, c.G, c.bid);
    mg::EpiSwigluT E{(bf16*)(ws + WS_H), FFN}; mg::gemm_phase(ldsl, g, S, E); } SEAM(PH_FGU);
  if constexpr (IN(PH_FD)) { const Ctx c = launder(c0); mg::Gemm g{(const bf16*)(ws + WS_H), (const bf16*)(ws + WS_FD), FFN, FFN, FFN}; mg::DenseOrder S; S.init(M / 256, D / 256, c.G, c.bid);
    mg::EpiF32 E{Y, D}; mg::gemm_phase(ldsl, g, S, E); } SEAM(PH_FD);
  if constexpr (IN(PH_NORM1)) { const Ctx c = launder(c0); norm_phase<1, 1>(c, args.out, args.out, Y, inp(c, I0_NPOF), inp(c, I1_NPM), XN, inp(c, I1_WIN), ODD_IN, 2048, (float*)(ws + WS_DT)); } SEAM(PH_NORM1);
  if constexpr (IN(PH_WIN1)) { const Ctx c = launder(c0); mg::Gemm g{XN, (const bf16*)(ws + WS_WIN1), D, D, D}; mg::DenseOrder S; S.init(M / 256, 2048 / 256, c.G, c.bid);
    mg::EpiBf16<false> E{(bf16*)(ws + WS_P1), 2048}; mg::gemm_phase(ldsl, g, S, E); } SEAM(PH_WIN1);
  if constexpr (IN(PH_L1A)) { const Ctx c = launder(c0); ssd_conv(c); s5_scan(c); cvt_moe(c, c.bid, c.G); } SEAM(PH_L1A);
  if constexpr (IN(PH_L1B)) { const Ctx c = launder(c0); ssd_pass1(c);
    mg::Gemm g{(const bf16*)(ws + WS_YC), (const bf16*)(ws + WS_GLU), 512, 512, 512}; mg::DenseOrder S; S.init(M / 256, 512 / 256, c.G, c.bid);
    mg::EpiGluT E{YM, D, (const bf16*)(ws + WS_YC), inp(c, I1_GLB)}; mg::gemm_phase(ldsl, g, S, E); } SEAM(PH_L1B);
  if constexpr (IN(PH_L1CARRY)) { const Ctx c = launder(c0); ssd_carry(c); } SEAM(PH_L1CARRY);
  if constexpr (IN(PH_L1C)) { const Ctx c = launder(c0); ssd_pass2(c); } SEAM(PH_L1C);
  if constexpr (IN(PH_WOUT1)) { const Ctx c = launder(c0); mg::Gemm g{YM, (const bf16*)(ws + WS_WOUT1), D, D, D}; mg::DenseOrder S; S.init(M / 256, D / 256, c.G, c.bid);
    mg::EpiF32 E{Y, D}; mg::gemm_phase(ldsl, g, S, E); } SEAM(PH_WOUT1);
  if constexpr (IN(PH_NORM2)) { const Ctx c = launder(c0); norm_phase<1, 2>(c, args.out, args.out, Y, inp(c, I1_NPOM), inp(c, I1_NPF), XN, inp(c, I1_RT), 8, 0, nullptr); } SEAM(PH_NORM2);
  if constexpr (IN(PH_ASSIGN)) { const Ctx c = launder(c0); moe_assign(c); } SEAM(PH_ASSIGN);
#define MOE_SCHED(S, nn, bse, bof) do { int acc_ = 0; \
    _Pragma("unroll") for (int e = 0; e < 8; ++e) { acc_ += ((int)c.ctl[CW_CNT + 64 * e] + 255) / 256 * 256; S.pend[e] = acc_; } \
    S.init(acc_ / 256, nn, c.G, c.bid); S.bstride_e = (bse); S.boff = (bof); S.rowidx = (const int*)(c.ctl + CW_SLOTTOK); } while (0)
  if constexpr (IN(PH_MGU0)) { const Ctx c = launder(c0); mg::Gemm g{XN, (const bf16*)(ws + WS_MGU), D, D, D}; mg::MoeOrder<true> S; MOE_SCHED(S, FH / 128, (size_t)2 * FE * D * 2, 0);
    mg::EpiSwigluT E{(bf16*)(ws + WS_HID), FH}; mg::gemm_phase(ldsl, g, S, E); } SEAM(PH_MGU0);
  if constexpr (IN(PH_MD0)) { const Ctx c = launder(c0); mg::Gemm g{(const bf16*)(ws + WS_HID), (const bf16*)(ws + WS_MD), FH, FE, FH}; mg::MoeOrder<false> S; MOE_SCHED(S, D / 256, (size_t)D * FE * 2, 0);
    mg::EpiBf16<false> E{(bf16*)(ws + WS_YS), D}; mg::gemm_phase(ldsl, g, S, E); } SEAM(PH_MD0);
  if constexpr (IN(PH_MGU1)) { const Ctx c = launder(c0); mg::Gemm g{XN, (const bf16*)(ws + WS_MGU), D, D, D}; mg::MoeOrder<true> S; MOE_SCHED(S, FH / 128, (size_t)2 * FE * D * 2, (size_t)(FH / 128) * 256 * D * 2);
    mg::EpiSwigluT E{(bf16*)(ws + WS_HID), FH}; mg::gemm_phase(ldsl, g, S, E); } SEAM(PH_MGU1);
  if constexpr (IN(PH_MD1)) { const Ctx c = launder(c0); mg::Gemm g{(const bf16*)(ws + WS_HID), (const bf16*)(ws + WS_MD), FH, FE, FH}; mg::MoeOrder<false> S; MOE_SCHED(S, D / 256, (size_t)D * FE * 2, (size_t)FH * 2);
    mg::EpiBf16<true> E{(bf16*)(ws + WS_YS), D}; mg::gemm_phase(ldsl, g, S, E); } SEAM(PH_MD1);
  if constexpr (IN(PH_FINAL)) { const Ctx c = launder(c0); norm_phase<2, 0>(c, args.out, args.out, nullptr, inp(c, I1_NPOF), nullptr, nullptr, nullptr, 0, 0, nullptr); }
#undef MOE_SCHED
#undef IN
#undef SEAM
}

template <int P> static void launch_one(const Args& a, hipStream_t stream) { hipLaunchKernelGGL((fwd_kernel<P, P + 1>), dim3(256), dim3(NT), LDS_BYTES, stream, a); }
template <int P> static bool set_attr_one() { return hipFuncSetAttribute((const void*)fwd_kernel<P, P + 1>, hipFuncAttributeMaxDynamicSharedMemorySize, LDS_BYTES) == hipSuccess; }
template <int... Ps> static void launch_all(const Args& a, hipStream_t stream, std::integer_sequence<int, Ps...>) { (launch_one<Ps>(a, stream), ...); }
template <int... Ps> static bool set_attr_all(std::integer_sequence<int, Ps...>) { return (set_attr_one<Ps>() && ...); }

extern "C" void kernel_launch(void* const* d_in, const int* in_sizes, int n_in, void* d_out, int out_size, void* d_ws, size_t ws_size, hipStream_t stream) {
  static int ready = 0;
  if (!ready) {
    bool ok = true;
    if (n_in != N_IN || out_size != M * D || ws_size < WS_END) { fprintf(stderr, "kernel_launch: unexpected problem: n_in %d out %d ws %zu (need %zu)\n", n_in, out_size, ws_size, (size_t)WS_END); ok = false; }
#if ONE_LAUNCH
    if (ok && hipFuncSetAttribute((const void*)fwd_kernel<0, LAST_PHASE>, hipFuncAttributeMaxDynamicSharedMemorySize, LDS_BYTES) != hipSuccess) ok = false;
#else
    if (ok && !set_attr_all(std::make_integer_sequence<int, LAST_PHASE>{})) ok = false;
#endif
    if (!ok) fprintf(stderr, "kernel_launch: setup failed\n");
    ready = ok ? 1 : -1;
  }
  if (ready < 0) return;
  (void)hipMemsetAsync((char*)d_ws + WS_CTL, 0, CTL_BYTES, stream);
  Args a{};
  for (int i = 0; i < N_IN; ++i) a.in[i] = (const float*)d_in[i];
  a.out = (float*)d_out; a.ws = (unsigned char*)d_ws;
#if ONE_LAUNCH
  hipLaunchKernelGGL((fwd_kernel<0, LAST_PHASE>), dim3(256), dim3(NT), LDS_BYTES, stream, a);
#else
  launch_all(a, stream, std::make_integer_sequence<int, LAST_PHASE>{});
#endif
}
```

```cpp
#include <hip/hip_runtime.h>
#include <stdint.h>
#include <stdio.h>
#include <utility>

#ifndef ONE_LAUNCH
#define ONE_LAUNCH 1
#endif

constexpr int D = 1024, BATCH = 8, SEQ = 2048, M = BATCH * SEQ;
constexpr int A_W = 512, A_IN = 1792, EVEN_IN = 2816, FFN = 2816;
constexpr int ODD_IN = 2056, NE = 8, FE = 3584;
constexpr int MAXSLOT = 2 * M + NE * 256;
constexpr int NT = 512, NW = 8;

typedef unsigned short bf16;
typedef float f32x4 __attribute__((ext_vector_type(4)));
#define LAS __attribute__((address_space(3)))

enum {
  I_X = 0,
  I0_NPM, I0_WIN, I0_MU, I0_W0, I0_W2, I0_A0, I0_A2, I0_G2, I0_KK, I0_KA, I0_RK, I0_LNW, I0_LNB,
  I0_GLNW, I0_GLNB, I0_GWS, I0_GBS, I0_WOUT, I0_NPOM, I0_NPF, I0_FG, I0_FU, I0_FD, I0_NPOF,
  I1_NPM, I1_WIN, I1_ARE, I1_AIM, I1_LDT, I1_BRE, I1_BIM, I1_CRE, I1_CIM, I1_SD, I1_GLW, I1_GLB,
  I1_CW, I1_CB, I1_DTB, I1_ALOG, I1_MD, I1_MNW, I1_WOUT, I1_NPOM, I1_NPF, I1_RT, I1_MG, I1_MU, I1_MDN, I1_NPOF,
  N_IN
};
static_assert(N_IN == 51, "input count");

constexpr size_t MiB = 1ull << 20;
constexpr size_t WS_CTL = 0, CTL_BYTES = 1 * MiB;
constexpr size_t KiB = 1024;
constexpr size_t WS_WIN0 = 1 * MiB;
constexpr size_t WS_WOUT0 = WS_WIN0 + 5632 * KiB;
constexpr size_t WS_FGU = WS_WOUT0 + 2048 * KiB;
constexpr size_t WS_FD = WS_FGU + 11264 * KiB;
constexpr size_t WS_WIN1 = WS_FD + 5632 * KiB;
constexpr size_t WS_GLU = WS_WIN1 + 4096 * KiB;
constexpr size_t WS_WOUT1 = WS_GLU + 512 * KiB;
constexpr size_t WS_WLORA = WS_WOUT1 + 2048 * KiB;
constexpr size_t WS_DENSE_END = WS_WLORA + 768 * KiB;
constexpr size_t WS_MGU = 33 * MiB;
constexpr size_t WS_MD = 145 * MiB;
constexpr size_t WS_XN = 201 * MiB;
constexpr size_t WS_YMIX = 233 * MiB;
constexpr size_t WS_Y = 265 * MiB;
constexpr size_t WS_BIG = 329 * MiB;
constexpr size_t WS_P0 = WS_BIG;
constexpr size_t WS_SR = WS_MGU;
constexpr size_t WS_SW = WS_SR + 32 * MiB, WS_SK = WS_SW + 32 * MiB, WS_SV = WS_SK + 32 * MiB, WS_SA = WS_SV + 32 * MiB, WS_SB = WS_Y;
constexpr size_t WS_LOG = WS_P0 + 88 * MiB;
constexpr size_t WS_BON = WS_LOG + 32 * MiB;
constexpr size_t WS_L0END = WS_BON + 1 * MiB;
constexpr size_t WS_ALORA = WS_MGU + 160 * MiB;
constexpr size_t WS_LOWA = WS_XN;
static_assert(WS_DENSE_END <= WS_MGU && WS_ALORA + 8 * MiB <= WS_XN, "lora buffers");
static_assert(WS_SA + 32 * MiB <= WS_XN, "streams inside the MoE weight region");
constexpr size_t WS_H = WS_BIG;
constexpr size_t WS_P1 = WS_BIG;
constexpr size_t WS_DT = WS_P1 + 64 * MiB;
constexpr size_t WS_S5A = WS_YMIX;
constexpr size_t WS_S5XE = WS_XN;
constexpr size_t WS_S5BE = WS_MD;
constexpr size_t WS_S5BTF = WS_MD + 4 * MiB;
constexpr size_t WS_S5POW = WS_BIG + 129 * MiB;
constexpr size_t WS_S5BB = WS_S5POW + 320 * KiB;
constexpr size_t WS_S5KT = WS_S5BB + 320 * KiB;
constexpr size_t WS_ATOT = WS_DT + 768 * KiB;
constexpr size_t WS_CONV = WS_DT + 1 * MiB;
constexpr size_t WS_YD = WS_CONV + 32 * MiB;
constexpr size_t WS_YC = WS_Y;
constexpr size_t WS_SE = WS_Y + 16 * MiB;
constexpr size_t WS_SPV = WS_SE + 32 * MiB;
constexpr int FH = FE / 2;
constexpr size_t WS_HID = WS_BIG;
constexpr size_t WS_YS = WS_YMIX;
constexpr size_t WS_ROUTE = WS_BIG + 120 * MiB;
constexpr size_t WS_END = 462 * MiB;
static_assert(WS_S5KT + 512 * KiB <= WS_END && WS_L0END <= WS_S5POW && WS_L0END <= WS_END && WS_YD + 32 * MiB <= WS_END && WS_ROUTE + 1 * MiB <= WS_END && WS_SPV + 16 * MiB <= WS_BIG, "workspace map");
static_assert((size_t)MAXSLOT * FH * 2 <= 120 * MiB && (size_t)MAXSLOT * D * 2 <= 96 * MiB, "moe buffers");
constexpr int CW_BAR = 4096;
constexpr int CW_CNT = 8192;
constexpr int CW_CUR = 8192 + 64 * 8;
constexpr int CW_SLOTTOK = 65536;
static_assert((CW_SLOTTOK + MAXSLOT) * 4 <= (int)CTL_BYTES, "ctl");

constexpr int LDS_BYTES = 147456;

__device__ __forceinline__ float bf2f(bf16 v) { return __uint_as_float(((unsigned)v) << 16); }
__device__ __forceinline__ bf16 f2bf(float f) { unsigned u = __float_as_uint(f); u += 0x7fffu + ((u >> 16) & 1u); return (bf16)(u >> 16); }
__device__ __forceinline__ float wave_sum(float v) {
#pragma unroll
  for (int o = 32; o > 0; o >>= 1) v += __shfl_xor(v, o);
  return v;
}
__device__ __forceinline__ float sigmoid_(float x) { return 1.f / (1.f + expf(-x)); }
__device__ __forceinline__ float silu_(float x) { return x / (1.f + expf(-x)); }
__device__ __forceinline__ float gelu_(float x) { const float u = 0.7978845608028654f * (x + 0.044715f * x * x * x); return 0.5f * x * (1.f + tanhf(u)); }
__device__ __forceinline__ float softplus_(float x) { return fmaxf(x, 0.f) + log1pf(expf(-fabsf(x))); }

#define XB_TMO      128
#define XB_XCNT(j)  (256  + 64 * (j))
#define XB_XSUB(j)  (1280 + 64 * (j))
#define XB_XGEN(j)  (2304 + 64 * (j))
#define XB_TOP      3328
#define XB_TOPGEN   3392
#define XCD_BAR_WORDS 3456
#define XB_SPIN_CAP (1u << 22)

__device__ __forceinline__ unsigned xb_ld(unsigned* p)              { return __hip_atomic_load(p, __ATOMIC_RELAXED, __HIP_MEMORY_SCOPE_AGENT); }
__device__ __forceinline__ unsigned xb_add(unsigned* p, unsigned v) { return __hip_atomic_fetch_add(p, v, __ATOMIC_RELAXED, __HIP_MEMORY_SCOPE_AGENT); }
__device__ __forceinline__ unsigned xb_xcc_id() { return (unsigned)__builtin_amdgcn_s_getreg((3 << 11) | 20) & 0xFu; }
#define XB_SPIN(cond, bar) do { unsigned _sp = 0; while (cond) { __builtin_amdgcn_s_sleep(1); \
    if ((++_sp & 255u) == 0u) { if (xb_ld(&(bar)[XB_TMO])) break; if (_sp > XB_SPIN_CAP) { atomicAdd(&(bar)[XB_TMO], 1u); break; } } } } while (0)

struct XcdBarrier { unsigned* bar; unsigned x; volatile LAS unsigned* st; };

__device__ __forceinline__ XcdBarrier xcd_barrier_post(unsigned* bar, volatile LAS unsigned* st) {
    XcdBarrier b; b.bar = bar; b.x = xb_xcc_id(); b.st = st;
    if (threadIdx.x == 0) (void)xb_add(&bar[XB_XCNT(b.x)], 1u);
    return b;
}
__device__ __forceinline__ void xcd_barrier_complete(unsigned* bar, unsigned x, unsigned& nloc, unsigned& nx) {
    const unsigned G = gridDim.x * gridDim.y * gridDim.z;
    unsigned sum, cnt, mine, sp = 0u;
    for (;;) {
        sum = 0u; cnt = 0u; mine = 0u;
#pragma unroll
        for (unsigned j = 0; j < 16; ++j) { const unsigned c = xb_ld(&bar[XB_XCNT(j)]); sum += c; cnt += (c > 0u) ? 1u : 0u; mine = (j == x) ? c : mine; }
        if (sum == G) break;
        __builtin_amdgcn_s_sleep(1);
        if ((++sp & 255u) == 0u) { if (xb_ld(&bar[XB_TMO])) break; if (sp > XB_SPIN_CAP) { atomicAdd(&bar[XB_TMO], 1u); break; } }
    }
    nloc = mine > 0u ? mine : 1u; nx = cnt > 0u ? cnt : 1u;
}
__device__ __forceinline__ void xcd_barrier(const XcdBarrier& b) {
    asm volatile("s_waitcnt vmcnt(0)" ::: "memory");
    __syncthreads();
    if (threadIdx.x == 0) {
        unsigned* bar = b.bar;
        __builtin_amdgcn_s_waitcnt(0);
        unsigned nloc = b.st[0], nx = b.st[1];
        if (nloc == 0u) { xcd_barrier_complete(bar, b.x, nloc, nx); b.st[0] = nloc; b.st[1] = nx; }
        const unsigned old = xb_add(&bar[XB_XSUB(b.x)], 1u);
        const unsigned gen = old / nloc;
        if (old + 1u == (gen + 1u) * nloc) {
            __builtin_amdgcn_fence(__ATOMIC_RELEASE, "agent");
            asm volatile("s_waitcnt vmcnt(0)" ::: "memory");
            const unsigned og = xb_add(&bar[XB_TOP], 1u);
            const unsigned tg = og / nx;
            if (og + 1u == (tg + 1u) * nx) xb_add(&bar[XB_TOPGEN], 1u);
            else XB_SPIN(xb_ld(&bar[XB_TOPGEN]) == tg, bar);
            __builtin_amdgcn_fence(__ATOMIC_ACQUIRE, "agent");
            xb_add(&bar[XB_XGEN(b.x)], 1u);
            asm volatile("s_waitcnt vmcnt(0)" ::: "memory");
        } else {
            XB_SPIN(xb_ld(&bar[XB_XGEN(b.x)]) == gen, bar);
            __builtin_amdgcn_fence(__ATOMIC_ACQUIRE, "agent");
            asm volatile("s_waitcnt vmcnt(0)" ::: "memory");
        }
    }
    __syncthreads();
}

struct Args { const float* in[N_IN]; float* out; unsigned char* ws; int lo, hi; };
struct Ctx {
  float* out; unsigned char* ws; unsigned* ctl;
  unsigned char* lds;
  int tid, lane, wave, bid, G;
};
__device__ __forceinline__ Ctx launder(Ctx c) {
  asm volatile("" : "+v"(c.tid), "+v"(c.lane));
  asm volatile("" : "+s"(c.wave), "+s"(c.bid), "+s"(c.G));
  return c;
}
constexpr int LDS_PTAB = LDS_BYTES - 1024;
constexpr int LDS_BST = LDS_BYTES - 16;
__device__ __forceinline__ const float* inp(const Ctx& c, int k) {
  const LAS unsigned* pt = (const LAS unsigned*)(LAS unsigned char*)(c.lds + LDS_PTAB);
  const unsigned lo = __builtin_amdgcn_readfirstlane(pt[2 * k]), hi = __builtin_amdgcn_readfirstlane(pt[2 * k + 1]);
  return (const float*)(((unsigned long long)hi << 32) | lo);
}


namespace mg {
typedef short bf16x8 __attribute__((ext_vector_type(8)));
typedef unsigned u32x4 __attribute__((ext_vector_type(4)));
constexpr int BM = 256, BK = 64, HALF = 128, HTB = HALF * BK * 2, STAGE_BYTES = 8 * HTB, NXCD = 8, WGM = 8;
constexpr int LDS_IDX = STAGE_BYTES;
__host__ __device__ __forceinline__ int lds_byte(int r, int c) { const int st = (r >> 4) * 2 + (c >> 5), rr = r & 15, cc = c & 31, ob = rr * 64 + cc * 2; return st * 1024 + (ob ^ (((ob >> 9) & 1) << 5)); }
__host__ __device__ __forceinline__ void stage_rc(int b, int& R, int& C) { const int st = b / 1024, sb = b % 1024, swz = sb ^ (((sb >> 9) & 1) << 5); R = (st >> 1) * 16 + swz / 64; C = (st & 1) * 32 + (swz % 64) / 2; }
__host__ __device__ __forceinline__ int perm32(int rho) { const int n = rho >> 4, i = rho & 15; return 8 * (i >> 2) + 4 * n + (i & 3); }
struct Unit { int pm, pn; };
struct Gemm { const bf16* A; const bf16* Bt; int lda, ldb, K; };

struct Tiles {
  int nM, nN, nwg, G, c;
  __device__ __forceinline__ void init(int nM_, int nN_, int G_, int c_) { nM = nM_; nN = nN_; nwg = nM * nN; G = G_; c = c_; }
  __device__ __forceinline__ bool next(int i, Unit& u) const {
    const long L = (long)i * G + c; if (L >= nwg) return false;
    int wgid = (int)L; { const int q = nwg / NXCD, r = nwg % NXCD, xcd = wgid % NXCD, off = wgid / NXCD; wgid = (xcd < r ? xcd * (q + 1) : r * (q + 1) + (xcd - r) * q) + off; }
    const int nig = WGM * nN, gid = wgid / nig, fm = gid * WGM, gsz = (nM - fm) < WGM ? (nM - fm) : WGM;
    u.pm = fm + ((wgid % nig) % gsz); u.pn = (wgid % nig) / gsz; return true;
  }
};
struct DenseOrder : Tiles {
  static constexpr bool GATHER = false;
  const int* rowidx;
  __device__ __forceinline__ const char* a_tile(const Gemm& g, const Unit& u) const { return (const char*)g.A + (size_t)u.pm * BM * g.lda * 2; }
  __device__ __forceinline__ const char* b_tile(const Gemm& g, const Unit& u) const { return (const char*)g.Bt + (size_t)u.pn * BM * g.ldb * 2; }
};
struct S5Order {
  static constexpr bool GATHER = false;
  int G, c; const int* rowidx;
  __device__ __forceinline__ bool next(int i, Unit& u) const { const int L = i * G + c; if (L >= 128) return false; u.pm = L; u.pn = 0; return true; }
  __device__ __forceinline__ const char* a_tile(const Gemm& g, const Unit& u) const { return (const char*)g.A + (size_t)u.pm * BM * g.lda * 2; }
  __device__ __forceinline__ const char* b_tile(const Gemm& g, const Unit& u) const { return (const char*)g.Bt + (size_t)(u.pm >> 2) * BM * g.ldb * 2; }
};
template <bool GATHER_> struct MoeOrder : Tiles {
  static constexpr bool GATHER = GATHER_;
  int pend[8]; size_t bstride_e, boff; const int* rowidx;
  __device__ __forceinline__ int expert(int pm) const { int e = 0;
#pragma unroll
    for (int q = 0; q < 7; ++q) e += (pm * BM >= pend[q]) ? 1 : 0;
    return e; }
  __device__ __forceinline__ const char* a_tile(const Gemm& g, const Unit& u) const { return (const char*)g.A + (size_t)u.pm * BM * g.lda * 2; }
  __device__ __forceinline__ const char* b_tile(const Gemm& g, const Unit& u) const { return (const char*)g.Bt + (size_t)expert(u.pm) * bstride_e + boff + (size_t)u.pn * BM * g.ldb * 2; }
};

__device__ __forceinline__ unsigned cvt_pk_bf16(float lo, float hi) { unsigned r; asm volatile("v_cvt_pk_bf16_f32 %0, %1, %2" : "=v"(r) : "v"(lo), "v"(hi)); return r; }

struct EpiF32 { static constexpr bool PERM = false; float* C; int ldc;
  __device__ __forceinline__ void operator()(const f32x4 (&acc)[2][2][4][2], const Unit& u, int wr, int wc, int fr, int fq) const {
    const int row0 = u.pm * BM + wr * 64 + fr, col0 = u.pn * BM + wc * 32 + 4 * fq;
#pragma unroll
    for (int ai = 0; ai < 2; ++ai)
#pragma unroll
      for (int m = 0; m < 4; ++m) { float* rowp = C + (size_t)(row0 + ai * HALF + m * 16) * ldc + col0;
#pragma unroll
        for (int bj = 0; bj < 2; ++bj)
#pragma unroll
          for (int n = 0; n < 2; ++n) *(f32x4*)(rowp + bj * HALF + n * 16) = acc[ai][bj][m][n]; }
  } };
template <bool ACCUM> struct EpiBf16 { static constexpr bool PERM = true; bf16* O; int ldc;
  __device__ __forceinline__ void operator()(const f32x4 (&acc)[2][2][4][2], const Unit& u, int wr, int wc, int fr, int fq) const {
    const int row0 = u.pm * BM + wr * 64 + fr, col0 = u.pn * BM + wc * 32 + 8 * fq;
#pragma unroll
    for (int ai = 0; ai < 2; ++ai)
#pragma unroll
      for (int m = 0; m < 4; ++m) { bf16* rowp = O + (size_t)(row0 + ai * HALF + m * 16) * ldc + col0;
#pragma unroll
        for (int bj = 0; bj < 2; ++bj) { f32x4 v0 = acc[ai][bj][m][0], v1 = acc[ai][bj][m][1];
          if (ACCUM) { const u32x4 o = *(const u32x4*)(rowp + bj * HALF);
            v0[0] += __uint_as_float(o.x << 16); v0[1] += __uint_as_float(o.x & 0xffff0000u); v0[2] += __uint_as_float(o.y << 16); v0[3] += __uint_as_float(o.y & 0xffff0000u);
            v1[0] += __uint_as_float(o.z << 16); v1[1] += __uint_as_float(o.z & 0xffff0000u); v1[2] += __uint_as_float(o.w << 16); v1[3] += __uint_as_float(o.w & 0xffff0000u); }
          u32x4 w; w.x = cvt_pk_bf16(v0[0], v0[1]); w.y = cvt_pk_bf16(v0[2], v0[3]); w.z = cvt_pk_bf16(v1[0], v1[1]); w.w = cvt_pk_bf16(v1[2], v1[3]);
          *(u32x4*)(rowp + bj * HALF) = w; } }
  } };
struct EpiP1 { static constexpr bool PERM = true; bf16* P1; bf16* AP;
  __device__ __forceinline__ void operator()(const f32x4 (&acc)[2][2][4][2], const Unit& u, int wr, int wc, int fr, int fq) const {
    const int row0 = u.pm * BM + wr * 64 + fr, col0 = u.pn * BM + wc * 32 + 8 * fq;
#pragma unroll
    for (int ai = 0; ai < 2; ++ai)
#pragma unroll
      for (int m = 0; m < 4; ++m) { const int row = row0 + ai * HALF + m * 16;
#pragma unroll
        for (int bj = 0; bj < 2; ++bj) { const int col = col0 + bj * HALF; const f32x4 v0 = acc[ai][bj][m][0], v1 = acc[ai][bj][m][1];
          u32x4 w; w.x = cvt_pk_bf16(v0[0], v0[1]); w.y = cvt_pk_bf16(v0[2], v0[3]); w.z = cvt_pk_bf16(v1[0], v1[1]); w.w = cvt_pk_bf16(v1[2], v1[3]);
          bf16* dst;
          if (u.pn < 2) { const int g = col >> 4, c0 = col & 15, b = row >> 11, ta = row & 2047; dst = AP + ((size_t)(g * 1024 + b * 128 + (ta >> 4)) * 384 + (ta & 15) * 16 + c0); }
          else dst = P1 + (size_t)row * 2048 + col;
          *(u32x4*)dst = w; } }
  } };
struct EpiS5E { static constexpr bool PERM = false; float* XE;
  __device__ __forceinline__ void operator()(const f32x4 (&acc)[2][2][4][2], const Unit& u, int wr, int wc, int fr, int fq) const {
    const int row0 = u.pm * BM + wr * 64 + fr, col0 = wc * 32 + 4 * fq;
#pragma unroll
    for (int ai = 0; ai < 2; ++ai)
#pragma unroll
      for (int m = 0; m < 4; ++m) { float* rowp = XE + (size_t)(row0 + ai * HALF + m * 16) * 128 + col0;
#pragma unroll
        for (int n = 0; n < 2; ++n) *(f32x4*)(rowp + n * 16) = acc[ai][0][m][n]; }
  } };
struct EpiS5Y { static constexpr bool PERM = true; bf16* YC; const bf16* AP; const float* dsk;
  __device__ __forceinline__ void operator()(const f32x4 (&acc)[2][2][4][2], const Unit& u, int wr, int wc, int fr, int fq) const {
    const int row0 = u.pm * BM + wr * 64 + fr, g = u.pm >> 2;
#pragma unroll
    for (int ai = 0; ai < 2; ++ai)
#pragma unroll
      for (int m = 0; m < 4; ++m) { const int row = row0 + ai * HALF + m * 16, rg = row & 1023, b = rg >> 7, blk = rg & 127;
#pragma unroll
        for (int bj = 0; bj < 2; ++bj) { const int col0 = bj * HALF + wc * 32 + 8 * fq, t = col0 >> 4, ch = g * 16 + (col0 & 15);
          const u32x4 uv = *(const u32x4*)(AP + (size_t)row * 384 + col0);
          const f32x4 d0 = *(const f32x4*)(dsk + ch), d1 = *(const f32x4*)(dsk + ch + 4);
          const float uu[8] = {__uint_as_float(uv.x << 16), __uint_as_float(uv.x & 0xffff0000u), __uint_as_float(uv.y << 16), __uint_as_float(uv.y & 0xffff0000u),
                               __uint_as_float(uv.z << 16), __uint_as_float(uv.z & 0xffff0000u), __uint_as_float(uv.w << 16), __uint_as_float(uv.w & 0xffff0000u)};
          float h[8];
#pragma unroll
          for (int e = 0; e < 4; ++e) { h[e] = gelu_(acc[ai][bj][m][0][e] + d0[e] * uu[e]); h[4 + e] = gelu_(acc[ai][bj][m][1][e] + d1[e] * uu[4 + e]); }
          u32x4 w; w.x = cvt_pk_bf16(h[0], h[1]); w.y = cvt_pk_bf16(h[2], h[3]); w.z = cvt_pk_bf16(h[4], h[5]); w.w = cvt_pk_bf16(h[6], h[7]);
          *(u32x4*)(YC + (size_t)(b * 2048 + blk * 16 + t) * 512 + ch) = w; } }
  } };
struct EpiLora { static constexpr bool PERM = true; bf16* O0; bf16* O1;
  __device__ __forceinline__ void operator()(const f32x4 (&acc)[2][2][4][2], const Unit& u, int wr, int wc, int fr, int fq) const {
    bf16* base = (u.pn < 4) ? O0 : O1; constexpr int ldc = 1024;
    const int row0 = u.pm * BM + wr * 64 + fr, col0 = (u.pn & 3) * BM + wc * 32 + 8 * fq;
#pragma unroll
    for (int ai = 0; ai < 2; ++ai)
#pragma unroll
      for (int m = 0; m < 4; ++m) { bf16* rowp = base + (size_t)(row0 + ai * HALF + m * 16) * ldc + col0;
#pragma unroll
        for (int bj = 0; bj < 2; ++bj) { const f32x4 v0 = acc[ai][bj][m][0], v1 = acc[ai][bj][m][1];
          u32x4 w; w.x = cvt_pk_bf16(v0[0], v0[1]); w.y = cvt_pk_bf16(v0[2], v0[3]); w.z = cvt_pk_bf16(v1[0], v1[1]); w.w = cvt_pk_bf16(v1[2], v1[3]);
          *(u32x4*)(rowp + bj * HALF) = w; } }
  } };
struct EpiSwigluT { static constexpr bool PERM = true; bf16* O; int ldc;
  __device__ __forceinline__ void operator()(const f32x4 (&acc)[2][2][4][2], const Unit& u, int wr, int wc, int fr, int fq) const {
    const int row0 = u.pm * BM + wr * 64 + fr, col0 = u.pn * HALF + wc * 32 + 8 * fq;
#pragma unroll
    for (int ai = 0; ai < 2; ++ai)
#pragma unroll
      for (int m = 0; m < 4; ++m) { bf16* rowp = O + (size_t)(row0 + ai * HALF + m * 16) * ldc + col0;
        float h[8];
#pragma unroll
        for (int n = 0; n < 2; ++n)
#pragma unroll
          for (int e = 0; e < 4; ++e) { const float gte = acc[ai][0][m][n][e], up = acc[ai][1][m][n][e]; h[n * 4 + e] = gte * __builtin_amdgcn_rcpf(1.f + __expf(-gte)) * up; }
        u32x4 w; w.x = cvt_pk_bf16(h[0], h[1]); w.y = cvt_pk_bf16(h[2], h[3]); w.z = cvt_pk_bf16(h[4], h[5]); w.w = cvt_pk_bf16(h[6], h[7]);
        *(u32x4*)rowp = w; }
  } };
struct EpiGluT { static constexpr bool PERM = true; bf16* O; int ldc; const bf16* Yc; const float* bias;
  __device__ __forceinline__ void operator()(const f32x4 (&acc)[2][2][4][2], const Unit& u, int wr, int wc, int fr, int fq) const {
    const int row0 = u.pm * BM + wr * 64 + fr, col0 = u.pn * BM + wc * 32 + 8 * fq;
#pragma unroll
    for (int ai = 0; ai < 2; ++ai)
#pragma unroll
      for (int m = 0; m < 4; ++m) { const int row = row0 + ai * HALF + m * 16;
#pragma unroll
        for (int bj = 0; bj < 2; ++bj) { const int col = col0 + bj * HALF;
          const u32x4 yv = *(const u32x4*)(Yc + (size_t)row * 512 + col);
          const f32x4 b0 = *(const f32x4*)(bias + col), b1 = *(const f32x4*)(bias + col + 4);
          const float y[8] = {__uint_as_float(yv.x << 16), __uint_as_float(yv.x & 0xffff0000u), __uint_as_float(yv.y << 16), __uint_as_float(yv.y & 0xffff0000u),
                              __uint_as_float(yv.z << 16), __uint_as_float(yv.z & 0xffff0000u), __uint_as_float(yv.w << 16), __uint_as_float(yv.w & 0xffff0000u)};
          float h[8];
#pragma unroll
          for (int e = 0; e < 4; ++e) { h[e] = y[e] * __builtin_amdgcn_rcpf(1.f + __expf(-(acc[ai][bj][m][0][e] + b0[e]))); h[4 + e] = y[4 + e] * __builtin_amdgcn_rcpf(1.f + __expf(-(acc[ai][bj][m][1][e] + b1[e]))); }
          u32x4 w; w.x = cvt_pk_bf16(h[0], h[1]); w.y = cvt_pk_bf16(h[2], h[3]); w.z = cvt_pk_bf16(h[4], h[5]); w.w = cvt_pk_bf16(h[6], h[7]);
          *(u32x4*)(O + (size_t)row * ldc + col) = w; } }
  } };

template <class Epi, class Sched>
__device__ __forceinline__ void gemm_phase(LAS unsigned char* lds, const Gemm g, const Sched& S, const Epi& E) {
  const int tid = threadIdx.x, wid = __builtin_amdgcn_readfirstlane(tid >> 6), lane = tid & 63, wr = wid >> 2, wc = wid & 3, fr = lane & 15, fq = lane >> 4;
  const int K = g.K, nt = K / BK;
  unsigned voffA[2], voffB[2]; int gR[2], gC[2];
#pragma unroll
  for (int i = 0; i < 2; ++i) { int R, C; stage_rc(tid * 16 + i * 8192, R, C); const int Rb = Epi::PERM ? ((R & ~31) + perm32(R & 31)) : R;
    voffA[i] = (unsigned)(R * g.lda + C) * 2u; voffB[i] = (unsigned)(Rb * g.ldb + C) * 2u; gR[i] = R; gC[i] = C * 2; }
  const size_t kstep = (size_t)(BK * 2);
  const size_t hstepA = (size_t)HALF * g.lda * 2, hstepB = (size_t)HALF * g.ldb * 2;
  const unsigned ldsw = (unsigned)wid * 1024u;
  const unsigned rowb = (unsigned)g.lda * 2u;
  const int aoff = lds_byte(wr * 64 + fr, fq * 8), boff = lds_byte(wc * 32 + fr, fq * 8);
#define PG8_SA(b, h) (((b) * 2 + (h)) * HTB)
#define PG8_SB(b, h) ((4 + (b) * 2 + (h)) * HTB)
#define PG8_STAGE(bufoff, gbase, voff) do { _Pragma("unroll") for (int _i = 0; _i < 2; ++_i) \
    __builtin_amdgcn_global_load_lds((const unsigned*)((const char*)(gbase) + (voff)[_i]), (LAS unsigned*)(lds + (bufoff) + ldsw + _i * 8192), 16, 0, 0); } while (0)
#define PG8_STAGE_A(bufoff, p, h, goff) do { if constexpr (Sched::GATHER) PG8_STAGE(bufoff, p, (goff)[h]); else PG8_STAGE(bufoff, (p) + (h) * hstepA, voffA); } while (0)
#define PG8_LDA(dst, b, h) do { _Pragma("unroll") for (int m = 0; m < 4; ++m) _Pragma("unroll") for (int k = 0; k < 2; ++k) dst[m][k] = *(const LAS bf16x8*)(lds + PG8_SA(b, h) + aoff + m * 2048 + k * 1024); } while (0)
#define PG8_LDB(dst, b, h) do { _Pragma("unroll") for (int n = 0; n < 2; ++n) _Pragma("unroll") for (int k = 0; k < 2; ++k) dst[n][k] = *(const LAS bf16x8*)(lds + PG8_SB(b, h) + boff + n * 2048 + k * 1024); } while (0)
#define PG8_MMA(ai, bj, At, Bt) do { __builtin_amdgcn_s_setprio(1); _Pragma("unroll") for (int m = 0; m < 4; ++m) _Pragma("unroll") for (int n = 0; n < 2; ++n) _Pragma("unroll") for (int k = 0; k < 2; ++k) \
    acc[ai][bj][m][n] = __builtin_amdgcn_mfma_f32_16x16x32_bf16(Bt[n][k], At[m][k], acc[ai][bj][m][n], 0, 0, 0); __builtin_amdgcn_s_setprio(0); } while (0)
#define PG8_WAIT_V(n) asm volatile("s_waitcnt vmcnt(" #n ")" ::: "memory")
#define PG8_WAIT_L(n) asm volatile("s_waitcnt lgkmcnt(" #n ")" ::: "memory")
#define PG8_BAR __builtin_amdgcn_s_barrier()
#define PG8_SCHED __builtin_amdgcn_sched_barrier(0)
  Unit cur, nxt; int ui = 0;
  if (!S.next(0, cur)) return;
  f32x4 acc[2][2][4][2];
#pragma unroll
  for (int a = 0; a < 2; ++a)
#pragma unroll
    for (int b = 0; b < 2; ++b)
#pragma unroll
      for (int m = 0; m < 4; ++m)
#pragma unroll
        for (int n = 0; n < 2; ++n) acc[a][b][m][n] = (f32x4){0.f, 0.f, 0.f, 0.f};
  bf16x8 At[4][2], B0[2][2], B1[2][2];
  unsigned gcu[2][2] = {{0u, 0u}, {0u, 0u}};
  const char* cA = Sched::GATHER ? (const char*)g.A : S.a_tile(g, cur); const char* cB = S.b_tile(g, cur);
  if constexpr (Sched::GATHER) {
#pragma unroll
    for (int h = 0; h < 2; ++h)
#pragma unroll
      for (int i = 0; i < 2; ++i) gcu[h][i] = (unsigned)S.rowidx[cur.pm * BM + h * HALF + gR[i]] * rowb + (unsigned)gC[i];
  }
  PG8_STAGE(PG8_SB(0, 0), cB, voffB); PG8_STAGE(PG8_SB(0, 1), cB + hstepB, voffB); PG8_STAGE_A(PG8_SA(0, 0), cA, 0, gcu); PG8_STAGE_A(PG8_SA(0, 1), cA, 1, gcu);
  if (wr == 1) PG8_BAR;
  PG8_WAIT_V(2); PG8_BAR;
  PG8_STAGE(PG8_SB(1, 0), cB + kstep, voffB); PG8_STAGE_A(PG8_SA(1, 0), cA + kstep, 0, gcu); PG8_STAGE(PG8_SB(1, 1), cB + hstepB + kstep, voffB);
  PG8_WAIT_V(6); PG8_BAR;
  for (;;) {
    const bool has_next = S.next(ui + 1, nxt);
    const char* nA = Sched::GATHER ? (const char*)g.A : (has_next ? S.a_tile(g, nxt) : cA); const char* nB = has_next ? S.b_tile(g, nxt) : cB;
    if constexpr (Sched::GATHER) {
      if (has_next && wid < 4) __builtin_amdgcn_global_load_lds((const unsigned*)(S.rowidx + nxt.pm * BM + wid * 64 + lane), (LAS unsigned*)(lds + LDS_IDX + ((ui + 1) & 1) * 1024 + wid * 256), 4, 0, 0);
    }
#pragma nounroll
    for (int t = 0; t < nt; t += 2) {
      const bool last = (t == nt - 2);
      const char* a1 = cA + (size_t)(t + 1) * kstep;
      const char* a2 = last ? nA : cA + (size_t)(t + 2) * kstep; const char* b2 = last ? nB : cB + (size_t)(t + 2) * kstep;
      const char* a3 = a2 + kstep; const char* b3 = b2 + kstep;
      unsigned g2[2][2];
#pragma unroll
      for (int h = 0; h < 2; ++h)
#pragma unroll
        for (int i = 0; i < 2; ++i) g2[h][i] = gcu[h][i];
      if constexpr (Sched::GATHER) {
        if (last && has_next) {
          const LAS unsigned* ix = (const LAS unsigned*)(lds + LDS_IDX + ((ui + 1) & 1) * 1024);
#pragma unroll
          for (int h = 0; h < 2; ++h)
#pragma unroll
            for (int i = 0; i < 2; ++i) g2[h][i] = ix[h * HALF + gR[i]] * rowb + (unsigned)gC[i];
        }
      }
      PG8_LDB(B0, 0, 0); PG8_LDB(B1, 0, 1); PG8_SCHED; PG8_LDA(At, 0, 0); PG8_STAGE_A(PG8_SA(1, 1), a1, 1, gcu);
      PG8_WAIT_V(8); PG8_WAIT_L(0); PG8_BAR; PG8_MMA(0, 0, At, B0); PG8_MMA(0, 1, At, B1); PG8_BAR; PG8_SCHED;
      PG8_LDA(At, 0, 1); PG8_STAGE(PG8_SB(0, 0), b2, voffB); PG8_STAGE(PG8_SB(0, 1), b2 + hstepB, voffB); PG8_STAGE_A(PG8_SA(0, 0), a2, 0, g2);
      PG8_WAIT_V(8); PG8_WAIT_L(0); PG8_BAR; PG8_MMA(1, 0, At, B0); PG8_MMA(1, 1, At, B1); PG8_BAR; PG8_SCHED;
      PG8_LDB(B0, 1, 0); PG8_LDB(B1, 1, 1); PG8_SCHED; PG8_LDA(At, 1, 0); PG8_STAGE_A(PG8_SA(0, 1), a2, 1, g2);
      PG8_WAIT_V(8); PG8_WAIT_L(0); PG8_BAR; PG8_MMA(0, 0, At, B0); PG8_MMA(0, 1, At, B1); PG8_BAR; PG8_SCHED;
      PG8_LDA(At, 1, 1); PG8_STAGE(PG8_SB(1, 0), b3, voffB); PG8_STAGE(PG8_SB(1, 1), b3 + hstepB, voffB); PG8_STAGE_A(PG8_SA(1, 0), a3, 0, g2);
      PG8_WAIT_V(8); PG8_WAIT_L(0); PG8_BAR; PG8_MMA(1, 0, At, B0); PG8_MMA(1, 1, At, B1); PG8_BAR; PG8_SCHED;
      if constexpr (Sched::GATHER) { if (last) {
#pragma unroll
        for (int h = 0; h < 2; ++h)
#pragma unroll
          for (int i = 0; i < 2; ++i) gcu[h][i] = g2[h][i]; } }
    }
    if (wr == 0) PG8_BAR;
    E(acc, cur, wr, wc, fr, fq);
    if (!has_next) break;
#pragma unroll
    for (int a = 0; a < 2; ++a)
#pragma unroll
      for (int b = 0; b < 2; ++b)
#pragma unroll
        for (int m = 0; m < 4; ++m)
#pragma unroll
          for (int n = 0; n < 2; ++n) acc[a][b][m][n] = (f32x4){0.f, 0.f, 0.f, 0.f};
    cur = nxt; cA = nA; cB = nB; ++ui;
    if (wr == 1) PG8_BAR;
  }
  PG8_WAIT_V(0);
  PG8_BAR;
#undef PG8_SA
#undef PG8_SB
#undef PG8_STAGE
#undef PG8_STAGE_A
#undef PG8_LDA
#undef PG8_LDB
#undef PG8_MMA
#undef PG8_WAIT_V
#undef PG8_WAIT_L
#undef PG8_BAR
#undef PG8_SCHED
}
}

__device__ __forceinline__ void cvt_item(const float* W, int ldw, bf16* WT, int Kd, int dst_row0, int k0, int n0, float* scr, int lane) {
#pragma unroll 8
  for (int i = 0; i < 32; ++i) { const int kk = 2 * i + (lane >> 5); scr[kk * 33 + (lane & 31)] = W[(size_t)(k0 + kk) * ldw + n0 + (lane & 31)]; }
  __builtin_amdgcn_s_waitcnt(0); __builtin_amdgcn_wave_barrier();
  const int cch = lane & 7;
#pragma unroll
  for (int j = 0; j < 4; ++j) { const int n = (lane >> 3) + 8 * j; const float* sp = scr + (8 * cch) * 33 + n;
    mg::u32x4 o; o.x = mg::cvt_pk_bf16(sp[0 * 33], sp[1 * 33]); o.y = mg::cvt_pk_bf16(sp[2 * 33], sp[3 * 33]); o.z = mg::cvt_pk_bf16(sp[4 * 33], sp[5 * 33]); o.w = mg::cvt_pk_bf16(sp[6 * 33], sp[7 * 33]);
    *(mg::u32x4*)(WT + (size_t)(dst_row0 + n) * Kd + k0 + 8 * cch) = o; }
  __builtin_amdgcn_s_waitcnt(0); __builtin_amdgcn_wave_barrier();
}
__device__ __forceinline__ void cvt_mat_item(const float* W, int K, int N, int ldw, bf16* WT, int mode, int it, float* scr, int lane) {
  const int nblk = N / 32, kb = it / nblk, nb = it % nblk, n0 = nb * 32;
  const int dst = mode == 0 ? n0 : ((n0 >> 7) * 256 + (n0 & 127) + (mode == 2 ? 128 : 0));
  cvt_item(W, ldw, WT, K, dst, kb * 64, n0, scr, lane);
}
__device__ __forceinline__ void cvt_dense(const Ctx& c) {
  float* scr = (float*)c.lds + c.wave * 4096;
  const float* win0 = inp(c, I0_WIN); const float* wout0 = inp(c, I0_WOUT); const float* fg = inp(c, I0_FG); const float* fu = inp(c, I0_FU); const float* fd = inp(c, I0_FD);
  const float* win1 = inp(c, I1_WIN); const float* glw = inp(c, I1_GLW); const float* wout1 = inp(c, I1_WOUT);
  unsigned char* ws = c.ws;
  for (int it = c.wave * c.G + c.bid; it < 7808; it += NW * c.G) {
    int r = it;
    if (r < 1408) { cvt_mat_item(win0, D, EVEN_IN, EVEN_IN, (bf16*)(ws + WS_WIN0), 0, r, scr, c.lane); continue; } r -= 1408;
    if (r < 512) { cvt_mat_item(wout0, D, D, D, (bf16*)(ws + WS_WOUT0), 0, r, scr, c.lane); continue; } r -= 512;
    if (r < 1408) { cvt_mat_item(fg, D, FFN, FFN, (bf16*)(ws + WS_FGU), 1, r, scr, c.lane); continue; } r -= 1408;
    if (r < 1408) { cvt_mat_item(fu, D, FFN, FFN, (bf16*)(ws + WS_FGU), 2, r, scr, c.lane); continue; } r -= 1408;
    if (r < 1408) { cvt_mat_item(fd, FFN, D, D, (bf16*)(ws + WS_FD), 0, r, scr, c.lane); continue; } r -= 1408;
    if (r < 1024) { cvt_mat_item(win1, D, 2048, ODD_IN, (bf16*)(ws + WS_WIN1), 0, r, scr, c.lane); continue; } r -= 1024;
    if (r < 128) { cvt_mat_item(glw, 512, 512, 512, (bf16*)(ws + WS_GLU), 0, r, scr, c.lane); continue; } r -= 128;
    cvt_mat_item(wout1, D, D, D, (bf16*)(ws + WS_WOUT1), 0, r, scr, c.lane);
  }
}
__device__ __forceinline__ void cvt_moe(const Ctx& c, int vb, int vG, int part) {
  float* scr = (float*)c.lds + c.wave * 4096;
  const float* mgp = inp(c, I1_MG); const float* mup = inp(c, I1_MU); const float* mdp = inp(c, I1_MDN);
  if (part == 0) {
    for (int it = c.wave * vG + vb; it < 8 * 3584; it += NW * vG) {
      const int e = it / 3584, r = it % 3584, which = r / 1792, idx = r % 1792;
      cvt_mat_item((which ? mup : mgp) + (size_t)e * D * FE, D, FE, FE, (bf16*)(c.ws + WS_MGU) + (size_t)e * 2 * FE * D, 1 + which, idx, scr, c.lane);
    }
  } else {
    for (int it = c.wave * vG + vb; it < 8 * 1792; it += NW * vG) {
      const int e = it / 1792, idx = it % 1792;
      cvt_mat_item(mdp + (size_t)e * FE * D, FE, D, D, (bf16*)(c.ws + WS_MD) + (size_t)e * D * FE, 0, idx, scr, c.lane);
    }
  }
}


template <int YMODE, int PROJ>
__device__ __forceinline__ void norm_phase(const Ctx& c, const float* resin, float* resout, const float* Y, const float* gpost, const float* gpre, bf16* XN,
                                           const float* W8, int ldw8, int c0, float* out8) {
  float* w8s = (float*)c.lds;
  LAS unsigned* hist = (LAS unsigned*)(c.lds + 32768);
  if (PROJ) {
    for (int i = c.tid; i < 1024 * 8; i += NT) w8s[i] = W8[(size_t)(i >> 3) * ldw8 + c0 + (i & 7)];
    if (PROJ == 2 && c.tid < 8) hist[c.tid] = 0u;
    __syncthreads();
  }
  int* tok_e = (int*)(c.ws + WS_ROUTE); float* tok_g = (float*)(c.ws + WS_ROUTE + 128 * 1024);
  const int* tok_slot = (const int*)(c.ws + WS_ROUTE + 256 * 1024);
  const bf16* YS = (const bf16*)(c.ws + WS_YS);
  for (int m = c.wave * c.G + c.bid; m < M; m += NW * c.G) {
    f32x4 r[4];
#pragma unroll
    for (int j = 0; j < 4; ++j) r[j] = *(const f32x4*)(resin + (size_t)m * D + j * 256 + c.lane * 4);
    if (YMODE) {
      f32x4 y[4]; float ss = 0.f;
      if (YMODE == 1) {
#pragma unroll
        for (int j = 0; j < 4; ++j) y[j] = *(const f32x4*)(Y + (size_t)m * D + j * 256 + c.lane * 4);
      } else {
        const int s0 = tok_slot[2 * m], s1 = tok_slot[2 * m + 1]; const float g0 = tok_g[2 * m], g1 = tok_g[2 * m + 1];
#pragma unroll
        for (int j = 0; j < 4; ++j) {
          const uint2 a = *(const uint2*)(YS + (size_t)s0 * D + j * 256 + c.lane * 4), b = *(const uint2*)(YS + (size_t)s1 * D + j * 256 + c.lane * 4);
          y[j][0] = g0 * bf2f((bf16)(a.x & 0xffff)) + g1 * bf2f((bf16)(b.x & 0xffff));
          y[j][1] = g0 * bf2f((bf16)(a.x >> 16)) + g1 * bf2f((bf16)(b.x >> 16));
          y[j][2] = g0 * bf2f((bf16)(a.y & 0xffff)) + g1 * bf2f((bf16)(b.y & 0xffff));
          y[j][3] = g0 * bf2f((bf16)(a.y >> 16)) + g1 * bf2f((bf16)(b.y >> 16));
        }
      }
#pragma unroll
      for (int j = 0; j < 4; ++j) ss += y[j][0] * y[j][0] + y[j][1] * y[j][1] + y[j][2] * y[j][2] + y[j][3] * y[j][3];
      const float rs = rsqrtf(wave_sum(ss) * (1.f / D) + 1e-6f);
#pragma unroll
      for (int j = 0; j < 4; ++j) {
        const f32x4 g = *(const f32x4*)(gpost + j * 256 + c.lane * 4);
        r[j] = r[j] + y[j] * rs * g;
        *(f32x4*)(resout + (size_t)m * D + j * 256 + c.lane * 4) = r[j];
      }
    }
    if (gpre) {
      float ss = 0.f;
#pragma unroll
      for (int j = 0; j < 4; ++j) ss += r[j][0] * r[j][0] + r[j][1] * r[j][1] + r[j][2] * r[j][2] + r[j][3] * r[j][3];
      const float rs = rsqrtf(wave_sum(ss) * (1.f / D) + 1e-6f);
      float p8[8];
#pragma unroll
      for (int q = 0; q < 8; ++q) p8[q] = 0.f;
#pragma unroll
      for (int j = 0; j < 4; ++j) {
        const f32x4 g = *(const f32x4*)(gpre + j * 256 + c.lane * 4);
        const f32x4 xn = r[j] * rs * g;
        uint2 o; o.x = (unsigned)f2bf(xn[0]) | ((unsigned)f2bf(xn[1]) << 16); o.y = (unsigned)f2bf(xn[2]) | ((unsigned)f2bf(xn[3]) << 16);
        *(uint2*)(XN + (size_t)m * D + j * 256 + c.lane * 4) = o;
        if (PROJ) {
#pragma unroll
          for (int e = 0; e < 4; ++e) {
            const float* wr = w8s + (j * 256 + c.lane * 4 + e) * 8;
#pragma unroll
            for (int q = 0; q < 8; ++q) p8[q] += xn[e] * wr[q];
          }
        }
      }
      if (PROJ) {
#pragma unroll
        for (int q = 0; q < 8; ++q) p8[q] = wave_sum(p8[q]);
        if (PROJ == 1) { if (c.lane < 8) { float v = p8[0];
#pragma unroll
            for (int q = 1; q < 8; ++q) v = (c.lane == q) ? p8[q] : v;
            out8[(size_t)m * 8 + c.lane] = v; } }
        if (PROJ == 2 && c.lane == 0) {
          int e0 = 0; float v0 = p8[0];
#pragma unroll
          for (int q = 1; q < 8; ++q) if (p8[q] > v0) { v0 = p8[q]; e0 = q; }
          int e1 = -1; float v1 = -3.0e38f;
#pragma unroll
          for (int q = 0; q < 8; ++q) if (q != e0 && p8[q] > v1) { v1 = p8[q]; e1 = q; }
          const float g1 = 1.f / (1.f + expf(v0 - v1)), g0 = 1.f - g1;
          tok_e[2 * m] = e0; tok_e[2 * m + 1] = e1; tok_g[2 * m] = g0; tok_g[2 * m + 1] = g1;
          atomicAdd((unsigned*)&hist[e0], 1u); atomicAdd((unsigned*)&hist[e1], 1u);
        }
      }
    }
  }
  if (PROJ == 2) { __syncthreads(); if (c.tid < 8) atomicAdd(c.ctl + CW_CNT + 64 * c.tid, hist[c.tid]); }
  __syncthreads();
}

__device__ __forceinline__ void rwkv_prep_a(const Ctx& c) {
  const float* mu = inp(c, I0_MU);
  const bf16* P = (const bf16*)(c.ws + WS_P0); bf16* AL = (bf16*)(c.ws + WS_ALORA);
  const f32x4 mu4 = *(const f32x4*)(mu + 1536 + c.lane * 4);
  for (int m = c.wave * c.G + c.bid; m < M; m += NW * c.G) {
    const int t = m % SEQ;
    const uint2 cu = *(const uint2*)(P + (size_t)m * EVEN_IN + 1536 + c.lane * 4);
    uint2 pv = {0u, 0u}; if (t > 0) pv = *(const uint2*)(P + (size_t)(m - 1) * EVEN_IN + 1536 + c.lane * 4);
    const float cv[4] = {__uint_as_float(cu.x << 16), __uint_as_float(cu.x & 0xffff0000u), __uint_as_float(cu.y << 16), __uint_as_float(cu.y & 0xffff0000u)};
    const float pp[4] = {__uint_as_float(pv.x << 16), __uint_as_float(pv.x & 0xffff0000u), __uint_as_float(pv.y << 16), __uint_as_float(pv.y & 0xffff0000u)};
    float o[4];
#pragma unroll
    for (int e = 0; e < 4; ++e) { float v = cv[e] + (pp[e] - cv[e]) * mu4[e]; if (c.lane < 16) v = tanhf(v); else if (c.lane >= 32) v = sigmoid_(v); o[e] = v; }
    uint2 w; w.x = (unsigned)f2bf(o[0]) | ((unsigned)f2bf(o[1]) << 16); w.y = (unsigned)f2bf(o[2]) | ((unsigned)f2bf(o[3]) << 16);
    *(uint2*)(AL + (size_t)m * 256 + c.lane * 4) = w;
  }
}
__device__ __forceinline__ void build_wlora(const Ctx& c) {
  const float* w2 = inp(c, I0_W2); const float* a2 = inp(c, I0_A2); const float* g2 = inp(c, I0_G2);
  bf16* WL = (bf16*)(c.ws + WS_WLORA);
  for (int i = c.bid * NT + c.tid; i < 1536 * 256; i += c.G * NT) {
    const int n = i >> 8, k = i & 255; float v = 0.f;
    if (n < 512) { if (k < 64) v = w2[k * 512 + n]; }
    else if (n < 1024) { if (k >= 64 && k < 128) v = a2[(k - 64) * 512 + (n - 512)]; }
    else { if (k >= 128) v = g2[(k - 128) * 512 + (n - 1024)]; }
    WL[i] = f2bf(v);
  }
}
__device__ __forceinline__ void rwkv_prep_c(const Ctx& c) {
  const float* mu = inp(c, I0_MU); const float* w0 = inp(c, I0_W0); const float* a0 = inp(c, I0_A0);
  const float* kkp = inp(c, I0_KK); const float* kap = inp(c, I0_KA); const float* rkp = inp(c, I0_RK);
  const bf16* P = (const bf16*)(c.ws + WS_P0); const bf16* LW = (const bf16*)(c.ws + WS_LOWA);
  float* SR = (float*)(c.ws + WS_SR); float* SW = (float*)(c.ws + WS_SW); float* SK = (float*)(c.ws + WS_SK); float* SV = (float*)(c.ws + WS_SV);
  float* SA = (float*)(c.ws + WS_SA); float* SB = (float*)(c.ws + WS_SB); float* BON = (float*)(c.ws + WS_BON);
  for (int m = c.wave * c.G + c.bid; m < M; m += NW * c.G) {
    const int t = m % SEQ;
    const bf16* pc = P + (size_t)m * EVEN_IN; const bf16* pp = P + (size_t)(m - 1) * EVEN_IN;
#pragma unroll 2
    for (int j = 0; j < 8; ++j) {
      const int ch = j * 64 + c.lane;
      const float rc = bf2f(pc[ch]), kc = bf2f(pc[512 + ch]), vc = bf2f(pc[1024 + ch]);
      float rp = 0.f, kp = 0.f, vp = 0.f; if (t > 0) { rp = bf2f(pp[ch]); kp = bf2f(pp[512 + ch]); vp = bf2f(pp[1024 + ch]); }
      const float r = rc + (rp - rc) * mu[ch], k = kc + (kp - kc) * mu[512 + ch], v = vc + (vp - vc) * mu[1024 + ch];
      const float aw = w0[ch] + bf2f(LW[(size_t)m * 1024 + ch]), aa = a0[ch] + bf2f(LW[(size_t)m * 1024 + 512 + ch]);
      const float wl = -softplus_(-aw) - 0.5f;
      const float decay = expf(-expf(wl));
      const float a = sigmoid_(aa);
      float kk = k * kkp[ch];
      const float nrm = sqrtf(wave_sum(kk * kk));
      kk = kk / fmaxf(nrm, 1e-12f);
      const float k2 = k * (1.f + (a - 1.f) * kap[ch]);
      const float bon = wave_sum(r * k2 * rkp[ch]);
      const size_t o = (size_t)m * 512 + ch;
      SR[o] = r; SW[o] = decay; SK[o] = k2; SV[o] = v; SA[o] = -kk; SB[o] = kk * a;
      if (c.lane == 0) BON[(size_t)m * 8 + j] = bon;
    }
  }
}

template <int CTRL> __device__ __forceinline__ float dpp_f(float v) { return __int_as_float(__builtin_amdgcn_update_dpp(0, __float_as_int(v), CTRL, 0xf, 0xf, true)); }
__device__ __forceinline__ float row16_sum(float v) { v += dpp_f<0xB1>(v); v += dpp_f<0x4E>(v); v += dpp_f<0x141>(v); v += dpp_f<0x140>(v); return v; }
constexpr size_t WS_YSC = WS_XN;
__device__ __forceinline__ void rwkv_scan(const Ctx& c) {
  const float* ST[6] = {(const float*)(c.ws + WS_SR), (const float*)(c.ws + WS_SW), (const float*)(c.ws + WS_SK), (const float*)(c.ws + WS_SV), (const float*)(c.ws + WS_SA), (const float*)(c.ws + WS_SB)};
  float* YO = (float*)(c.ws + WS_YSC);
  float* buf = (float*)c.lds;
  float* ysm = (float*)c.lds + 2 * 6 * 32 * 64;
  const int ltt = c.tid >> 4, lq = c.tid & 15;
  const int rr = c.lane >> 4, kq = c.lane & 15, rloc = c.wave * 4 + rr;
  for (int it = c.bid; it < BATCH * 8 * 2; it += c.G) {
    const int b = it >> 4, h = (it >> 1) & 7, half = it & 1;
    const size_t m0 = (size_t)b * SEQ;
    const int row = half * 32 + rloc;
    f32x4 S = {0.f, 0.f, 0.f, 0.f};
    f32x4 ld[6];
    __syncthreads();
#pragma unroll
    for (int s6 = 0; s6 < 6; ++s6) ld[s6] = *(const f32x4*)(ST[s6] + (m0 + ltt) * 512 + h * 64 + lq * 4);
#pragma unroll
    for (int s6 = 0; s6 < 6; ++s6) *(f32x4*)(buf + ((0 * 6 + s6) * 32 + ltt) * 64 + lq * 4) = ld[s6];
    __syncthreads();
    for (int ck = 0; ck < SEQ / 32; ++ck) {
      const int cur = ck & 1;
      if (ck + 1 < SEQ / 32) {
#pragma unroll
        for (int s6 = 0; s6 < 6; ++s6) ld[s6] = *(const f32x4*)(ST[s6] + (m0 + (ck + 1) * 32 + ltt) * 512 + h * 64 + lq * 4);
      }
      const float* bb = buf + cur * 6 * 32 * 64;
#pragma unroll 4
      for (int tt = 0; tt < 32; ++tt) {
        const f32x4 r4 = *(const f32x4*)(bb + (0 * 32 + tt) * 64 + kq * 4), w4 = *(const f32x4*)(bb + (1 * 32 + tt) * 64 + kq * 4), k4 = *(const f32x4*)(bb + (2 * 32 + tt) * 64 + kq * 4);
        const f32x4 a4 = *(const f32x4*)(bb + (4 * 32 + tt) * 64 + kq * 4), b4 = *(const f32x4*)(bb + (5 * 32 + tt) * 64 + kq * 4);
        const float v = bb[(3 * 32 + tt) * 64 + row];
        const float sa = row16_sum((S[0] * a4[0] + S[1] * a4[1]) + (S[2] * a4[2] + S[3] * a4[3]));
        S = S * w4 + sa * b4 + v * k4;
        const float y = row16_sum((S[0] * r4[0] + S[1] * r4[1]) + (S[2] * r4[2] + S[3] * r4[3]));
        if (kq == 0) ysm[tt * 32 + rloc] = y;
      }
      __syncthreads();
      if (ck + 1 < SEQ / 32) {
#pragma unroll
        for (int s6 = 0; s6 < 6; ++s6) *(f32x4*)(buf + (((cur ^ 1) * 6 + s6) * 32 + ltt) * 64 + lq * 4) = ld[s6];
      }
      if (c.tid < 256) { const int tt = c.tid >> 3, q = c.tid & 7; *(f32x4*)(YO + (m0 + ck * 32 + tt) * 512 + h * 64 + half * 32 + q * 4) = *(const f32x4*)(ysm + tt * 32 + q * 4); }
      __syncthreads();
    }
  }
  __syncthreads();
}

__device__ __forceinline__ void rwkv_post(const Ctx& c) {
  const float* YS = (const float*)(c.ws + WS_YSC); const float* SV = (const float*)(c.ws + WS_SV); const bf16* GG = (const bf16*)(c.ws + WS_LOG);
  const float* BON = (const float*)(c.ws + WS_BON); bf16* YM = (bf16*)(c.ws + WS_YMIX);
  const float* lnw = inp(c, I0_LNW); const float* lnb = inp(c, I0_LNB);
  for (int m = c.wave * c.G + c.bid; m < M; m += NW * c.G) {
#pragma unroll
    for (int j = 0; j < 8; ++j) {
      const int ch = j * 64 + c.lane; const size_t o = (size_t)m * 512 + ch;
      const float y = YS[o];
      const float mean = wave_sum(y) * (1.f / 64.f);
      const float d = y - mean;
      const float var = wave_sum(d * d) * (1.f / 64.f);
      float v = d * rsqrtf(var + 64e-5f) * lnw[ch] + lnb[ch];
      v += BON[(size_t)m * 8 + j] * SV[o];
      YM[(size_t)m * D + ch] = f2bf(v * bf2f(GG[(size_t)m * 1024 + ch]));
    }
  }
}

__device__ __forceinline__ void gmlp_phase(const Ctx& c, int vb, int vG) {
  const bf16* P = (const bf16*)(c.ws + WS_P0); bf16* YM = (bf16*)(c.ws + WS_YMIX);
  const float* lnw = inp(c, I0_GLNW); const float* lnb = inp(c, I0_GLNB); const float* ws = inp(c, I0_GWS); const float* bs = inp(c, I0_GBS);
  float* vn = (float*)c.lds;
  for (int it = vb; it < BATCH * 16 * 4; it += vG) {
    const int g = it & 3, ck = (it >> 2) & 15, b = it >> 6;
    const size_t m0 = (size_t)b * SEQ + ck * 128;
    __syncthreads();
    for (int j = c.wave; j < 128; j += NW) {
      const bf16* row = P + (m0 + j) * EVEN_IN + 2304 + g * 128;
      const float v0 = gelu_(bf2f(row[c.lane])), v1 = gelu_(bf2f(row[c.lane + 64]));
      const float mean = wave_sum(v0 + v1) * (1.f / 128.f);
      const float d0 = v0 - mean, d1 = v1 - mean;
      const float rs = rsqrtf(wave_sum(d0 * d0 + d1 * d1) * (1.f / 128.f) + 1e-6f);
      vn[j * 128 + c.lane] = d0 * rs * lnw[g * 128 + c.lane] + lnb[g * 128 + c.lane];
      vn[j * 128 + c.lane + 64] = d1 * rs * lnw[g * 128 + c.lane + 64] + lnb[g * 128 + c.lane + 64];
    }
    __syncthreads();
    const int d = c.tid & 127, iq = c.tid >> 7;
    for (int ii = 0; ii < 32; ++ii) {
      const int i = iq + 4 * ii;
      const float* wrow = ws + ((size_t)g * 128 + i) * 128;
      float acc = bs[g * 128 + i];
      for (int j = 0; j <= i; ++j) acc += wrow[j] * vn[j * 128 + d];
      const float u = gelu_(bf2f(P[(m0 + i) * EVEN_IN + 1792 + g * 128 + d]));
      YM[(m0 + i) * D + 512 + g * 128 + d] = f2bf(u * acc);
    }
  }
  __syncthreads();
}

__device__ __forceinline__ void s5_tables(const Ctx& c) {
  const float* are = inp(c, I1_ARE); const float* aim = inp(c, I1_AIM); const float* ldt = inp(c, I1_LDT); const float* bre = inp(c, I1_BRE); const float* bim = inp(c, I1_BIM);
  float* POW = (float*)(c.ws + WS_S5POW); float* BB = (float*)(c.ws + WS_S5BB);
  for (int i = c.bid * NT + c.tid; i < 32 * 17 * 64; i += c.G * NT) {
    const int p = i & 63, tau = (i >> 6) % 17, g = i / (17 * 64);
    const float lr = are[g * 64 + p], li = aim[g * 64 + p], dt = expf(ldt[g]);
    const float mag = expf(lr * dt * (float)tau), ang = li * dt * (float)tau;
    POW[2 * i] = mag * cosf(ang); POW[2 * i + 1] = mag * sinf(ang);
  }
  for (int i = c.bid * NT + c.tid; i < 32 * 64 * 16; i += c.G * NT) {
    const int gp = i >> 4, g = gp >> 6;
    const float lr = are[gp], li = aim[gp], dt = expf(ldt[g]);
    const float mag = expf(lr * dt), ar = mag * cosf(li * dt), ai = mag * sinf(li * dt);
    const float nr = ar - 1.f, ni = ai, den = lr * lr + li * li;
    const float fr = (nr * lr + ni * li) / den, fi = (ni * lr - nr * li) / den;
    const float br = bre[i], bi = bim[i];
    BB[2 * i] = fr * br - fi * bi; BB[2 * i + 1] = fr * bi + fi * br;
  }
}
__device__ __forceinline__ void s5_taps(const Ctx& c) {
  const float* cre = inp(c, I1_CRE); const float* cim = inp(c, I1_CIM);
  const float* POW = (const float*)(c.ws + WS_S5POW); const float* BB = (const float*)(c.ws + WS_S5BB); float* KT = (float*)(c.ws + WS_S5KT);
  for (int i = c.bid * NT + c.tid; i < 32 * 16 * 256; i += c.G * NT) {
    const int c2 = i & 15, c1 = (i >> 4) & 15, tau = (i >> 8) & 15, g = i >> 12;
    float acc = 0.f;
    for (int p = 0; p < 64; ++p) {
      const float cr = cre[(g * 16 + c1) * 64 + p], ci = cim[(g * 16 + c1) * 64 + p];
      const float pr = POW[((g * 17 + tau) * 64 + p) * 2], pi = POW[((g * 17 + tau) * 64 + p) * 2 + 1];
      const float br = BB[((g * 64 + p) * 16 + c2) * 2], bi = BB[((g * 64 + p) * 16 + c2) * 2 + 1];
      const float wr = cr * pr - ci * pi, wi = cr * pi + ci * pr;
      acc += wr * br - wi * bi;
    }
    KT[i] = acc;
  }
}
__device__ __forceinline__ void s5_mats(const Ctx& c) {
  const float* cre = inp(c, I1_CRE); const float* cim = inp(c, I1_CIM);
  const float* POW = (const float*)(c.ws + WS_S5POW); const float* BB = (const float*)(c.ws + WS_S5BB); const float* KT = (const float*)(c.ws + WS_S5KT);
  bf16* BE = (bf16*)(c.ws + WS_S5BE); bf16* BTF = (bf16*)(c.ws + WS_S5BTF);
  for (int i = c.bid * NT + c.tid; i < 32 * 256 * 256; i += c.G * NT) {
    const int k = i & 255, n = (i >> 8) & 255, g = i >> 16; float v = 0.f;
    if (n < 128) { const int p = n & 63, s16 = k >> 4, c2 = k & 15;
      const float pr = POW[((g * 17 + 15 - s16) * 64 + p) * 2], pi = POW[((g * 17 + 15 - s16) * 64 + p) * 2 + 1];
      const float br = BB[((g * 64 + p) * 16 + c2) * 2], bi = BB[((g * 64 + p) * 16 + c2) * 2 + 1];
      v = (n < 64) ? (pr * br - pi * bi) : (pr * bi + pi * br); }
    BE[i] = f2bf(v);
  }
  for (int i = c.bid * NT + c.tid; i < 32 * 256 * 384; i += c.G * NT) {
    const int k = i % 384, n = (i / 384) & 255, g = i / (384 * 256), t = n >> 4, c1 = n & 15; float v = 0.f;
    if (k < 256) { const int s16 = k >> 4, c2 = k & 15; if (s16 <= t) v = KT[((g * 16 + (t - s16)) * 16 + c1) * 16 + c2]; }
    else { const int kk = k - 256, p = kk & 63;
      const float cr = cre[(g * 16 + c1) * 64 + p], ci = cim[(g * 16 + c1) * 64 + p];
      const float pr = POW[((g * 17 + t + 1) * 64 + p) * 2], pi = POW[((g * 17 + t + 1) * 64 + p) * 2 + 1];
      v = (kk < 64) ? (cr * pr - ci * pi) : -(cr * pi + ci * pr); }
    BTF[i] = f2bf(v);
  }
}
__device__ __forceinline__ void s5_carry(const Ctx& c) {
  const float* XE = (const float*)(c.ws + WS_S5XE); bf16* AP = (bf16*)(c.ws + WS_S5A); const float* POW = (const float*)(c.ws + WS_S5POW);
  for (int it = c.wave * c.G + c.bid; it < BATCH * 32; it += NW * c.G) {
    const int b = it >> 5, g = it & 31, p = c.lane;
    const float ar = POW[((g * 17 + 16) * 64 + p) * 2], ai = POW[((g * 17 + 16) * 64 + p) * 2 + 1];
    float xr = 0.f, xi = 0.f;
    const size_t row0 = (size_t)g * 1024 + b * 128;
    for (int blk0 = 0; blk0 < 128; blk0 += 8) {
      float er[8], ei[8];
#pragma unroll
      for (int j = 0; j < 8; ++j) { er[j] = XE[(row0 + blk0 + j) * 128 + p]; ei[j] = XE[(row0 + blk0 + j) * 128 + 64 + p]; }
#pragma unroll
      for (int j = 0; j < 8; ++j) {
        bf16* ap = AP + (row0 + blk0 + j) * 384 + 256;
        ap[p] = f2bf(xr); ap[64 + p] = f2bf(xi);
        const float nr = ar * xr - ai * xi + er[j], ni = ar * xi + ai * xr + ei[j];
        xr = nr; xi = ni;
      }
    }
  }
}

__device__ __forceinline__ void ssd_conv(const Ctx& c) {
  const bf16* P1 = (const bf16*)(c.ws + WS_P1); bf16* CV = (bf16*)(c.ws + WS_CONV);
  const float* cw = inp(c, I1_CW); const float* cb = inp(c, I1_CB);
  for (size_t i = (size_t)c.bid * NT + c.tid; i < (size_t)M * 128; i += (size_t)c.G * NT) {
    const int ch = (int)(i & 127) * 8; const size_t m = i >> 7; const int t = (int)(m % SEQ);
    float acc[8];
#pragma unroll
    for (int e = 0; e < 8; ++e) acc[e] = cb[ch + e];
#pragma unroll
    for (int j = 0; j < 4; ++j) { const int tt = t - 3 + j; if (tt >= 0) {
        const uint4 v = *(const uint4*)(P1 + (m - 3 + j) * 2048 + 1024 + ch); const unsigned vw[4] = {v.x, v.y, v.z, v.w};
#pragma unroll
        for (int e = 0; e < 4; ++e) { acc[2 * e] += cw[j * 1024 + ch + 2 * e] * __uint_as_float(vw[e] << 16); acc[2 * e + 1] += cw[j * 1024 + ch + 2 * e + 1] * __uint_as_float(vw[e] & 0xffff0000u); } } }
    uint4 o; o.x = mg::cvt_pk_bf16(silu_(acc[0]), silu_(acc[1])); o.y = mg::cvt_pk_bf16(silu_(acc[2]), silu_(acc[3])); o.z = mg::cvt_pk_bf16(silu_(acc[4]), silu_(acc[5])); o.w = mg::cvt_pk_bf16(silu_(acc[6]), silu_(acc[7]));
    *(uint4*)(CV + m * 1024 + ch) = o;
  }
}

constexpr int SPI = 136;
constexpr int SL_C = 0, SL_B = 34816, SL_BT = 69632, SL_XT = 104448, SL_DT = 121856, SL_ACS = 123904;
__device__ __forceinline__ void ssd_dt_acs(const Ctx& c, size_t m0, int g, const float* DT, const float* dtb, const float* alog, float* sdt, float* sacs) {
  if (c.wave < 4) {
    const int h = g * 4 + c.wave; const float av = -expf(alog[h]), bias = dtb[h];
    const float d0 = softplus_(DT[(m0 + 2 * c.lane) * 8 + h] + bias), d1 = softplus_(DT[(m0 + 2 * c.lane + 1) * 8 + h] + bias);
    const float a0 = av * d0, a1 = av * d1;
    float sc = a0 + a1;
#pragma unroll
    for (int o = 1; o < 64; o <<= 1) { const float t = __shfl_up(sc, o); if (c.lane >= o) sc += t; }
    sdt[c.wave * 128 + 2 * c.lane] = d0; sdt[c.wave * 128 + 2 * c.lane + 1] = d1;
    sacs[c.wave * 128 + 2 * c.lane] = sc - a1; sacs[c.wave * 128 + 2 * c.lane + 1] = sc;
  }
}
__device__ __forceinline__ void ssd_pass1(const Ctx& c) {
  const bf16* CV = (const bf16*)(c.ws + WS_CONV); const float* DT = (const float*)(c.ws + WS_DT);
  float* YD = (float*)(c.ws + WS_YD); float* SE = (float*)(c.ws + WS_SE); float* ATOT = (float*)(c.ws + WS_ATOT);
  const float* dtb = inp(c, I1_DTB); const float* alog = inp(c, I1_ALOG);
  bf16* Cs = (bf16*)(c.lds + SL_C); bf16* Bs = (bf16*)(c.lds + SL_B); bf16* BTs = (bf16*)(c.lds + SL_BT); bf16* XT = (bf16*)(c.lds + SL_XT);
  float* sdt = (float*)(c.lds + SL_DT); float* sacs = (float*)(c.lds + SL_ACS);
  const int w = c.wave, q = c.lane >> 4, lr = c.lane & 15;
  for (int unit = c.bid; unit < BATCH * 16 * 2; unit += c.G) {
    const int g = unit & 1, ck = (unit >> 1) & 15, b = unit >> 5;
    const size_t m0 = (size_t)b * SEQ + ck * 128;
    __syncthreads();
#pragma unroll
    for (int i = 0; i < 8; ++i) { const int idx = c.tid + NT * i, mat = idx >> 11, r = (idx >> 4) & 127, qq = idx & 15;
      const uint4 v = *(const uint4*)(CV + (m0 + r) * 1024 + 512 + mat * 256 + g * 128 + qq * 8);
      *(uint4*)((mat ? Cs : Bs) + r * SPI + qq * 8) = v; }
#pragma unroll
    for (int i = 0; i < 4; ++i) { const int task = c.tid + NT * i, n = task & 127, l0 = (task >> 7) * 8;
      unsigned short e[8];
#pragma unroll
      for (int j = 0; j < 8; ++j) e[j] = CV[(m0 + l0 + j) * 1024 + 512 + g * 128 + n];
      uint4 o; o.x = e[0] | ((unsigned)e[1] << 16); o.y = e[2] | ((unsigned)e[3] << 16); o.z = e[4] | ((unsigned)e[5] << 16); o.w = e[6] | ((unsigned)e[7] << 16);
      *(uint4*)(BTs + n * SPI + l0) = o; }
    ssd_dt_acs(c, m0, g, DT, dtb, alog, sdt, sacs);
    __syncthreads();
    mg::bf16x8 cf[4];
#pragma unroll
    for (int ks = 0; ks < 4; ++ks) cf[ks] = *(const mg::bf16x8*)(Cs + (16 * w + lr) * SPI + 32 * ks + 8 * q);
    f32x4 cb[8];
#pragma unroll
    for (int j = 0; j < 8; ++j) { cb[j] = (f32x4){0.f, 0.f, 0.f, 0.f};
#pragma unroll
      for (int ks = 0; ks < 4; ++ks) { const mg::bf16x8 bf = *(const mg::bf16x8*)(Bs + (16 * j + lr) * SPI + 32 * ks + 8 * q); cb[j] = __builtin_amdgcn_mfma_f32_16x16x32_bf16(cf[ks], bf, cb[j], 0, 0, 0); } }
    __syncthreads();
    bf16* Ms = Bs;
    for (int r = 0; r < 4; ++r) {
      const int h = g * 4 + r;
#pragma unroll
      for (int i = 0; i < 2; ++i) { const int task = c.tid + NT * i, p = task & 63, l0 = (task >> 6) * 8;
        unsigned short e[8];
#pragma unroll
        for (int j = 0; j < 8; ++j) e[j] = CV[(m0 + l0 + j) * 1024 + h * 64 + p];
        uint4 o; o.x = e[0] | ((unsigned)e[1] << 16); o.y = e[2] | ((unsigned)e[3] << 16); o.z = e[4] | ((unsigned)e[5] << 16); o.w = e[6] | ((unsigned)e[7] << 16);
        *(uint4*)(XT + p * SPI + l0) = o; }
      const float* ac = sacs + r * 128; const float* dl = sdt + r * 128;
#pragma unroll
      for (int j = 0; j < 8; ++j) { const int sidx = 16 * j + lr; const float as = ac[sidx], ds = dl[sidx];
#pragma unroll
        for (int i = 0; i < 4; ++i) { const int l = 16 * w + 4 * q + i;
          const float v = (sidx <= l) ? cb[j][i] * __expf(fminf(ac[l] - as, 0.f)) * ds : 0.f;
          Ms[l * SPI + sidx] = f2bf(v); } }
      __syncthreads();
      { f32x4 ya[4];
#pragma unroll
        for (int pt = 0; pt < 4; ++pt) ya[pt] = (f32x4){0.f, 0.f, 0.f, 0.f};
        const int kmax = (16 * w + 15) >> 5;
        for (int ks = 0; ks <= kmax; ++ks) { const mg::bf16x8 mf = *(const mg::bf16x8*)(Ms + (16 * w + lr) * SPI + 32 * ks + 8 * q);
#pragma unroll
          for (int pt = 0; pt < 4; ++pt) { const mg::bf16x8 xf = *(const mg::bf16x8*)(XT + (16 * pt + lr) * SPI + 32 * ks + 8 * q); ya[pt] = __builtin_amdgcn_mfma_f32_16x16x32_bf16(mf, xf, ya[pt], 0, 0, 0); } }
#pragma unroll
        for (int pt = 0; pt < 4; ++pt)
#pragma unroll
          for (int i = 0; i < 4; ++i) YD[(m0 + 16 * w + 4 * q + i) * 512 + h * 64 + 16 * pt + lr] = ya[pt][i]; }
      { const int pt = w & 3, ntb = (w >> 2) * 4; const float aend = ac[127];
        f32x4 sa[4];
#pragma unroll
        for (int nt = 0; nt < 4; ++nt) sa[nt] = (f32x4){0.f, 0.f, 0.f, 0.f};
#pragma unroll
        for (int ks = 0; ks < 4; ++ks) { const uint4 xr = *(const uint4*)(XT + (16 * pt + lr) * SPI + 32 * ks + 8 * q); const unsigned xw[4] = {xr.x, xr.y, xr.z, xr.w};
          float xv[8];
#pragma unroll
          for (int e = 0; e < 4; ++e) { const int l = 32 * ks + 8 * q + 2 * e;
            xv[2 * e] = __uint_as_float(xw[e] << 16) * dl[l] * __expf(aend - ac[l]); xv[2 * e + 1] = __uint_as_float(xw[e] & 0xffff0000u) * dl[l + 1] * __expf(aend - ac[l + 1]); }
          union { uint4 u; mg::bf16x8 v; } xs; xs.u.x = mg::cvt_pk_bf16(xv[0], xv[1]); xs.u.y = mg::cvt_pk_bf16(xv[2], xv[3]); xs.u.z = mg::cvt_pk_bf16(xv[4], xv[5]); xs.u.w = mg::cvt_pk_bf16(xv[6], xv[7]);
#pragma unroll
          for (int nt = 0; nt < 4; ++nt) { const mg::bf16x8 bt = *(const mg::bf16x8*)(BTs + (16 * (ntb + nt) + lr) * SPI + 32 * ks + 8 * q); sa[nt] = __builtin_amdgcn_mfma_f32_16x16x32_bf16(xs.v, bt, sa[nt], 0, 0, 0); } }
        float* Eo = SE + ((size_t)(b * 8 + h) * 16 + ck) * 8192;
#pragma unroll
        for (int nt = 0; nt < 4; ++nt)
#pragma unroll
          for (int i = 0; i < 4; ++i) Eo[(16 * pt + 4 * q + i) * 128 + 16 * (ntb + nt) + lr] = sa[nt][i];
        if (c.tid == 0) ATOT[(b * 8 + h) * 16 + ck] = aend; }
      __syncthreads();
    }
  }
  __syncthreads();
}
__device__ __forceinline__ void ssd_carry(const Ctx& c) {
  const float* SE = (const float*)(c.ws + WS_SE); const float* ATOT = (const float*)(c.ws + WS_ATOT); bf16* SPV = (bf16*)(c.ws + WS_SPV);
  for (int i = c.bid * NT + c.tid; i < BATCH * 8 * 2048; i += c.G * NT) {
    const int bh = i >> 11, e4 = (i & 2047) * 4;
    f32x4 S = {0.f, 0.f, 0.f, 0.f};
    for (int ck = 0; ck < 16; ++ck) {
      const size_t o = ((size_t)bh * 16 + ck) * 8192 + e4;
      uint2 pk; pk.x = mg::cvt_pk_bf16(S[0], S[1]); pk.y = mg::cvt_pk_bf16(S[2], S[3]);
      *(uint2*)(SPV + o) = pk;
      const float d = __expf(ATOT[bh * 16 + ck]); const f32x4 e = *(const f32x4*)(SE + o);
      S = S * d + e;
    }
  }
}
__device__ __forceinline__ void ssd_pass2(const Ctx& c) {
  const bf16* CV = (const bf16*)(c.ws + WS_CONV); const float* DT = (const float*)(c.ws + WS_DT); const bf16* P1 = (const bf16*)(c.ws + WS_P1);
  const float* YD = (const float*)(c.ws + WS_YD); const bf16* SPV = (const bf16*)(c.ws + WS_SPV); bf16* YM = (bf16*)(c.ws + WS_YMIX);
  const float* dtb = inp(c, I1_DTB); const float* alog = inp(c, I1_ALOG); const float* dsk = inp(c, I1_MD); const float* nw = inp(c, I1_MNW);
  bf16* Cs = (bf16*)(c.lds + SL_C); bf16* SPs = (bf16*)(c.lds + SL_B);
  float* sdt = (float*)(c.lds + SL_DT); float* sacs = (float*)(c.lds + SL_ACS);
  const int w = c.wave, q = c.lane >> 4, lr = c.lane & 15;
  for (int unit = c.bid; unit < BATCH * 16 * 2; unit += c.G) {
    const int g = unit & 1, ck = (unit >> 1) & 15, b = unit >> 5;
    const size_t m0 = (size_t)b * SEQ + ck * 128;
    __syncthreads();
#pragma unroll
    for (int i = 0; i < 4; ++i) { const int idx = c.tid + NT * i, r = idx >> 4, qq = idx & 15;
      *(uint4*)(Cs + r * SPI + qq * 8) = *(const uint4*)(CV + (m0 + r) * 1024 + 768 + g * 128 + qq * 8); }
#pragma unroll
    for (int i = 0; i < 8; ++i) { const int idx = c.tid + NT * i, r = idx >> 10, p = (idx >> 4) & 63, qq = idx & 15;
      *(uint4*)(SPs + (r * 64 + p) * SPI + qq * 8) = *(const uint4*)(SPV + ((size_t)(b * 8 + g * 4 + r) * 16 + ck) * 8192 + p * 128 + qq * 8); }
    ssd_dt_acs(c, m0, g, DT, dtb, alog, sdt, sacs);
    __syncthreads();
    mg::bf16x8 cf[4];
#pragma unroll
    for (int ks = 0; ks < 4; ++ks) cf[ks] = *(const mg::bf16x8*)(Cs + (16 * w + lr) * SPI + 32 * ks + 8 * q);
    f32x4 yo[4][4];
#pragma unroll
    for (int r = 0; r < 4; ++r)
#pragma unroll
      for (int pt = 0; pt < 4; ++pt) { yo[r][pt] = (f32x4){0.f, 0.f, 0.f, 0.f};
#pragma unroll
        for (int ks = 0; ks < 4; ++ks) { const mg::bf16x8 sf = *(const mg::bf16x8*)(SPs + (r * 64 + 16 * pt + lr) * SPI + 32 * ks + 8 * q); yo[r][pt] = __builtin_amdgcn_mfma_f32_16x16x32_bf16(cf[ks], sf, yo[r][pt], 0, 0, 0); } }
    float dh[4];
#pragma unroll
    for (int r = 0; r < 4; ++r) dh[r] = dsk[g * 4 + r];
    float ss[4];
#pragma unroll
    for (int i = 0; i < 4; ++i) {
      const int l = 16 * w + 4 * q + i; const size_t m = m0 + l;
      const float* ydp = YD + m * 512 + g * 256 + lr; const bf16* cvp = CV + m * 1024 + g * 256 + lr; const bf16* zp = P1 + m * 2048 + 512 + g * 256 + lr;
      float sq = 0.f;
#pragma unroll
      for (int r = 0; r < 4; ++r) { const float ea = __expf(sacs[r * 128 + l]);
#pragma unroll
        for (int pt = 0; pt < 4; ++pt) { const int o = r * 64 + 16 * pt;
          const float y = ydp[o] + ea * yo[r][pt][i] + dh[r] * bf2f(cvp[o]);
          const float vv = y * silu_(bf2f(zp[o]));
          yo[r][pt][i] = vv; sq += vv * vv; } }
      ss[i] = rsqrtf(row16_sum(sq) * (1.f / 256.f) + 1e-6f);
      asm volatile("" ::: "memory");
    }
#pragma unroll
    for (int i = 0; i < 4; ++i) { const int l = 16 * w + 4 * q + i;
      bf16* ymp = YM + (m0 + l) * D + 512 + g * 256 + lr; const float* nwp = nw + g * 256 + lr;
#pragma unroll
      for (int r = 0; r < 4; ++r)
#pragma unroll
        for (int pt = 0; pt < 4; ++pt) { const int o = r * 64 + 16 * pt; ymp[o] = f2bf(yo[r][pt][i] * ss[i] * nwp[o]); }
      asm volatile("" ::: "memory");
    }
  }
  __syncthreads();
}

__device__ __forceinline__ void moe_assign(const Ctx& c) {
  LAS unsigned* lcnt = (LAS unsigned*)c.lds; LAS unsigned* lbase = lcnt + 8;
  const int* tok_e = (const int*)(c.ws + WS_ROUTE); int* tok_slot = (int*)(c.ws + WS_ROUTE + 256 * 1024); int* slot_tok = (int*)(c.ctl + CW_SLOTTOK);
  int pstart[8]; { int acc = 0;
#pragma unroll
    for (int e = 0; e < 8; ++e) { pstart[e] = acc; acc += ((int)c.ctl[CW_CNT + 64 * e] + 255) / 256 * 256; } }
  for (int tb = c.bid; tb < M / 64; tb += c.G) {
    __syncthreads();
    if (c.tid < 8) lcnt[c.tid] = 0u;
    __syncthreads();
    int e = 0; unsigned rank = 0; const int pair = tb * 128 + c.tid;
    if (c.tid < 128) { e = tok_e[pair]; rank = atomicAdd((unsigned*)&lcnt[e], 1u); }
    __syncthreads();
    if (c.tid < 8) lbase[c.tid] = atomicAdd(c.ctl + CW_CUR + 64 * c.tid, lcnt[c.tid]);
    __syncthreads();
    if (c.tid < 128) {
      int ps = 0;
#pragma unroll
      for (int q = 0; q < 8; ++q) ps = (e == q) ? pstart[q] : ps;
      const int slot = ps + (int)lbase[e] + (int)rank;
      slot_tok[slot] = pair >> 1; tok_slot[pair] = slot;
    }
  }
  __syncthreads();
}


enum { PH_PRO, PH_WIN0, PH_PREPA, PH_LORA, PH_PREPC, PH_SCAN, PH_POST, PH_WOUT0, PH_NORM0, PH_FGU, PH_FD, PH_NORM1, PH_WIN1, PH_L1A, PH_L1B, PH_L1C, PH_L1D, PH_WOUT1, PH_NORM2, PH_ASSIGN, PH_MGU0, PH_MD0, PH_MGU1, PH_MD1, PH_FINAL, PH_COUNT };
constexpr int LAST_PHASE = PH_COUNT;
template <int LO, int HI>
__global__ void __launch_bounds__(NT, 2) fwd_kernel(Args args) {
  extern __shared__ __attribute__((aligned(16))) unsigned char lds[];
  Ctx c0; c0.out = args.out; c0.ws = args.ws; c0.ctl = (unsigned*)(args.ws + WS_CTL); c0.lds = lds;
  c0.tid = threadIdx.x; c0.lane = c0.tid & 63; c0.wave = __builtin_amdgcn_readfirstlane(c0.tid >> 6); c0.bid = blockIdx.x; c0.G = gridDim.x;
  volatile LAS unsigned* bst = (volatile LAS unsigned*)(LAS unsigned char*)(lds + LDS_BST);
  if (c0.tid == 0) { LAS unsigned long long* pt = (LAS unsigned long long*)(LAS unsigned char*)(lds + LDS_PTAB);
#pragma unroll
    for (int i = 0; i < N_IN; ++i) pt[i] = (unsigned long long)args.in[i];
    bst[0] = 0u; bst[1] = 0u; }
  __syncthreads();
  constexpr int lo = LO, hi = HI;
  XcdBarrier bar; bar.bar = c0.ctl + CW_BAR; bar.x = 0; bar.st = bst;
  if constexpr (hi - lo > 1) bar = xcd_barrier_post(c0.ctl + CW_BAR, bst);
#define IN(k) (lo <= (k) && (k) < hi)
#define SEAM(k) do { if constexpr (IN(k) && IN((k) + 1)) xcd_barrier(bar); } while (0)
  unsigned char* ws = args.ws;
  bf16* XN = (bf16*)(ws + WS_XN); bf16* YM = (bf16*)(ws + WS_YMIX); float* Y = (float*)(ws + WS_Y);

  LAS unsigned char* const ldsl = (LAS unsigned char*)lds;
  if constexpr (IN(PH_PRO)) { const Ctx c = launder(c0); cvt_dense(c); build_wlora(c); s5_tables(c); norm_phase<0, 0>(c, inp(c, I_X), nullptr, nullptr, nullptr, inp(c, I0_NPM), XN, nullptr, 0, 0, nullptr); } SEAM(PH_PRO);
  if constexpr (IN(PH_WIN0)) { const Ctx c = launder(c0); s5_taps(c); mg::Gemm g{XN, (const bf16*)(ws + WS_WIN0), D, D, D}; mg::DenseOrder S; S.init(M / 256, EVEN_IN / 256, c.G, c.bid);
    mg::EpiBf16<false> E{(bf16*)(ws + WS_P0), EVEN_IN}; mg::gemm_phase(ldsl, g, S, E); } SEAM(PH_WIN0);
  if constexpr (IN(PH_PREPA)) { const Ctx c = launder(c0); rwkv_prep_a(c); } SEAM(PH_PREPA);
  if constexpr (IN(PH_LORA)) { const Ctx c = launder(c0); mg::Gemm g{(const bf16*)(ws + WS_ALORA), (const bf16*)(ws + WS_WLORA), 256, 256, 256}; mg::DenseOrder S; S.init(M / 256, 1536 / 256, c.G, c.bid);
    mg::EpiLora E{(bf16*)(ws + WS_LOWA), (bf16*)(ws + WS_LOG)}; mg::gemm_phase(ldsl, g, S, E); } SEAM(PH_LORA);
  if constexpr (IN(PH_PREPC)) { const Ctx c = launder(c0); rwkv_prep_c(c); } SEAM(PH_PREPC);
  if constexpr (IN(PH_SCAN)) { const Ctx c = launder(c0); if (c.G >= 256) { if (c.bid < 128) rwkv_scan(c); else gmlp_phase(c, c.bid - 128, c.G - 128); } else { rwkv_scan(c); gmlp_phase(c, c.bid, c.G); } } SEAM(PH_SCAN);
  if constexpr (IN(PH_POST)) { const Ctx c = launder(c0); rwkv_post(c); } SEAM(PH_POST);
  if constexpr (IN(PH_WOUT0)) { const Ctx c = launder(c0); mg::Gemm g{YM, (const bf16*)(ws + WS_WOUT0), D, D, D}; mg::DenseOrder S; S.init(M / 256, D / 256, c.G, c.bid);
    mg::EpiF32 E{Y, D}; mg::gemm_phase(ldsl, g, S, E); } SEAM(PH_WOUT0);
  if constexpr (IN(PH_NORM0)) { const Ctx c = launder(c0); norm_phase<1, 0>(c, inp(c, I_X), args.out, Y, inp(c, I0_NPOM), inp(c, I0_NPF), XN, nullptr, 0, 0, nullptr); } SEAM(PH_NORM0);
  if constexpr (IN(PH_FGU)) { const Ctx c = launder(c0); mg::Gemm g{XN, (const bf16*)(ws + WS_FGU), D, D, D}; mg::DenseOrder S; S.init(M / 256, 2 * FFN / 256, c.G, c.bid);
    mg::EpiSwigluT E{(bf16*)(ws + WS_H), FFN}; mg::gemm_phase(ldsl, g, S, E); } SEAM(PH_FGU);
  if constexpr (IN(PH_FD)) { const Ctx c = launder(c0); mg::Gemm g{(const bf16*)(ws + WS_H), (const bf16*)(ws + WS_FD), FFN, FFN, FFN}; mg::DenseOrder S; S.init(M / 256, D / 256, c.G, c.bid);
    mg::EpiF32 E{Y, D}; mg::gemm_phase(ldsl, g, S, E); } SEAM(PH_FD);
  if constexpr (IN(PH_NORM1)) { const Ctx c = launder(c0); s5_mats(c); norm_phase<1, 1>(c, args.out, args.out, Y, inp(c, I0_NPOF), inp(c, I1_NPM), XN, inp(c, I1_WIN), ODD_IN, 2048, (float*)(ws + WS_DT)); } SEAM(PH_NORM1);
  if constexpr (IN(PH_WIN1)) { const Ctx c = launder(c0); mg::Gemm g{XN, (const bf16*)(ws + WS_WIN1), D, D, D}; mg::DenseOrder S; S.init(M / 256, 2048 / 256, c.G, c.bid);
    mg::EpiP1 E{(bf16*)(ws + WS_P1), (bf16*)(ws + WS_S5A)}; mg::gemm_phase(ldsl, g, S, E); } SEAM(PH_WIN1);
  if constexpr (IN(PH_L1A)) { const Ctx c = launder(c0);
    { mg::Gemm g{(const bf16*)(ws + WS_S5A), (const bf16*)(ws + WS_S5BE), 384, 256, 256}; mg::S5Order S; S.G = c.G; S.c = c.bid; mg::EpiS5E E{(float*)(ws + WS_S5XE)}; mg::gemm_phase(ldsl, g, S, E); }
    ssd_conv(c); cvt_moe(c, c.bid, c.G, 0); } SEAM(PH_L1A);
  if constexpr (IN(PH_L1B)) { const Ctx c = launder(c0); s5_carry(c); ssd_pass1(c); } SEAM(PH_L1B);
  if constexpr (IN(PH_L1C)) { const Ctx c = launder(c0);
    { mg::Gemm g{(const bf16*)(ws + WS_S5A), (const bf16*)(ws + WS_S5BTF), 384, 384, 384}; mg::S5Order S; S.G = c.G; S.c = c.bid; mg::EpiS5Y E{(bf16*)(ws + WS_YC), (const bf16*)(ws + WS_S5A), inp(c, I1_SD)}; mg::gemm_phase(ldsl, g, S, E); }
    ssd_carry(c); } SEAM(PH_L1C);
  if constexpr (IN(PH_L1D)) { const Ctx c = launder(c0);
    { mg::Gemm g{(const bf16*)(ws + WS_YC), (const bf16*)(ws + WS_GLU), 512, 512, 512}; mg::DenseOrder S; S.init(M / 256, 512 / 256, c.G, c.bid);
      mg::EpiGluT E{YM, D, (const bf16*)(ws + WS_YC), inp(c, I1_GLB)}; mg::gemm_phase(ldsl, g, S, E); }
    ssd_pass2(c); cvt_moe(c, c.bid, c.G, 1); } SEAM(PH_L1D);
  if constexpr (IN(PH_WOUT1)) { const Ctx c = launder(c0); mg::Gemm g{YM, (const bf16*)(ws + WS_WOUT1), D, D, D}; mg::DenseOrder S; S.init(M / 256, D / 256, c.G, c.bid);
    mg::EpiF32 E{Y, D}; mg::gemm_phase(ldsl, g, S, E); } SEAM(PH_WOUT1);
  if constexpr (IN(PH_NORM2)) { const Ctx c = launder(c0); norm_phase<1, 2>(c, args.out, args.out, Y, inp(c, I1_NPOM), inp(c, I1_NPF), XN, inp(c, I1_RT), 8, 0, nullptr); } SEAM(PH_NORM2);
  if constexpr (IN(PH_ASSIGN)) { const Ctx c = launder(c0); moe_assign(c); } SEAM(PH_ASSIGN);
#define MOE_SCHED(S, nn, bse, bof) do { int acc_ = 0; \
    _Pragma("unroll") for (int e = 0; e < 8; ++e) { acc_ += ((int)c.ctl[CW_CNT + 64 * e] + 255) / 256 * 256; S.pend[e] = acc_; } \
    S.init(acc_ / 256, nn, c.G, c.bid); S.bstride_e = (bse); S.boff = (bof); S.rowidx = (const int*)(c.ctl + CW_SLOTTOK); } while (0)
  if constexpr (IN(PH_MGU0)) { const Ctx c = launder(c0); mg::Gemm g{XN, (const bf16*)(ws + WS_MGU), D, D, D}; mg::MoeOrder<true> S; MOE_SCHED(S, FH / 128, (size_t)2 * FE * D * 2, 0);
    mg::EpiSwigluT E{(bf16*)(ws + WS_HID), FH}; mg::gemm_phase(ldsl, g, S, E); } SEAM(PH_MGU0);
  if constexpr (IN(PH_MD0)) { const Ctx c = launder(c0); mg::Gemm g{(const bf16*)(ws + WS_HID), (const bf16*)(ws + WS_MD), FH, FE, FH}; mg::MoeOrder<false> S; MOE_SCHED(S, D / 256, (size_t)D * FE * 2, 0);
    mg::EpiBf16<false> E{(bf16*)(ws + WS_YS), D}; mg::gemm_phase(ldsl, g, S, E); } SEAM(PH_MD0);
  if constexpr (IN(PH_MGU1)) { const Ctx c = launder(c0); mg::Gemm g{XN, (const bf16*)(ws + WS_MGU), D, D, D}; mg::MoeOrder<true> S; MOE_SCHED(S, FH / 128, (size_t)2 * FE * D * 2, (size_t)(FH / 128) * 256 * D * 2);
    mg::EpiSwigluT E{(bf16*)(ws + WS_HID), FH}; mg::gemm_phase(ldsl, g, S, E); } SEAM(PH_MGU1);
  if constexpr (IN(PH_MD1)) { const Ctx c = launder(c0); mg::Gemm g{(const bf16*)(ws + WS_HID), (const bf16*)(ws + WS_MD), FH, FE, FH}; mg::MoeOrder<false> S; MOE_SCHED(S, D / 256, (size_t)D * FE * 2, (size_t)FH * 2);
    mg::EpiBf16<true> E{(bf16*)(ws + WS_YS), D}; mg::gemm_phase(ldsl, g, S, E); } SEAM(PH_MD1);
  if constexpr (IN(PH_FINAL)) { const Ctx c = launder(c0); norm_phase<2, 0>(c, args.out, args.out, nullptr, inp(c, I1_NPOF), nullptr, nullptr, nullptr, 0, 0, nullptr); }
#undef MOE_SCHED
#undef IN
#undef SEAM
}

template <int P> static void launch_one(const Args& a, hipStream_t stream) { hipLaunchKernelGGL((fwd_kernel<P, P + 1>), dim3(256), dim3(NT), LDS_BYTES, stream, a); }
template <int P> static bool set_attr_one() { return hipFuncSetAttribute((const void*)fwd_kernel<P, P + 1>, hipFuncAttributeMaxDynamicSharedMemorySize, LDS_BYTES) == hipSuccess; }
template <int... Ps> static void launch_all(const Args& a, hipStream_t stream, std::integer_sequence<int, Ps...>) { (launch_one<Ps>(a, stream), ...); }
template <int... Ps> static bool set_attr_all(std::integer_sequence<int, Ps...>) { return (set_attr_one<Ps>() && ...); }

extern "C" void kernel_launch(void* const* d_in, const int* in_sizes, int n_in, void* d_out, int out_size, void* d_ws, size_t ws_size, hipStream_t stream) {
  static int ready = 0;
  if (!ready) {
    bool ok = true;
    if (n_in != N_IN || out_size != M * D || ws_size < WS_END) { fprintf(stderr, "kernel_launch: unexpected problem: n_in %d out %d ws %zu (need %zu)\n", n_in, out_size, ws_size, (size_t)WS_END); ok = false; }
#if ONE_LAUNCH
    if (ok && hipFuncSetAttribute((const void*)fwd_kernel<0, LAST_PHASE>, hipFuncAttributeMaxDynamicSharedMemorySize, LDS_BYTES) != hipSuccess) ok = false;
#else
    if (ok && !set_attr_all(std::make_integer_sequence<int, LAST_PHASE>{})) ok = false;
#endif
    if (!ok) fprintf(stderr, "kernel_launch: setup failed\n");
    ready = ok ? 1 : -1;
  }
  if (ready < 0) return;
  (void)hipMemsetAsync((char*)d_ws + WS_CTL, 0, CTL_BYTES, stream);
  Args a{};
  for (int i = 0; i < N_IN; ++i) a.in[i] = (const float*)d_in[i];
  a.out = (float*)d_out; a.ws = (unsigned char*)d_ws;
#if ONE_LAUNCH
  hipLaunchKernelGGL((fwd_kernel<0, LAST_PHASE>), dim3(256), dim3(NT), LDS_BYTES, stream, a);
#else
  launch_all(a, stream, std::make_integer_sequence<int, LAST_PHASE>{});
#endif
}
```

```cpp
#include <hip/hip_runtime.h>
#include <stdint.h>
#include <stdio.h>
#include <utility>

#ifndef PROBE_PHASE
#define PROBE_PHASE -1
#endif
#ifndef ONE_LAUNCH
#define ONE_LAUNCH 1
#endif

constexpr int D = 1024, BATCH = 8, SEQ = 2048, M = BATCH * SEQ;
constexpr int A_W = 512, A_IN = 1792, EVEN_IN = 2816, FFN = 2816;
constexpr int ODD_IN = 2056, NE = 8, FE = 3584;
constexpr int MAXSLOT = 2 * M + NE * 256;
constexpr int NT = 512, NW = 8;

typedef unsigned short bf16;
typedef float f32x4 __attribute__((ext_vector_type(4)));
#define LAS __attribute__((address_space(3)))

enum {
  I_X = 0,
  I0_NPM, I0_WIN, I0_MU, I0_W0, I0_W2, I0_A0, I0_A2, I0_G2, I0_KK, I0_KA, I0_RK, I0_LNW, I0_LNB,
  I0_GLNW, I0_GLNB, I0_GWS, I0_GBS, I0_WOUT, I0_NPOM, I0_NPF, I0_FG, I0_FU, I0_FD, I0_NPOF,
  I1_NPM, I1_WIN, I1_ARE, I1_AIM, I1_LDT, I1_BRE, I1_BIM, I1_CRE, I1_CIM, I1_SD, I1_GLW, I1_GLB,
  I1_CW, I1_CB, I1_DTB, I1_ALOG, I1_MD, I1_MNW, I1_WOUT, I1_NPOM, I1_NPF, I1_RT, I1_MG, I1_MU, I1_MDN, I1_NPOF,
  N_IN
};
static_assert(N_IN == 51, "input count");

constexpr size_t MiB = 1ull << 20;
constexpr size_t WS_CTL = 0, CTL_BYTES = 1 * MiB;
constexpr size_t KiB = 1024;
constexpr size_t WS_WIN0 = 1 * MiB;
constexpr size_t WS_WOUT0 = WS_WIN0 + 5632 * KiB;
constexpr size_t WS_FGU = WS_WOUT0 + 2048 * KiB;
constexpr size_t WS_FD = WS_FGU + 11264 * KiB;
constexpr size_t WS_WIN1 = WS_FD + 5632 * KiB;
constexpr size_t WS_GLU = WS_WIN1 + 4096 * KiB;
constexpr size_t WS_WOUT1 = WS_GLU + 512 * KiB;
constexpr size_t WS_WLORA = WS_WOUT1 + 2048 * KiB;
constexpr size_t WS_DENSE_END = WS_WLORA + 768 * KiB;
constexpr size_t WS_MGU = 33 * MiB;
constexpr size_t WS_MD = 145 * MiB;
constexpr size_t WS_XN = 201 * MiB;
constexpr size_t WS_YMIX = 233 * MiB;
constexpr size_t WS_Y = 265 * MiB;
constexpr size_t WS_BIG = 329 * MiB;
constexpr size_t WS_P0 = WS_BIG;
constexpr size_t WS_SR = WS_MGU;
constexpr size_t WS_SW = WS_SR + 32 * MiB, WS_SK = WS_SW + 32 * MiB, WS_SV = WS_SK + 32 * MiB, WS_SA = WS_SV + 32 * MiB, WS_SB = WS_Y;
constexpr size_t WS_LOG = WS_P0 + 88 * MiB;
constexpr size_t WS_BON = WS_LOG + 32 * MiB;
constexpr size_t WS_L0END = WS_BON + 1 * MiB;
constexpr size_t WS_CHK = WS_MGU;
constexpr int CHB = 11264;
constexpr size_t WS_ALORA = WS_MGU + 160 * MiB;
constexpr size_t WS_LOWA = WS_XN;
static_assert(WS_DENSE_END <= WS_MGU && WS_ALORA + 8 * MiB <= WS_XN, "lora buffers");
static_assert(WS_SA + 32 * MiB <= WS_XN && WS_CHK + (size_t)BATCH * 8 * 128 * CHB <= WS_ALORA, "streams / chunk operators inside the MoE weight region");
constexpr size_t WS_H = WS_BIG;
constexpr size_t WS_P1 = WS_BIG;
constexpr size_t WS_DT = WS_P1 + 64 * MiB;
constexpr size_t WS_S5A = WS_YMIX;
constexpr size_t WS_S5XE = WS_XN;
constexpr size_t WS_S5BE = WS_MD;
constexpr size_t WS_S5BTF = WS_MD + 4 * MiB;
constexpr size_t WS_S5POW = WS_BIG + 129 * MiB;
constexpr size_t WS_S5BB = WS_S5POW + 320 * KiB;
constexpr size_t WS_S5KT = WS_S5BB + 320 * KiB;
constexpr size_t WS_ATOT = WS_DT + 768 * KiB;
constexpr size_t WS_CONV = WS_DT + 1 * MiB;
constexpr size_t WS_YD = WS_CONV + 32 * MiB;
constexpr size_t WS_YC = WS_Y;
constexpr size_t WS_SE = WS_Y + 16 * MiB;
constexpr size_t WS_SPV = WS_SE + 32 * MiB;
constexpr int FH = FE / 2;
constexpr size_t WS_HID = WS_BIG;
constexpr size_t WS_YS = WS_YMIX;
constexpr size_t WS_ROUTE = WS_BIG + 120 * MiB;
constexpr size_t WS_END = 462 * MiB;
static_assert(WS_S5KT + 512 * KiB <= WS_END && WS_L0END <= WS_S5POW && WS_L0END <= WS_END && WS_YD + 32 * MiB <= WS_END && WS_ROUTE + 1 * MiB <= WS_END && WS_SPV + 16 * MiB <= WS_BIG, "workspace map");
static_assert((size_t)MAXSLOT * FH * 2 <= 120 * MiB && (size_t)MAXSLOT * D * 2 <= 96 * MiB, "moe buffers");
constexpr int CW_BAR = 16384;
constexpr int CW_CNT = 8192;
constexpr int CW_CUR = 8192 + 64 * 8;
constexpr int CW_SLOTTOK = 65536;
static_assert((CW_SLOTTOK + MAXSLOT) * 4 <= (int)CTL_BYTES, "ctl");

constexpr int SPI = 136;
constexpr int LDS_BYTES = 147456;

__device__ __forceinline__ float bf2f(bf16 v) { return __uint_as_float(((unsigned)v) << 16); }
__device__ __forceinline__ bf16 f2bf(float f) { unsigned u = __float_as_uint(f); u += 0x7fffu + ((u >> 16) & 1u); return (bf16)(u >> 16); }
__device__ __forceinline__ float wave_sum(float v) {
#pragma unroll
  for (int o = 32; o > 0; o >>= 1) v += __shfl_xor(v, o);
  return v;
}
__device__ __forceinline__ float sigmoid_(float x) { return 1.f / (1.f + expf(-x)); }
__device__ __forceinline__ float silu_(float x) { return x / (1.f + expf(-x)); }
__device__ __forceinline__ float gelu_(float x) { const float u = 0.7978845608028654f * (x + 0.044715f * x * x * x); return 0.5f * x * (1.f + tanhf(u)); }
__device__ __forceinline__ float softplus_(float x) { return fmaxf(x, 0.f) + log1pf(expf(-fabsf(x))); }

#define XB_TMO      128
#define XB_XCNT(j)  (256  + 64 * (j))
#define XB_XSUB(j)  (1280 + 64 * (j))
#define XB_XGEN(j)  (2304 + 64 * (j))
#define XB_TOP      3328
#define XB_TOPGEN   3392
#define XCD_BAR_WORDS 3456
#define XB_SPIN_CAP (1u << 22)

__device__ __forceinline__ unsigned xb_ld(unsigned* p)              { return __hip_atomic_load(p, __ATOMIC_RELAXED, __HIP_MEMORY_SCOPE_AGENT); }
__device__ __forceinline__ unsigned xb_add(unsigned* p, unsigned v) { return __hip_atomic_fetch_add(p, v, __ATOMIC_RELAXED, __HIP_MEMORY_SCOPE_AGENT); }
__device__ __forceinline__ unsigned xb_xcc_id() { return (unsigned)__builtin_amdgcn_s_getreg((3 << 11) | 20) & 0xFu; }
#define XB_SPIN(cond, bar) do { unsigned _sp = 0; while (cond) { __builtin_amdgcn_s_sleep(1); \
    if ((++_sp & 255u) == 0u) { if (xb_ld(&(bar)[XB_TMO])) break; if (_sp > XB_SPIN_CAP) { atomicAdd(&(bar)[XB_TMO], 1u); break; } } } } while (0)

struct XcdBarrier { unsigned* bar; unsigned x; volatile LAS unsigned* st; };

__device__ __forceinline__ XcdBarrier xcd_barrier_post(unsigned* bar, volatile LAS unsigned* st) {
    XcdBarrier b; b.bar = bar; b.x = xb_xcc_id(); b.st = st;
    if (threadIdx.x == 0) (void)xb_add(&bar[XB_XCNT(b.x)], 1u);
    return b;
}
__device__ __forceinline__ void xcd_barrier_complete(unsigned* bar, unsigned x, unsigned& nloc, unsigned& nx) {
    const unsigned G = gridDim.x * gridDim.y * gridDim.z;
    unsigned sum, cnt, mine, sp = 0u;
    for (;;) {
        sum = 0u; cnt = 0u; mine = 0u;
#pragma unroll
        for (unsigned j = 0; j < 16; ++j) { const unsigned c = xb_ld(&bar[XB_XCNT(j)]); sum += c; cnt += (c > 0u) ? 1u : 0u; mine = (j == x) ? c : mine; }
        if (sum == G) break;
        __builtin_amdgcn_s_sleep(1);
        if ((++sp & 255u) == 0u) { if (xb_ld(&bar[XB_TMO])) break; if (sp > XB_SPIN_CAP) { atomicAdd(&bar[XB_TMO], 1u); break; } }
    }
    nloc = mine > 0u ? mine : 1u; nx = cnt > 0u ? cnt : 1u;
}
__device__ __forceinline__ void xcd_barrier(const XcdBarrier& b) {
    asm volatile("s_waitcnt vmcnt(0)" ::: "memory");
    __syncthreads();
    if (threadIdx.x == 0) {
        unsigned* bar = b.bar;
        __builtin_amdgcn_s_waitcnt(0);
        unsigned nloc = b.st[0], nx = b.st[1];
        if (nloc == 0u) { xcd_barrier_complete(bar, b.x, nloc, nx); b.st[0] = nloc; b.st[1] = nx; }
        const unsigned old = xb_add(&bar[XB_XSUB(b.x)], 1u);
        const unsigned gen = old / nloc;
        if (old + 1u == (gen + 1u) * nloc) {
            __builtin_amdgcn_fence(__ATOMIC_RELEASE, "agent");
            asm volatile("s_waitcnt vmcnt(0)" ::: "memory");
            const unsigned og = xb_add(&bar[XB_TOP], 1u);
            const unsigned tg = og / nx;
            if (og + 1u == (tg + 1u) * nx) xb_add(&bar[XB_TOPGEN], 1u);
            else XB_SPIN(xb_ld(&bar[XB_TOPGEN]) == tg, bar);
            __builtin_amdgcn_fence(__ATOMIC_ACQUIRE, "agent");
            xb_add(&bar[XB_XGEN(b.x)], 1u);
            asm volatile("s_waitcnt vmcnt(0)" ::: "memory");
        } else {
            XB_SPIN(xb_ld(&bar[XB_XGEN(b.x)]) == gen, bar);
            __builtin_amdgcn_fence(__ATOMIC_ACQUIRE, "agent");
            asm volatile("s_waitcnt vmcnt(0)" ::: "memory");
        }
    }
    __syncthreads();
}

struct Args { const float* in[N_IN]; float* out; unsigned char* ws; int lo, hi; };
struct Ctx {
  float* out; unsigned char* ws; unsigned* ctl;
  unsigned char* lds;
  int tid, lane, wave, bid, G;
};
__device__ __forceinline__ Ctx launder(Ctx c) {
  asm volatile("" : "+v"(c.tid), "+v"(c.lane));
  asm volatile("" : "+s"(c.wave), "+s"(c.bid), "+s"(c.G));
  return c;
}
constexpr int LDS_PTAB = LDS_BYTES - 1024;
constexpr int LDS_BST = LDS_BYTES - 16;
__device__ __forceinline__ const float* inp(const Ctx& c, int k) {
  const LAS unsigned* pt = (const LAS unsigned*)(LAS unsigned char*)(c.lds + LDS_PTAB);
  const unsigned lo = __builtin_amdgcn_readfirstlane(pt[2 * k]), hi = __builtin_amdgcn_readfirstlane(pt[2 * k + 1]);
  return (const float*)(((unsigned long long)hi << 32) | lo);
}


namespace mg {
typedef short bf16x8 __attribute__((ext_vector_type(8)));
typedef unsigned u32x4 __attribute__((ext_vector_type(4)));
constexpr int BM = 256, BK = 64, HALF = 128, HTB = HALF * BK * 2, STAGE_BYTES = 8 * HTB, NXCD = 8, WGM = 8;
constexpr int LDS_IDX = STAGE_BYTES;
__host__ __device__ __forceinline__ int lds_byte(int r, int c) { const int st = (r >> 4) * 2 + (c >> 5), rr = r & 15, cc = c & 31, ob = rr * 64 + cc * 2; return st * 1024 + (ob ^ (((ob >> 9) & 1) << 5)); }
__host__ __device__ __forceinline__ void stage_rc(int b, int& R, int& C) { const int st = b / 1024, sb = b % 1024, swz = sb ^ (((sb >> 9) & 1) << 5); R = (st >> 1) * 16 + swz / 64; C = (st & 1) * 32 + (swz % 64) / 2; }
__host__ __device__ __forceinline__ int perm32(int rho) { const int n = rho >> 4, i = rho & 15; return 8 * (i >> 2) + 4 * n + (i & 3); }
struct Unit { int pm, pn; };
struct Gemm { const bf16* A; const bf16* Bt; int lda, ldb, K; };

struct Tiles {
  int nM, nN, nwg, G, c;
  __device__ __forceinline__ void init(int nM_, int nN_, int G_, int c_) { nM = nM_; nN = nN_; nwg = nM * nN; G = G_; c = c_; }
  __device__ __forceinline__ bool next(int i, Unit& u) const {
    const long L = (long)i * G + c; if (L >= nwg) return false;
    int wgid = (int)L; { const int q = nwg / NXCD, r = nwg % NXCD, xcd = wgid % NXCD, off = wgid / NXCD; wgid = (xcd < r ? xcd * (q + 1) : r * (q + 1) + (xcd - r) * q) + off; }
    const int nig = WGM * nN, gid = wgid / nig, fm = gid * WGM, gsz = (nM - fm) < WGM ? (nM - fm) : WGM;
    u.pm = fm + ((wgid % nig) % gsz); u.pn = (wgid % nig) / gsz; return true;
  }
};
struct DenseOrder : Tiles {
  static constexpr bool GATHER = false;
  const int* rowidx;
  __device__ __forceinline__ const char* a_tile(const Gemm& g, const Unit& u) const { return (const char*)g.A + (size_t)u.pm * BM * g.lda * 2; }
  __device__ __forceinline__ const char* b_tile(const Gemm& g, const Unit& u) const { return (const char*)g.Bt + (size_t)u.pn * BM * g.ldb * 2; }
};
struct S5Order {
  static constexpr bool GATHER = false;
  int G, c; const int* rowidx;
  __device__ __forceinline__ bool next(int i, Unit& u) const { const int L = i * G + c; if (L >= 128) return false; u.pm = L; u.pn = 0; return true; }
  __device__ __forceinline__ const char* a_tile(const Gemm& g, const Unit& u) const { return (const char*)g.A + (size_t)u.pm * BM * g.lda * 2; }
  __device__ __forceinline__ const char* b_tile(const Gemm& g, const Unit& u) const { return (const char*)g.Bt + (size_t)(u.pm >> 2) * BM * g.ldb * 2; }
};
template <bool GATHER_> struct MoeOrder : Tiles {
  static constexpr bool GATHER = GATHER_;
  int pend[8]; size_t bstride_e, boff; const int* rowidx;
  __device__ __forceinline__ int expert(int pm) const { int e = 0;
#pragma unroll
    for (int q = 0; q < 7; ++q) e += (pm * BM >= pend[q]) ? 1 : 0;
    return e; }
  __device__ __forceinline__ const char* a_tile(const Gemm& g, const Unit& u) const { return (const char*)g.A + (size_t)u.pm * BM * g.lda * 2; }
  __device__ __forceinline__ const char* b_tile(const Gemm& g, const Unit& u) const { return (const char*)g.Bt + (size_t)expert(u.pm) * bstride_e + boff + (size_t)u.pn * BM * g.ldb * 2; }
};

typedef float f32x2_ __attribute__((ext_vector_type(2)));
typedef __bf16 bfx2_ __attribute__((ext_vector_type(2)));
__device__ __forceinline__ unsigned cvt_pk_bf16(float lo, float hi) { const f32x2_ v = {lo, hi}; const bfx2_ r = __builtin_convertvector(v, bfx2_); return __builtin_bit_cast(unsigned, r); }

struct EpiF32 { static constexpr bool PERM = false; float* C; int ldc;
  __device__ __forceinline__ void operator()(const f32x4 (&acc)[2][2][4][2], const Unit& u, int wr, int wc, int fr, int fq) const {
    const int row0 = u.pm * BM + wr * 64 + fr, col0 = u.pn * BM + wc * 32 + 4 * fq;
#pragma unroll
    for (int ai = 0; ai < 2; ++ai)
#pragma unroll
      for (int m = 0; m < 4; ++m) { float* rowp = C + (size_t)(row0 + ai * HALF + m * 16) * ldc + col0;
#pragma unroll
        for (int bj = 0; bj < 2; ++bj)
#pragma unroll
          for (int n = 0; n < 2; ++n) *(f32x4*)(rowp + bj * HALF + n * 16) = acc[ai][bj][m][n]; }
  } };
template <bool ACCUM> struct EpiBf16 { static constexpr bool PERM = true; bf16* O; int ldc;
  __device__ __forceinline__ void operator()(const f32x4 (&acc)[2][2][4][2], const Unit& u, int wr, int wc, int fr, int fq) const {
    const int row0 = u.pm * BM + wr * 64 + fr, col0 = u.pn * BM + wc * 32 + 8 * fq;
#pragma unroll
    for (int ai = 0; ai < 2; ++ai)
#pragma unroll
      for (int m = 0; m < 4; ++m) { bf16* rowp = O + (size_t)(row0 + ai * HALF + m * 16) * ldc + col0;
#pragma unroll
        for (int bj = 0; bj < 2; ++bj) { f32x4 v0 = acc[ai][bj][m][0], v1 = acc[ai][bj][m][1];
          if (ACCUM) { const u32x4 o = *(const u32x4*)(rowp + bj * HALF);
            v0[0] += __uint_as_float(o.x << 16); v0[1] += __uint_as_float(o.x & 0xffff0000u); v0[2] += __uint_as_float(o.y << 16); v0[3] += __uint_as_float(o.y & 0xffff0000u);
            v1[0] += __uint_as_float(o.z << 16); v1[1] += __uint_as_float(o.z & 0xffff0000u); v1[2] += __uint_as_float(o.w << 16); v1[3] += __uint_as_float(o.w & 0xffff0000u); }
          u32x4 w; w.x = cvt_pk_bf16(v0[0], v0[1]); w.y = cvt_pk_bf16(v0[2], v0[3]); w.z = cvt_pk_bf16(v1[0], v1[1]); w.w = cvt_pk_bf16(v1[2], v1[3]);
          *(u32x4*)(rowp + bj * HALF) = w; } }
  } };
struct EpiP1 { static constexpr bool PERM = true; bf16* P1; bf16* AP;
  __device__ __forceinline__ void operator()(const f32x4 (&acc)[2][2][4][2], const Unit& u, int wr, int wc, int fr, int fq) const {
    const int row0 = u.pm * BM + wr * 64 + fr, col0 = u.pn * BM + wc * 32 + 8 * fq;
#pragma unroll
    for (int ai = 0; ai < 2; ++ai)
#pragma unroll
      for (int m = 0; m < 4; ++m) { const int row = row0 + ai * HALF + m * 16;
#pragma unroll
        for (int bj = 0; bj < 2; ++bj) { const int col = col0 + bj * HALF; const f32x4 v0 = acc[ai][bj][m][0], v1 = acc[ai][bj][m][1];
          u32x4 w; w.x = cvt_pk_bf16(v0[0], v0[1]); w.y = cvt_pk_bf16(v0[2], v0[3]); w.z = cvt_pk_bf16(v1[0], v1[1]); w.w = cvt_pk_bf16(v1[2], v1[3]);
          bf16* dst;
          if (u.pn < 2) { const int g = col >> 4, c0 = col & 15, b = row >> 11, ta = row & 2047; dst = AP + ((size_t)(g * 1024 + b * 128 + (ta >> 4)) * 384 + (ta & 15) * 16 + c0); }
          else dst = P1 + (size_t)row * 2048 + col;
          *(u32x4*)dst = w; } }
  } };
struct EpiS5E { static constexpr bool PERM = false; float* XE;
  __device__ __forceinline__ void operator()(const f32x4 (&acc)[2][2][4][2], const Unit& u, int wr, int wc, int fr, int fq) const {
    const int row0 = u.pm * BM + wr * 64 + fr, col0 = wc * 32 + 4 * fq;
#pragma unroll
    for (int ai = 0; ai < 2; ++ai)
#pragma unroll
      for (int m = 0; m < 4; ++m) { float* rowp = XE + (size_t)(row0 + ai * HALF + m * 16) * 128 + col0;
#pragma unroll
        for (int n = 0; n < 2; ++n) *(f32x4*)(rowp + n * 16) = acc[ai][0][m][n]; }
  } };
struct EpiS5Y { static constexpr bool PERM = true; bf16* YC; const bf16* AP; const float* dsk;
  __device__ __forceinline__ void operator()(const f32x4 (&acc)[2][2][4][2], const Unit& u, int wr, int wc, int fr, int fq) const {
    const int row0 = u.pm * BM + wr * 64 + fr, g = u.pm >> 2;
#pragma unroll
    for (int ai = 0; ai < 2; ++ai)
#pragma unroll
      for (int m = 0; m < 4; ++m) { const int row = row0 + ai * HALF + m * 16, rg = row & 1023, b = rg >> 7, blk = rg & 127;
#pragma unroll
        for (int bj = 0; bj < 2; ++bj) { const int col0 = bj * HALF + wc * 32 + 8 * fq, t = col0 >> 4, ch = g * 16 + (col0 & 15);
          const u32x4 uv = *(const u32x4*)(AP + (size_t)row * 384 + col0);
          const f32x4 d0 = *(const f32x4*)(dsk + ch), d1 = *(const f32x4*)(dsk + ch + 4);
          const float uu[8] = {__uint_as_float(uv.x << 16), __uint_as_float(uv.x & 0xffff0000u), __uint_as_float(uv.y << 16), __uint_as_float(uv.y & 0xffff0000u),
                               __uint_as_float(uv.z << 16), __uint_as_float(uv.z & 0xffff0000u), __uint_as_float(uv.w << 16), __uint_as_float(uv.w & 0xffff0000u)};
          float h[8];
#pragma unroll
          for (int e = 0; e < 4; ++e) { h[e] = gelu_(acc[ai][bj][m][0][e] + d0[e] * uu[e]); h[4 + e] = gelu_(acc[ai][bj][m][1][e] + d1[e] * uu[4 + e]); }
          u32x4 w; w.x = cvt_pk_bf16(h[0], h[1]); w.y = cvt_pk_bf16(h[2], h[3]); w.z = cvt_pk_bf16(h[4], h[5]); w.w = cvt_pk_bf16(h[6], h[7]);
          *(u32x4*)(YC + (size_t)(b * 2048 + blk * 16 + t) * 512 + ch) = w; } }
  } };
struct EpiLora { static constexpr bool PERM = true; bf16* O0; bf16* O1;
  __device__ __forceinline__ void operator()(const f32x4 (&acc)[2][2][4][2], const Unit& u, int wr, int wc, int fr, int fq) const {
    bf16* base = (u.pn < 4) ? O0 : O1; constexpr int ldc = 1024;
    const int row0 = u.pm * BM + wr * 64 + fr, col0 = (u.pn & 3) * BM + wc * 32 + 8 * fq;
#pragma unroll
    for (int ai = 0; ai < 2; ++ai)
#pragma unroll
      for (int m = 0; m < 4; ++m) { bf16* rowp = base + (size_t)(row0 + ai * HALF + m * 16) * ldc + col0;
#pragma unroll
        for (int bj = 0; bj < 2; ++bj) { const f32x4 v0 = acc[ai][bj][m][0], v1 = acc[ai][bj][m][1];
          u32x4 w; w.x = cvt_pk_bf16(v0[0], v0[1]); w.y = cvt_pk_bf16(v0[2], v0[3]); w.z = cvt_pk_bf16(v1[0], v1[1]); w.w = cvt_pk_bf16(v1[2], v1[3]);
          *(u32x4*)(rowp + bj * HALF) = w; } }
  } };
struct EpiSwigluT { static constexpr bool PERM = true; bf16* O; int ldc;
  __device__ __forceinline__ void operator()(const f32x4 (&acc)[2][2][4][2], const Unit& u, int wr, int wc, int fr, int fq) const {
    const int row0 = u.pm * BM + wr * 64 + fr, col0 = u.pn * HALF + wc * 32 + 8 * fq;
#pragma unroll
    for (int ai = 0; ai < 2; ++ai)
#pragma unroll
      for (int m = 0; m < 4; ++m) { bf16* rowp = O + (size_t)(row0 + ai * HALF + m * 16) * ldc + col0;
        float h[8];
#pragma unroll
        for (int n = 0; n < 2; ++n)
#pragma unroll
          for (int e = 0; e < 4; ++e) { const float gte = acc[ai][0][m][n][e], up = acc[ai][1][m][n][e]; h[n * 4 + e] = gte * __builtin_amdgcn_rcpf(1.f + __expf(-gte)) * up; }
        u32x4 w; w.x = cvt_pk_bf16(h[0], h[1]); w.y = cvt_pk_bf16(h[2], h[3]); w.z = cvt_pk_bf16(h[4], h[5]); w.w = cvt_pk_bf16(h[6], h[7]);
        *(u32x4*)rowp = w; }
  } };
struct EpiGluT { static constexpr bool PERM = true; bf16* O; int ldc; const bf16* Yc; const float* bias;
  __device__ __forceinline__ void operator()(const f32x4 (&acc)[2][2][4][2], const Unit& u, int wr, int wc, int fr, int fq) const {
    const int row0 = u.pm * BM + wr * 64 + fr, col0 = u.pn * BM + wc * 32 + 8 * fq;
#pragma unroll
    for (int ai = 0; ai < 2; ++ai)
#pragma unroll
      for (int m = 0; m < 4; ++m) { const int row = row0 + ai * HALF + m * 16;
#pragma unroll
        for (int bj = 0; bj < 2; ++bj) { const int col = col0 + bj * HALF;
          const u32x4 yv = *(const u32x4*)(Yc + (size_t)row * 512 + col);
          const f32x4 b0 = *(const f32x4*)(bias + col), b1 = *(const f32x4*)(bias + col + 4);
          const float y[8] = {__uint_as_float(yv.x << 16), __uint_as_float(yv.x & 0xffff0000u), __uint_as_float(yv.y << 16), __uint_as_float(yv.y & 0xffff0000u),
                              __uint_as_float(yv.z << 16), __uint_as_float(yv.z & 0xffff0000u), __uint_as_float(yv.w << 16), __uint_as_float(yv.w & 0xffff0000u)};
          float h[8];
#pragma unroll
          for (int e = 0; e < 4; ++e) { h[e] = y[e] * __builtin_amdgcn_rcpf(1.f + __expf(-(acc[ai][bj][m][0][e] + b0[e]))); h[4 + e] = y[4 + e] * __builtin_amdgcn_rcpf(1.f + __expf(-(acc[ai][bj][m][1][e] + b1[e]))); }
          u32x4 w; w.x = cvt_pk_bf16(h[0], h[1]); w.y = cvt_pk_bf16(h[2], h[3]); w.z = cvt_pk_bf16(h[4], h[5]); w.w = cvt_pk_bf16(h[6], h[7]);
          *(u32x4*)(O + (size_t)row * ldc + col) = w; } }
  } };

template <class Epi, class Sched>
__device__ __forceinline__ void gemm_phase(LAS unsigned char* lds, const Gemm g, const Sched& S, const Epi& E) {
  const int tid = threadIdx.x, wid = __builtin_amdgcn_readfirstlane(tid >> 6), lane = tid & 63, wr = wid >> 2, wc = wid & 3, fr = lane & 15, fq = lane >> 4;
  const int K = g.K, nt = K / BK;
  unsigned voffA[2], voffB[2]; int gR[2], gC[2];
#pragma unroll
  for (int i = 0; i < 2; ++i) { int R, C; stage_rc(tid * 16 + i * 8192, R, C); const int Rb = Epi::PERM ? ((R & ~31) + perm32(R & 31)) : R;
    voffA[i] = (unsigned)(R * g.lda + C) * 2u; voffB[i] = (unsigned)(Rb * g.ldb + C) * 2u; gR[i] = R; gC[i] = C * 2; }
  const size_t kstep = (size_t)(BK * 2);
  const size_t hstepA = (size_t)HALF * g.lda * 2, hstepB = (size_t)HALF * g.ldb * 2;
  const unsigned ldsw = (unsigned)wid * 1024u;
  const unsigned rowb = (unsigned)g.lda * 2u;
  const int aoff = lds_byte(wr * 64 + fr, fq * 8), boff = lds_byte(wc * 32 + fr, fq * 8);
#define PG8_SA(b, h) (((b) * 2 + (h)) * HTB)
#define PG8_SB(b, h) ((4 + (b) * 2 + (h)) * HTB)
#define PG8_STAGE(bufoff, gbase, voff) do { _Pragma("unroll") for (int _i = 0; _i < 2; ++_i) \
    __builtin_amdgcn_global_load_lds((const unsigned*)((const char*)(gbase) + (voff)[_i]), (LAS unsigned*)(lds + (bufoff) + ldsw + _i * 8192), 16, 0, 0); } while (0)
#define PG8_STAGE_A(bufoff, p, h, goff) do { if constexpr (Sched::GATHER) PG8_STAGE(bufoff, p, (goff)[h]); else PG8_STAGE(bufoff, (p) + (h) * hstepA, voffA); } while (0)
#define PG8_LDA(dst, b, h) do { _Pragma("unroll") for (int m = 0; m < 4; ++m) _Pragma("unroll") for (int k = 0; k < 2; ++k) dst[m][k] = *(const LAS bf16x8*)(lds + PG8_SA(b, h) + aoff + m * 2048 + k * 1024); } while (0)
#define PG8_LDB(dst, b, h) do { _Pragma("unroll") for (int n = 0; n < 2; ++n) _Pragma("unroll") for (int k = 0; k < 2; ++k) dst[n][k] = *(const LAS bf16x8*)(lds + PG8_SB(b, h) + boff + n * 2048 + k * 1024); } while (0)
#define PG8_MMA(ai, bj, At, Bt) do { __builtin_amdgcn_s_setprio(1); _Pragma("unroll") for (int m = 0; m < 4; ++m) _Pragma("unroll") for (int n = 0; n < 2; ++n) _Pragma("unroll") for (int k = 0; k < 2; ++k) \
    acc[ai][bj][m][n] = __builtin_amdgcn_mfma_f32_16x16x32_bf16(Bt[n][k], At[m][k], acc[ai][bj][m][n], 0, 0, 0); __builtin_amdgcn_s_setprio(0); } while (0)
#define PG8_WAIT_V(n) asm volatile("s_waitcnt vmcnt(" #n ")" ::: "memory")
#define PG8_WAIT_L(n) asm volatile("s_waitcnt lgkmcnt(" #n ")" ::: "memory")
#define PG8_BAR __builtin_amdgcn_s_barrier()
#define PG8_SCHED __builtin_amdgcn_sched_barrier(0)
  Unit cur, nxt; int ui = 0;
  if (!S.next(0, cur)) return;
  f32x4 acc[2][2][4][2];
#pragma unroll
  for (int a = 0; a < 2; ++a)
#pragma unroll
    for (int b = 0; b < 2; ++b)
#pragma unroll
      for (int m = 0; m < 4; ++m)
#pragma unroll
        for (int n = 0; n < 2; ++n) acc[a][b][m][n] = (f32x4){0.f, 0.f, 0.f, 0.f};
  bf16x8 At[4][2], B0[2][2], B1[2][2];
  unsigned gcu[2][2] = {{0u, 0u}, {0u, 0u}};
  const char* cA = Sched::GATHER ? (const char*)g.A : S.a_tile(g, cur); const char* cB = S.b_tile(g, cur);
  if constexpr (Sched::GATHER) {
#pragma unroll
    for (int h = 0; h < 2; ++h)
#pragma unroll
      for (int i = 0; i < 2; ++i) gcu[h][i] = (unsigned)S.rowidx[cur.pm * BM + h * HALF + gR[i]] * rowb + (unsigned)gC[i];
  }
  PG8_STAGE(PG8_SB(0, 0), cB, voffB); PG8_STAGE(PG8_SB(0, 1), cB + hstepB, voffB); PG8_STAGE_A(PG8_SA(0, 0), cA, 0, gcu); PG8_STAGE_A(PG8_SA(0, 1), cA, 1, gcu);
  if (wr == 1) PG8_BAR;
  PG8_WAIT_V(2); PG8_BAR;
  PG8_STAGE(PG8_SB(1, 0), cB + kstep, voffB); PG8_STAGE_A(PG8_SA(1, 0), cA + kstep, 0, gcu); PG8_STAGE(PG8_SB(1, 1), cB + hstepB + kstep, voffB);
  PG8_WAIT_V(6); PG8_BAR;
  for (;;) {
    const bool has_next = S.next(ui + 1, nxt);
    const char* nA = Sched::GATHER ? (const char*)g.A : (has_next ? S.a_tile(g, nxt) : cA); const char* nB = has_next ? S.b_tile(g, nxt) : cB;
    if constexpr (Sched::GATHER) {
      if (has_next && wid < 4) __builtin_amdgcn_global_load_lds((const unsigned*)(S.rowidx + nxt.pm * BM + wid * 64 + lane), (LAS unsigned*)(lds + LDS_IDX + ((ui + 1) & 1) * 1024 + wid * 256), 4, 0, 0);
    }
#pragma nounroll
    for (int t = 0; t < nt; t += 2) {
      const bool last = (t == nt - 2);
      const char* a1 = cA + (size_t)(t + 1) * kstep;
      const char* a2 = last ? nA : cA + (size_t)(t + 2) * kstep; const char* b2 = last ? nB : cB + (size_t)(t + 2) * kstep;
      const char* a3 = a2 + kstep; const char* b3 = b2 + kstep;
      unsigned g2[2][2];
#pragma unroll
      for (int h = 0; h < 2; ++h)
#pragma unroll
        for (int i = 0; i < 2; ++i) g2[h][i] = gcu[h][i];
      if constexpr (Sched::GATHER) {
        if (last && has_next) {
          const LAS unsigned* ix = (const LAS unsigned*)(lds + LDS_IDX + ((ui + 1) & 1) * 1024);
#pragma unroll
          for (int h = 0; h < 2; ++h)
#pragma unroll
            for (int i = 0; i < 2; ++i) g2[h][i] = ix[h * HALF + gR[i]] * rowb + (unsigned)gC[i];
        }
      }
      PG8_LDB(B0, 0, 0); PG8_LDB(B1, 0, 1); PG8_SCHED; PG8_LDA(At, 0, 0); PG8_STAGE_A(PG8_SA(1, 1), a1, 1, gcu);
      PG8_WAIT_V(8); PG8_WAIT_L(0); PG8_BAR; PG8_MMA(0, 0, At, B0); PG8_MMA(0, 1, At, B1); PG8_BAR; PG8_SCHED;
      PG8_LDA(At, 0, 1); PG8_STAGE(PG8_SB(0, 0), b2, voffB); PG8_STAGE(PG8_SB(0, 1), b2 + hstepB, voffB); PG8_STAGE_A(PG8_SA(0, 0), a2, 0, g2);
      PG8_WAIT_V(8); PG8_WAIT_L(0); PG8_BAR; PG8_MMA(1, 0, At, B0); PG8_MMA(1, 1, At, B1); PG8_BAR; PG8_SCHED;
      PG8_LDB(B0, 1, 0); PG8_LDB(B1, 1, 1); PG8_SCHED; PG8_LDA(At, 1, 0); PG8_STAGE_A(PG8_SA(0, 1), a2, 1, g2);
      PG8_WAIT_V(8); PG8_WAIT_L(0); PG8_BAR; PG8_MMA(0, 0, At, B0); PG8_MMA(0, 1, At, B1); PG8_BAR; PG8_SCHED;
      PG8_LDA(At, 1, 1); PG8_STAGE(PG8_SB(1, 0), b3, voffB); PG8_STAGE(PG8_SB(1, 1), b3 + hstepB, voffB); PG8_STAGE_A(PG8_SA(1, 0), a3, 0, g2);
      PG8_WAIT_V(8); PG8_WAIT_L(0); PG8_BAR; PG8_MMA(1, 0, At, B0); PG8_MMA(1, 1, At, B1); PG8_BAR; PG8_SCHED;
      if constexpr (Sched::GATHER) { if (last) {
#pragma unroll
        for (int h = 0; h < 2; ++h)
#pragma unroll
          for (int i = 0; i < 2; ++i) gcu[h][i] = g2[h][i]; } }
    }
    if (wr == 0) PG8_BAR;
    E(acc, cur, wr, wc, fr, fq);
    if (!has_next) break;
#pragma unroll
    for (int a = 0; a < 2; ++a)
#pragma unroll
      for (int b = 0; b < 2; ++b)
#pragma unroll
        for (int m = 0; m < 4; ++m)
#pragma unroll
          for (int n = 0; n < 2; ++n) acc[a][b][m][n] = (f32x4){0.f, 0.f, 0.f, 0.f};
    cur = nxt; cA = nA; cB = nB; ++ui;
    if (wr == 1) PG8_BAR;
  }
  PG8_WAIT_V(0);
  PG8_BAR;
#undef PG8_SA
#undef PG8_SB
#undef PG8_STAGE
#undef PG8_STAGE_A
#undef PG8_LDA
#undef PG8_LDB
#undef PG8_MMA
#undef PG8_WAIT_V
#undef PG8_WAIT_L
#undef PG8_BAR
#undef PG8_SCHED
}
}

__device__ __forceinline__ void cvt_item(const float* W, int ldw, bf16* WT, int Kd, int dst_row0, int k0, int n0, int lane) {
  const int kg = lane >> 4, nq = lane & 15;
  const float* src = W + (size_t)(k0 + 16 * kg) * ldw + n0 + 4 * nq;
  f32x4 r[16];
#pragma unroll
  for (int i = 0; i < 16; ++i) r[i] = *(const f32x4*)(src + (size_t)i * ldw);
  bf16* dst = WT + (size_t)(dst_row0 + 4 * nq) * Kd + k0 + 16 * kg;
#pragma unroll
  for (int e = 0; e < 4; ++e) {
    mg::u32x4 o0, o1;
    o0.x = mg::cvt_pk_bf16(r[0][e], r[1][e]); o0.y = mg::cvt_pk_bf16(r[2][e], r[3][e]); o0.z = mg::cvt_pk_bf16(r[4][e], r[5][e]); o0.w = mg::cvt_pk_bf16(r[6][e], r[7][e]);
    o1.x = mg::cvt_pk_bf16(r[8][e], r[9][e]); o1.y = mg::cvt_pk_bf16(r[10][e], r[11][e]); o1.z = mg::cvt_pk_bf16(r[12][e], r[13][e]); o1.w = mg::cvt_pk_bf16(r[14][e], r[15][e]);
    *(mg::u32x4*)(dst + (size_t)e * Kd) = o0; *(mg::u32x4*)(dst + (size_t)e * Kd + 8) = o1;
  }
}
__device__ __forceinline__ void cvt_mat_item(const float* W, int K, int N, int ldw, bf16* WT, int mode, int it, int lane) {
  const int nblk = N / 64, kb = it / nblk, nb = it % nblk, n0 = nb * 64;
  const int dst = mode == 0 ? n0 : ((n0 >> 7) * 256 + (n0 & 127) + (mode == 2 ? 128 : 0));
  cvt_item(W, ldw, WT, K, dst, kb * 64, n0, lane);
}
__device__ __forceinline__ void cvt_dense(const Ctx& c) {
  const float* win0 = inp(c, I0_WIN); const float* wout0 = inp(c, I0_WOUT); const float* fg = inp(c, I0_FG); const float* fu = inp(c, I0_FU); const float* fd = inp(c, I0_FD);
  const float* win1 = inp(c, I1_WIN); const float* glw = inp(c, I1_GLW); const float* wout1 = inp(c, I1_WOUT);
  unsigned char* ws = c.ws;
  for (int it = c.wave * c.G + c.bid; it < 3904; it += NW * c.G) {
    int r = it;
    if (r < 704) { cvt_mat_item(win0, D, EVEN_IN, EVEN_IN, (bf16*)(ws + WS_WIN0), 0, r, c.lane); continue; } r -= 704;
    if (r < 256) { cvt_mat_item(wout0, D, D, D, (bf16*)(ws + WS_WOUT0), 0, r, c.lane); continue; } r -= 256;
    if (r < 704) { cvt_mat_item(fg, D, FFN, FFN, (bf16*)(ws + WS_FGU), 1, r, c.lane); continue; } r -= 704;
    if (r < 704) { cvt_mat_item(fu, D, FFN, FFN, (bf16*)(ws + WS_FGU), 2, r, c.lane); continue; } r -= 704;
    if (r < 704) { cvt_mat_item(fd, FFN, D, D, (bf16*)(ws + WS_FD), 0, r, c.lane); continue; } r -= 704;
    if (r < 512) { cvt_mat_item(win1, D, 2048, ODD_IN, (bf16*)(ws + WS_WIN1), 0, r, c.lane); continue; } r -= 512;
    if (r < 64) { cvt_mat_item(glw, 512, 512, 512, (bf16*)(ws + WS_GLU), 0, r, c.lane); continue; } r -= 64;
    cvt_mat_item(wout1, D, D, D, (bf16*)(ws + WS_WOUT1), 0, r, c.lane);
  }
}
__device__ __forceinline__ void cvt_moe(const Ctx& c, int vb, int vG, int part) {
  const float* mgp = inp(c, I1_MG); const float* mup = inp(c, I1_MU); const float* mdp = inp(c, I1_MDN);
  if (part == 0) {
    for (int it = c.wave * vG + vb; it < 8 * 1792; it += NW * vG) {
      const int e = it / 1792, r = it % 1792, which = r / 896, idx = r % 896;
      cvt_mat_item((which ? mup : mgp) + (size_t)e * D * FE, D, FE, FE, (bf16*)(c.ws + WS_MGU) + (size_t)e * 2 * FE * D, 1 + which, idx, c.lane);
    }
  } else {
    for (int it = c.wave * vG + vb; it < 8 * 896; it += NW * vG) {
      const int e = it / 896, idx = it % 896;
      cvt_mat_item(mdp + (size_t)e * FE * D, FE, D, D, (bf16*)(c.ws + WS_MD) + (size_t)e * D * FE, 0, idx, c.lane);
    }
  }
}


template <int YMODE, int PROJ>
__device__ __forceinline__ void norm_phase(const Ctx& c, const float* resin, float* resout, const float* Y, const float* gpost, const float* gpre, bf16* XN,
                                           const float* W8, int ldw8, int c0, float* out8) {
  float* w8s = (float*)c.lds;
  LAS unsigned* hist = (LAS unsigned*)(c.lds + 32768);
  if (PROJ) {
    for (int i = c.tid; i < 1024 * 8; i += NT) w8s[i] = W8[(size_t)(i >> 3) * ldw8 + c0 + (i & 7)];
    if (PROJ == 2 && c.tid < 8) hist[c.tid] = 0u;
    __syncthreads();
  }
  int* tok_e = (int*)(c.ws + WS_ROUTE); float* tok_g = (float*)(c.ws + WS_ROUTE + 128 * 1024);
  const int* tok_slot = (const int*)(c.ws + WS_ROUTE + 256 * 1024);
  const bf16* YS = (const bf16*)(c.ws + WS_YS);
  for (int m = c.wave * c.G + c.bid; m < M; m += NW * c.G) {
    f32x4 r[4];
#pragma unroll
    for (int j = 0; j < 4; ++j) r[j] = *(const f32x4*)(resin + (size_t)m * D + j * 256 + c.lane * 4);
    if (YMODE) {
      f32x4 y[4]; float ss = 0.f;
      if (YMODE == 1) {
#pragma unroll
        for (int j = 0; j < 4; ++j) y[j] = *(const f32x4*)(Y + (size_t)m * D + j * 256 + c.lane * 4);
      } else {
        const int s0 = tok_slot[2 * m], s1 = tok_slot[2 * m + 1]; const float g0 = tok_g[2 * m], g1 = tok_g[2 * m + 1];
#pragma unroll
        for (int j = 0; j < 4; ++j) {
          const uint2 a = *(const uint2*)(YS + (size_t)s0 * D + j * 256 + c.lane * 4), b = *(const uint2*)(YS + (size_t)s1 * D + j * 256 + c.lane * 4);
          y[j][0] = g0 * bf2f((bf16)(a.x & 0xffff)) + g1 * bf2f((bf16)(b.x & 0xffff));
          y[j][1] = g0 * bf2f((bf16)(a.x >> 16)) + g1 * bf2f((bf16)(b.x >> 16));
          y[j][2] = g0 * bf2f((bf16)(a.y & 0xffff)) + g1 * bf2f((bf16)(b.y & 0xffff));
          y[j][3] = g0 * bf2f((bf16)(a.y >> 16)) + g1 * bf2f((bf16)(b.y >> 16));
        }
      }
#pragma unroll
      for (int j = 0; j < 4; ++j) ss += y[j][0] * y[j][0] + y[j][1] * y[j][1] + y[j][2] * y[j][2] + y[j][3] * y[j][3];
      const float rs = rsqrtf(wave_sum(ss) * (1.f / D) + 1e-6f);
#pragma unroll
      for (int j = 0; j < 4; ++j) {
        const f32x4 g = *(const f32x4*)(gpost + j * 256 + c.lane * 4);
        r[j] = r[j] + y[j] * rs * g;
        *(f32x4*)(resout + (size_t)m * D + j * 256 + c.lane * 4) = r[j];
      }
    }
    if (gpre) {
      float ss = 0.f;
#pragma unroll
      for (int j = 0; j < 4; ++j) ss += r[j][0] * r[j][0] + r[j][1] * r[j][1] + r[j][2] * r[j][2] + r[j][3] * r[j][3];
      const float rs = rsqrtf(wave_sum(ss) * (1.f / D) + 1e-6f);
      float p8[8];
#pragma unroll
      for (int q = 0; q < 8; ++q) p8[q] = 0.f;
#pragma unroll
      for (int j = 0; j < 4; ++j) {
        const f32x4 g = *(const f32x4*)(gpre + j * 256 + c.lane * 4);
        const f32x4 xn = r[j] * rs * g;
        uint2 o; o.x = (unsigned)f2bf(xn[0]) | ((unsigned)f2bf(xn[1]) << 16); o.y = (unsigned)f2bf(xn[2]) | ((unsigned)f2bf(xn[3]) << 16);
        *(uint2*)(XN + (size_t)m * D + j * 256 + c.lane * 4) = o;
        if (PROJ) {
#pragma unroll
          for (int e = 0; e < 4; ++e) {
            const float* wr = w8s + (j * 256 + c.lane * 4 + e) * 8;
#pragma unroll
            for (int q = 0; q < 8; ++q) p8[q] += xn[e] * wr[q];
          }
        }
      }
      if (PROJ) {
#pragma unroll
        for (int q = 0; q < 8; ++q) p8[q] = wave_sum(p8[q]);
        if (PROJ == 1) { if (c.lane < 8) { float v = p8[0];
#pragma unroll
            for (int q = 1; q < 8; ++q) v = (c.lane == q) ? p8[q] : v;
            out8[(size_t)m * 8 + c.lane] = v; } }
        if (PROJ == 2 && c.lane == 0) {
          int e0 = 0; float v0 = p8[0];
#pragma unroll
          for (int q = 1; q < 8; ++q) if (p8[q] > v0) { v0 = p8[q]; e0 = q; }
          int e1 = -1; float v1 = -3.0e38f;
#pragma unroll
          for (int q = 0; q < 8; ++q) if (q != e0 && p8[q] > v1) { v1 = p8[q]; e1 = q; }
          const float g1 = 1.f / (1.f + expf(v0 - v1)), g0 = 1.f - g1;
          tok_e[2 * m] = e0; tok_e[2 * m + 1] = e1; tok_g[2 * m] = g0; tok_g[2 * m + 1] = g1;
          atomicAdd((unsigned*)&hist[e0], 1u); atomicAdd((unsigned*)&hist[e1], 1u);
        }
      }
    }
  }
  if (PROJ == 2) { __syncthreads(); if (c.tid < 8) atomicAdd(c.ctl + CW_CNT + 64 * c.tid, hist[c.tid]); }
  __syncthreads();
}

__device__ __forceinline__ void rwkv_prep_a(const Ctx& c) {
  const float* mu = inp(c, I0_MU);
  const bf16* P = (const bf16*)(c.ws + WS_P0); bf16* AL = (bf16*)(c.ws + WS_ALORA);
  const f32x4 mu4 = *(const f32x4*)(mu + 1536 + c.lane * 4);
  for (int m = c.wave * c.G + c.bid; m < M; m += NW * c.G) {
    const int t = m % SEQ;
    const uint2 cu = *(const uint2*)(P + (size_t)m * EVEN_IN + 1536 + c.lane * 4);
    uint2 pv = {0u, 0u}; if (t > 0) pv = *(const uint2*)(P + (size_t)(m - 1) * EVEN_IN + 1536 + c.lane * 4);
    const float cv[4] = {__uint_as_float(cu.x << 16), __uint_as_float(cu.x & 0xffff0000u), __uint_as_float(cu.y << 16), __uint_as_float(cu.y & 0xffff0000u)};
    const float pp[4] = {__uint_as_float(pv.x << 16), __uint_as_float(pv.x & 0xffff0000u), __uint_as_float(pv.y << 16), __uint_as_float(pv.y & 0xffff0000u)};
    float o[4];
#pragma unroll
    for (int e = 0; e < 4; ++e) { float v = cv[e] + (pp[e] - cv[e]) * mu4[e]; if (c.lane < 16) v = tanhf(v); else if (c.lane >= 32) v = sigmoid_(v); o[e] = v; }
    uint2 w; w.x = (unsigned)f2bf(o[0]) | ((unsigned)f2bf(o[1]) << 16); w.y = (unsigned)f2bf(o[2]) | ((unsigned)f2bf(o[3]) << 16);
    *(uint2*)(AL + (size_t)m * 256 + c.lane * 4) = w;
  }
}
__device__ __forceinline__ void build_wlora(const Ctx& c) {
  const float* w2 = inp(c, I0_W2); const float* a2 = inp(c, I0_A2); const float* g2 = inp(c, I0_G2);
  bf16* WL = (bf16*)(c.ws + WS_WLORA);
  for (int i = c.bid * NT + c.tid; i < 1536 * 256; i += c.G * NT) {
    const int n = i >> 8, k = i & 255; float v = 0.f;
    if (n < 512) { if (k < 64) v = w2[k * 512 + n]; }
    else if (n < 1024) { if (k >= 64 && k < 128) v = a2[(k - 64) * 512 + (n - 512)]; }
    else { if (k >= 128) v = g2[(k - 128) * 512 + (n - 1024)]; }
    WL[i] = f2bf(v);
  }
}
template <int CTRL> __device__ __forceinline__ float dpp_f(float v) { return __int_as_float(__builtin_amdgcn_update_dpp(0, __float_as_int(v), CTRL, 0xf, 0xf, true)); }
__device__ __forceinline__ float row16_sum(float v) { v += dpp_f<0xB1>(v); v += dpp_f<0x4E>(v); v += dpp_f<0x141>(v); v += dpp_f<0x140>(v); return v; }
constexpr size_t WS_YSC = WS_XN;
typedef short bf16x4 __attribute__((ext_vector_type(4)));
__device__ __forceinline__ bf16x4 pack4(f32x4 v) { union { uint2 u; bf16x4 b; } x; x.u.x = mg::cvt_pk_bf16(v[0], v[1]); x.u.y = mg::cvt_pk_bf16(v[2], v[3]); return x.b; }
__device__ __forceinline__ f32x4 mma16(bf16x4 p, bf16x4 q, f32x4 c) { return __builtin_amdgcn_mfma_f32_16x16x16bf16_1k(p, q, c, 0, 0, 0); }
__device__ __forceinline__ float wave_sum_fast(float v) { v = row16_sum(v); v += __shfl_xor(v, 16); v += __shfl_xor(v, 32); return v; }
constexpr int RK_SK = 72;
__device__ __forceinline__ void rwkv_chunk_prep(const Ctx& c) {
  const float* mu = inp(c, I0_MU); const float* w0 = inp(c, I0_W0); const float* a0 = inp(c, I0_A0);
  const float* kkp = inp(c, I0_KK); const float* kap = inp(c, I0_KA); const float* rkp = inp(c, I0_RK);
  const bf16* P = (const bf16*)(c.ws + WS_P0); const bf16* LW = (const bf16*)(c.ws + WS_LOWA);
  float* BON = (float*)(c.ws + WS_BON); unsigned char* CHK = c.ws + WS_CHK;
  bf16* wl = (bf16*)(c.lds + c.wave * 17408);
  bf16* sAt = wl, *sBh = wl + 1152, *sKh = wl + 2304, *sRt = wl + 3456;
  bf16* tAt = wl + 4608, *tRt = tAt + 1024, *tBp = tAt + 2048, *tKp = tAt + 3072;
  const int lane = c.lane, q = lane >> 4, lr = lane & 15;
  for (int unit = c.wave * c.G + c.bid; unit < BATCH * 8 * 128; unit += NW * c.G) {
    const int ck = unit & 127, bh = unit >> 7, h = bh & 7, b = bh >> 3, ch = h * 64 + lane;
    const size_t m0 = (size_t)b * SEQ + ck * 16;
    const float mur = mu[ch], muk = mu[512 + ch], muv = mu[1024 + ch], w0c = w0[ch], a0c = a0[ch], kkc = kkp[ch], kac = kap[ch], rkc = rkp[ch];
    float At[16], Bh[16], Kh[16], Rt[16], Vs[16];
    float rp = 0.f, kp = 0.f, vp = 0.f;
    if (ck > 0) { const bf16* pp = P + (m0 - 1) * EVEN_IN + ch; rp = bf2f(pp[0]); kp = bf2f(pp[512]); vp = bf2f(pp[1024]); }
    float lg = 0.f;
#pragma unroll
    for (int t = 0; t < 16; ++t) {
      const bf16* pc = P + (m0 + t) * EVEN_IN + ch;
      const float rc = bf2f(pc[0]), kc = bf2f(pc[512]), vc = bf2f(pc[1024]);
      const float r = rc + (rp - rc) * mur, k = kc + (kp - kc) * muk, v = vc + (vp - vc) * muv;
      rp = rc; kp = kc; vp = vc;
      const float aw = w0c + bf2f(LW[(m0 + t) * 1024 + ch]), aa = a0c + bf2f(LW[(m0 + t) * 1024 + 512 + ch]);
      const float lw = -__expf(-softplus_(-aw) - 0.5f);
      const float ag = sigmoid_(aa);
      float kk = k * kkc;
      kk = kk / fmaxf(sqrtf(wave_sum_fast(kk * kk)), 1e-12f);
      const float k2 = k * (1.f + (ag - 1.f) * kac);
      const float bon = wave_sum_fast(r * k2 * rkc);
      if (lane == 0) BON[(m0 + t) * 8 + h] = bon;
      const float gprev = __expf(lg); lg += lw; const float g = __expf(lg), gi = __expf(-lg);
      At[t] = -kk * gprev; Bh[t] = kk * ag * gi; Kh[t] = k2 * gi; Rt[t] = r * g; Vs[t] = v;
    }
    const float gL = __expf(lg);
    unsigned char* cb = CHK + (size_t)unit * CHB;
#pragma unroll
    for (int t = 0; t < 16; ++t) { sAt[t * RK_SK + lane] = f2bf(At[t]); sBh[t * RK_SK + lane] = f2bf(Bh[t]); sKh[t * RK_SK + lane] = f2bf(Kh[t]); sRt[t * RK_SK + lane] = f2bf(Rt[t]); }
    { mg::u32x4 o0, o1;
#define PK16(arr, sc) o0.x = mg::cvt_pk_bf16(arr[0] * sc, arr[1] * sc); o0.y = mg::cvt_pk_bf16(arr[2] * sc, arr[3] * sc); o0.z = mg::cvt_pk_bf16(arr[4] * sc, arr[5] * sc); o0.w = mg::cvt_pk_bf16(arr[6] * sc, arr[7] * sc); \
      o1.x = mg::cvt_pk_bf16(arr[8] * sc, arr[9] * sc); o1.y = mg::cvt_pk_bf16(arr[10] * sc, arr[11] * sc); o1.z = mg::cvt_pk_bf16(arr[12] * sc, arr[13] * sc); o1.w = mg::cvt_pk_bf16(arr[14] * sc, arr[15] * sc);
      PK16(At, 1.f) *(mg::u32x4*)(tAt + lane * 16) = o0; *(mg::u32x4*)(tAt + lane * 16 + 8) = o1;
      PK16(Rt, 1.f) *(mg::u32x4*)(tRt + lane * 16) = o0; *(mg::u32x4*)(tRt + lane * 16 + 8) = o1;
      PK16(Bh, gL) *(mg::u32x4*)(tBp + lane * 16) = o0; *(mg::u32x4*)(tBp + lane * 16 + 8) = o1;
      *(mg::u32x4*)(cb + 6656 + lane * 32) = o0; *(mg::u32x4*)(cb + 6656 + lane * 32 + 16) = o1;
      PK16(Kh, gL) *(mg::u32x4*)(tKp + lane * 16) = o0; *(mg::u32x4*)(tKp + lane * 16 + 8) = o1;
      PK16(Vs, 1.f) *(mg::u32x4*)(cb + 8704 + lane * 32) = o0; *(mg::u32x4*)(cb + 8704 + lane * 32 + 16) = o1;
#undef PK16
      *(float*)(cb + 10752 + lane * 4) = gL; }
    __builtin_amdgcn_s_waitcnt(0xc07f); __builtin_amdgcn_wave_barrier();
    mg::bf16x8 fAt[2], fBh[2], fKh[2], fRt[2];
#pragma unroll
    for (int ks = 0; ks < 2; ++ks) { fAt[ks] = *(const mg::bf16x8*)(sAt + lr * RK_SK + 32 * ks + 8 * q); fBh[ks] = *(const mg::bf16x8*)(sBh + lr * RK_SK + 32 * ks + 8 * q);
      fKh[ks] = *(const mg::bf16x8*)(sKh + lr * RK_SK + 32 * ks + 8 * q); fRt[ks] = *(const mg::bf16x8*)(sRt + lr * RK_SK + 32 * ks + 8 * q); }
    const f32x4 z4 = {0.f, 0.f, 0.f, 0.f};
    f32x4 nab = z4, nabT = z4, nak = z4, nakT = z4, mbr = z4, mkr = z4;
#pragma unroll
    for (int ks = 0; ks < 2; ++ks) {
      nab = __builtin_amdgcn_mfma_f32_16x16x32_bf16(fBh[ks], fAt[ks], nab, 0, 0, 0); nabT = __builtin_amdgcn_mfma_f32_16x16x32_bf16(fAt[ks], fBh[ks], nabT, 0, 0, 0);
      nak = __builtin_amdgcn_mfma_f32_16x16x32_bf16(fKh[ks], fAt[ks], nak, 0, 0, 0); nakT = __builtin_amdgcn_mfma_f32_16x16x32_bf16(fAt[ks], fKh[ks], nakT, 0, 0, 0);
      mbr = __builtin_amdgcn_mfma_f32_16x16x32_bf16(fBh[ks], fRt[ks], mbr, 0, 0, 0); mkr = __builtin_amdgcn_mfma_f32_16x16x32_bf16(fKh[ks], fRt[ks], mkr, 0, 0, 0);
    }
    f32x4 eye;
#pragma unroll
    for (int i = 0; i < 4; ++i) { const int row = 4 * q + i;
      eye[i] = (row == lr) ? 1.f : 0.f;
      nab[i] = (row < lr) ? nab[i] : 0.f; nak[i] = (row < lr) ? nak[i] : 0.f; nabT[i] = (lr < row) ? nabT[i] : 0.f; nakT[i] = (lr < row) ? nakT[i] : 0.f;
      mbr[i] = (row <= lr) ? mbr[i] : 0.f; mkr[i] = (row <= lr) ? mkr[i] : 0.f; }
    const bf16x4 dN = pack4(nab), dNT = pack4(nabT);
    const f32x4 n2 = mma16(dNT, dN, z4), nT2 = mma16(dN, dNT, z4);
    const bf16x4 dN2 = pack4(n2), dNT2 = pack4(nT2);
    const f32x4 n4 = mma16(dNT2, dN2, z4), nT4 = mma16(dN2, dNT2, z4);
    const bf16x4 dN4 = pack4(n4), dNT4 = pack4(nT4);
    const f32x4 nT8 = mma16(dN4, dNT4, z4);
    f32x4 Tm = nab + eye;
    Tm = mma16(pack4(nT2 + eye), pack4(Tm), z4);
    Tm = mma16(pack4(nT4 + eye), pack4(Tm), z4);
    Tm = mma16(pack4(nT8 + eye), pack4(Tm), z4);
    const bf16x4 dT = pack4(Tm), dEye = pack4(eye), dMbr = pack4(mbr), dNakT = pack4(nakT);
    const f32x4 w1 = mma16(dNakT, dT, z4);
    const f32x4 w1T = mma16(dT, dNakT, z4);
    const bf16x4 dW1T = pack4(w1T); (void)w1;
    const f32x4 w2 = mma16(dW1T, dMbr, mkr);
    *(bf16x4*)(cb + 4096 + lane * 8) = pack4(w2);
#pragma unroll
    for (int kt = 0; kt < 4; ++kt) {
      const bf16x4 atT = *(const bf16x4*)(tAt + (16 * kt + lr) * 16 + 4 * q);
      const bf16x4 rtT = *(const bf16x4*)(tRt + (16 * kt + lr) * 16 + 4 * q);
      const bf16x4 bpT = *(const bf16x4*)(tBp + (16 * kt + lr) * 16 + 4 * q);
      const bf16x4 kpT = *(const bf16x4*)(tKp + (16 * kt + lr) * 16 + 4 * q);
      const f32x4 ap = mma16(atT, dT, z4);
      const f32x4 apT = mma16(dT, atT, z4);
      f32x4 rpt = mma16(pack4(apT), dMbr, z4);
      rpt = mma16(rtT, dEye, rpt);
      f32x4 ht = mma16(dW1T, bpT, z4);
      ht = mma16(dEye, kpT, ht);
      *(bf16x4*)(cb + kt * 512 + lane * 8) = pack4(ap);
      *(bf16x4*)(cb + 2048 + kt * 512 + lane * 8) = pack4(rpt);
      *(bf16x4*)(cb + 4608 + kt * 512 + lane * 8) = pack4(ht);
    }
    __builtin_amdgcn_s_waitcnt(0xc07f); __builtin_amdgcn_wave_barrier();
  }
}
__device__ __forceinline__ void rwkv_chunk_scan(const Ctx& c) {
  const unsigned char* CHK = c.ws + WS_CHK; float* YO = (float*)(c.ws + WS_YSC);
  if (c.wave >= 4) return;
  const int lane = c.lane, q = lane >> 4, lr = lane & 15, w = c.wave;
  for (int bh = c.bid; bh < BATCH * 8; bh += c.G) {
    const int h = bh & 7, b = bh >> 3;
    f32x4 S[4];
#pragma unroll
    for (int kt = 0; kt < 4; ++kt) S[kt] = (f32x4){0.f, 0.f, 0.f, 0.f};
    bf16x4 nAp[4], nRp[4], nH[4], nBp[4], nW2, nV; f32x4 nG[4];
#define RK2_LOAD(cb_) do { const unsigned char* cb__ = (cb_); \
      _Pragma("unroll") for (int kt = 0; kt < 4; ++kt) { nAp[kt] = *(const bf16x4*)(cb__ + kt * 512 + lane * 8); nRp[kt] = *(const bf16x4*)(cb__ + 2048 + kt * 512 + lane * 8); \
        nH[kt] = *(const bf16x4*)(cb__ + 4608 + kt * 512 + lane * 8); nBp[kt] = *(const bf16x4*)(cb__ + 6656 + (16 * kt + lr) * 32 + 8 * q); nG[kt] = *(const f32x4*)(cb__ + 10752 + (16 * kt + 4 * q) * 4); } \
      nW2 = *(const bf16x4*)(cb__ + 4096 + lane * 8); nV = *(const bf16x4*)(cb__ + 8704 + (16 * w + lr) * 32 + 8 * q); } while (0)
    RK2_LOAD(CHK + (size_t)(bh * 128) * CHB);
    for (int ck = 0; ck < 128; ++ck) {
      bf16x4 Ap[4], Rp[4], Hd[4], Bp[4]; f32x4 G[4];
#pragma unroll
      for (int kt = 0; kt < 4; ++kt) { Ap[kt] = nAp[kt]; Rp[kt] = nRp[kt]; Hd[kt] = nH[kt]; Bp[kt] = nBp[kt]; G[kt] = nG[kt]; }
      const bf16x4 W2 = nW2, Vq = nV;
      if (ck + 1 < 128) RK2_LOAD(CHK + (size_t)(bh * 128 + ck + 1) * CHB);
      bf16x4 Sb[4];
#pragma unroll
      for (int kt = 0; kt < 4; ++kt) Sb[kt] = pack4(S[kt]);
      f32x4 x1 = {0.f, 0.f, 0.f, 0.f}, y = {0.f, 0.f, 0.f, 0.f};
#pragma unroll
      for (int kt = 0; kt < 4; ++kt) { x1 = mma16(Ap[kt], Sb[kt], x1); y = mma16(Rp[kt], Sb[kt], y); }
      y = mma16(W2, Vq, y);
      const bf16x4 X1b = pack4(x1);
#pragma unroll
      for (int kt = 0; kt < 4; ++kt) { S[kt] = S[kt] * G[kt]; S[kt] = mma16(Bp[kt], X1b, S[kt]); S[kt] = mma16(Hd[kt], Vq, S[kt]); }
      float* yo = YO + ((size_t)b * SEQ + ck * 16 + 4 * q) * 512 + h * 64 + 16 * w + lr;
#pragma unroll
      for (int i = 0; i < 4; ++i) yo[i * 512] = y[i];
    }
#undef RK2_LOAD
  }
}

__device__ __forceinline__ void rwkv_post(const Ctx& c) {
  const float* YS = (const float*)(c.ws + WS_YSC); const bf16* P = (const bf16*)(c.ws + WS_P0); const bf16* GG = (const bf16*)(c.ws + WS_LOG);
  const float* BON = (const float*)(c.ws + WS_BON); bf16* YM = (bf16*)(c.ws + WS_YMIX);
  const float* lnw = inp(c, I0_LNW); const float* lnb = inp(c, I0_LNB); const float* mu = inp(c, I0_MU);
  for (int m = c.wave * c.G + c.bid; m < M; m += NW * c.G) {
    const int t = m % SEQ;
#pragma unroll
    for (int j = 0; j < 8; ++j) {
      const int ch = j * 64 + c.lane; const size_t o = (size_t)m * 512 + ch;
      const float y = YS[o];
      const float mean = wave_sum(y) * (1.f / 64.f);
      const float d = y - mean;
      const float var = wave_sum(d * d) * (1.f / 64.f);
      float v = d * rsqrtf(var + 64e-5f) * lnw[ch] + lnb[ch];
      const float vc = bf2f(P[(size_t)m * EVEN_IN + 1024 + ch]), vp = t > 0 ? bf2f(P[(size_t)(m - 1) * EVEN_IN + 1024 + ch]) : 0.f;
      v += BON[(size_t)m * 8 + j] * (vc + (vp - vc) * mu[1024 + ch]);
      YM[(size_t)m * D + ch] = f2bf(v * bf2f(GG[(size_t)m * 1024 + ch]));
    }
  }
}

__device__ __forceinline__ void gmlp_phase(const Ctx& c, int vb, int vG) {
  const bf16* P = (const bf16*)(c.ws + WS_P0); bf16* YM = (bf16*)(c.ws + WS_YMIX);
  const float* lnw = inp(c, I0_GLNW); const float* lnb = inp(c, I0_GLNB); const float* ws = inp(c, I0_GWS); const float* bs = inp(c, I0_GBS);
  bf16* Ws = (bf16*)c.lds; bf16* VT = (bf16*)(c.lds + 34816);
  const int w = c.wave, q = c.lane >> 4, lr = c.lane & 15;
  int gcur = -1;
  for (int it = vb; it < BATCH * 16 * 4; it += vG) {
    const int g = it & 3, ck = (it >> 2) & 15, b = it >> 6;
    const size_t m0 = (size_t)b * SEQ + ck * 128;
    __syncthreads();
    if (g != gcur) { gcur = g;
#pragma unroll
      for (int k = 0; k < 8; ++k) { const int idx = c.tid + NT * k, i = idx >> 5, j4 = (idx & 31) * 4;
        const f32x4 v = *(const f32x4*)(ws + ((size_t)g * 128 + i) * 128 + j4);
        uint2 o; o.x = mg::cvt_pk_bf16(j4 <= i ? v[0] : 0.f, j4 + 1 <= i ? v[1] : 0.f); o.y = mg::cvt_pk_bf16(j4 + 2 <= i ? v[2] : 0.f, j4 + 3 <= i ? v[3] : 0.f);
        *(uint2*)(Ws + i * SPI + j4) = o; } }
    { const float w0 = lnw[g * 128 + c.lane], w1 = lnw[g * 128 + c.lane + 64], b0 = lnb[g * 128 + c.lane], b1 = lnb[g * 128 + c.lane + 64];
      for (int j = w; j < 128; j += NW) {
        const bf16* row = P + (m0 + j) * EVEN_IN + 2304 + g * 128;
        const float v0 = gelu_(bf2f(row[c.lane])), v1 = gelu_(bf2f(row[c.lane + 64]));
        const float mean = wave_sum(v0 + v1) * (1.f / 128.f);
        const float d0 = v0 - mean, d1 = v1 - mean;
        const float rs = rsqrtf(wave_sum(d0 * d0 + d1 * d1) * (1.f / 128.f) + 1e-6f);
        VT[c.lane * SPI + j] = f2bf(d0 * rs * w0 + b0);
        VT[(c.lane + 64) * SPI + j] = f2bf(d1 * rs * w1 + b1);
      } }
    __syncthreads();
    f32x4 acc[8];
#pragma unroll
    for (int dt = 0; dt < 8; ++dt) acc[dt] = (f32x4){0.f, 0.f, 0.f, 0.f};
    const int kmax = (16 * w + 15) >> 5;
    for (int ks = 0; ks <= kmax; ++ks) { const mg::bf16x8 wf = *(const mg::bf16x8*)(Ws + (16 * w + lr) * SPI + 32 * ks + 8 * q);
#pragma unroll
      for (int dt = 0; dt < 8; ++dt) { const mg::bf16x8 vf = *(const mg::bf16x8*)(VT + (16 * dt + lr) * SPI + 32 * ks + 8 * q); acc[dt] = __builtin_amdgcn_mfma_f32_16x16x32_bf16(wf, vf, acc[dt], 0, 0, 0); } }
#pragma unroll
    for (int i = 0; i < 4; ++i) { const int r = 16 * w + 4 * q + i; const float bias = bs[g * 128 + r];
      const bf16* up = P + (m0 + r) * EVEN_IN + 1792 + g * 128 + lr; bf16* op = YM + (m0 + r) * D + 512 + g * 128 + lr;
#pragma unroll
      for (int dt = 0; dt < 8; ++dt) op[16 * dt] = f2bf(gelu_(bf2f(up[16 * dt])) * (acc[dt][i] + bias));
      asm volatile("" ::: "memory"); }
  }
  __syncthreads();
}

__device__ __forceinline__ void s5_tables(const Ctx& c) {
  const float* are = inp(c, I1_ARE); const float* aim = inp(c, I1_AIM); const float* ldt = inp(c, I1_LDT); const float* bre = inp(c, I1_BRE); const float* bim = inp(c, I1_BIM);
  float* POW = (float*)(c.ws + WS_S5POW); float* BB = (float*)(c.ws + WS_S5BB);
  for (int i = c.bid * NT + c.tid; i < 32 * 17 * 64; i += c.G * NT) {
    const int p = i & 63, tau = (i >> 6) % 17, g = i / (17 * 64);
    const float lr = are[g * 64 + p], li = aim[g * 64 + p], dt = expf(ldt[g]);
    const float mag = expf(lr * dt * (float)tau), ang = li * dt * (float)tau;
    POW[2 * i] = mag * cosf(ang); POW[2 * i + 1] = mag * sinf(ang);
  }
  for (int i = c.bid * NT + c.tid; i < 32 * 64 * 16; i += c.G * NT) {
    const int gp = i >> 4, g = gp >> 6;
    const float lr = are[gp], li = aim[gp], dt = expf(ldt[g]);
    const float mag = expf(lr * dt), ar = mag * cosf(li * dt), ai = mag * sinf(li * dt);
    const float nr = ar - 1.f, ni = ai, den = lr * lr + li * li;
    const float fr = (nr * lr + ni * li) / den, fi = (ni * lr - nr * li) / den;
    const float br = bre[i], bi = bim[i];
    BB[2 * i] = fr * br - fi * bi; BB[2 * i + 1] = fr * bi + fi * br;
  }
}
__device__ __forceinline__ void s5_taps(const Ctx& c) {
  const float* cre = inp(c, I1_CRE); const float* cim = inp(c, I1_CIM);
  const float* POW = (const float*)(c.ws + WS_S5POW); const float* BB = (const float*)(c.ws + WS_S5BB); float* KT = (float*)(c.ws + WS_S5KT);
  for (int i = c.bid * NT + c.tid; i < 32 * 16 * 256; i += c.G * NT) {
    const int c2 = i & 15, c1 = (i >> 4) & 15, tau = (i >> 8) & 15, g = i >> 12;
    float acc = 0.f;
    for (int p = 0; p < 64; ++p) {
      const float cr = cre[(g * 16 + c1) * 64 + p], ci = cim[(g * 16 + c1) * 64 + p];
      const float pr = POW[((g * 17 + tau) * 64 + p) * 2], pi = POW[((g * 17 + tau) * 64 + p) * 2 + 1];
      const float br = BB[((g * 64 + p) * 16 + c2) * 2], bi = BB[((g * 64 + p) * 16 + c2) * 2 + 1];
      const float wr = cr * pr - ci * pi, wi = cr * pi + ci * pr;
      acc += wr * br - wi * bi;
    }
    KT[i] = acc;
  }
}
__device__ __forceinline__ void s5_mats(const Ctx& c) {
  const float* cre = inp(c, I1_CRE); const float* cim = inp(c, I1_CIM);
  const float* POW = (const float*)(c.ws + WS_S5POW); const float* BB = (const float*)(c.ws + WS_S5BB); const float* KT = (const float*)(c.ws + WS_S5KT);
  bf16* BE = (bf16*)(c.ws + WS_S5BE); bf16* BTF = (bf16*)(c.ws + WS_S5BTF);
  for (int i = c.bid * NT + c.tid; i < 32 * 256 * 256; i += c.G * NT) {
    const int k = i & 255, n = (i >> 8) & 255, g = i >> 16; float v = 0.f;
    if (n < 128) { const int p = n & 63, s16 = k >> 4, c2 = k & 15;
      const float pr = POW[((g * 17 + 15 - s16) * 64 + p) * 2], pi = POW[((g * 17 + 15 - s16) * 64 + p) * 2 + 1];
      const float br = BB[((g * 64 + p) * 16 + c2) * 2], bi = BB[((g * 64 + p) * 16 + c2) * 2 + 1];
      v = (n < 64) ? (pr * br - pi * bi) : (pr * bi + pi * br); }
    BE[i] = f2bf(v);
  }
  for (int i = c.bid * NT + c.tid; i < 32 * 256 * 384; i += c.G * NT) {
    const int k = i % 384, n = (i / 384) & 255, g = i / (384 * 256), t = n >> 4, c1 = n & 15; float v = 0.f;
    if (k < 256) { const int s16 = k >> 4, c2 = k & 15; if (s16 <= t) v = KT[((g * 16 + (t - s16)) * 16 + c1) * 16 + c2]; }
    else { const int kk = k - 256, p = kk & 63;
      const float cr = cre[(g * 16 + c1) * 64 + p], ci = cim[(g * 16 + c1) * 64 + p];
      const float pr = POW[((g * 17 + t + 1) * 64 + p) * 2], pi = POW[((g * 17 + t + 1) * 64 + p) * 2 + 1];
      v = (kk < 64) ? (cr * pr - ci * pi) : -(cr * pi + ci * pr); }
    BTF[i] = f2bf(v);
  }
}
__device__ __forceinline__ void s5_carry(const Ctx& c) {
  const float* XE = (const float*)(c.ws + WS_S5XE); bf16* AP = (bf16*)(c.ws + WS_S5A); const float* POW = (const float*)(c.ws + WS_S5POW);
  for (int it = c.wave * c.G + c.bid; it < BATCH * 32; it += NW * c.G) {
    const int b = it >> 5, g = it & 31, p = c.lane;
    const float ar = POW[((g * 17 + 16) * 64 + p) * 2], ai = POW[((g * 17 + 16) * 64 + p) * 2 + 1];
    float xr = 0.f, xi = 0.f;
    const size_t row0 = (size_t)g * 1024 + b * 128;
    for (int blk0 = 0; blk0 < 128; blk0 += 8) {
      float er[8], ei[8];
#pragma unroll
      for (int j = 0; j < 8; ++j) { er[j] = XE[(row0 + blk0 + j) * 128 + p]; ei[j] = XE[(row0 + blk0 + j) * 128 + 64 + p]; }
#pragma unroll
      for (int j = 0; j < 8; ++j) {
        bf16* ap = AP + (row0 + blk0 + j) * 384 + 256;
        ap[p] = f2bf(xr); ap[64 + p] = f2bf(xi);
        const float nr = ar * xr - ai * xi + er[j], ni = ar * xi + ai * xr + ei[j];
        xr = nr; xi = ni;
      }
    }
  }
}

__device__ __forceinline__ void ssd_conv(const Ctx& c) {
  const bf16* P1 = (const bf16*)(c.ws + WS_P1); bf16* CV = (bf16*)(c.ws + WS_CONV);
  const float* cw = inp(c, I1_CW); const float* cb = inp(c, I1_CB);
  for (size_t i = (size_t)c.bid * NT + c.tid; i < (size_t)M * 128; i += (size_t)c.G * NT) {
    const int ch = (int)(i & 127) * 8; const size_t m = i >> 7; const int t = (int)(m % SEQ);
    float acc[8];
#pragma unroll
    for (int e = 0; e < 8; ++e) acc[e] = cb[ch + e];
#pragma unroll
    for (int j = 0; j < 4; ++j) { const int tt = t - 3 + j; if (tt >= 0) {
        const uint4 v = *(const uint4*)(P1 + (m - 3 + j) * 2048 + 1024 + ch); const unsigned vw[4] = {v.x, v.y, v.z, v.w};
#pragma unroll
        for (int e = 0; e < 4; ++e) { acc[2 * e] += cw[j * 1024 + ch + 2 * e] * __uint_as_float(vw[e] << 16); acc[2 * e + 1] += cw[j * 1024 + ch + 2 * e + 1] * __uint_as_float(vw[e] & 0xffff0000u); } } }
    uint4 o; o.x = mg::cvt_pk_bf16(silu_(acc[0]), silu_(acc[1])); o.y = mg::cvt_pk_bf16(silu_(acc[2]), silu_(acc[3])); o.z = mg::cvt_pk_bf16(silu_(acc[4]), silu_(acc[5])); o.w = mg::cvt_pk_bf16(silu_(acc[6]), silu_(acc[7]));
    *(uint4*)(CV + m * 1024 + ch) = o;
  }
}

constexpr int SL_C = 0, SL_B = 34816, SL_BT = 69632, SL_XT = 104448, SL_DT = 121856, SL_ACS = 123904;
__device__ __forceinline__ void ssd_dt_acs(const Ctx& c, size_t m0, int g, const float* DT, const float* dtb, const float* alog, float* sdt, float* sacs) {
  if (c.wave < 4) {
    const int h = g * 4 + c.wave; const float av = -expf(alog[h]), bias = dtb[h];
    const float d0 = softplus_(DT[(m0 + 2 * c.lane) * 8 + h] + bias), d1 = softplus_(DT[(m0 + 2 * c.lane + 1) * 8 + h] + bias);
    const float a0 = av * d0, a1 = av * d1;
    float sc = a0 + a1;
#pragma unroll
    for (int o = 1; o < 64; o <<= 1) { const float t = __shfl_up(sc, o); if (c.lane >= o) sc += t; }
    sdt[c.wave * 128 + 2 * c.lane] = d0; sdt[c.wave * 128 + 2 * c.lane + 1] = d1;
    sacs[c.wave * 128 + 2 * c.lane] = sc - a1; sacs[c.wave * 128 + 2 * c.lane + 1] = sc;
  }
}
__device__ __forceinline__ void ssd_pass1(const Ctx& c) {
  const bf16* CV = (const bf16*)(c.ws + WS_CONV); const float* DT = (const float*)(c.ws + WS_DT);
  float* YD = (float*)(c.ws + WS_YD); float* SE = (float*)(c.ws + WS_SE); float* ATOT = (float*)(c.ws + WS_ATOT);
  const float* dtb = inp(c, I1_DTB); const float* alog = inp(c, I1_ALOG);
  bf16* Cs = (bf16*)(c.lds + SL_C); bf16* Bs = (bf16*)(c.lds + SL_B); bf16* BTs = (bf16*)(c.lds + SL_BT); bf16* XT = (bf16*)(c.lds + SL_XT);
  float* sdt = (float*)(c.lds + SL_DT); float* sacs = (float*)(c.lds + SL_ACS);
  const int w = c.wave, q = c.lane >> 4, lr = c.lane & 15;
  for (int unit = c.bid; unit < BATCH * 16 * 2; unit += c.G) {
    const int g = unit & 1, ck = (unit >> 1) & 15, b = unit >> 5;
    const size_t m0 = (size_t)b * SEQ + ck * 128;
    __syncthreads();
#pragma unroll
    for (int i = 0; i < 8; ++i) { const int idx = c.tid + NT * i, mat = idx >> 11, r = (idx >> 4) & 127, qq = idx & 15;
      const uint4 v = *(const uint4*)(CV + (m0 + r) * 1024 + 512 + mat * 256 + g * 128 + qq * 8);
      *(uint4*)((mat ? Cs : Bs) + r * SPI + qq * 8) = v; }
#pragma unroll
    for (int i = 0; i < 4; ++i) { const int task = c.tid + NT * i, n = task & 127, l0 = (task >> 7) * 8;
      unsigned short e[8];
#pragma unroll
      for (int j = 0; j < 8; ++j) e[j] = CV[(m0 + l0 + j) * 1024 + 512 + g * 128 + n];
      uint4 o; o.x = e[0] | ((unsigned)e[1] << 16); o.y = e[2] | ((unsigned)e[3] << 16); o.z = e[4] | ((unsigned)e[5] << 16); o.w = e[6] | ((unsigned)e[7] << 16);
      *(uint4*)(BTs + n * SPI + l0) = o; }
    ssd_dt_acs(c, m0, g, DT, dtb, alog, sdt, sacs);
    __syncthreads();
    mg::bf16x8 cf[4];
#pragma unroll
    for (int ks = 0; ks < 4; ++ks) cf[ks] = *(const mg::bf16x8*)(Cs + (16 * w + lr) * SPI + 32 * ks + 8 * q);
    f32x4 cb[8];
#pragma unroll
    for (int j = 0; j < 8; ++j) { cb[j] = (f32x4){0.f, 0.f, 0.f, 0.f};
#pragma unroll
      for (int ks = 0; ks < 4; ++ks) { const mg::bf16x8 bf = *(const mg::bf16x8*)(Bs + (16 * j + lr) * SPI + 32 * ks + 8 * q); cb[j] = __builtin_amdgcn_mfma_f32_16x16x32_bf16(cf[ks], bf, cb[j], 0, 0, 0); } }
    __syncthreads();
    bf16* Ms = Bs;
    for (int r = 0; r < 4; ++r) {
      const int h = g * 4 + r;
#pragma unroll
      for (int i = 0; i < 2; ++i) { const int task = c.tid + NT * i, p = task & 63, l0 = (task >> 6) * 8;
        unsigned short e[8];
#pragma unroll
        for (int j = 0; j < 8; ++j) e[j] = CV[(m0 + l0 + j) * 1024 + h * 64 + p];
        uint4 o; o.x = e[0] | ((unsigned)e[1] << 16); o.y = e[2] | ((unsigned)e[3] << 16); o.z = e[4] | ((unsigned)e[5] << 16); o.w = e[6] | ((unsigned)e[7] << 16);
        *(uint4*)(XT + p * SPI + l0) = o; }
      const float* ac = sacs + r * 128; const float* dl = sdt + r * 128;
#pragma unroll
      for (int j = 0; j < 8; ++j) { const int sidx = 16 * j + lr; const float as = ac[sidx], ds = dl[sidx];
#pragma unroll
        for (int i = 0; i < 4; ++i) { const int l = 16 * w + 4 * q + i;
          const float v = (sidx <= l) ? cb[j][i] * __expf(fminf(ac[l] - as, 0.f)) * ds : 0.f;
          Ms[l * SPI + sidx] = f2bf(v); } }
      __syncthreads();
      { f32x4 ya[4];
#pragma unroll
        for (int pt = 0; pt < 4; ++pt) ya[pt] = (f32x4){0.f, 0.f, 0.f, 0.f};
        const int kmax = (16 * w + 15) >> 5;
        for (int ks = 0; ks <= kmax; ++ks) { const mg::bf16x8 mf = *(const mg::bf16x8*)(Ms + (16 * w + lr) * SPI + 32 * ks + 8 * q);
#pragma unroll
          for (int pt = 0; pt < 4; ++pt) { const mg::bf16x8 xf = *(const mg::bf16x8*)(XT + (16 * pt + lr) * SPI + 32 * ks + 8 * q); ya[pt] = __builtin_amdgcn_mfma_f32_16x16x32_bf16(mf, xf, ya[pt], 0, 0, 0); } }
#pragma unroll
        for (int pt = 0; pt < 4; ++pt)
#pragma unroll
          for (int i = 0; i < 4; ++i) YD[(m0 + 16 * w + 4 * q + i) * 512 + h * 64 + 16 * pt + lr] = ya[pt][i]; }
      { const int pt = w & 3, ntb = (w >> 2) * 4; const float aend = ac[127];
        f32x4 sa[4];
#pragma unroll
        for (int nt = 0; nt < 4; ++nt) sa[nt] = (f32x4){0.f, 0.f, 0.f, 0.f};
#pragma unroll
        for (int ks = 0; ks < 4; ++ks) { const uint4 xr = *(const uint4*)(XT + (16 * pt + lr) * SPI + 32 * ks + 8 * q); const unsigned xw[4] = {xr.x, xr.y, xr.z, xr.w};
          float xv[8];
#pragma unroll
          for (int e = 0; e < 4; ++e) { const int l = 32 * ks + 8 * q + 2 * e;
            xv[2 * e] = __uint_as_float(xw[e] << 16) * dl[l] * __expf(aend - ac[l]); xv[2 * e + 1] = __uint_as_float(xw[e] & 0xffff0000u) * dl[l + 1] * __expf(aend - ac[l + 1]); }
          union { uint4 u; mg::bf16x8 v; } xs; xs.u.x = mg::cvt_pk_bf16(xv[0], xv[1]); xs.u.y = mg::cvt_pk_bf16(xv[2], xv[3]); xs.u.z = mg::cvt_pk_bf16(xv[4], xv[5]); xs.u.w = mg::cvt_pk_bf16(xv[6], xv[7]);
#pragma unroll
          for (int nt = 0; nt < 4; ++nt) { const mg::bf16x8 bt = *(const mg::bf16x8*)(BTs + (16 * (ntb + nt) + lr) * SPI + 32 * ks + 8 * q); sa[nt] = __builtin_amdgcn_mfma_f32_16x16x32_bf16(xs.v, bt, sa[nt], 0, 0, 0); } }
        float* Eo = SE + ((size_t)(b * 8 + h) * 16 + ck) * 8192;
#pragma unroll
        for (int nt = 0; nt < 4; ++nt)
#pragma unroll
          for (int i = 0; i < 4; ++i) Eo[(16 * pt + 4 * q + i) * 128 + 16 * (ntb + nt) + lr] = sa[nt][i];
        if (c.tid == 0) ATOT[(b * 8 + h) * 16 + ck] = aend; }
      __syncthreads();
    }
  }
  __syncthreads();
}
__device__ __forceinline__ void ssd_carry(const Ctx& c) {
  const float* SE = (const float*)(c.ws + WS_SE); const float* ATOT = (const float*)(c.ws + WS_ATOT); bf16* SPV = (bf16*)(c.ws + WS_SPV);
  for (int i = c.bid * NT + c.tid; i < BATCH * 8 * 2048; i += c.G * NT) {
    const int bh = i >> 11, e4 = (i & 2047) * 4;
    f32x4 S = {0.f, 0.f, 0.f, 0.f};
    for (int ck = 0; ck < 16; ++ck) {
      const size_t o = ((size_t)bh * 16 + ck) * 8192 + e4;
      uint2 pk; pk.x = mg::cvt_pk_bf16(S[0], S[1]); pk.y = mg::cvt_pk_bf16(S[2], S[3]);
      *(uint2*)(SPV + o) = pk;
      const float d = __expf(ATOT[bh * 16 + ck]); const f32x4 e = *(const f32x4*)(SE + o);
      S = S * d + e;
    }
  }
}
__device__ __forceinline__ void ssd_pass2(const Ctx& c) {
  const bf16* CV = (const bf16*)(c.ws + WS_CONV); const float* DT = (const float*)(c.ws + WS_DT); const bf16* P1 = (const bf16*)(c.ws + WS_P1);
  const float* YD = (const float*)(c.ws + WS_YD); const bf16* SPV = (const bf16*)(c.ws + WS_SPV); bf16* YM = (bf16*)(c.ws + WS_YMIX);
  const float* dtb = inp(c, I1_DTB); const float* alog = inp(c, I1_ALOG); const float* dsk = inp(c, I1_MD); const float* nw = inp(c, I1_MNW);
  bf16* Cs = (bf16*)(c.lds + SL_C); bf16* SPs = (bf16*)(c.lds + SL_B);
  float* sdt = (float*)(c.lds + SL_DT); float* sacs = (float*)(c.lds + SL_ACS);
  const int w = c.wave, q = c.lane >> 4, lr = c.lane & 15;
  for (int unit = c.bid; unit < BATCH * 16 * 2; unit += c.G) {
    const int g = unit & 1, ck = (unit >> 1) & 15, b = unit >> 5;
    const size_t m0 = (size_t)b * SEQ + ck * 128;
    __syncthreads();
#pragma unroll
    for (int i = 0; i < 4; ++i) { const int idx = c.tid + NT * i, r = idx >> 4, qq = idx & 15;
      *(uint4*)(Cs + r * SPI + qq * 8) = *(const uint4*)(CV + (m0 + r) * 1024 + 768 + g * 128 + qq * 8); }
#pragma unroll
    for (int i = 0; i < 8; ++i) { const int idx = c.tid + NT * i, r = idx >> 10, p = (idx >> 4) & 63, qq = idx & 15;
      *(uint4*)(SPs + (r * 64 + p) * SPI + qq * 8) = *(const uint4*)(SPV + ((size_t)(b * 8 + g * 4 + r) * 16 + ck) * 8192 + p * 128 + qq * 8); }
    ssd_dt_acs(c, m0, g, DT, dtb, alog, sdt, sacs);
    __syncthreads();
    mg::bf16x8 cf[4];
#pragma unroll
    for (int ks = 0; ks < 4; ++ks) cf[ks] = *(const mg::bf16x8*)(Cs + (16 * w + lr) * SPI + 32 * ks + 8 * q);
    f32x4 yo[4][4];
#pragma unroll
    for (int r = 0; r < 4; ++r)
#pragma unroll
      for (int pt = 0; pt < 4; ++pt) { yo[r][pt] = (f32x4){0.f, 0.f, 0.f, 0.f};
#pragma unroll
        for (int ks = 0; ks < 4; ++ks) { const mg::bf16x8 sf = *(const mg::bf16x8*)(SPs + (r * 64 + 16 * pt + lr) * SPI + 32 * ks + 8 * q); yo[r][pt] = __builtin_amdgcn_mfma_f32_16x16x32_bf16(cf[ks], sf, yo[r][pt], 0, 0, 0); } }
    float dh[4];
#pragma unroll
    for (int r = 0; r < 4; ++r) dh[r] = dsk[g * 4 + r];
    float ss[4];
#pragma unroll
    for (int i = 0; i < 4; ++i) {
      const int l = 16 * w + 4 * q + i; const size_t m = m0 + l;
      const float* ydp = YD + m * 512 + g * 256 + lr; const bf16* cvp = CV + m * 1024 + g * 256 + lr; const bf16* zp = P1 + m * 2048 + 512 + g * 256 + lr;
      float sq = 0.f;
#pragma unroll
      for (int r = 0; r < 4; ++r) { const float ea = __expf(sacs[r * 128 + l]);
#pragma unroll
        for (int pt = 0; pt < 4; ++pt) { const int o = r * 64 + 16 * pt;
          const float y = ydp[o] + ea * yo[r][pt][i] + dh[r] * bf2f(cvp[o]);
          const float vv = y * silu_(bf2f(zp[o]));
          yo[r][pt][i] = vv; sq += vv * vv; } }
      ss[i] = rsqrtf(row16_sum(sq) * (1.f / 256.f) + 1e-6f);
      asm volatile("" ::: "memory");
    }
#pragma unroll
    for (int i = 0; i < 4; ++i) { const int l = 16 * w + 4 * q + i;
      bf16* ymp = YM + (m0 + l) * D + 512 + g * 256 + lr; const float* nwp = nw + g * 256 + lr;
#pragma unroll
      for (int r = 0; r < 4; ++r)
#pragma unroll
        for (int pt = 0; pt < 4; ++pt) { const int o = r * 64 + 16 * pt; ymp[o] = f2bf(yo[r][pt][i] * ss[i] * nwp[o]); }
      asm volatile("" ::: "memory");
    }
  }
  __syncthreads();
}

__device__ __forceinline__ void moe_assign(const Ctx& c) {
  LAS unsigned* lcnt = (LAS unsigned*)c.lds; LAS unsigned* lbase = lcnt + 8;
  const int* tok_e = (const int*)(c.ws + WS_ROUTE); int* tok_slot = (int*)(c.ws + WS_ROUTE + 256 * 1024); int* slot_tok = (int*)(c.ctl + CW_SLOTTOK);
  int pstart[8]; { int acc = 0;
#pragma unroll
    for (int e = 0; e < 8; ++e) { pstart[e] = acc; acc += ((int)c.ctl[CW_CNT + 64 * e] + 255) / 256 * 256; } }
  for (int tb = c.bid; tb < M / 64; tb += c.G) {
    __syncthreads();
    if (c.tid < 8) lcnt[c.tid] = 0u;
    __syncthreads();
    int e = 0; unsigned rank = 0; const int pair = tb * 128 + c.tid;
    if (c.tid < 128) { e = tok_e[pair]; rank = atomicAdd((unsigned*)&lcnt[e], 1u); }
    __syncthreads();
    if (c.tid < 8) lbase[c.tid] = atomicAdd(c.ctl + CW_CUR + 64 * c.tid, lcnt[c.tid]);
    __syncthreads();
    if (c.tid < 128) {
      int ps = 0;
#pragma unroll
      for (int q = 0; q < 8; ++q) ps = (e == q) ? pstart[q] : ps;
      const int slot = ps + (int)lbase[e] + (int)rank;
      slot_tok[slot] = pair >> 1; tok_slot[pair] = slot;
    }
  }
  __syncthreads();
}


enum { PH_PRO, PH_WIN0, PH_PREPA, PH_LORA, PH_PREPC, PH_SCAN, PH_POST, PH_WOUT0, PH_NORM0, PH_FGU, PH_FD, PH_NORM1, PH_WIN1, PH_L1A, PH_L1B, PH_L1C, PH_L1D, PH_WOUT1, PH_NORM2, PH_ASSIGN, PH_MGU0, PH_MD0, PH_MGU1, PH_MD1, PH_FINAL, PH_COUNT };
constexpr int LAST_PHASE = PH_COUNT;
template <int LO, int HI, int BREG = 0>
__global__ void __launch_bounds__(NT, 2) fwd_kernel(Args args) {
  extern __shared__ __attribute__((aligned(16))) unsigned char lds[];
  Ctx c0; c0.out = args.out; c0.ws = args.ws; c0.ctl = (unsigned*)(args.ws + WS_CTL); c0.lds = lds;
  c0.tid = threadIdx.x; c0.lane = c0.tid & 63; c0.wave = __builtin_amdgcn_readfirstlane(c0.tid >> 6); c0.bid = blockIdx.x; c0.G = gridDim.x;
  volatile LAS unsigned* bst = (volatile LAS unsigned*)(LAS unsigned char*)(lds + LDS_BST);
  if (c0.tid == 0) { LAS unsigned long long* pt = (LAS unsigned long long*)(LAS unsigned char*)(lds + LDS_PTAB);
#pragma unroll
    for (int i = 0; i < N_IN; ++i) pt[i] = (unsigned long long)args.in[i];
    bst[0] = 0u; bst[1] = 0u; }
  __syncthreads();
  constexpr int lo = LO, hi = HI;
  if constexpr (hi - lo > 1) (void)xcd_barrier_post(c0.ctl + CW_BAR + BREG * 4096, bst);
#define IN(k) (lo <= (k) && (k) < hi)
#define SEAM(k) do { if constexpr (IN(k) && IN((k) + 1)) { XcdBarrier bar_; bar_.bar = (unsigned*)(args.ws + WS_CTL) + CW_BAR + BREG * 4096; bar_.x = xb_xcc_id(); \
    bar_.st = (volatile LAS unsigned*)(LAS unsigned char*)(lds + LDS_BST); xcd_barrier(bar_); } } while (0)

  LAS unsigned char* const ldsl = (LAS unsigned char*)lds;
  if constexpr (IN(PH_PRO)) { const Ctx c = launder(c0); cvt_dense(c); build_wlora(c); s5_tables(c); norm_phase<0, 0>(c, inp(c, I_X), nullptr, nullptr, nullptr, inp(c, I0_NPM), ((bf16*)(c.ws + WS_XN)), nullptr, 0, 0, nullptr); } SEAM(PH_PRO);
  if constexpr (IN(PH_WIN0)) { const Ctx c = launder(c0); s5_taps(c); mg::Gemm g{((bf16*)(c.ws + WS_XN)), (const bf16*)(c.ws + WS_WIN0), D, D, D}; mg::DenseOrder S; S.init(M / 256, EVEN_IN / 256, c.G, c.bid);
    mg::EpiBf16<false> E{(bf16*)(c.ws + WS_P0), EVEN_IN}; mg::gemm_phase(ldsl, g, S, E); } SEAM(PH_WIN0);
  if constexpr (IN(PH_PREPA)) { const Ctx c = launder(c0); rwkv_prep_a(c); } SEAM(PH_PREPA);
  if constexpr (IN(PH_LORA)) { const Ctx c = launder(c0); mg::Gemm g{(const bf16*)(c.ws + WS_ALORA), (const bf16*)(c.ws + WS_WLORA), 256, 256, 256}; mg::DenseOrder S; S.init(M / 256, 1536 / 256, c.G, c.bid);
    mg::EpiLora E{(bf16*)(c.ws + WS_LOWA), (bf16*)(c.ws + WS_LOG)}; mg::gemm_phase(ldsl, g, S, E); } SEAM(PH_LORA);
  if constexpr (IN(PH_PREPC)) { const Ctx c = launder(c0); rwkv_chunk_prep(c); } SEAM(PH_PREPC);
  if constexpr (IN(PH_SCAN)) { const Ctx c = launder(c0); if (c.G >= 256) { if (c.bid < 64) rwkv_chunk_scan(c); else gmlp_phase(c, c.bid - 64, c.G - 64); } else { rwkv_chunk_scan(c); gmlp_phase(c, c.bid, c.G); } } SEAM(PH_SCAN);
  if constexpr (IN(PH_POST)) { const Ctx c = launder(c0); rwkv_post(c); } SEAM(PH_POST);
  if constexpr (IN(PH_WOUT0)) { const Ctx c = launder(c0); mg::Gemm g{((bf16*)(c.ws + WS_YMIX)), (const bf16*)(c.ws + WS_WOUT0), D, D, D}; mg::DenseOrder S; S.init(M / 256, D / 256, c.G, c.bid);
    mg::EpiF32 E{((float*)(c.ws + WS_Y)), D}; mg::gemm_phase(ldsl, g, S, E); } SEAM(PH_WOUT0);
  if constexpr (IN(PH_NORM0)) { const Ctx c = launder(c0); norm_phase<1, 0>(c, inp(c, I_X), args.out, ((float*)(c.ws + WS_Y)), inp(c, I0_NPOM), inp(c, I0_NPF), ((bf16*)(c.ws + WS_XN)), nullptr, 0, 0, nullptr); } SEAM(PH_NORM0);
  if constexpr (IN(PH_FGU)) { const Ctx c = launder(c0); mg::Gemm g{((bf16*)(c.ws + WS_XN)), (const bf16*)(c.ws + WS_FGU), D, D, D}; mg::DenseOrder S; S.init(M / 256, 2 * FFN / 256, c.G, c.bid);
    mg::EpiSwigluT E{(bf16*)(c.ws + WS_H), FFN}; mg::gemm_phase(ldsl, g, S, E); } SEAM(PH_FGU);
  if constexpr (IN(PH_FD)) { const Ctx c = launder(c0); mg::Gemm g{(const bf16*)(c.ws + WS_H), (const bf16*)(c.ws + WS_FD), FFN, FFN, FFN}; mg::DenseOrder S; S.init(M / 256, D / 256, c.G, c.bid);
    mg::EpiF32 E{((float*)(c.ws + WS_Y)), D}; mg::gemm_phase(ldsl, g, S, E); } SEAM(PH_FD);
  if constexpr (IN(PH_NORM1)) { const Ctx c = launder(c0); s5_mats(c); norm_phase<1, 1>(c, args.out, args.out, ((float*)(c.ws + WS_Y)), inp(c, I0_NPOF), inp(c, I1_NPM), ((bf16*)(c.ws + WS_XN)), inp(c, I1_WIN), ODD_IN, 2048, (float*)(c.ws + WS_DT)); } SEAM(PH_NORM1);
  if constexpr (IN(PH_WIN1)) { const Ctx c = launder(c0); mg::Gemm g{((bf16*)(c.ws + WS_XN)), (const bf16*)(c.ws + WS_WIN1), D, D, D}; mg::DenseOrder S; S.init(M / 256, 2048 / 256, c.G, c.bid);
    mg::EpiP1 E{(bf16*)(c.ws + WS_P1), (bf16*)(c.ws + WS_S5A)}; mg::gemm_phase(ldsl, g, S, E); } SEAM(PH_WIN1);
  if constexpr (IN(PH_L1A)) { const Ctx c = launder(c0);
    { mg::Gemm g{(const bf16*)(c.ws + WS_S5A), (const bf16*)(c.ws + WS_S5BE), 384, 256, 256}; mg::S5Order S; S.G = c.G; S.c = c.bid; mg::EpiS5E E{(float*)(c.ws + WS_S5XE)}; mg::gemm_phase(ldsl, g, S, E); }
    ssd_conv(c); cvt_moe(c, c.bid, c.G, 0); } SEAM(PH_L1A);
  if constexpr (IN(PH_L1B)) { const Ctx c = launder(c0); s5_carry(c); ssd_pass1(c); } SEAM(PH_L1B);
  if constexpr (IN(PH_L1C)) { const Ctx c = launder(c0);
    { mg::Gemm g{(const bf16*)(c.ws + WS_S5A), (const bf16*)(c.ws + WS_S5BTF), 384, 384, 384}; mg::S5Order S; S.G = c.G; S.c = c.bid; mg::EpiS5Y E{(bf16*)(c.ws + WS_YC), (const bf16*)(c.ws + WS_S5A), inp(c, I1_SD)}; mg::gemm_phase(ldsl, g, S, E); }
    ssd_carry(c); } SEAM(PH_L1C);
  if constexpr (IN(PH_L1D)) { const Ctx c = launder(c0);
    { mg::Gemm g{(const bf16*)(c.ws + WS_YC), (const bf16*)(c.ws + WS_GLU), 512, 512, 512}; mg::DenseOrder S; S.init(M / 256, 512 / 256, c.G, c.bid);
      mg::EpiGluT E{((bf16*)(c.ws + WS_YMIX)), D, (const bf16*)(c.ws + WS_YC), inp(c, I1_GLB)}; mg::gemm_phase(ldsl, g, S, E); }
    ssd_pass2(c); cvt_moe(c, c.bid, c.G, 1); } SEAM(PH_L1D);
  if constexpr (IN(PH_WOUT1)) { const Ctx c = launder(c0); mg::Gemm g{((bf16*)(c.ws + WS_YMIX)), (const bf16*)(c.ws + WS_WOUT1), D, D, D}; mg::DenseOrder S; S.init(M / 256, D / 256, c.G, c.bid);
    mg::EpiF32 E{((float*)(c.ws + WS_Y)), D}; mg::gemm_phase(ldsl, g, S, E); } SEAM(PH_WOUT1);
  if constexpr (IN(PH_NORM2)) { const Ctx c = launder(c0); norm_phase<1, 2>(c, args.out, args.out, ((float*)(c.ws + WS_Y)), inp(c, I1_NPOM), inp(c, I1_NPF), ((bf16*)(c.ws + WS_XN)), inp(c, I1_RT), 8, 0, nullptr); } SEAM(PH_NORM2);
  if constexpr (IN(PH_ASSIGN)) { const Ctx c = launder(c0); moe_assign(c); } SEAM(PH_ASSIGN);
#define MOE_SCHED(S, nn, bse, bof) do { int acc_ = 0; \
    _Pragma("unroll") for (int e = 0; e < 8; ++e) { acc_ += ((int)c.ctl[CW_CNT + 64 * e] + 255) / 256 * 256; S.pend[e] = acc_; } \
    S.init(acc_ / 256, nn, c.G, c.bid); S.bstride_e = (bse); S.boff = (bof); S.rowidx = (const int*)(c.ctl + CW_SLOTTOK); } while (0)
  if constexpr (IN(PH_MGU0)) { const Ctx c = launder(c0); mg::Gemm g{((bf16*)(c.ws + WS_XN)), (const bf16*)(c.ws + WS_MGU), D, D, D}; mg::MoeOrder<true> S; MOE_SCHED(S, FH / 128, (size_t)2 * FE * D * 2, 0);
    mg::EpiSwigluT E{(bf16*)(c.ws + WS_HID), FH}; mg::gemm_phase(ldsl, g, S, E); } SEAM(PH_MGU0);
  if constexpr (IN(PH_MD0)) { const Ctx c = launder(c0); mg::Gemm g{(const bf16*)(c.ws + WS_HID), (const bf16*)(c.ws + WS_MD), FH, FE, FH}; mg::MoeOrder<false> S; MOE_SCHED(S, D / 256, (size_t)D * FE * 2, 0);
    mg::EpiBf16<false> E{(bf16*)(c.ws + WS_YS), D}; mg::gemm_phase(ldsl, g, S, E); } SEAM(PH_MD0);
  if constexpr (IN(PH_MGU1)) { const Ctx c = launder(c0); mg::Gemm g{((bf16*)(c.ws + WS_XN)), (const bf16*)(c.ws + WS_MGU), D, D, D}; mg::MoeOrder<true> S; MOE_SCHED(S, FH / 128, (size_t)2 * FE * D * 2, (size_t)(FH / 128) * 256 * D * 2);
    mg::EpiSwigluT E{(bf16*)(c.ws + WS_HID), FH}; mg::gemm_phase(ldsl, g, S, E); } SEAM(PH_MGU1);
  if constexpr (IN(PH_MD1)) { const Ctx c = launder(c0); mg::Gemm g{(const bf16*)(c.ws + WS_HID), (const bf16*)(c.ws + WS_MD), FH, FE, FH}; mg::MoeOrder<false> S; MOE_SCHED(S, D / 256, (size_t)D * FE * 2, (size_t)FH * 2);
    mg::EpiBf16<true> E{(bf16*)(c.ws + WS_YS), D}; mg::gemm_phase(ldsl, g, S, E); } SEAM(PH_MD1);
  if constexpr (IN(PH_FINAL)) { const Ctx c = launder(c0); norm_phase<2, 0>(c, args.out, args.out, nullptr, inp(c, I1_NPOF), nullptr, nullptr, nullptr, 0, 0, nullptr); }
#undef MOE_SCHED
#undef IN
#undef SEAM
}

template <int P> static void launch_one(const Args& a, hipStream_t stream) { hipLaunchKernelGGL((fwd_kernel<P, P + 1>), dim3(256), dim3(NT), LDS_BYTES, stream, a); }
template <int P> static bool set_attr_one() { return hipFuncSetAttribute((const void*)fwd_kernel<P, P + 1>, hipFuncAttributeMaxDynamicSharedMemorySize, LDS_BYTES) == hipSuccess; }
template <int... Ps> static void launch_all(const Args& a, hipStream_t stream, std::integer_sequence<int, Ps...>) { (launch_one<Ps>(a, stream), ...); }
template <int... Ps> static bool set_attr_all(std::integer_sequence<int, Ps...>) { return (set_attr_one<Ps>() && ...); }

extern "C" void kernel_launch(void* const* d_in, const int* in_sizes, int n_in, void* d_out, int out_size, void* d_ws, size_t ws_size, hipStream_t stream) {
  static int ready = 0;
  if (!ready) {
    bool ok = true;
    if (n_in != N_IN || out_size != M * D || ws_size < WS_END) { fprintf(stderr, "kernel_launch: unexpected problem: n_in %d out %d ws %zu (need %zu)\n", n_in, out_size, ws_size, (size_t)WS_END); ok = false; }
#if PROBE_PHASE >= 0
    if (ok && (hipFuncSetAttribute((const void*)fwd_kernel<0, PROBE_PHASE + 1, 0>, hipFuncAttributeMaxDynamicSharedMemorySize, LDS_BYTES) != hipSuccess ||
               hipFuncSetAttribute((const void*)fwd_kernel<PROBE_PHASE, PROBE_PHASE + 1, 1>, hipFuncAttributeMaxDynamicSharedMemorySize, LDS_BYTES) != hipSuccess ||
               hipFuncSetAttribute((const void*)fwd_kernel<PROBE_PHASE + 1, LAST_PHASE, 2>, hipFuncAttributeMaxDynamicSharedMemorySize, LDS_BYTES) != hipSuccess)) ok = false;
#elif ONE_LAUNCH
    if (ok && hipFuncSetAttribute((const void*)fwd_kernel<0, LAST_PHASE>, hipFuncAttributeMaxDynamicSharedMemorySize, LDS_BYTES) != hipSuccess) ok = false;
#else
    if (ok && !set_attr_all(std::make_integer_sequence<int, LAST_PHASE>{})) ok = false;
#endif
    if (!ok) fprintf(stderr, "kernel_launch: setup failed\n");
    ready = ok ? 1 : -1;
  }
  if (ready < 0) return;
  (void)hipMemsetAsync((char*)d_ws + WS_CTL, 0, CTL_BYTES, stream);
  Args a{};
  for (int i = 0; i < N_IN; ++i) a.in[i] = (const float*)d_in[i];
  a.out = (float*)d_out; a.ws = (unsigned char*)d_ws;
#if PROBE_PHASE >= 0
  hipLaunchKernelGGL((fwd_kernel<0, PROBE_PHASE + 1, 0>), dim3(256), dim3(NT), LDS_BYTES, stream, a);
  hipLaunchKernelGGL((fwd_kernel<PROBE_PHASE, PROBE_PHASE + 1, 1>), dim3(256), dim3(NT), LDS_BYTES, stream, a);
  hipLaunchKernelGGL((fwd_kernel<PROBE_PHASE + 1, LAST_PHASE, 2>), dim3(256), dim3(NT), LDS_BYTES, stream, a);
#elif ONE_LAUNCH
  hipLaunchKernelGGL((fwd_kernel<0, LAST_PHASE>), dim3(256), dim3(NT), LDS_BYTES, stream, a);
#else
  launch_all(a, stream, std::make_integer_sequence<int, LAST_PHASE>{});
#endif
}
```

```cpp
#include <hip/hip_runtime.h>
#include <stdint.h>
#include <stdio.h>
#include <utility>

#ifndef PROBE_PHASE
#define PROBE_PHASE -1
#endif
#ifndef ONE_LAUNCH
#define ONE_LAUNCH 1
#endif

constexpr int D = 1024, BATCH = 8, SEQ = 2048, M = BATCH * SEQ;
constexpr int A_W = 512, A_IN = 1792, EVEN_IN = 2816, FFN = 2816;
constexpr int ODD_IN = 2056, NE = 8, FE = 3584;
constexpr int MAXSLOT = 2 * M + NE * 256;
constexpr int NT = 512, NW = 8;

typedef unsigned short bf16;
typedef float f32x4 __attribute__((ext_vector_type(4)));
#define LAS __attribute__((address_space(3)))

enum {
  I_X = 0,
  I0_NPM, I0_WIN, I0_MU, I0_W0, I0_W2, I0_A0, I0_A2, I0_G2, I0_KK, I0_KA, I0_RK, I0_LNW, I0_LNB,
  I0_GLNW, I0_GLNB, I0_GWS, I0_GBS, I0_WOUT, I0_NPOM, I0_NPF, I0_FG, I0_FU, I0_FD, I0_NPOF,
  I1_NPM, I1_WIN, I1_ARE, I1_AIM, I1_LDT, I1_BRE, I1_BIM, I1_CRE, I1_CIM, I1_SD, I1_GLW, I1_GLB,
  I1_CW, I1_CB, I1_DTB, I1_ALOG, I1_MD, I1_MNW, I1_WOUT, I1_NPOM, I1_NPF, I1_RT, I1_MG, I1_MU, I1_MDN, I1_NPOF,
  N_IN
};
static_assert(N_IN == 51, "input count");

constexpr size_t MiB = 1ull << 20;
constexpr size_t WS_CTL = 0, CTL_BYTES = 1 * MiB;
constexpr size_t KiB = 1024;
constexpr size_t WS_WIN0 = 1 * MiB;
constexpr size_t WS_WOUT0 = WS_WIN0 + 5632 * KiB;
constexpr size_t WS_FGU = WS_WOUT0 + 2048 * KiB;
constexpr size_t WS_FD = WS_FGU + 11264 * KiB;
constexpr size_t WS_WIN1 = WS_FD + 5632 * KiB;
constexpr size_t WS_GLU = WS_WIN1 + 4096 * KiB;
constexpr size_t WS_WOUT1 = WS_GLU + 512 * KiB;
constexpr size_t WS_WLORA = WS_WOUT1 + 2048 * KiB;
constexpr size_t WS_DENSE_END = WS_WLORA + 768 * KiB;
constexpr size_t WS_MGU = 33 * MiB;
constexpr size_t WS_MD = 145 * MiB;
constexpr size_t WS_XN = 201 * MiB;
constexpr size_t WS_YMIX = 233 * MiB;
constexpr size_t WS_Y = 265 * MiB;
constexpr size_t WS_BIG = 329 * MiB;
constexpr size_t WS_P0 = WS_BIG;
constexpr size_t WS_SR = WS_MGU;
constexpr size_t WS_SW = WS_SR + 32 * MiB, WS_SK = WS_SW + 32 * MiB, WS_SV = WS_SK + 32 * MiB, WS_SA = WS_SV + 32 * MiB, WS_SB = WS_Y;
constexpr size_t WS_LOG = WS_P0 + 88 * MiB;
constexpr size_t WS_BON = WS_LOG + 32 * MiB;
constexpr size_t WS_L0END = WS_BON + 1 * MiB;
constexpr size_t WS_CHK = WS_MGU;
constexpr int CHB = 11264;
constexpr size_t WS_ALORA = WS_MGU + 160 * MiB;
constexpr size_t WS_LOWA = WS_XN;
static_assert(WS_DENSE_END <= WS_MGU && WS_ALORA + 8 * MiB <= WS_XN, "lora buffers");
static_assert(WS_SA + 32 * MiB <= WS_XN && WS_CHK + (size_t)BATCH * 8 * 128 * CHB <= WS_ALORA, "streams / chunk operators inside the MoE weight region");
constexpr size_t WS_H = WS_BIG;
constexpr size_t WS_P1 = WS_BIG;
constexpr size_t WS_DT = WS_P1 + 64 * MiB;
constexpr size_t WS_S5A = WS_YMIX;
constexpr size_t WS_S5XE = WS_XN;
constexpr size_t WS_S5BE = WS_MD;
constexpr size_t WS_S5BTF = WS_MD + 4 * MiB;
constexpr size_t WS_S5POW = WS_BIG + 129 * MiB;
constexpr size_t WS_S5BB = WS_S5POW + 320 * KiB;
constexpr size_t WS_S5KT = WS_S5BB + 320 * KiB;
constexpr size_t WS_ATOT = WS_DT + 768 * KiB;
constexpr size_t WS_CONV = WS_DT + 1 * MiB;
constexpr size_t WS_YD = WS_CONV + 32 * MiB;
constexpr size_t WS_YC = WS_Y;
constexpr size_t WS_SE = WS_Y + 16 * MiB;
constexpr size_t WS_SPV = WS_SE + 32 * MiB;
constexpr size_t WS_HID = WS_BIG;
constexpr size_t WS_XN8 = 176 * MiB;
constexpr size_t WS_YS = WS_YMIX;
constexpr size_t WS_ROUTE = WS_BIG + 120 * MiB;
constexpr size_t WS_END = 462 * MiB;
static_assert(WS_S5KT + 512 * KiB <= WS_END && WS_L0END <= WS_S5POW && WS_L0END <= WS_END && WS_YD + 32 * MiB <= WS_END && WS_ROUTE + 1 * MiB <= WS_END && WS_SPV + 16 * MiB <= WS_BIG, "workspace map");
static_assert((size_t)MAXSLOT * FE <= 120 * MiB && (size_t)MAXSLOT * D * 2 <= 96 * MiB && WS_MD + (size_t)8 * D * FE <= WS_XN8 && WS_MGU + (size_t)8 * 2 * FE * D <= WS_MD, "moe buffers");
constexpr int CW_BAR = 16384;
constexpr int CW_CNT = 8192;
constexpr int CW_CUR = 8192 + 64 * 8;
constexpr int CW_SLOTTOK = 65536;
static_assert((CW_SLOTTOK + MAXSLOT) * 4 <= (int)CTL_BYTES, "ctl");

constexpr int SPI = 136;
constexpr int LDS_BYTES = 147456;

__device__ __forceinline__ float bf2f(bf16 v) { return __uint_as_float(((unsigned)v) << 16); }
__device__ __forceinline__ bf16 f2bf(float f) { unsigned u = __float_as_uint(f); u += 0x7fffu + ((u >> 16) & 1u); return (bf16)(u >> 16); }
__device__ __forceinline__ float wave_sum(float v) {
#pragma unroll
  for (int o = 32; o > 0; o >>= 1) v += __shfl_xor(v, o);
  return v;
}
__device__ __forceinline__ float sigmoid_(float x) { return 1.f / (1.f + expf(-x)); }
__device__ __forceinline__ float silu_(float x) { return x / (1.f + expf(-x)); }
__device__ __forceinline__ float gelu_(float x) { const float u = 0.7978845608028654f * (x + 0.044715f * x * x * x); return 0.5f * x * (1.f + tanhf(u)); }
__device__ __forceinline__ float softplus_(float x) { return fmaxf(x, 0.f) + log1pf(expf(-fabsf(x))); }

#define XB_TMO      128
#define XB_XCNT(j)  (256  + 64 * (j))
#define XB_XSUB(j)  (1280 + 64 * (j))
#define XB_XGEN(j)  (2304 + 64 * (j))
#define XB_TOP      3328
#define XB_TOPGEN   3392
#define XCD_BAR_WORDS 3456
#define XB_SPIN_CAP (1u << 22)

__device__ __forceinline__ unsigned xb_ld(unsigned* p)              { return __hip_atomic_load(p, __ATOMIC_RELAXED, __HIP_MEMORY_SCOPE_AGENT); }
__device__ __forceinline__ unsigned xb_add(unsigned* p, unsigned v) { return __hip_atomic_fetch_add(p, v, __ATOMIC_RELAXED, __HIP_MEMORY_SCOPE_AGENT); }
__device__ __forceinline__ unsigned xb_xcc_id() { return (unsigned)__builtin_amdgcn_s_getreg((3 << 11) | 20) & 0xFu; }
#define XB_SPIN(cond, bar) do { unsigned _sp = 0; while (cond) { __builtin_amdgcn_s_sleep(1); \
    if ((++_sp & 255u) == 0u) { if (xb_ld(&(bar)[XB_TMO])) break; if (_sp > XB_SPIN_CAP) { atomicAdd(&(bar)[XB_TMO], 1u); break; } } } } while (0)

struct XcdBarrier { unsigned* bar; unsigned x; volatile LAS unsigned* st; };

__device__ __forceinline__ XcdBarrier xcd_barrier_post(unsigned* bar, volatile LAS unsigned* st) {
    XcdBarrier b; b.bar = bar; b.x = xb_xcc_id(); b.st = st;
    if (threadIdx.x == 0) (void)xb_add(&bar[XB_XCNT(b.x)], 1u);
    return b;
}
__device__ __forceinline__ void xcd_barrier_complete(unsigned* bar, unsigned x, unsigned& nloc, unsigned& nx) {
    const unsigned G = gridDim.x * gridDim.y * gridDim.z;
    unsigned sum, cnt, mine, sp = 0u;
    for (;;) {
        sum = 0u; cnt = 0u; mine = 0u;
#pragma unroll
        for (unsigned j = 0; j < 16; ++j) { const unsigned c = xb_ld(&bar[XB_XCNT(j)]); sum += c; cnt += (c > 0u) ? 1u : 0u; mine = (j == x) ? c : mine; }
        if (sum == G) break;
        __builtin_amdgcn_s_sleep(1);
        if ((++sp & 255u) == 0u) { if (xb_ld(&bar[XB_TMO])) break; if (sp > XB_SPIN_CAP) { atomicAdd(&bar[XB_TMO], 1u); break; } }
    }
    nloc = mine > 0u ? mine : 1u; nx = cnt > 0u ? cnt : 1u;
}
__device__ __forceinline__ void xcd_barrier(const XcdBarrier& b) {
    asm volatile("s_waitcnt vmcnt(0)" ::: "memory");
    __syncthreads();
    if (threadIdx.x == 0) {
        unsigned* bar = b.bar;
        __builtin_amdgcn_s_waitcnt(0);
        unsigned nloc = b.st[0], nx = b.st[1];
        if (nloc == 0u) { xcd_barrier_complete(bar, b.x, nloc, nx); b.st[0] = nloc; b.st[1] = nx; }
        const unsigned old = xb_add(&bar[XB_XSUB(b.x)], 1u);
        const unsigned gen = old / nloc;
        if (old + 1u == (gen + 1u) * nloc) {
            __builtin_amdgcn_fence(__ATOMIC_RELEASE, "agent");
            asm volatile("s_waitcnt vmcnt(0)" ::: "memory");
            const unsigned og = xb_add(&bar[XB_TOP], 1u);
            const unsigned tg = og / nx;
            if (og + 1u == (tg + 1u) * nx) xb_add(&bar[XB_TOPGEN], 1u);
            else XB_SPIN(xb_ld(&bar[XB_TOPGEN]) == tg, bar);
            __builtin_amdgcn_fence(__ATOMIC_ACQUIRE, "agent");
            xb_add(&bar[XB_XGEN(b.x)], 1u);
            asm volatile("s_waitcnt vmcnt(0)" ::: "memory");
        } else {
            XB_SPIN(xb_ld(&bar[XB_XGEN(b.x)]) == gen, bar);
            __builtin_amdgcn_fence(__ATOMIC_ACQUIRE, "agent");
            asm volatile("s_waitcnt vmcnt(0)" ::: "memory");
        }
    }
    __syncthreads();
}

struct Args { const float* in[N_IN]; float* out; unsigned char* ws; int lo, hi; };
struct Ctx {
  float* out; unsigned char* ws; unsigned* ctl;
  unsigned char* lds;
  int tid, lane, wave, bid, G;
};
__device__ __forceinline__ Ctx launder(Ctx c) {
  asm volatile("" : "+v"(c.tid), "+v"(c.lane));
  asm volatile("" : "+s"(c.wave), "+s"(c.bid), "+s"(c.G));
  return c;
}
constexpr int LDS_PTAB = LDS_BYTES - 1024;
constexpr int LDS_BST = LDS_BYTES - 16;
__device__ __forceinline__ const float* inp(const Ctx& c, int k) {
  const LAS unsigned* pt = (const LAS unsigned*)(LAS unsigned char*)(c.lds + LDS_PTAB);
  const unsigned lo = __builtin_amdgcn_readfirstlane(pt[2 * k]), hi = __builtin_amdgcn_readfirstlane(pt[2 * k + 1]);
  return (const float*)(((unsigned long long)hi << 32) | lo);
}


namespace mg {
typedef short bf16x8 __attribute__((ext_vector_type(8)));
typedef unsigned u32x4 __attribute__((ext_vector_type(4)));
constexpr int BM = 256, BK = 64, HALF = 128, HTB = HALF * BK * 2, STAGE_BYTES = 8 * HTB, NXCD = 8, WGM = 8;
constexpr int LDS_IDX = STAGE_BYTES;
__host__ __device__ __forceinline__ int lds_byte(int r, int c) { const int st = (r >> 4) * 2 + (c >> 5), rr = r & 15, cc = c & 31, ob = rr * 64 + cc * 2; return st * 1024 + (ob ^ (((ob >> 9) & 1) << 5)); }
__host__ __device__ __forceinline__ void stage_rc(int b, int& R, int& C) { const int st = b / 1024, sb = b % 1024, swz = sb ^ (((sb >> 9) & 1) << 5); R = (st >> 1) * 16 + swz / 64; C = (st & 1) * 32 + (swz % 64) / 2; }
__host__ __device__ __forceinline__ int perm32(int rho) { const int n = rho >> 4, i = rho & 15; return 8 * (i >> 2) + 4 * n + (i & 3); }
typedef int i32x4_ __attribute__((ext_vector_type(4)));
typedef int i32x8_ __attribute__((ext_vector_type(8)));
__device__ __forceinline__ i32x8_ cat8(bf16x8 a, bf16x8 b) { const i32x4_ x = __builtin_bit_cast(i32x4_, a), y = __builtin_bit_cast(i32x4_, b); return __builtin_shufflevector(x, y, 0, 1, 2, 3, 4, 5, 6, 7); }
struct Unit { int pm, pn; };
struct Gemm { const bf16* A; const bf16* Bt; int lda, ldb, K; };

struct Tiles {
  int nM, nN, nwg, G, c;
  __device__ __forceinline__ void init(int nM_, int nN_, int G_, int c_) { nM = nM_; nN = nN_; nwg = nM * nN; G = G_; c = c_; }
  __device__ __forceinline__ bool next(int i, Unit& u) const {
    const long L = (long)i * G + c; if (L >= nwg) return false;
    int wgid = (int)L; { const int q = nwg / NXCD, r = nwg % NXCD, xcd = wgid % NXCD, off = wgid / NXCD; wgid = (xcd < r ? xcd * (q + 1) : r * (q + 1) + (xcd - r) * q) + off; }
    const int nig = WGM * nN, gid = wgid / nig, fm = gid * WGM, gsz = (nM - fm) < WGM ? (nM - fm) : WGM;
    u.pm = fm + ((wgid % nig) % gsz); u.pn = (wgid % nig) / gsz; return true;
  }
};
struct DenseOrder : Tiles {
  static constexpr bool GATHER = false, FP8 = false;
  const int* rowidx;
  __device__ __forceinline__ const char* a_tile(const Gemm& g, const Unit& u) const { return (const char*)g.A + (size_t)u.pm * BM * g.lda * 2; }
  __device__ __forceinline__ const char* b_tile(const Gemm& g, const Unit& u) const { return (const char*)g.Bt + (size_t)u.pn * BM * g.ldb * 2; }
};
struct S5Order {
  static constexpr bool GATHER = false, FP8 = false;
  int G, c; const int* rowidx;
  __device__ __forceinline__ bool next(int i, Unit& u) const { const int L = i * G + c; if (L >= 128) return false; u.pm = L; u.pn = 0; return true; }
  __device__ __forceinline__ const char* a_tile(const Gemm& g, const Unit& u) const { return (const char*)g.A + (size_t)u.pm * BM * g.lda * 2; }
  __device__ __forceinline__ const char* b_tile(const Gemm& g, const Unit& u) const { return (const char*)g.Bt + (size_t)(u.pm >> 2) * BM * g.ldb * 2; }
};
template <bool GATHER_, bool FP8_> struct MoeOrder : Tiles {
  static constexpr bool GATHER = GATHER_, FP8 = FP8_; static constexpr int ES = FP8_ ? 1 : 2;
  int pend[8]; size_t bstride_e, boff; const int* rowidx;
  __device__ __forceinline__ int expert(int pm) const { int e = 0;
#pragma unroll
    for (int q = 0; q < 7; ++q) e += (pm * BM >= pend[q]) ? 1 : 0;
    return e; }
  __device__ __forceinline__ const char* a_tile(const Gemm& g, const Unit& u) const { return (const char*)g.A + (size_t)u.pm * BM * g.lda * ES; }
  __device__ __forceinline__ const char* b_tile(const Gemm& g, const Unit& u) const { return (const char*)g.Bt + (size_t)expert(u.pm) * bstride_e + boff + (size_t)u.pn * BM * g.ldb * ES; }
};

typedef float f32x2_ __attribute__((ext_vector_type(2)));
typedef __bf16 bfx2_ __attribute__((ext_vector_type(2)));
__device__ __forceinline__ unsigned cvt_pk_bf16(float lo, float hi) { const f32x2_ v = {lo, hi}; const bfx2_ r = __builtin_convertvector(v, bfx2_); return __builtin_bit_cast(unsigned, r); }

struct EpiF32 { static constexpr bool PERM = false; float* C; int ldc;
  __device__ __forceinline__ void operator()(const f32x4 (&acc)[2][2][4][2], const Unit& u, int wr, int wc, int fr, int fq) const {
    const int row0 = u.pm * BM + wr * 64 + fr, col0 = u.pn * BM + wc * 32 + 4 * fq;
#pragma unroll
    for (int ai = 0; ai < 2; ++ai)
#pragma unroll
      for (int m = 0; m < 4; ++m) { float* rowp = C + (size_t)(row0 + ai * HALF + m * 16) * ldc + col0;
#pragma unroll
        for (int bj = 0; bj < 2; ++bj)
#pragma unroll
          for (int n = 0; n < 2; ++n) *(f32x4*)(rowp + bj * HALF + n * 16) = acc[ai][bj][m][n]; }
  } };
template <bool ACCUM> struct EpiBf16 { static constexpr bool PERM = true; bf16* O; int ldc;
  __device__ __forceinline__ void operator()(const f32x4 (&acc)[2][2][4][2], const Unit& u, int wr, int wc, int fr, int fq) const {
    const int row0 = u.pm * BM + wr * 64 + fr, col0 = u.pn * BM + wc * 32 + 8 * fq;
#pragma unroll
    for (int ai = 0; ai < 2; ++ai)
#pragma unroll
      for (int m = 0; m < 4; ++m) { bf16* rowp = O + (size_t)(row0 + ai * HALF + m * 16) * ldc + col0;
#pragma unroll
        for (int bj = 0; bj < 2; ++bj) { f32x4 v0 = acc[ai][bj][m][0], v1 = acc[ai][bj][m][1];
          if (ACCUM) { const u32x4 o = *(const u32x4*)(rowp + bj * HALF);
            v0[0] += __uint_as_float(o.x << 16); v0[1] += __uint_as_float(o.x & 0xffff0000u); v0[2] += __uint_as_float(o.y << 16); v0[3] += __uint_as_float(o.y & 0xffff0000u);
            v1[0] += __uint_as_float(o.z << 16); v1[1] += __uint_as_float(o.z & 0xffff0000u); v1[2] += __uint_as_float(o.w << 16); v1[3] += __uint_as_float(o.w & 0xffff0000u); }
          u32x4 w; w.x = cvt_pk_bf16(v0[0], v0[1]); w.y = cvt_pk_bf16(v0[2], v0[3]); w.z = cvt_pk_bf16(v1[0], v1[1]); w.w = cvt_pk_bf16(v1[2], v1[3]);
          *(u32x4*)(rowp + bj * HALF) = w; } }
  } };
struct EpiP1 { static constexpr bool PERM = true; bf16* P1; bf16* AP;
  __device__ __forceinline__ void operator()(const f32x4 (&acc)[2][2][4][2], const Unit& u, int wr, int wc, int fr, int fq) const {
    const int row0 = u.pm * BM + wr * 64 + fr, col0 = u.pn * BM + wc * 32 + 8 * fq;
#pragma unroll
    for (int ai = 0; ai < 2; ++ai)
#pragma unroll
      for (int m = 0; m < 4; ++m) { const int row = row0 + ai * HALF + m * 16;
#pragma unroll
        for (int bj = 0; bj < 2; ++bj) { const int col = col0 + bj * HALF; const f32x4 v0 = acc[ai][bj][m][0], v1 = acc[ai][bj][m][1];
          u32x4 w; w.x = cvt_pk_bf16(v0[0], v0[1]); w.y = cvt_pk_bf16(v0[2], v0[3]); w.z = cvt_pk_bf16(v1[0], v1[1]); w.w = cvt_pk_bf16(v1[2], v1[3]);
          bf16* dst;
          if (u.pn < 2) { const int g = col >> 4, c0 = col & 15, b = row >> 11, ta = row & 2047; dst = AP + ((size_t)(g * 1024 + b * 128 + (ta >> 4)) * 384 + (ta & 15) * 16 + c0); }
          else dst = P1 + (size_t)row * 2048 + col;
          *(u32x4*)dst = w; } }
  } };
struct EpiS5E { static constexpr bool PERM = false; float* XE;
  __device__ __forceinline__ void operator()(const f32x4 (&acc)[2][2][4][2], const Unit& u, int wr, int wc, int fr, int fq) const {
    const int row0 = u.pm * BM + wr * 64 + fr, col0 = wc * 32 + 4 * fq;
#pragma unroll
    for (int ai = 0; ai < 2; ++ai)
#pragma unroll
      for (int m = 0; m < 4; ++m) { float* rowp = XE + (size_t)(row0 + ai * HALF + m * 16) * 128 + col0;
#pragma unroll
        for (int n = 0; n < 2; ++n) *(f32x4*)(rowp + n * 16) = acc[ai][0][m][n]; }
  } };
struct EpiS5Y { static constexpr bool PERM = true; bf16* YC; const bf16* AP; const float* dsk;
  __device__ __forceinline__ void operator()(const f32x4 (&acc)[2][2][4][2], const Unit& u, int wr, int wc, int fr, int fq) const {
    const int row0 = u.pm * BM + wr * 64 + fr, g = u.pm >> 2;
#pragma unroll
    for (int ai = 0; ai < 2; ++ai)
#pragma unroll
      for (int m = 0; m < 4; ++m) { const int row = row0 + ai * HALF + m * 16, rg = row & 1023, b = rg >> 7, blk = rg & 127;
#pragma unroll
        for (int bj = 0; bj < 2; ++bj) { const int col0 = bj * HALF + wc * 32 + 8 * fq, t = col0 >> 4, ch = g * 16 + (col0 & 15);
          const u32x4 uv = *(const u32x4*)(AP + (size_t)row * 384 + col0);
          const f32x4 d0 = *(const f32x4*)(dsk + ch), d1 = *(const f32x4*)(dsk + ch + 4);
          const float uu[8] = {__uint_as_float(uv.x << 16), __uint_as_float(uv.x & 0xffff0000u), __uint_as_float(uv.y << 16), __uint_as_float(uv.y & 0xffff0000u),
                               __uint_as_float(uv.z << 16), __uint_as_float(uv.z & 0xffff0000u), __uint_as_float(uv.w << 16), __uint_as_float(uv.w & 0xffff0000u)};
          float h[8];
#pragma unroll
          for (int e = 0; e < 4; ++e) { h[e] = gelu_(acc[ai][bj][m][0][e] + d0[e] * uu[e]); h[4 + e] = gelu_(acc[ai][bj][m][1][e] + d1[e] * uu[4 + e]); }
          u32x4 w; w.x = cvt_pk_bf16(h[0], h[1]); w.y = cvt_pk_bf16(h[2], h[3]); w.z = cvt_pk_bf16(h[4], h[5]); w.w = cvt_pk_bf16(h[6], h[7]);
          *(u32x4*)(YC + (size_t)(b * 2048 + blk * 16 + t) * 512 + ch) = w; } }
  } };
struct EpiLora { static constexpr bool PERM = true; bf16* O0; bf16* O1;
  __device__ __forceinline__ void operator()(const f32x4 (&acc)[2][2][4][2], const Unit& u, int wr, int wc, int fr, int fq) const {
    bf16* base = (u.pn < 4) ? O0 : O1; constexpr int ldc = 1024;
    const int row0 = u.pm * BM + wr * 64 + fr, col0 = (u.pn & 3) * BM + wc * 32 + 8 * fq;
#pragma unroll
    for (int ai = 0; ai < 2; ++ai)
#pragma unroll
      for (int m = 0; m < 4; ++m) { bf16* rowp = base + (size_t)(row0 + ai * HALF + m * 16) * ldc + col0;
#pragma unroll
        for (int bj = 0; bj < 2; ++bj) { const f32x4 v0 = acc[ai][bj][m][0], v1 = acc[ai][bj][m][1];
          u32x4 w; w.x = cvt_pk_bf16(v0[0], v0[1]); w.y = cvt_pk_bf16(v0[2], v0[3]); w.z = cvt_pk_bf16(v1[0], v1[1]); w.w = cvt_pk_bf16(v1[2], v1[3]);
          *(u32x4*)(rowp + bj * HALF) = w; } }
  } };
struct EpiSwigluT { static constexpr bool PERM = true; bf16* O; int ldc;
  __device__ __forceinline__ void operator()(const f32x4 (&acc)[2][2][4][2], const Unit& u, int wr, int wc, int fr, int fq) const {
    const int row0 = u.pm * BM + wr * 64 + fr, col0 = u.pn * HALF + wc * 32 + 8 * fq;
#pragma unroll
    for (int ai = 0; ai < 2; ++ai)
#pragma unroll
      for (int m = 0; m < 4; ++m) { bf16* rowp = O + (size_t)(row0 + ai * HALF + m * 16) * ldc + col0;
        float h[8];
#pragma unroll
        for (int n = 0; n < 2; ++n)
#pragma unroll
          for (int e = 0; e < 4; ++e) { const float gte = acc[ai][0][m][n][e], up = acc[ai][1][m][n][e]; h[n * 4 + e] = gte * __builtin_amdgcn_rcpf(1.f + __expf(-gte)) * up; }
        u32x4 w; w.x = cvt_pk_bf16(h[0], h[1]); w.y = cvt_pk_bf16(h[2], h[3]); w.z = cvt_pk_bf16(h[4], h[5]); w.w = cvt_pk_bf16(h[6], h[7]);
        *(u32x4*)rowp = w; }
  } };
__device__ __forceinline__ unsigned pk4_fp8(float a, float b, float c, float d) {
  a = fminf(fmaxf(a, -448.f), 448.f); b = fminf(fmaxf(b, -448.f), 448.f); c = fminf(fmaxf(c, -448.f), 448.f); d = fminf(fmaxf(d, -448.f), 448.f);
  int w = 0; w = __builtin_amdgcn_cvt_pk_fp8_f32(a, b, w, false); w = __builtin_amdgcn_cvt_pk_fp8_f32(c, d, w, true); return (unsigned)w; }
struct EpiSwigluF8 { static constexpr bool PERM = true; unsigned char* O; int ldc;
  __device__ __forceinline__ void operator()(const f32x4 (&acc)[2][2][4][2], const Unit& u, int wr, int wc, int fr, int fq) const {
    const int row0 = u.pm * BM + wr * 64 + fr, col0 = u.pn * HALF + wc * 32 + 8 * fq;
#pragma unroll
    for (int ai = 0; ai < 2; ++ai)
#pragma unroll
      for (int m = 0; m < 4; ++m) { unsigned char* rowp = O + (size_t)(row0 + ai * HALF + m * 16) * ldc + col0;
        float h[8];
#pragma unroll
        for (int n = 0; n < 2; ++n)
#pragma unroll
          for (int e = 0; e < 4; ++e) { const float gte = acc[ai][0][m][n][e] * (1.f / 4096.f), up = acc[ai][1][m][n][e] * (8.f / 4096.f); h[n * 4 + e] = gte * __builtin_amdgcn_rcpf(1.f + __expf(-gte)) * up; }
        uint2 w; w.x = pk4_fp8(h[0], h[1], h[2], h[3]); w.y = pk4_fp8(h[4], h[5], h[6], h[7]);
        *(uint2*)rowp = w; }
  } };
struct EpiBf16S { static constexpr bool PERM = true; bf16* O; int ldc; float scale;
  __device__ __forceinline__ void operator()(const f32x4 (&acc)[2][2][4][2], const Unit& u, int wr, int wc, int fr, int fq) const {
    const int row0 = u.pm * BM + wr * 64 + fr, col0 = u.pn * BM + wc * 32 + 8 * fq;
#pragma unroll
    for (int ai = 0; ai < 2; ++ai)
#pragma unroll
      for (int m = 0; m < 4; ++m) { bf16* rowp = O + (size_t)(row0 + ai * HALF + m * 16) * ldc + col0;
#pragma unroll
        for (int bj = 0; bj < 2; ++bj) { const f32x4 v0 = acc[ai][bj][m][0] * scale, v1 = acc[ai][bj][m][1] * scale;
          u32x4 w; w.x = cvt_pk_bf16(v0[0], v0[1]); w.y = cvt_pk_bf16(v0[2], v0[3]); w.z = cvt_pk_bf16(v1[0], v1[1]); w.w = cvt_pk_bf16(v1[2], v1[3]);
          *(u32x4*)(rowp + bj * HALF) = w; } }
  } };
struct EpiGluT { static constexpr bool PERM = true; bf16* O; int ldc; const bf16* Yc; const float* bias;
  __device__ __forceinline__ void operator()(const f32x4 (&acc)[2][2][4][2], const Unit& u, int wr, int wc, int fr, int fq) const {
    const int row0 = u.pm * BM + wr * 64 + fr, col0 = u.pn * BM + wc * 32 + 8 * fq;
#pragma unroll
    for (int ai = 0; ai < 2; ++ai)
#pragma unroll
      for (int m = 0; m < 4; ++m) { const int row = row0 + ai * HALF + m * 16;
#pragma unroll
        for (int bj = 0; bj < 2; ++bj) { const int col = col0 + bj * HALF;
          const u32x4 yv = *(const u32x4*)(Yc + (size_t)row * 512 + col);
          const f32x4 b0 = *(const f32x4*)(bias + col), b1 = *(const f32x4*)(bias + col + 4);
          const float y[8] = {__uint_as_float(yv.x << 16), __uint_as_float(yv.x & 0xffff0000u), __uint_as_float(yv.y << 16), __uint_as_float(yv.y & 0xffff0000u),
                              __uint_as_float(yv.z << 16), __uint_as_float(yv.z & 0xffff0000u), __uint_as_float(yv.w << 16), __uint_as_float(yv.w & 0xffff0000u)};
          float h[8];
#pragma unroll
          for (int e = 0; e < 4; ++e) { h[e] = y[e] * __builtin_amdgcn_rcpf(1.f + __expf(-(acc[ai][bj][m][0][e] + b0[e]))); h[4 + e] = y[4 + e] * __builtin_amdgcn_rcpf(1.f + __expf(-(acc[ai][bj][m][1][e] + b1[e]))); }
          u32x4 w; w.x = cvt_pk_bf16(h[0], h[1]); w.y = cvt_pk_bf16(h[2], h[3]); w.z = cvt_pk_bf16(h[4], h[5]); w.w = cvt_pk_bf16(h[6], h[7]);
          *(u32x4*)(O + (size_t)row * ldc + col) = w; } }
  } };

template <class Epi, class Sched>
__device__ __forceinline__ void gemm_phase(LAS unsigned char* lds, const Gemm g, const Sched& S, const Epi& E) {
  const int tid = threadIdx.x, wid = __builtin_amdgcn_readfirstlane(tid >> 6), lane = tid & 63, wr = wid >> 2, wc = wid & 3, fr = lane & 15, fq = lane >> 4;
  constexpr int ES = Sched::FP8 ? 1 : 2;
  const int K = g.K, nt = K * ES / 128;
  unsigned voffA[2], voffB[2]; int gR[2], gC[2];
#pragma unroll
  for (int i = 0; i < 2; ++i) { int R, C; stage_rc(tid * 16 + i * 8192, R, C); const int Rb = Epi::PERM ? ((R & ~31) + perm32(R & 31)) : R;
    voffA[i] = (unsigned)(R * g.lda * ES + C * 2); voffB[i] = (unsigned)(Rb * g.ldb * ES + C * 2); gR[i] = R; gC[i] = C * 2; }
  const size_t kstep = (size_t)(BK * 2);
  const size_t hstepA = (size_t)HALF * g.lda * ES, hstepB = (size_t)HALF * g.ldb * ES;
  const unsigned ldsw = (unsigned)wid * 1024u;
  const unsigned rowb = (unsigned)(g.lda * ES);
  const int aoff = lds_byte(wr * 64 + fr, fq * 8), boff = lds_byte(wc * 32 + fr, fq * 8);
#define PG8_SA(b, h) (((b) * 2 + (h)) * HTB)
#define PG8_SB(b, h) ((4 + (b) * 2 + (h)) * HTB)
#define PG8_STAGE(bufoff, gbase, voff) do { _Pragma("unroll") for (int _i = 0; _i < 2; ++_i) \
    __builtin_amdgcn_global_load_lds((const unsigned*)((const char*)(gbase) + (voff)[_i]), (LAS unsigned*)(lds + (bufoff) + ldsw + _i * 8192), 16, 0, 0); } while (0)
#define PG8_STAGE_A(bufoff, p, h, goff) do { if constexpr (Sched::GATHER) PG8_STAGE(bufoff, p, (goff)[h]); else PG8_STAGE(bufoff, (p) + (h) * hstepA, voffA); } while (0)
#define PG8_LDA(dst, b, h) do { _Pragma("unroll") for (int m = 0; m < 4; ++m) { if constexpr (Sched::FP8) dst##8[m] = __builtin_shufflevector(*(const LAS i32x4_*)(lds + PG8_SA(b, h) + aoff + m * 2048), *(const LAS i32x4_*)(lds + PG8_SA(b, h) + aoff + m * 2048 + 1024), 0, 1, 2, 3, 4, 5, 6, 7); \
    else { _Pragma("unroll") for (int k = 0; k < 2; ++k) dst[m][k] = *(const LAS bf16x8*)(lds + PG8_SA(b, h) + aoff + m * 2048 + k * 1024); } } } while (0)
#define PG8_LDB(dst, b, h) do { _Pragma("unroll") for (int n = 0; n < 2; ++n) { if constexpr (Sched::FP8) dst##8[n] = __builtin_shufflevector(*(const LAS i32x4_*)(lds + PG8_SB(b, h) + boff + n * 2048), *(const LAS i32x4_*)(lds + PG8_SB(b, h) + boff + n * 2048 + 1024), 0, 1, 2, 3, 4, 5, 6, 7); \
    else { _Pragma("unroll") for (int k = 0; k < 2; ++k) dst[n][k] = *(const LAS bf16x8*)(lds + PG8_SB(b, h) + boff + n * 2048 + k * 1024); } } } while (0)
  int sc1 = 0x7f7f7f7f; asm volatile("" : "+v"(sc1));
#define PG8_MMA(ai, bj, At, Bt) do { __builtin_amdgcn_s_setprio(1); _Pragma("unroll") for (int m = 0; m < 4; ++m) _Pragma("unroll") for (int n = 0; n < 2; ++n) { \
    if constexpr (Sched::FP8) asm volatile("v_mfma_scale_f32_16x16x128_f8f6f4 %0, %1, %2, %0, %3, %3 op_sel_hi:[0,0,0]" : "+v"(acc[ai][bj][m][n]) : "v"(Bt##8[n]), "v"(At##8[m]), "v"(sc1)); \
    else { _Pragma("unroll") for (int k = 0; k < 2; ++k) acc[ai][bj][m][n] = __builtin_amdgcn_mfma_f32_16x16x32_bf16(Bt[n][k], At[m][k], acc[ai][bj][m][n], 0, 0, 0); } } \
    __builtin_amdgcn_s_setprio(0); } while (0)
#define PG8_WAIT_V(n) asm volatile("s_waitcnt vmcnt(" #n ")" ::: "memory")
#define PG8_WAIT_L(n) asm volatile("s_waitcnt lgkmcnt(" #n ")" ::: "memory")
#define PG8_BAR __builtin_amdgcn_s_barrier()
#define PG8_SCHED __builtin_amdgcn_sched_barrier(0)
  Unit cur, nxt; int ui = 0;
  if (!S.next(0, cur)) return;
  f32x4 acc[2][2][4][2];
#pragma unroll
  for (int a = 0; a < 2; ++a)
#pragma unroll
    for (int b = 0; b < 2; ++b)
#pragma unroll
      for (int m = 0; m < 4; ++m)
#pragma unroll
        for (int n = 0; n < 2; ++n) acc[a][b][m][n] = (f32x4){0.f, 0.f, 0.f, 0.f};
  bf16x8 At[4][2], B0[2][2], B1[2][2];
  i32x8_ At8[4], B08[2], B18[2];
  unsigned gcu[2][2] = {{0u, 0u}, {0u, 0u}};
  const char* cA = Sched::GATHER ? (const char*)g.A : S.a_tile(g, cur); const char* cB = S.b_tile(g, cur);
  if constexpr (Sched::GATHER) {
#pragma unroll
    for (int h = 0; h < 2; ++h)
#pragma unroll
      for (int i = 0; i < 2; ++i) gcu[h][i] = (unsigned)S.rowidx[cur.pm * BM + h * HALF + gR[i]] * rowb + (unsigned)gC[i];
  }
  PG8_STAGE(PG8_SB(0, 0), cB, voffB); PG8_STAGE(PG8_SB(0, 1), cB + hstepB, voffB); PG8_STAGE_A(PG8_SA(0, 0), cA, 0, gcu); PG8_STAGE_A(PG8_SA(0, 1), cA, 1, gcu);
  if (wr == 1) PG8_BAR;
  PG8_WAIT_V(2); PG8_BAR;
  PG8_STAGE(PG8_SB(1, 0), cB + kstep, voffB); PG8_STAGE_A(PG8_SA(1, 0), cA + kstep, 0, gcu); PG8_STAGE(PG8_SB(1, 1), cB + hstepB + kstep, voffB);
  PG8_WAIT_V(6); PG8_BAR;
  for (;;) {
    const bool has_next = S.next(ui + 1, nxt);
    const char* nA = Sched::GATHER ? (const char*)g.A : (has_next ? S.a_tile(g, nxt) : cA); const char* nB = has_next ? S.b_tile(g, nxt) : cB;
    if constexpr (Sched::GATHER) {
      if (has_next && wid < 4) __builtin_amdgcn_global_load_lds((const unsigned*)(S.rowidx + nxt.pm * BM + wid * 64 + lane), (LAS unsigned*)(lds + LDS_IDX + ((ui + 1) & 1) * 1024 + wid * 256), 4, 0, 0);
    }
#pragma nounroll
    for (int t = 0; t < nt; t += 2) {
      const bool last = (t == nt - 2);
      const char* a1 = cA + (size_t)(t + 1) * kstep;
      const char* a2 = last ? nA : cA + (size_t)(t + 2) * kstep; const char* b2 = last ? nB : cB + (size_t)(t + 2) * kstep;
      const char* a3 = a2 + kstep; const char* b3 = b2 + kstep;
      unsigned g2[2][2];
#pragma unroll
      for (int h = 0; h < 2; ++h)
#pragma unroll
        for (int i = 0; i < 2; ++i) g2[h][i] = gcu[h][i];
      if constexpr (Sched::GATHER) {
        if (last && has_next) {
          const LAS unsigned* ix = (const LAS unsigned*)(lds + LDS_IDX + ((ui + 1) & 1) * 1024);
#pragma unroll
          for (int h = 0; h < 2; ++h)
#pragma unroll
            for (int i = 0; i < 2; ++i) g2[h][i] = ix[h * HALF + gR[i]] * rowb + (unsigned)gC[i];
        }
      }
      PG8_LDB(B0, 0, 0); PG8_LDB(B1, 0, 1); PG8_SCHED; PG8_LDA(At, 0, 0); PG8_STAGE_A(PG8_SA(1, 1), a1, 1, gcu);
      PG8_WAIT_V(8); PG8_WAIT_L(0); PG8_BAR; PG8_MMA(0, 0, At, B0); PG8_MMA(0, 1, At, B1); PG8_BAR; PG8_SCHED;
      PG8_LDA(At, 0, 1); PG8_STAGE(PG8_SB(0, 0), b2, voffB); PG8_STAGE(PG8_SB(0, 1), b2 + hstepB, voffB); PG8_STAGE_A(PG8_SA(0, 0), a2, 0, g2);
      PG8_WAIT_V(8); PG8_WAIT_L(0); PG8_BAR; PG8_MMA(1, 0, At, B0); PG8_MMA(1, 1, At, B1); PG8_BAR; PG8_SCHED;
      PG8_LDB(B0, 1, 0); PG8_LDB(B1, 1, 1); PG8_SCHED; PG8_LDA(At, 1, 0); PG8_STAGE_A(PG8_SA(0, 1), a2, 1, g2);
      PG8_WAIT_V(8); PG8_WAIT_L(0); PG8_BAR; PG8_MMA(0, 0, At, B0); PG8_MMA(0, 1, At, B1); PG8_BAR; PG8_SCHED;
      PG8_LDA(At, 1, 1); PG8_STAGE(PG8_SB(1, 0), b3, voffB); PG8_STAGE(PG8_SB(1, 1), b3 + hstepB, voffB); PG8_STAGE_A(PG8_SA(1, 0), a3, 0, g2);
      PG8_WAIT_V(8); PG8_WAIT_L(0); PG8_BAR; PG8_MMA(1, 0, At, B0); PG8_MMA(1, 1, At, B1); PG8_BAR; PG8_SCHED;
      if constexpr (Sched::GATHER) { if (last) {
#pragma unroll
        for (int h = 0; h < 2; ++h)
#pragma unroll
          for (int i = 0; i < 2; ++i) gcu[h][i] = g2[h][i]; } }
    }
    if (wr == 0) PG8_BAR;
    if constexpr (Sched::FP8) asm volatile("s_nop 15\n\ts_nop 15" ::: "memory");
    E(acc, cur, wr, wc, fr, fq);
    if (!has_next) break;
#pragma unroll
    for (int a = 0; a < 2; ++a)
#pragma unroll
      for (int b = 0; b < 2; ++b)
#pragma unroll
        for (int m = 0; m < 4; ++m)
#pragma unroll
          for (int n = 0; n < 2; ++n) acc[a][b][m][n] = (f32x4){0.f, 0.f, 0.f, 0.f};
    cur = nxt; cA = nA; cB = nB; ++ui;
    if (wr == 1) PG8_BAR;
  }
  PG8_WAIT_V(0);
  PG8_BAR;
#undef PG8_SA
#undef PG8_SB
#undef PG8_STAGE
#undef PG8_STAGE_A
#undef PG8_LDA
#undef PG8_LDB
#undef PG8_MMA
#undef PG8_WAIT_V
#undef PG8_WAIT_L
#undef PG8_BAR
#undef PG8_SCHED
}
}

__device__ __forceinline__ void cvt_item(const float* W, int ldw, bf16* WT, int Kd, int dst_row0, int k0, int n0, int lane) {
  const int kg = lane >> 4, nq = lane & 15;
  const float* src = W + (size_t)(k0 + 16 * kg) * ldw + n0 + 4 * nq;
  f32x4 r[16];
#pragma unroll
  for (int i = 0; i < 16; ++i) r[i] = *(const f32x4*)(src + (size_t)i * ldw);
  bf16* dst = WT + (size_t)(dst_row0 + 4 * nq) * Kd + k0 + 16 * kg;
#pragma unroll
  for (int e = 0; e < 4; ++e) {
    mg::u32x4 o0, o1;
    o0.x = mg::cvt_pk_bf16(r[0][e], r[1][e]); o0.y = mg::cvt_pk_bf16(r[2][e], r[3][e]); o0.z = mg::cvt_pk_bf16(r[4][e], r[5][e]); o0.w = mg::cvt_pk_bf16(r[6][e], r[7][e]);
    o1.x = mg::cvt_pk_bf16(r[8][e], r[9][e]); o1.y = mg::cvt_pk_bf16(r[10][e], r[11][e]); o1.z = mg::cvt_pk_bf16(r[12][e], r[13][e]); o1.w = mg::cvt_pk_bf16(r[14][e], r[15][e]);
    *(mg::u32x4*)(dst + (size_t)e * Kd) = o0; *(mg::u32x4*)(dst + (size_t)e * Kd + 8) = o1;
  }
}
__device__ __forceinline__ void cvt_item_f8(const float* W, int ldw, unsigned char* WT, int Kd, int dst_row0, int k0, int n0, int lane) {
  const int kg = lane >> 4, nq = lane & 15;
  const float* src = W + (size_t)(k0 + 16 * kg) * ldw + n0 + 4 * nq;
  f32x4 r[16];
#pragma unroll
  for (int i = 0; i < 16; ++i) r[i] = *(const f32x4*)(src + (size_t)i * ldw) * 256.f;
  unsigned char* dst = WT + (size_t)(dst_row0 + 4 * nq) * Kd + k0 + 16 * kg;
#pragma unroll
  for (int e = 0; e < 4; ++e) {
    mg::u32x4 o; o.x = mg::pk4_fp8(r[0][e], r[1][e], r[2][e], r[3][e]); o.y = mg::pk4_fp8(r[4][e], r[5][e], r[6][e], r[7][e]);
    o.z = mg::pk4_fp8(r[8][e], r[9][e], r[10][e], r[11][e]); o.w = mg::pk4_fp8(r[12][e], r[13][e], r[14][e], r[15][e]);
    *(mg::u32x4*)(dst + (size_t)e * Kd) = o;
  }
}
__device__ __forceinline__ void cvt_mat_item_f8(const float* W, int K, int N, int ldw, unsigned char* WT, int mode, int it, int lane) {
  const int nblk = N / 64, kb = it / nblk, nb = it % nblk, n0 = nb * 64;
  const int dst = mode == 0 ? n0 : ((n0 >> 7) * 256 + (n0 & 127) + (mode == 2 ? 128 : 0));
  cvt_item_f8(W, ldw, WT, K, dst, kb * 64, n0, lane);
}
__device__ __forceinline__ void cvt_mat_item(const float* W, int K, int N, int ldw, bf16* WT, int mode, int it, int lane) {
  const int nblk = N / 64, kb = it / nblk, nb = it % nblk, n0 = nb * 64;
  const int dst = mode == 0 ? n0 : ((n0 >> 7) * 256 + (n0 & 127) + (mode == 2 ? 128 : 0));
  cvt_item(W, ldw, WT, K, dst, kb * 64, n0, lane);
}
__device__ __forceinline__ void cvt_dense(const Ctx& c) {
  const float* win0 = inp(c, I0_WIN); const float* wout0 = inp(c, I0_WOUT); const float* fg = inp(c, I0_FG); const float* fu = inp(c, I0_FU); const float* fd = inp(c, I0_FD);
  const float* win1 = inp(c, I1_WIN); const float* glw = inp(c, I1_GLW); const float* wout1 = inp(c, I1_WOUT);
  unsigned char* ws = c.ws;
  for (int it = c.wave * c.G + c.bid; it < 3904; it += NW * c.G) {
    int r = it;
    if (r < 704) { cvt_mat_item(win0, D, EVEN_IN, EVEN_IN, (bf16*)(ws + WS_WIN0), 0, r, c.lane); continue; } r -= 704;
    if (r < 256) { cvt_mat_item(wout0, D, D, D, (bf16*)(ws + WS_WOUT0), 0, r, c.lane); continue; } r -= 256;
    if (r < 704) { cvt_mat_item(fg, D, FFN, FFN, (bf16*)(ws + WS_FGU), 1, r, c.lane); continue; } r -= 704;
    if (r < 704) { cvt_mat_item(fu, D, FFN, FFN, (bf16*)(ws + WS_FGU), 2, r, c.lane); continue; } r -= 704;
    if (r < 704) { cvt_mat_item(fd, FFN, D, D, (bf16*)(ws + WS_FD), 0, r, c.lane); continue; } r -= 704;
    if (r < 512) { cvt_mat_item(win1, D, 2048, ODD_IN, (bf16*)(ws + WS_WIN1), 0, r, c.lane); continue; } r -= 512;
    if (r < 64) { cvt_mat_item(glw, 512, 512, 512, (bf16*)(ws + WS_GLU), 0, r, c.lane); continue; } r -= 64;
    cvt_mat_item(wout1, D, D, D, (bf16*)(ws + WS_WOUT1), 0, r, c.lane);
  }
}
__device__ __forceinline__ void cvt_moe(const Ctx& c, int vb, int vG, int part) {
  const float* mgp = inp(c, I1_MG); const float* mup = inp(c, I1_MU); const float* mdp = inp(c, I1_MDN);
  if (part == 0) {
    for (int it = c.wave * vG + vb; it < 8 * 1792; it += NW * vG) {
      const int e = it / 1792, r = it % 1792, which = r / 896, idx = r % 896;
      cvt_mat_item_f8((which ? mup : mgp) + (size_t)e * D * FE, D, FE, FE, c.ws + WS_MGU + (size_t)e * 2 * FE * D, 1 + which, idx, c.lane);
    }
  } else {
    for (int it = c.wave * vG + vb; it < 8 * 896; it += NW * vG) {
      const int e = it / 896, idx = it % 896;
      cvt_mat_item_f8(mdp + (size_t)e * FE * D, FE, D, D, c.ws + WS_MD + (size_t)e * D * FE, 0, idx, c.lane);
    }
  }
}


template <int YMODE, int PROJ>
__device__ __forceinline__ void norm_phase(const Ctx& c, const float* resin, float* resout, const float* Y, const float* gpost, const float* gpre, bf16* XN,
                                           const float* W8, int ldw8, int c0, float* out8) {
  float* w8s = (float*)c.lds;
  LAS unsigned* hist = (LAS unsigned*)(c.lds + 32768);
  if (PROJ) {
    for (int i = c.tid; i < 1024 * 8; i += NT) w8s[i] = W8[(size_t)(i >> 3) * ldw8 + c0 + (i & 7)];
    if (PROJ == 2 && c.tid < 8) hist[c.tid] = 0u;
    __syncthreads();
  }
  int* tok_e = (int*)(c.ws + WS_ROUTE); float* tok_g = (float*)(c.ws + WS_ROUTE + 128 * 1024);
  const int* tok_slot = (const int*)(c.ws + WS_ROUTE + 256 * 1024);
  const bf16* YS = (const bf16*)(c.ws + WS_YS);
  for (int m = c.wave * c.G + c.bid; m < M; m += NW * c.G) {
    f32x4 r[4];
#pragma unroll
    for (int j = 0; j < 4; ++j) r[j] = *(const f32x4*)(resin + (size_t)m * D + j * 256 + c.lane * 4);
    if (YMODE) {
      f32x4 y[4]; float ss = 0.f;
      if (YMODE == 1) {
#pragma unroll
        for (int j = 0; j < 4; ++j) y[j] = *(const f32x4*)(Y + (size_t)m * D + j * 256 + c.lane * 4);
      } else {
        const int s0 = tok_slot[2 * m], s1 = tok_slot[2 * m + 1]; const float g0 = tok_g[2 * m], g1 = tok_g[2 * m + 1];
#pragma unroll
        for (int j = 0; j < 4; ++j) {
          const uint2 a = *(const uint2*)(YS + (size_t)s0 * D + j * 256 + c.lane * 4), b = *(const uint2*)(YS + (size_t)s1 * D + j * 256 + c.lane * 4);
          y[j][0] = g0 * bf2f((bf16)(a.x & 0xffff)) + g1 * bf2f((bf16)(b.x & 0xffff));
          y[j][1] = g0 * bf2f((bf16)(a.x >> 16)) + g1 * bf2f((bf16)(b.x >> 16));
          y[j][2] = g0 * bf2f((bf16)(a.y & 0xffff)) + g1 * bf2f((bf16)(b.y & 0xffff));
          y[j][3] = g0 * bf2f((bf16)(a.y >> 16)) + g1 * bf2f((bf16)(b.y >> 16));
        }
      }
#pragma unroll
      for (int j = 0; j < 4; ++j) ss += y[j][0] * y[j][0] + y[j][1] * y[j][1] + y[j][2] * y[j][2] + y[j][3] * y[j][3];
      const float rs = rsqrtf(wave_sum(ss) * (1.f / D) + 1e-6f);
#pragma unroll
      for (int j = 0; j < 4; ++j) {
        const f32x4 g = *(const f32x4*)(gpost + j * 256 + c.lane * 4);
        r[j] = r[j] + y[j] * rs * g;
        *(f32x4*)(resout + (size_t)m * D + j * 256 + c.lane * 4) = r[j];
      }
    }
    if (gpre) {
      float ss = 0.f;
#pragma unroll
      for (int j = 0; j < 4; ++j) ss += r[j][0] * r[j][0] + r[j][1] * r[j][1] + r[j][2] * r[j][2] + r[j][3] * r[j][3];
      const float rs = rsqrtf(wave_sum(ss) * (1.f / D) + 1e-6f);
      float p8[8];
#pragma unroll
      for (int q = 0; q < 8; ++q) p8[q] = 0.f;
#pragma unroll
      for (int j = 0; j < 4; ++j) {
        const f32x4 g = *(const f32x4*)(gpre + j * 256 + c.lane * 4);
        const f32x4 xn = r[j] * rs * g;
        if (PROJ == 2) { *(unsigned*)(c.ws + WS_XN8 + (size_t)m * D + j * 256 + c.lane * 4) = mg::pk4_fp8(xn[0] * 16.f, xn[1] * 16.f, xn[2] * 16.f, xn[3] * 16.f); }
        else { uint2 o; o.x = (unsigned)f2bf(xn[0]) | ((unsigned)f2bf(xn[1]) << 16); o.y = (unsigned)f2bf(xn[2]) | ((unsigned)f2bf(xn[3]) << 16);
          *(uint2*)(XN + (size_t)m * D + j * 256 + c.lane * 4) = o; }
        if (PROJ) {
#pragma unroll
          for (int e = 0; e < 4; ++e) {
            const float* wr = w8s + (j * 256 + c.lane * 4 + e) * 8;
#pragma unroll
            for (int q = 0; q < 8; ++q) p8[q] += xn[e] * wr[q];
          }
        }
      }
      if (PROJ) {
#pragma unroll
        for (int q = 0; q < 8; ++q) p8[q] = wave_sum(p8[q]);
        if (PROJ == 1) { if (c.lane < 8) { float v = p8[0];
#pragma unroll
            for (int q = 1; q < 8; ++q) v = (c.lane == q) ? p8[q] : v;
            out8[(size_t)m * 8 + c.lane] = v; } }
        if (PROJ == 2 && c.lane == 0) {
          int e0 = 0; float v0 = p8[0];
#pragma unroll
          for (int q = 1; q < 8; ++q) if (p8[q] > v0) { v0 = p8[q]; e0 = q; }
          int e1 = -1; float v1 = -3.0e38f;
#pragma unroll
          for (int q = 0; q < 8; ++q) if (q != e0 && p8[q] > v1) { v1 = p8[q]; e1 = q; }
          const float g1 = 1.f / (1.f + expf(v0 - v1)), g0 = 1.f - g1;
          tok_e[2 * m] = e0; tok_e[2 * m + 1] = e1; tok_g[2 * m] = g0; tok_g[2 * m + 1] = g1;
          atomicAdd((unsigned*)&hist[e0], 1u); atomicAdd((unsigned*)&hist[e1], 1u);
        }
      }
    }
  }
  if (PROJ == 2) { __syncthreads(); if (c.tid < 8) atomicAdd(c.ctl + CW_CNT + 64 * c.tid, hist[c.tid]); }
  __syncthreads();
}

__device__ __forceinline__ void rwkv_prep_a(const Ctx& c) {
  const float* mu = inp(c, I0_MU);
  const bf16* P = (const bf16*)(c.ws + WS_P0); bf16* AL = (bf16*)(c.ws + WS_ALORA);
  const f32x4 mu4 = *(const f32x4*)(mu + 1536 + c.lane * 4);
  for (int m = c.wave * c.G + c.bid; m < M; m += NW * c.G) {
    const int t = m % SEQ;
    const uint2 cu = *(const uint2*)(P + (size_t)m * EVEN_IN + 1536 + c.lane * 4);
    uint2 pv = {0u, 0u}; if (t > 0) pv = *(const uint2*)(P + (size_t)(m - 1) * EVEN_IN + 1536 + c.lane * 4);
    const float cv[4] = {__uint_as_float(cu.x << 16), __uint_as_float(cu.x & 0xffff0000u), __uint_as_float(cu.y << 16), __uint_as_float(cu.y & 0xffff0000u)};
    const float pp[4] = {__uint_as_float(pv.x << 16), __uint_as_float(pv.x & 0xffff0000u), __uint_as_float(pv.y << 16), __uint_as_float(pv.y & 0xffff0000u)};
    float o[4];
#pragma unroll
    for (int e = 0; e < 4; ++e) { float v = cv[e] + (pp[e] - cv[e]) * mu4[e]; if (c.lane < 16) v = tanhf(v); else if (c.lane >= 32) v = sigmoid_(v); o[e] = v; }
    uint2 w; w.x = (unsigned)f2bf(o[0]) | ((unsigned)f2bf(o[1]) << 16); w.y = (unsigned)f2bf(o[2]) | ((unsigned)f2bf(o[3]) << 16);
    *(uint2*)(AL + (size_t)m * 256 + c.lane * 4) = w;
  }
}
__device__ __forceinline__ void build_wlora(const Ctx& c) {
  const float* w2 = inp(c, I0_W2); const float* a2 = inp(c, I0_A2); const float* g2 = inp(c, I0_G2);
  bf16* WL = (bf16*)(c.ws + WS_WLORA);
  for (int i = c.bid * NT + c.tid; i < 1536 * 256; i += c.G * NT) {
    const int n = i >> 8, k = i & 255; float v = 0.f;
    if (n < 512) { if (k < 64) v = w2[k * 512 + n]; }
    else if (n < 1024) { if (k >= 64 && k < 128) v = a2[(k - 64) * 512 + (n - 512)]; }
    else { if (k >= 128) v = g2[(k - 128) * 512 + (n - 1024)]; }
    WL[i] = f2bf(v);
  }
}
template <int CTRL> __device__ __forceinline__ float dpp_f(float v) { return __int_as_float(__builtin_amdgcn_update_dpp(0, __float_as_int(v), CTRL, 0xf, 0xf, true)); }
__device__ __forceinline__ float row16_sum(float v) { v += dpp_f<0xB1>(v); v += dpp_f<0x4E>(v); v += dpp_f<0x141>(v); v += dpp_f<0x140>(v); return v; }
constexpr size_t WS_YSC = WS_XN;
typedef short bf16x4 __attribute__((ext_vector_type(4)));
__device__ __forceinline__ bf16x4 pack4(f32x4 v) { union { uint2 u; bf16x4 b; } x; x.u.x = mg::cvt_pk_bf16(v[0], v[1]); x.u.y = mg::cvt_pk_bf16(v[2], v[3]); return x.b; }
__device__ __forceinline__ f32x4 mma16(bf16x4 p, bf16x4 q, f32x4 c) { return __builtin_amdgcn_mfma_f32_16x16x16bf16_1k(p, q, c, 0, 0, 0); }
__device__ __forceinline__ float wave_sum_fast(float v) { v = row16_sum(v); v += __shfl_xor(v, 16); v += __shfl_xor(v, 32); return v; }
constexpr int RK_SK = 72;
__device__ __forceinline__ void rwkv_chunk_prep(const Ctx& c) {
  const float* mu = inp(c, I0_MU); const float* w0 = inp(c, I0_W0); const float* a0 = inp(c, I0_A0);
  const float* kkp = inp(c, I0_KK); const float* kap = inp(c, I0_KA); const float* rkp = inp(c, I0_RK);
  const bf16* P = (const bf16*)(c.ws + WS_P0); const bf16* LW = (const bf16*)(c.ws + WS_LOWA);
  float* BON = (float*)(c.ws + WS_BON); unsigned char* CHK = c.ws + WS_CHK;
  bf16* wl = (bf16*)(c.lds + c.wave * 17408);
  bf16* sAt = wl, *sBh = wl + 1152, *sKh = wl + 2304, *sRt = wl + 3456;
  bf16* tAt = wl + 4608, *tRt = tAt + 1024, *tBp = tAt + 2048, *tKp = tAt + 3072;
  const int lane = c.lane, q = lane >> 4, lr = lane & 15;
  for (int unit = c.wave * c.G + c.bid; unit < BATCH * 8 * 128; unit += NW * c.G) {
    const int ck = unit & 127, bh = unit >> 7, h = bh & 7, b = bh >> 3, ch = h * 64 + lane;
    const size_t m0 = (size_t)b * SEQ + ck * 16;
    const float mur = mu[ch], muk = mu[512 + ch], muv = mu[1024 + ch], w0c = w0[ch], a0c = a0[ch], kkc = kkp[ch], kac = kap[ch], rkc = rkp[ch];
    float At[16], Bh[16], Kh[16], Rt[16], Vs[16];
    float rp = 0.f, kp = 0.f, vp = 0.f;
    if (ck > 0) { const bf16* pp = P + (m0 - 1) * EVEN_IN + ch; rp = bf2f(pp[0]); kp = bf2f(pp[512]); vp = bf2f(pp[1024]); }
    float lg = 0.f;
#pragma unroll
    for (int t = 0; t < 16; ++t) {
      const bf16* pc = P + (m0 + t) * EVEN_IN + ch;
      const float rc = bf2f(pc[0]), kc = bf2f(pc[512]), vc = bf2f(pc[1024]);
      const float r = rc + (rp - rc) * mur, k = kc + (kp - kc) * muk, v = vc + (vp - vc) * muv;
      rp = rc; kp = kc; vp = vc;
      const float aw = w0c + bf2f(LW[(m0 + t) * 1024 + ch]), aa = a0c + bf2f(LW[(m0 + t) * 1024 + 512 + ch]);
      const float lw = -__expf(-softplus_(-aw) - 0.5f);
      const float ag = sigmoid_(aa);
      float kk = k * kkc;
      kk = kk / fmaxf(sqrtf(wave_sum_fast(kk * kk)), 1e-12f);
      const float k2 = k * (1.f + (ag - 1.f) * kac);
      const float bon = wave_sum_fast(r * k2 * rkc);
      if (lane == 0) BON[(m0 + t) * 8 + h] = bon;
      const float gprev = __expf(lg); lg += lw; const float g = __expf(lg), gi = __expf(-lg);
      At[t] = -kk * gprev; Bh[t] = kk * ag * gi; Kh[t] = k2 * gi; Rt[t] = r * g; Vs[t] = v;
    }
    const float gL = __expf(lg);
    unsigned char* cb = CHK + (size_t)unit * CHB;
#pragma unroll
    for (int t = 0; t < 16; ++t) { sAt[t * RK_SK + lane] = f2bf(At[t]); sBh[t * RK_SK + lane] = f2bf(Bh[t]); sKh[t * RK_SK + lane] = f2bf(Kh[t]); sRt[t * RK_SK + lane] = f2bf(Rt[t]); }
    { mg::u32x4 o0, o1;
#define PK16(arr, sc) o0.x = mg::cvt_pk_bf16(arr[0] * sc, arr[1] * sc); o0.y = mg::cvt_pk_bf16(arr[2] * sc, arr[3] * sc); o0.z = mg::cvt_pk_bf16(arr[4] * sc, arr[5] * sc); o0.w = mg::cvt_pk_bf16(arr[6] * sc, arr[7] * sc); \
      o1.x = mg::cvt_pk_bf16(arr[8] * sc, arr[9] * sc); o1.y = mg::cvt_pk_bf16(arr[10] * sc, arr[11] * sc); o1.z = mg::cvt_pk_bf16(arr[12] * sc, arr[13] * sc); o1.w = mg::cvt_pk_bf16(arr[14] * sc, arr[15] * sc);
      PK16(At, 1.f) *(mg::u32x4*)(tAt + lane * 16) = o0; *(mg::u32x4*)(tAt + lane * 16 + 8) = o1;
      PK16(Rt, 1.f) *(mg::u32x4*)(tRt + lane * 16) = o0; *(mg::u32x4*)(tRt + lane * 16 + 8) = o1;
      PK16(Bh, gL) *(mg::u32x4*)(tBp + lane * 16) = o0; *(mg::u32x4*)(tBp + lane * 16 + 8) = o1;
      *(mg::u32x4*)(cb + 6656 + lane * 32) = o0; *(mg::u32x4*)(cb + 6656 + lane * 32 + 16) = o1;
      PK16(Kh, gL) *(mg::u32x4*)(tKp + lane * 16) = o0; *(mg::u32x4*)(tKp + lane * 16 + 8) = o1;
      PK16(Vs, 1.f) *(mg::u32x4*)(cb + 8704 + lane * 32) = o0; *(mg::u32x4*)(cb + 8704 + lane * 32 + 16) = o1;
#undef PK16
      *(float*)(cb + 10752 + lane * 4) = gL; }
    __builtin_amdgcn_s_waitcnt(0xc07f); __builtin_amdgcn_wave_barrier();
    mg::bf16x8 fAt[2], fBh[2], fKh[2], fRt[2];
#pragma unroll
    for (int ks = 0; ks < 2; ++ks) { fAt[ks] = *(const mg::bf16x8*)(sAt + lr * RK_SK + 32 * ks + 8 * q); fBh[ks] = *(const mg::bf16x8*)(sBh + lr * RK_SK + 32 * ks + 8 * q);
      fKh[ks] = *(const mg::bf16x8*)(sKh + lr * RK_SK + 32 * ks + 8 * q); fRt[ks] = *(const mg::bf16x8*)(sRt + lr * RK_SK + 32 * ks + 8 * q); }
    const f32x4 z4 = {0.f, 0.f, 0.f, 0.f};
    f32x4 nab = z4, nabT = z4, nak = z4, nakT = z4, mbr = z4, mkr = z4;
#pragma unroll
    for (int ks = 0; ks < 2; ++ks) {
      nab = __builtin_amdgcn_mfma_f32_16x16x32_bf16(fBh[ks], fAt[ks], nab, 0, 0, 0); nabT = __builtin_amdgcn_mfma_f32_16x16x32_bf16(fAt[ks], fBh[ks], nabT, 0, 0, 0);
      nak = __builtin_amdgcn_mfma_f32_16x16x32_bf16(fKh[ks], fAt[ks], nak, 0, 0, 0); nakT = __builtin_amdgcn_mfma_f32_16x16x32_bf16(fAt[ks], fKh[ks], nakT, 0, 0, 0);
      mbr = __builtin_amdgcn_mfma_f32_16x16x32_bf16(fBh[ks], fRt[ks], mbr, 0, 0, 0); mkr = __builtin_amdgcn_mfma_f32_16x16x32_bf16(fKh[ks], fRt[ks], mkr, 0, 0, 0);
    }
    f32x4 eye;
#pragma unroll
    for (int i = 0; i < 4; ++i) { const int row = 4 * q + i;
      eye[i] = (row == lr) ? 1.f : 0.f;
      nab[i] = (row < lr) ? nab[i] : 0.f; nak[i] = (row < lr) ? nak[i] : 0.f; nabT[i] = (lr < row) ? nabT[i] : 0.f; nakT[i] = (lr < row) ? nakT[i] : 0.f;
      mbr[i] = (row <= lr) ? mbr[i] : 0.f; mkr[i] = (row <= lr) ? mkr[i] : 0.f; }
    const bf16x4 dN = pack4(nab), dNT = pack4(nabT);
    const f32x4 n2 = mma16(dNT, dN, z4), nT2 = mma16(dN, dNT, z4);
    const bf16x4 dN2 = pack4(n2), dNT2 = pack4(nT2);
    const f32x4 n4 = mma16(dNT2, dN2, z4), nT4 = mma16(dN2, dNT2, z4);
    const bf16x4 dN4 = pack4(n4), dNT4 = pack4(nT4);
    const f32x4 nT8 = mma16(dN4, dNT4, z4);
    f32x4 Tm = nab + eye;
    Tm = mma16(pack4(nT2 + eye), pack4(Tm), z4);
    Tm = mma16(pack4(nT4 + eye), pack4(Tm), z4);
    Tm = mma16(pack4(nT8 + eye), pack4(Tm), z4);
    const bf16x4 dT = pack4(Tm), dEye = pack4(eye), dMbr = pack4(mbr), dNakT = pack4(nakT);
    const f32x4 w1 = mma16(dNakT, dT, z4);
    const f32x4 w1T = mma16(dT, dNakT, z4);
    const bf16x4 dW1T = pack4(w1T); (void)w1;
    const f32x4 w2 = mma16(dW1T, dMbr, mkr);
    *(bf16x4*)(cb + 4096 + lane * 8) = pack4(w2);
#pragma unroll
    for (int kt = 0; kt < 4; ++kt) {
      const bf16x4 atT = *(const bf16x4*)(tAt + (16 * kt + lr) * 16 + 4 * q);
      const bf16x4 rtT = *(const bf16x4*)(tRt + (16 * kt + lr) * 16 + 4 * q);
      const bf16x4 bpT = *(const bf16x4*)(tBp + (16 * kt + lr) * 16 + 4 * q);
      const bf16x4 kpT = *(const bf16x4*)(tKp + (16 * kt + lr) * 16 + 4 * q);
      const f32x4 ap = mma16(atT, dT, z4);
      const f32x4 apT = mma16(dT, atT, z4);
      f32x4 rpt = mma16(pack4(apT), dMbr, z4);
      rpt = mma16(rtT, dEye, rpt);
      f32x4 ht = mma16(dW1T, bpT, z4);
      ht = mma16(dEye, kpT, ht);
      *(bf16x4*)(cb + kt * 512 + lane * 8) = pack4(ap);
      *(bf16x4*)(cb + 2048 + kt * 512 + lane * 8) = pack4(rpt);
      *(bf16x4*)(cb + 4608 + kt * 512 + lane * 8) = pack4(ht);
    }
    __builtin_amdgcn_s_waitcnt(0xc07f); __builtin_amdgcn_wave_barrier();
  }
}
__device__ __forceinline__ void rwkv_chunk_scan(const Ctx& c) {
  const unsigned char* CHK = c.ws + WS_CHK; float* YO = (float*)(c.ws + WS_YSC);
  if (c.wave >= 4) return;
  const int lane = c.lane, q = lane >> 4, lr = lane & 15, w = c.wave;
  for (int bh = c.bid; bh < BATCH * 8; bh += c.G) {
    const int h = bh & 7, b = bh >> 3;
    f32x4 S[4];
#pragma unroll
    for (int kt = 0; kt < 4; ++kt) S[kt] = (f32x4){0.f, 0.f, 0.f, 0.f};
    bf16x4 nAp[4], nRp[4], nH[4], nBp[4], nW2, nV; f32x4 nG[4];
#define RK2_LOAD(cb_) do { const unsigned char* cb__ = (cb_); \
      _Pragma("unroll") for (int kt = 0; kt < 4; ++kt) { nAp[kt] = *(const bf16x4*)(cb__ + kt * 512 + lane * 8); nRp[kt] = *(const bf16x4*)(cb__ + 2048 + kt * 512 + lane * 8); \
        nH[kt] = *(const bf16x4*)(cb__ + 4608 + kt * 512 + lane * 8); nBp[kt] = *(const bf16x4*)(cb__ + 6656 + (16 * kt + lr) * 32 + 8 * q); nG[kt] = *(const f32x4*)(cb__ + 10752 + (16 * kt + 4 * q) * 4); } \
      nW2 = *(const bf16x4*)(cb__ + 4096 + lane * 8); nV = *(const bf16x4*)(cb__ + 8704 + (16 * w + lr) * 32 + 8 * q); } while (0)
    RK2_LOAD(CHK + (size_t)(bh * 128) * CHB);
    for (int ck = 0; ck < 128; ++ck) {
      bf16x4 Ap[4], Rp[4], Hd[4], Bp[4]; f32x4 G[4];
#pragma unroll
      for (int kt = 0; kt < 4; ++kt) { Ap[kt] = nAp[kt]; Rp[kt] = nRp[kt]; Hd[kt] = nH[kt]; Bp[kt] = nBp[kt]; G[kt] = nG[kt]; }
      const bf16x4 W2 = nW2, Vq = nV;
      if (ck + 1 < 128) RK2_LOAD(CHK + (size_t)(bh * 128 + ck + 1) * CHB);
      bf16x4 Sb[4];
#pragma unroll
      for (int kt = 0; kt < 4; ++kt) Sb[kt] = pack4(S[kt]);
      f32x4 x1 = {0.f, 0.f, 0.f, 0.f}, y = {0.f, 0.f, 0.f, 0.f};
#pragma unroll
      for (int kt = 0; kt < 4; ++kt) { x1 = mma16(Ap[kt], Sb[kt], x1); y = mma16(Rp[kt], Sb[kt], y); }
      y = mma16(W2, Vq, y);
      const bf16x4 X1b = pack4(x1);
#pragma unroll
      for (int kt = 0; kt < 4; ++kt) { S[kt] = S[kt] * G[kt]; S[kt] = mma16(Bp[kt], X1b, S[kt]); S[kt] = mma16(Hd[kt], Vq, S[kt]); }
      float* yo = YO + ((size_t)b * SEQ + ck * 16 + 4 * q) * 512 + h * 64 + 16 * w + lr;
#pragma unroll
      for (int i = 0; i < 4; ++i) yo[i * 512] = y[i];
    }
#undef RK2_LOAD
  }
}

__device__ __forceinline__ void rwkv_post(const Ctx& c) {
  const float* YS = (const float*)(c.ws + WS_YSC); const bf16* P = (const bf16*)(c.ws + WS_P0); const bf16* GG = (const bf16*)(c.ws + WS_LOG);
  const float* BON = (const float*)(c.ws + WS_BON); bf16* YM = (bf16*)(c.ws + WS_YMIX);
  const float* lnw = inp(c, I0_LNW); const float* lnb = inp(c, I0_LNB); const float* mu = inp(c, I0_MU);
  for (int m = c.wave * c.G + c.bid; m < M; m += NW * c.G) {
    const int t = m % SEQ;
#pragma unroll
    for (int j = 0; j < 8; ++j) {
      const int ch = j * 64 + c.lane; const size_t o = (size_t)m * 512 + ch;
      const float y = YS[o];
      const float mean = wave_sum(y) * (1.f / 64.f);
      const float d = y - mean;
      const float var = wave_sum(d * d) * (1.f / 64.f);
      float v = d * rsqrtf(var + 64e-5f) * lnw[ch] + lnb[ch];
      const float vc = bf2f(P[(size_t)m * EVEN_IN + 1024 + ch]), vp = t > 0 ? bf2f(P[(size_t)(m - 1) * EVEN_IN + 1024 + ch]) : 0.f;
      v += BON[(size_t)m * 8 + j] * (vc + (vp - vc) * mu[1024 + ch]);
      YM[(size_t)m * D + ch] = f2bf(v * bf2f(GG[(size_t)m * 1024 + ch]));
    }
  }
}

__device__ __forceinline__ void gmlp_phase(const Ctx& c, int vb, int vG) {
  const bf16* P = (const bf16*)(c.ws + WS_P0); bf16* YM = (bf16*)(c.ws + WS_YMIX);
  const float* lnw = inp(c, I0_GLNW); const float* lnb = inp(c, I0_GLNB); const float* ws = inp(c, I0_GWS); const float* bs = inp(c, I0_GBS);
  bf16* Ws = (bf16*)c.lds; bf16* VT = (bf16*)(c.lds + 34816);
  const int w = c.wave, q = c.lane >> 4, lr = c.lane & 15;
  int gcur = -1;
  for (int it = vb; it < BATCH * 16 * 4; it += vG) {
    const int g = it & 3, ck = (it >> 2) & 15, b = it >> 6;
    const size_t m0 = (size_t)b * SEQ + ck * 128;
    __syncthreads();
    if (g != gcur) { gcur = g;
#pragma unroll
      for (int k = 0; k < 8; ++k) { const int idx = c.tid + NT * k, i = idx >> 5, j4 = (idx & 31) * 4;
        const f32x4 v = *(const f32x4*)(ws + ((size_t)g * 128 + i) * 128 + j4);
        uint2 o; o.x = mg::cvt_pk_bf16(j4 <= i ? v[0] : 0.f, j4 + 1 <= i ? v[1] : 0.f); o.y = mg::cvt_pk_bf16(j4 + 2 <= i ? v[2] : 0.f, j4 + 3 <= i ? v[3] : 0.f);
        *(uint2*)(Ws + i * SPI + j4) = o; } }
    { const float w0 = lnw[g * 128 + c.lane], w1 = lnw[g * 128 + c.lane + 64], b0 = lnb[g * 128 + c.lane], b1 = lnb[g * 128 + c.lane + 64];
      for (int j = w; j < 128; j += NW) {
        const bf16* row = P + (m0 + j) * EVEN_IN + 2304 + g * 128;
        const float v0 = gelu_(bf2f(row[c.lane])), v1 = gelu_(bf2f(row[c.lane + 64]));
        const float mean = wave_sum(v0 + v1) * (1.f / 128.f);
        const float d0 = v0 - mean, d1 = v1 - mean;
        const float rs = rsqrtf(wave_sum(d0 * d0 + d1 * d1) * (1.f / 128.f) + 1e-6f);
        VT[c.lane * SPI + j] = f2bf(d0 * rs * w0 + b0);
        VT[(c.lane + 64) * SPI + j] = f2bf(d1 * rs * w1 + b1);
      } }
    __syncthreads();
    f32x4 acc[8];
#pragma unroll
    for (int dt = 0; dt < 8; ++dt) acc[dt] = (f32x4){0.f, 0.f, 0.f, 0.f};
    const int kmax = (16 * w + 15) >> 5;
    for (int ks = 0; ks <= kmax; ++ks) { const mg::bf16x8 wf = *(const mg::bf16x8*)(Ws + (16 * w + lr) * SPI + 32 * ks + 8 * q);
#pragma unroll
      for (int dt = 0; dt < 8; ++dt) { const mg::bf16x8 vf = *(const mg::bf16x8*)(VT + (16 * dt + lr) * SPI + 32 * ks + 8 * q); acc[dt] = __builtin_amdgcn_mfma_f32_16x16x32_bf16(wf, vf, acc[dt], 0, 0, 0); } }
#pragma unroll
    for (int i = 0; i < 4; ++i) { const int r = 16 * w + 4 * q + i; const float bias = bs[g * 128 + r];
      const bf16* up = P + (m0 + r) * EVEN_IN + 1792 + g * 128 + lr; bf16* op = YM + (m0 + r) * D + 512 + g * 128 + lr;
#pragma unroll
      for (int dt = 0; dt < 8; ++dt) op[16 * dt] = f2bf(gelu_(bf2f(up[16 * dt])) * (acc[dt][i] + bias));
      asm volatile("" ::: "memory"); }
  }
  __syncthreads();
}

__device__ __forceinline__ void s5_tables(const Ctx& c) {
  const float* are = inp(c, I1_ARE); const float* aim = inp(c, I1_AIM); const float* ldt = inp(c, I1_LDT); const float* bre = inp(c, I1_BRE); const float* bim = inp(c, I1_BIM);
  float* POW = (float*)(c.ws + WS_S5POW); float* BB = (float*)(c.ws + WS_S5BB);
  for (int i = c.bid * NT + c.tid; i < 32 * 17 * 64; i += c.G * NT) {
    const int p = i & 63, tau = (i >> 6) % 17, g = i / (17 * 64);
    const float lr = are[g * 64 + p], li = aim[g * 64 + p], dt = expf(ldt[g]);
    const float mag = expf(lr * dt * (float)tau), ang = li * dt * (float)tau;
    POW[2 * i] = mag * cosf(ang); POW[2 * i + 1] = mag * sinf(ang);
  }
  for (int i = c.bid * NT + c.tid; i < 32 * 64 * 16; i += c.G * NT) {
    const int gp = i >> 4, g = gp >> 6;
    const float lr = are[gp], li = aim[gp], dt = expf(ldt[g]);
    const float mag = expf(lr * dt), ar = mag * cosf(li * dt), ai = mag * sinf(li * dt);
    const float nr = ar - 1.f, ni = ai, den = lr * lr + li * li;
    const float fr = (nr * lr + ni * li) / den, fi = (ni * lr - nr * li) / den;
    const float br = bre[i], bi = bim[i];
    BB[2 * i] = fr * br - fi * bi; BB[2 * i + 1] = fr * bi + fi * br;
  }
}
__device__ __forceinline__ void s5_taps(const Ctx& c) {
  const float* cre = inp(c, I1_CRE); const float* cim = inp(c, I1_CIM);
  const float* POW = (const float*)(c.ws + WS_S5POW); const float* BB = (const float*)(c.ws + WS_S5BB); float* KT = (float*)(c.ws + WS_S5KT);
  for (int i = c.bid * NT + c.tid; i < 32 * 16 * 256; i += c.G * NT) {
    const int c2 = i & 15, c1 = (i >> 4) & 15, tau = (i >> 8) & 15, g = i >> 12;
    float acc = 0.f;
    for (int p = 0; p < 64; ++p) {
      const float cr = cre[(g * 16 + c1) * 64 + p], ci = cim[(g * 16 + c1) * 64 + p];
      const float pr = POW[((g * 17 + tau) * 64 + p) * 2], pi = POW[((g * 17 + tau) * 64 + p) * 2 + 1];
      const float br = BB[((g * 64 + p) * 16 + c2) * 2], bi = BB[((g * 64 + p) * 16 + c2) * 2 + 1];
      const float wr = cr * pr - ci * pi, wi = cr * pi + ci * pr;
      acc += wr * br - wi * bi;
    }
    KT[i] = acc;
  }
}
__device__ __forceinline__ void s5_mats(const Ctx& c) {
  const float* cre = inp(c, I1_CRE); const float* cim = inp(c, I1_CIM);
  const float* POW = (const float*)(c.ws + WS_S5POW); const float* BB = (const float*)(c.ws + WS_S5BB); const float* KT = (const float*)(c.ws + WS_S5KT);
  bf16* BE = (bf16*)(c.ws + WS_S5BE); bf16* BTF = (bf16*)(c.ws + WS_S5BTF);
  for (int i = c.bid * NT + c.tid; i < 32 * 256 * 256; i += c.G * NT) {
    const int k = i & 255, n = (i >> 8) & 255, g = i >> 16; float v = 0.f;
    if (n < 128) { const int p = n & 63, s16 = k >> 4, c2 = k & 15;
      const float pr = POW[((g * 17 + 15 - s16) * 64 + p) * 2], pi = POW[((g * 17 + 15 - s16) * 64 + p) * 2 + 1];
      const float br = BB[((g * 64 + p) * 16 + c2) * 2], bi = BB[((g * 64 + p) * 16 + c2) * 2 + 1];
      v = (n < 64) ? (pr * br - pi * bi) : (pr * bi + pi * br); }
    BE[i] = f2bf(v);
  }
  for (int i = c.bid * NT + c.tid; i < 32 * 256 * 384; i += c.G * NT) {
    const int k = i % 384, n = (i / 384) & 255, g = i / (384 * 256), t = n >> 4, c1 = n & 15; float v = 0.f;
    if (k < 256) { const int s16 = k >> 4, c2 = k & 15; if (s16 <= t) v = KT[((g * 16 + (t - s16)) * 16 + c1) * 16 + c2]; }
    else { const int kk = k - 256, p = kk & 63;
      const float cr = cre[(g * 16 + c1) * 64 + p], ci = cim[(g * 16 + c1) * 64 + p];
      const float pr = POW[((g * 17 + t + 1) * 64 + p) * 2], pi = POW[((g * 17 + t + 1) * 64 + p) * 2 + 1];
      v = (kk < 64) ? (cr * pr - ci * pi) : -(cr * pi + ci * pr); }
    BTF[i] = f2bf(v);
  }
}
__device__ __forceinline__ void s5_carry(const Ctx& c) {
  const float* XE = (const float*)(c.ws + WS_S5XE); bf16* AP = (bf16*)(c.ws + WS_S5A); const float* POW = (const float*)(c.ws + WS_S5POW);
  for (int it = c.wave * c.G + c.bid; it < BATCH * 32; it += NW * c.G) {
    const int b = it >> 5, g = it & 31, p = c.lane;
    const float ar = POW[((g * 17 + 16) * 64 + p) * 2], ai = POW[((g * 17 + 16) * 64 + p) * 2 + 1];
    float xr = 0.f, xi = 0.f;
    const size_t row0 = (size_t)g * 1024 + b * 128;
    for (int blk0 = 0; blk0 < 128; blk0 += 8) {
      float er[8], ei[8];
#pragma unroll
      for (int j = 0; j < 8; ++j) { er[j] = XE[(row0 + blk0 + j) * 128 + p]; ei[j] = XE[(row0 + blk0 + j) * 128 + 64 + p]; }
#pragma unroll
      for (int j = 0; j < 8; ++j) {
        bf16* ap = AP + (row0 + blk0 + j) * 384 + 256;
        ap[p] = f2bf(xr); ap[64 + p] = f2bf(xi);
        const float nr = ar * xr - ai * xi + er[j], ni = ar * xi + ai * xr + ei[j];
        xr = nr; xi = ni;
      }
    }
  }
}

__device__ __forceinline__ void ssd_conv(const Ctx& c) {
  const bf16* P1 = (const bf16*)(c.ws + WS_P1); bf16* CV = (bf16*)(c.ws + WS_CONV);
  const float* cw = inp(c, I1_CW); const float* cb = inp(c, I1_CB);
  for (size_t i = (size_t)c.bid * NT + c.tid; i < (size_t)M * 128; i += (size_t)c.G * NT) {
    const int ch = (int)(i & 127) * 8; const size_t m = i >> 7; const int t = (int)(m % SEQ);
    float acc[8];
#pragma unroll
    for (int e = 0; e < 8; ++e) acc[e] = cb[ch + e];
#pragma unroll
    for (int j = 0; j < 4; ++j) { const int tt = t - 3 + j; if (tt >= 0) {
        const uint4 v = *(const uint4*)(P1 + (m - 3 + j) * 2048 + 1024 + ch); const unsigned vw[4] = {v.x, v.y, v.z, v.w};
#pragma unroll
        for (int e = 0; e < 4; ++e) { acc[2 * e] += cw[j * 1024 + ch + 2 * e] * __uint_as_float(vw[e] << 16); acc[2 * e + 1] += cw[j * 1024 + ch + 2 * e + 1] * __uint_as_float(vw[e] & 0xffff0000u); } } }
    uint4 o; o.x = mg::cvt_pk_bf16(silu_(acc[0]), silu_(acc[1])); o.y = mg::cvt_pk_bf16(silu_(acc[2]), silu_(acc[3])); o.z = mg::cvt_pk_bf16(silu_(acc[4]), silu_(acc[5])); o.w = mg::cvt_pk_bf16(silu_(acc[6]), silu_(acc[7]));
    *(uint4*)(CV + m * 1024 + ch) = o;
  }
}

constexpr int SL_C = 0, SL_B = 34816, SL_BT = 69632, SL_XT = 104448, SL_DT = 121856, SL_ACS = 123904;
__device__ __forceinline__ void ssd_dt_acs(const Ctx& c, size_t m0, int g, const float* DT, const float* dtb, const float* alog, float* sdt, float* sacs) {
  if (c.wave < 4) {
    const int h = g * 4 + c.wave; const float av = -expf(alog[h]), bias = dtb[h];
    const float d0 = softplus_(DT[(m0 + 2 * c.lane) * 8 + h] + bias), d1 = softplus_(DT[(m0 + 2 * c.lane + 1) * 8 + h] + bias);
    const float a0 = av * d0, a1 = av * d1;
    float sc = a0 + a1;
#pragma unroll
    for (int o = 1; o < 64; o <<= 1) { const float t = __shfl_up(sc, o); if (c.lane >= o) sc += t; }
    sdt[c.wave * 128 + 2 * c.lane] = d0; sdt[c.wave * 128 + 2 * c.lane + 1] = d1;
    sacs[c.wave * 128 + 2 * c.lane] = sc - a1; sacs[c.wave * 128 + 2 * c.lane + 1] = sc;
  }
}
__device__ __forceinline__ void ssd_pass1(const Ctx& c) {
  const bf16* CV = (const bf16*)(c.ws + WS_CONV); const float* DT = (const float*)(c.ws + WS_DT);
  float* YD = (float*)(c.ws + WS_YD); float* SE = (float*)(c.ws + WS_SE); float* ATOT = (float*)(c.ws + WS_ATOT);
  const float* dtb = inp(c, I1_DTB); const float* alog = inp(c, I1_ALOG);
  bf16* Cs = (bf16*)(c.lds + SL_C); bf16* Bs = (bf16*)(c.lds + SL_B); bf16* BTs = (bf16*)(c.lds + SL_BT); bf16* XT = (bf16*)(c.lds + SL_XT);
  float* sdt = (float*)(c.lds + SL_DT); float* sacs = (float*)(c.lds + SL_ACS);
  const int w = c.wave, q = c.lane >> 4, lr = c.lane & 15;
  for (int unit = c.bid; unit < BATCH * 16 * 2; unit += c.G) {
    const int g = unit & 1, ck = (unit >> 1) & 15, b = unit >> 5;
    const size_t m0 = (size_t)b * SEQ + ck * 128;
    __syncthreads();
#pragma unroll
    for (int i = 0; i < 8; ++i) { const int idx = c.tid + NT * i, mat = idx >> 11, r = (idx >> 4) & 127, qq = idx & 15;
      const uint4 v = *(const uint4*)(CV + (m0 + r) * 1024 + 512 + mat * 256 + g * 128 + qq * 8);
      *(uint4*)((mat ? Cs : Bs) + r * SPI + qq * 8) = v; }
#pragma unroll
    for (int i = 0; i < 4; ++i) { const int task = c.tid + NT * i, n = task & 127, l0 = (task >> 7) * 8;
      unsigned short e[8];
#pragma unroll
      for (int j = 0; j < 8; ++j) e[j] = CV[(m0 + l0 + j) * 1024 + 512 + g * 128 + n];
      uint4 o; o.x = e[0] | ((unsigned)e[1] << 16); o.y = e[2] | ((unsigned)e[3] << 16); o.z = e[4] | ((unsigned)e[5] << 16); o.w = e[6] | ((unsigned)e[7] << 16);
      *(uint4*)(BTs + n * SPI + l0) = o; }
    ssd_dt_acs(c, m0, g, DT, dtb, alog, sdt, sacs);
    __syncthreads();
    mg::bf16x8 cf[4];
#pragma unroll
    for (int ks = 0; ks < 4; ++ks) cf[ks] = *(const mg::bf16x8*)(Cs + (16 * w + lr) * SPI + 32 * ks + 8 * q);
    f32x4 cb[8];
#pragma unroll
    for (int j = 0; j < 8; ++j) { cb[j] = (f32x4){0.f, 0.f, 0.f, 0.f};
#pragma unroll
      for (int ks = 0; ks < 4; ++ks) { const mg::bf16x8 bf = *(const mg::bf16x8*)(Bs + (16 * j + lr) * SPI + 32 * ks + 8 * q); cb[j] = __builtin_amdgcn_mfma_f32_16x16x32_bf16(cf[ks], bf, cb[j], 0, 0, 0); } }
    __syncthreads();
    bf16* Ms = Bs;
    for (int r = 0; r < 4; ++r) {
      const int h = g * 4 + r;
#pragma unroll
      for (int i = 0; i < 2; ++i) { const int task = c.tid + NT * i, p = task & 63, l0 = (task >> 6) * 8;
        unsigned short e[8];
#pragma unroll
        for (int j = 0; j < 8; ++j) e[j] = CV[(m0 + l0 + j) * 1024 + h * 64 + p];
        uint4 o; o.x = e[0] | ((unsigned)e[1] << 16); o.y = e[2] | ((unsigned)e[3] << 16); o.z = e[4] | ((unsigned)e[5] << 16); o.w = e[6] | ((unsigned)e[7] << 16);
        *(uint4*)(XT + p * SPI + l0) = o; }
      const float* ac = sacs + r * 128; const float* dl = sdt + r * 128;
#pragma unroll
      for (int j = 0; j < 8; ++j) { const int sidx = 16 * j + lr; const float as = ac[sidx], ds = dl[sidx];
#pragma unroll
        for (int i = 0; i < 4; ++i) { const int l = 16 * w + 4 * q + i;
          const float v = (sidx <= l) ? cb[j][i] * __expf(fminf(ac[l] - as, 0.f)) * ds : 0.f;
          Ms[l * SPI + sidx] = f2bf(v); } }
      __syncthreads();
      { f32x4 ya[4];
#pragma unroll
        for (int pt = 0; pt < 4; ++pt) ya[pt] = (f32x4){0.f, 0.f, 0.f, 0.f};
        const int kmax = (16 * w + 15) >> 5;
        for (int ks = 0; ks <= kmax; ++ks) { const mg::bf16x8 mf = *(const mg::bf16x8*)(Ms + (16 * w + lr) * SPI + 32 * ks + 8 * q);
#pragma unroll
          for (int pt = 0; pt < 4; ++pt) { const mg::bf16x8 xf = *(const mg::bf16x8*)(XT + (16 * pt + lr) * SPI + 32 * ks + 8 * q); ya[pt] = __builtin_amdgcn_mfma_f32_16x16x32_bf16(mf, xf, ya[pt], 0, 0, 0); } }
#pragma unroll
        for (int pt = 0; pt < 4; ++pt)
#pragma unroll
          for (int i = 0; i < 4; ++i) YD[(m0 + 16 * w + 4 * q + i) * 512 + h * 64 + 16 * pt + lr] = ya[pt][i]; }
      { const int pt = w & 3, ntb = (w >> 2) * 4; const float aend = ac[127];
        f32x4 sa[4];
#pragma unroll
        for (int nt = 0; nt < 4; ++nt) sa[nt] = (f32x4){0.f, 0.f, 0.f, 0.f};
#pragma unroll
        for (int ks = 0; ks < 4; ++ks) { const uint4 xr = *(const uint4*)(XT + (16 * pt + lr) * SPI + 32 * ks + 8 * q); const unsigned xw[4] = {xr.x, xr.y, xr.z, xr.w};
          float xv[8];
#pragma unroll
          for (int e = 0; e < 4; ++e) { const int l = 32 * ks + 8 * q + 2 * e;
            xv[2 * e] = __uint_as_float(xw[e] << 16) * dl[l] * __expf(aend - ac[l]); xv[2 * e + 1] = __uint_as_float(xw[e] & 0xffff0000u) * dl[l + 1] * __expf(aend - ac[l + 1]); }
          union { uint4 u; mg::bf16x8 v; } xs; xs.u.x = mg::cvt_pk_bf16(xv[0], xv[1]); xs.u.y = mg::cvt_pk_bf16(xv[2], xv[3]); xs.u.z = mg::cvt_pk_bf16(xv[4], xv[5]); xs.u.w = mg::cvt_pk_bf16(xv[6], xv[7]);
#pragma unroll
          for (int nt = 0; nt < 4; ++nt) { const mg::bf16x8 bt = *(const mg::bf16x8*)(BTs + (16 * (ntb + nt) + lr) * SPI + 32 * ks + 8 * q); sa[nt] = __builtin_amdgcn_mfma_f32_16x16x32_bf16(xs.v, bt, sa[nt], 0, 0, 0); } }
        float* Eo = SE + ((size_t)(b * 8 + h) * 16 + ck) * 8192;
#pragma unroll
        for (int nt = 0; nt < 4; ++nt)
#pragma unroll
          for (int i = 0; i < 4; ++i) Eo[(16 * pt + 4 * q + i) * 128 + 16 * (ntb + nt) + lr] = sa[nt][i];
        if (c.tid == 0) ATOT[(b * 8 + h) * 16 + ck] = aend; }
      __syncthreads();
    }
  }
  __syncthreads();
}
__device__ __forceinline__ void ssd_carry(const Ctx& c) {
  const float* SE = (const float*)(c.ws + WS_SE); const float* ATOT = (const float*)(c.ws + WS_ATOT); bf16* SPV = (bf16*)(c.ws + WS_SPV);
  for (int i = c.bid * NT + c.tid; i < BATCH * 8 * 2048; i += c.G * NT) {
    const int bh = i >> 11, e4 = (i & 2047) * 4;
    f32x4 S = {0.f, 0.f, 0.f, 0.f};
    for (int ck = 0; ck < 16; ++ck) {
      const size_t o = ((size_t)bh * 16 + ck) * 8192 + e4;
      uint2 pk; pk.x = mg::cvt_pk_bf16(S[0], S[1]); pk.y = mg::cvt_pk_bf16(S[2], S[3]);
      *(uint2*)(SPV + o) = pk;
      const float d = __expf(ATOT[bh * 16 + ck]); const f32x4 e = *(const f32x4*)(SE + o);
      S = S * d + e;
    }
  }
}
__device__ __forceinline__ void ssd_pass2(const Ctx& c) {
  const bf16* CV = (const bf16*)(c.ws + WS_CONV); const float* DT = (const float*)(c.ws + WS_DT); const bf16* P1 = (const bf16*)(c.ws + WS_P1);
  const float* YD = (const float*)(c.ws + WS_YD); const bf16* SPV = (const bf16*)(c.ws + WS_SPV); bf16* YM = (bf16*)(c.ws + WS_YMIX);
  const float* dtb = inp(c, I1_DTB); const float* alog = inp(c, I1_ALOG); const float* dsk = inp(c, I1_MD); const float* nw = inp(c, I1_MNW);
  bf16* Cs = (bf16*)(c.lds + SL_C); bf16* SPs = (bf16*)(c.lds + SL_B);
  float* sdt = (float*)(c.lds + SL_DT); float* sacs = (float*)(c.lds + SL_ACS);
  const int w = c.wave, q = c.lane >> 4, lr = c.lane & 15;
  for (int unit = c.bid; unit < BATCH * 16 * 2; unit += c.G) {
    const int g = unit & 1, ck = (unit >> 1) & 15, b = unit >> 5;
    const size_t m0 = (size_t)b * SEQ + ck * 128;
    __syncthreads();
#pragma unroll
    for (int i = 0; i < 4; ++i) { const int idx = c.tid + NT * i, r = idx >> 4, qq = idx & 15;
      *(uint4*)(Cs + r * SPI + qq * 8) = *(const uint4*)(CV + (m0 + r) * 1024 + 768 + g * 128 + qq * 8); }
#pragma unroll
    for (int i = 0; i < 8; ++i) { const int idx = c.tid + NT * i, r = idx >> 10, p = (idx >> 4) & 63, qq = idx & 15;
      *(uint4*)(SPs + (r * 64 + p) * SPI + qq * 8) = *(const uint4*)(SPV + ((size_t)(b * 8 + g * 4 + r) * 16 + ck) * 8192 + p * 128 + qq * 8); }
    ssd_dt_acs(c, m0, g, DT, dtb, alog, sdt, sacs);
    __syncthreads();
    mg::bf16x8 cf[4];
#pragma unroll
    for (int ks = 0; ks < 4; ++ks) cf[ks] = *(const mg::bf16x8*)(Cs + (16 * w + lr) * SPI + 32 * ks + 8 * q);
    f32x4 yo[4][4];
#pragma unroll
    for (int r = 0; r < 4; ++r)
#pragma unroll
      for (int pt = 0; pt < 4; ++pt) { yo[r][pt] = (f32x4){0.f, 0.f, 0.f, 0.f};
#pragma unroll
        for (int ks = 0; ks < 4; ++ks) { const mg::bf16x8 sf = *(const mg::bf16x8*)(SPs + (r * 64 + 16 * pt + lr) * SPI + 32 * ks + 8 * q); yo[r][pt] = __builtin_amdgcn_mfma_f32_16x16x32_bf16(cf[ks], sf, yo[r][pt], 0, 0, 0); } }
    float dh[4];
#pragma unroll
    for (int r = 0; r < 4; ++r) dh[r] = dsk[g * 4 + r];
    float ss[4];
#pragma unroll
    for (int i = 0; i < 4; ++i) {
      const int l = 16 * w + 4 * q + i; const size_t m = m0 + l;
      const float* ydp = YD + m * 512 + g * 256 + lr; const bf16* cvp = CV + m * 1024 + g * 256 + lr; const bf16* zp = P1 + m * 2048 + 512 + g * 256 + lr;
      float sq = 0.f;
#pragma unroll
      for (int r = 0; r < 4; ++r) { const float ea = __expf(sacs[r * 128 + l]);
#pragma unroll
        for (int pt = 0; pt < 4; ++pt) { const int o = r * 64 + 16 * pt;
          const float y = ydp[o] + ea * yo[r][pt][i] + dh[r] * bf2f(cvp[o]);
          const float vv = y * silu_(bf2f(zp[o]));
          yo[r][pt][i] = vv; sq += vv * vv; } }
      ss[i] = rsqrtf(row16_sum(sq) * (1.f / 256.f) + 1e-6f);
      asm volatile("" ::: "memory");
    }
#pragma unroll
    for (int i = 0; i < 4; ++i) { const int l = 16 * w + 4 * q + i;
      bf16* ymp = YM + (m0 + l) * D + 512 + g * 256 + lr; const float* nwp = nw + g * 256 + lr;
#pragma unroll
      for (int r = 0; r < 4; ++r)
#pragma unroll
        for (int pt = 0; pt < 4; ++pt) { const int o = r * 64 + 16 * pt; ymp[o] = f2bf(yo[r][pt][i] * ss[i] * nwp[o]); }
      asm volatile("" ::: "memory");
    }
  }
  __syncthreads();
}

__device__ __forceinline__ void moe_assign(const Ctx& c) {
  LAS unsigned* lcnt = (LAS unsigned*)c.lds; LAS unsigned* lbase = lcnt + 8;
  const int* tok_e = (const int*)(c.ws + WS_ROUTE); int* tok_slot = (int*)(c.ws + WS_ROUTE + 256 * 1024); int* slot_tok = (int*)(c.ctl + CW_SLOTTOK);
  int pstart[8]; { int acc = 0;
#pragma unroll
    for (int e = 0; e < 8; ++e) { pstart[e] = acc; acc += ((int)c.ctl[CW_CNT + 64 * e] + 255) / 256 * 256; } }
  for (int tb = c.bid; tb < M / 64; tb += c.G) {
    __syncthreads();
    if (c.tid < 8) lcnt[c.tid] = 0u;
    __syncthreads();
    int e = 0; unsigned rank = 0; const int pair = tb * 128 + c.tid;
    if (c.tid < 128) { e = tok_e[pair]; rank = atomicAdd((unsigned*)&lcnt[e], 1u); }
    __syncthreads();
    if (c.tid < 8) lbase[c.tid] = atomicAdd(c.ctl + CW_CUR + 64 * c.tid, lcnt[c.tid]);
    __syncthreads();
    if (c.tid < 128) {
      int ps = 0;
#pragma unroll
      for (int q = 0; q < 8; ++q) ps = (e == q) ? pstart[q] : ps;
      const int slot = ps + (int)lbase[e] + (int)rank;
      slot_tok[slot] = pair >> 1; tok_slot[pair] = slot;
    }
  }
  __syncthreads();
}


enum { PH_PRO, PH_WIN0, PH_PREPA, PH_LORA, PH_PREPC, PH_SCAN, PH_POST, PH_WOUT0, PH_NORM0, PH_FGU, PH_FD, PH_NORM1, PH_WIN1, PH_L1A, PH_L1B, PH_L1C, PH_L1D, PH_WOUT1, PH_NORM2, PH_ASSIGN, PH_MGU, PH_MD, PH_FINAL, PH_COUNT };
constexpr int LAST_PHASE = PH_COUNT;
template <int LO, int HI, int BREG = 0>
__global__ void __launch_bounds__(NT, 2) fwd_kernel(Args args) {
  extern __shared__ __attribute__((aligned(16))) unsigned char lds[];
  Ctx c0; c0.out = args.out; c0.ws = args.ws; c0.ctl = (unsigned*)(args.ws + WS_CTL); c0.lds = lds;
  c0.tid = threadIdx.x; c0.lane = c0.tid & 63; c0.wave = __builtin_amdgcn_readfirstlane(c0.tid >> 6); c0.bid = blockIdx.x; c0.G = gridDim.x;
  volatile LAS unsigned* bst = (volatile LAS unsigned*)(LAS unsigned char*)(lds + LDS_BST);
  if (c0.tid == 0) { LAS unsigned long long* pt = (LAS unsigned long long*)(LAS unsigned char*)(lds + LDS_PTAB);
#pragma unroll
    for (int i = 0; i < N_IN; ++i) pt[i] = (unsigned long long)args.in[i];
    bst[0] = 0u; bst[1] = 0u; }
  __syncthreads();
  constexpr int lo = LO, hi = HI;
  if constexpr (hi - lo > 1) (void)xcd_barrier_post(c0.ctl + CW_BAR + BREG * 4096, bst);
#define IN(k) (lo <= (k) && (k) < hi)
#define SEAM(k) do { if constexpr (IN(k) && IN((k) + 1)) { XcdBarrier bar_; bar_.bar = (unsigned*)(args.ws + WS_CTL) + CW_BAR + BREG * 4096; bar_.x = xb_xcc_id(); \
    bar_.st = (volatile LAS unsigned*)(LAS unsigned char*)(lds + LDS_BST); xcd_barrier(bar_); } } while (0)

  LAS unsigned char* const ldsl = (LAS unsigned char*)lds;
  if constexpr (IN(PH_PRO)) { const Ctx c = launder(c0); cvt_dense(c); build_wlora(c); s5_tables(c); norm_phase<0, 0>(c, inp(c, I_X), nullptr, nullptr, nullptr, inp(c, I0_NPM), ((bf16*)(c.ws + WS_XN)), nullptr, 0, 0, nullptr); } SEAM(PH_PRO);
  if constexpr (IN(PH_WIN0)) { const Ctx c = launder(c0); s5_taps(c); mg::Gemm g{((bf16*)(c.ws + WS_XN)), (const bf16*)(c.ws + WS_WIN0), D, D, D}; mg::DenseOrder S; S.init(M / 256, EVEN_IN / 256, c.G, c.bid);
    mg::EpiBf16<false> E{(bf16*)(c.ws + WS_P0), EVEN_IN}; mg::gemm_phase(ldsl, g, S, E); } SEAM(PH_WIN0);
  if constexpr (IN(PH_PREPA)) { const Ctx c = launder(c0); rwkv_prep_a(c); } SEAM(PH_PREPA);
  if constexpr (IN(PH_LORA)) { const Ctx c = launder(c0); mg::Gemm g{(const bf16*)(c.ws + WS_ALORA), (const bf16*)(c.ws + WS_WLORA), 256, 256, 256}; mg::DenseOrder S; S.init(M / 256, 1536 / 256, c.G, c.bid);
    mg::EpiLora E{(bf16*)(c.ws + WS_LOWA), (bf16*)(c.ws + WS_LOG)}; mg::gemm_phase(ldsl, g, S, E); } SEAM(PH_LORA);
  if constexpr (IN(PH_PREPC)) { const Ctx c = launder(c0); rwkv_chunk_prep(c); } SEAM(PH_PREPC);
  if constexpr (IN(PH_SCAN)) { const Ctx c = launder(c0); if (c.G >= 256) { if (c.bid < 64) rwkv_chunk_scan(c); else gmlp_phase(c, c.bid - 64, c.G - 64); } else { rwkv_chunk_scan(c); gmlp_phase(c, c.bid, c.G); } } SEAM(PH_SCAN);
  if constexpr (IN(PH_POST)) { const Ctx c = launder(c0); rwkv_post(c); } SEAM(PH_POST);
  if constexpr (IN(PH_WOUT0)) { const Ctx c = launder(c0); mg::Gemm g{((bf16*)(c.ws + WS_YMIX)), (const bf16*)(c.ws + WS_WOUT0), D, D, D}; mg::DenseOrder S; S.init(M / 256, D / 256, c.G, c.bid);
    mg::EpiF32 E{((float*)(c.ws + WS_Y)), D}; mg::gemm_phase(ldsl, g, S, E); } SEAM(PH_WOUT0);
  if constexpr (IN(PH_NORM0)) { const Ctx c = launder(c0); norm_phase<1, 0>(c, inp(c, I_X), args.out, ((float*)(c.ws + WS_Y)), inp(c, I0_NPOM), inp(c, I0_NPF), ((bf16*)(c.ws + WS_XN)), nullptr, 0, 0, nullptr); } SEAM(PH_NORM0);
  if constexpr (IN(PH_FGU)) { const Ctx c = launder(c0); mg::Gemm g{((bf16*)(c.ws + WS_XN)), (const bf16*)(c.ws + WS_FGU), D, D, D}; mg::DenseOrder S; S.init(M / 256, 2 * FFN / 256, c.G, c.bid);
    mg::EpiSwigluT E{(bf16*)(c.ws + WS_H), FFN}; mg::gemm_phase(ldsl, g, S, E); } SEAM(PH_FGU);
  if constexpr (IN(PH_FD)) { const Ctx c = launder(c0); mg::Gemm g{(const bf16*)(c.ws + WS_H), (const bf16*)(c.ws + WS_FD), FFN, FFN, FFN}; mg::DenseOrder S; S.init(M / 256, D / 256, c.G, c.bid);
    mg::EpiF32 E{((float*)(c.ws + WS_Y)), D}; mg::gemm_phase(ldsl, g, S, E); } SEAM(PH_FD);
  if constexpr (IN(PH_NORM1)) { const Ctx c = launder(c0); s5_mats(c); norm_phase<1, 1>(c, args.out, args.out, ((float*)(c.ws + WS_Y)), inp(c, I0_NPOF), inp(c, I1_NPM), ((bf16*)(c.ws + WS_XN)), inp(c, I1_WIN), ODD_IN, 2048, (float*)(c.ws + WS_DT)); } SEAM(PH_NORM1);
  if constexpr (IN(PH_WIN1)) { const Ctx c = launder(c0); mg::Gemm g{((bf16*)(c.ws + WS_XN)), (const bf16*)(c.ws + WS_WIN1), D, D, D}; mg::DenseOrder S; S.init(M / 256, 2048 / 256, c.G, c.bid);
    mg::EpiP1 E{(bf16*)(c.ws + WS_P1), (bf16*)(c.ws + WS_S5A)}; mg::gemm_phase(ldsl, g, S, E); } SEAM(PH_WIN1);
  if constexpr (IN(PH_L1A)) { const Ctx c = launder(c0);
    { mg::Gemm g{(const bf16*)(c.ws + WS_S5A), (const bf16*)(c.ws + WS_S5BE), 384, 256, 256}; mg::S5Order S; S.G = c.G; S.c = c.bid; mg::EpiS5E E{(float*)(c.ws + WS_S5XE)}; mg::gemm_phase(ldsl, g, S, E); }
    ssd_conv(c); cvt_moe(c, c.bid, c.G, 0); } SEAM(PH_L1A);
  if constexpr (IN(PH_L1B)) { const Ctx c = launder(c0); s5_carry(c); ssd_pass1(c); } SEAM(PH_L1B);
  if constexpr (IN(PH_L1C)) { const Ctx c = launder(c0);
    { mg::Gemm g{(const bf16*)(c.ws + WS_S5A), (const bf16*)(c.ws + WS_S5BTF), 384, 384, 384}; mg::S5Order S; S.G = c.G; S.c = c.bid; mg::EpiS5Y E{(bf16*)(c.ws + WS_YC), (const bf16*)(c.ws + WS_S5A), inp(c, I1_SD)}; mg::gemm_phase(ldsl, g, S, E); }
    ssd_carry(c); } SEAM(PH_L1C);
  if constexpr (IN(PH_L1D)) { const Ctx c = launder(c0);
    { mg::Gemm g{(const bf16*)(c.ws + WS_YC), (const bf16*)(c.ws + WS_GLU), 512, 512, 512}; mg::DenseOrder S; S.init(M / 256, 512 / 256, c.G, c.bid);
      mg::EpiGluT E{((bf16*)(c.ws + WS_YMIX)), D, (const bf16*)(c.ws + WS_YC), inp(c, I1_GLB)}; mg::gemm_phase(ldsl, g, S, E); }
    ssd_pass2(c); cvt_moe(c, c.bid, c.G, 1); } SEAM(PH_L1D);
  if constexpr (IN(PH_WOUT1)) { const Ctx c = launder(c0); mg::Gemm g{((bf16*)(c.ws + WS_YMIX)), (const bf16*)(c.ws + WS_WOUT1), D, D, D}; mg::DenseOrder S; S.init(M / 256, D / 256, c.G, c.bid);
    mg::EpiF32 E{((float*)(c.ws + WS_Y)), D}; mg::gemm_phase(ldsl, g, S, E); } SEAM(PH_WOUT1);
  if constexpr (IN(PH_NORM2)) { const Ctx c = launder(c0); norm_phase<1, 2>(c, args.out, args.out, ((float*)(c.ws + WS_Y)), inp(c, I1_NPOM), inp(c, I1_NPF), ((bf16*)(c.ws + WS_XN)), inp(c, I1_RT), 8, 0, nullptr); } SEAM(PH_NORM2);
  if constexpr (IN(PH_ASSIGN)) { const Ctx c = launder(c0); moe_assign(c); } SEAM(PH_ASSIGN);
#define MOE_SCHED(S, nn, bse, bof) do { int acc_ = 0; \
    _Pragma("unroll") for (int e = 0; e < 8; ++e) { acc_ += ((int)c.ctl[CW_CNT + 64 * e] + 255) / 256 * 256; S.pend[e] = acc_; } \
    S.init(acc_ / 256, nn, c.G, c.bid); S.bstride_e = (bse); S.boff = (bof); S.rowidx = (const int*)(c.ctl + CW_SLOTTOK); } while (0)
  if constexpr (IN(PH_MGU)) { const Ctx c = launder(c0); mg::Gemm g{(const bf16*)(c.ws + WS_XN8), (const bf16*)(c.ws + WS_MGU), D, D, D}; mg::MoeOrder<true, true> S; MOE_SCHED(S, FE / 128, (size_t)2 * FE * D, 0);
    mg::EpiSwigluF8 E{c.ws + WS_HID, FE}; mg::gemm_phase(ldsl, g, S, E); } SEAM(PH_MGU);
  if constexpr (IN(PH_MD)) { const Ctx c = launder(c0); mg::Gemm g{(const bf16*)(c.ws + WS_HID), (const bf16*)(c.ws + WS_MD), FE, FE, FE}; mg::MoeOrder<false, true> S; MOE_SCHED(S, D / 256, (size_t)D * FE, 0);
    mg::EpiBf16S E{(bf16*)(c.ws + WS_YS), D, 1.f / 2048.f}; mg::gemm_phase(ldsl, g, S, E); } SEAM(PH_MD);
  if constexpr (IN(PH_FINAL)) { const Ctx c = launder(c0); norm_phase<2, 0>(c, args.out, args.out, nullptr, inp(c, I1_NPOF), nullptr, nullptr, nullptr, 0, 0, nullptr); }
#undef MOE_SCHED
#undef IN
#undef SEAM
}

template <int P> static void launch_one(const Args& a, hipStream_t stream) { hipLaunchKernelGGL((fwd_kernel<P, P + 1>), dim3(256), dim3(NT), LDS_BYTES, stream, a); }
template <int P> static bool set_attr_one() { return hipFuncSetAttribute((const void*)fwd_kernel<P, P + 1>, hipFuncAttributeMaxDynamicSharedMemorySize, LDS_BYTES) == hipSuccess; }
template <int... Ps> static void launch_all(const Args& a, hipStream_t stream, std::integer_sequence<int, Ps...>) { (launch_one<Ps>(a, stream), ...); }
template <int... Ps> static bool set_attr_all(std::integer_sequence<int, Ps...>) { return (set_attr_one<Ps>() && ...); }

extern "C" void kernel_launch(void* const* d_in, const int* in_sizes, int n_in, void* d_out, int out_size, void* d_ws, size_t ws_size, hipStream_t stream) {
  static int ready = 0;
  if (!ready) {
    bool ok = true;
    if (n_in != N_IN || out_size != M * D || ws_size < WS_END) { fprintf(stderr, "kernel_launch: unexpected problem: n_in %d out %d ws %zu (need %zu)\n", n_in, out_size, ws_size, (size_t)WS_END); ok = false; }
#if PROBE_PHASE >= 0
    if (ok && (hipFuncSetAttribute((const void*)fwd_kernel<0, PROBE_PHASE + 1, 0>, hipFuncAttributeMaxDynamicSharedMemorySize, LDS_BYTES) != hipSuccess ||
               hipFuncSetAttribute((const void*)fwd_kernel<PROBE_PHASE, PROBE_PHASE + 1, 1>, hipFuncAttributeMaxDynamicSharedMemorySize, LDS_BYTES) != hipSuccess ||
               hipFuncSetAttribute((const void*)fwd_kernel<PROBE_PHASE + 1, LAST_PHASE, 2>, hipFuncAttributeMaxDynamicSharedMemorySize, LDS_BYTES) != hipSuccess)) ok = false;
#elif ONE_LAUNCH
    if (ok && hipFuncSetAttribute((const void*)fwd_kernel<0, LAST_PHASE>, hipFuncAttributeMaxDynamicSharedMemorySize, LDS_BYTES) != hipSuccess) ok = false;
#else
    if (ok && !set_attr_all(std::make_integer_sequence<int, LAST_PHASE>{})) ok = false;
#endif
    if (!ok) fprintf(stderr, "kernel_launch: setup failed\n");
    ready = ok ? 1 : -1;
  }
  if (ready < 0) return;
  (void)hipMemsetAsync((char*)d_ws + WS_CTL, 0, CTL_BYTES, stream);
  Args a{};
  for (int i = 0; i < N_IN; ++i) a.in[i] = (const float*)d_in[i];
  a.out = (float*)d_out; a.ws = (unsigned char*)d_ws;
#if PROBE_PHASE >= 0
  hipLaunchKernelGGL((fwd_kernel<0, PROBE_PHASE + 1, 0>), dim3(256), dim3(NT), LDS_BYTES, stream, a);
  hipLaunchKernelGGL((fwd_kernel<PROBE_PHASE, PROBE_PHASE + 1, 1>), dim3(256), dim3(NT), LDS_BYTES, stream, a);
  hipLaunchKernelGGL((fwd_kernel<PROBE_PHASE + 1, LAST_PHASE, 2>), dim3(256), dim3(NT), LDS_BYTES, stream, a);
#elif ONE_LAUNCH
  hipLaunchKernelGGL((fwd_kernel<0, LAST_PHASE>), dim3(256), dim3(NT), LDS_BYTES, stream, a);
#else
  launch_all(a, stream, std::make_integer_sequence<int, LAST_PHASE>{});
#endif
}
```

```cpp
#include <hip/hip_runtime.h>
#include <stdint.h>
#include <stdio.h>
#include <utility>

#ifndef PROBE_PHASE
#define PROBE_PHASE -1
#endif
#ifndef ONE_LAUNCH
#define ONE_LAUNCH 1
#endif

constexpr int D = 1024, BATCH = 8, SEQ = 2048, M = BATCH * SEQ;
constexpr int A_W = 512, A_IN = 1792, EVEN_IN = 2816, FFN = 2816;
constexpr int ODD_IN = 2056, NE = 8, FE = 3584;
constexpr int MAXSLOT = 2 * M + NE * 256;
constexpr int NT = 512, NW = 8;

typedef unsigned short bf16;
typedef float f32x4 __attribute__((ext_vector_type(4)));
#define LAS __attribute__((address_space(3)))

enum {
  I_X = 0,
  I0_NPM, I0_WIN, I0_MU, I0_W0, I0_W2, I0_A0, I0_A2, I0_G2, I0_KK, I0_KA, I0_RK, I0_LNW, I0_LNB,
  I0_GLNW, I0_GLNB, I0_GWS, I0_GBS, I0_WOUT, I0_NPOM, I0_NPF, I0_FG, I0_FU, I0_FD, I0_NPOF,
  I1_NPM, I1_WIN, I1_ARE, I1_AIM, I1_LDT, I1_BRE, I1_BIM, I1_CRE, I1_CIM, I1_SD, I1_GLW, I1_GLB,
  I1_CW, I1_CB, I1_DTB, I1_ALOG, I1_MD, I1_MNW, I1_WOUT, I1_NPOM, I1_NPF, I1_RT, I1_MG, I1_MU, I1_MDN, I1_NPOF,
  N_IN
};
static_assert(N_IN == 51, "input count");

constexpr size_t MiB = 1ull << 20;
constexpr size_t WS_CTL = 0, CTL_BYTES = 1 * MiB;
constexpr size_t KiB = 1024;
constexpr size_t WS_WIN0 = 1 * MiB;
constexpr size_t WS_WOUT0 = WS_WIN0 + 5632 * KiB;
constexpr size_t WS_FGU = WS_WOUT0 + 2048 * KiB;
constexpr size_t WS_FD = WS_FGU + 11264 * KiB;
constexpr size_t WS_WIN1 = WS_FD + 5632 * KiB;
constexpr size_t WS_GLU = WS_WIN1 + 4096 * KiB;
constexpr size_t WS_WOUT1 = WS_GLU + 512 * KiB;
constexpr size_t WS_WLORA = WS_WOUT1 + 2048 * KiB;
constexpr size_t WS_DENSE_END = WS_WLORA + 768 * KiB;
constexpr size_t WS_MGU = 33 * MiB;
constexpr size_t WS_MD = 145 * MiB;
constexpr size_t WS_XN = 201 * MiB;
constexpr size_t WS_YMIX = 233 * MiB;
constexpr size_t WS_Y = 265 * MiB;
constexpr size_t WS_BIG = 329 * MiB;
constexpr size_t WS_P0 = WS_BIG;
constexpr size_t WS_SR = WS_MGU;
constexpr size_t WS_SW = WS_SR + 32 * MiB, WS_SK = WS_SW + 32 * MiB, WS_SV = WS_SK + 32 * MiB, WS_SA = WS_SV + 32 * MiB, WS_SB = WS_Y;
constexpr size_t WS_LOG = WS_P0 + 88 * MiB;
constexpr size_t WS_BON = WS_LOG + 32 * MiB;
constexpr size_t WS_L0END = WS_BON + 1 * MiB;
constexpr size_t WS_CHK = WS_MGU;
constexpr int CHB = 11264;
constexpr size_t WS_ALORA = WS_MGU + 160 * MiB;
constexpr size_t WS_LOWA = WS_XN;
static_assert(WS_DENSE_END <= WS_MGU && WS_ALORA + 8 * MiB <= WS_XN, "lora buffers");
static_assert(WS_SA + 32 * MiB <= WS_XN && WS_CHK + (size_t)BATCH * 8 * 128 * CHB <= WS_ALORA, "streams / chunk operators inside the MoE weight region");
constexpr size_t WS_H = WS_BIG;
constexpr size_t WS_P1 = WS_BIG;
constexpr size_t WS_DT = WS_P1 + 64 * MiB;
constexpr size_t WS_S5A = WS_YMIX;
constexpr size_t WS_S5XE = WS_XN;
constexpr size_t WS_S5BE = WS_MD;
constexpr size_t WS_S5BTF = WS_MD + 4 * MiB;
constexpr size_t WS_S5POW = WS_BIG + 129 * MiB;
constexpr size_t WS_S5BB = WS_S5POW + 320 * KiB;
constexpr size_t WS_S5KT = WS_S5BB + 320 * KiB;
constexpr size_t WS_ATOT = WS_DT + 768 * KiB;
constexpr size_t WS_CONV = WS_DT + 1 * MiB;
constexpr size_t WS_YD = WS_CONV + 32 * MiB;
constexpr size_t WS_YC = WS_Y;
constexpr size_t WS_SE = WS_Y + 16 * MiB;
constexpr size_t WS_SPV = WS_SE + 32 * MiB;
constexpr size_t WS_HID = WS_BIG;
constexpr size_t WS_XN8 = 176 * MiB;
constexpr size_t WS_YS = WS_YMIX;
constexpr size_t WS_ROUTE = WS_BIG + 120 * MiB;
constexpr size_t WS_END = 462 * MiB;
static_assert(WS_S5KT + 512 * KiB <= WS_END && WS_L0END <= WS_S5POW && WS_L0END <= WS_END && WS_YD + 32 * MiB <= WS_END && WS_ROUTE + 1 * MiB <= WS_END && WS_SPV + 16 * MiB <= WS_BIG, "workspace map");
static_assert((size_t)MAXSLOT * FE <= 120 * MiB && (size_t)MAXSLOT * D * 2 <= 96 * MiB && WS_MD + (size_t)8 * D * FE <= WS_XN8 && WS_MGU + (size_t)8 * 2 * FE * D <= WS_MD, "moe buffers");
constexpr int CW_BAR = 16384;
constexpr int CW_CNT = 8192;
constexpr int CW_CUR = 8192 + 64 * 8;
constexpr int CW_SLOTTOK = 65536;
static_assert((CW_SLOTTOK + MAXSLOT) * 4 <= (int)CTL_BYTES, "ctl");

constexpr int SPI = 136;
constexpr int LDS_BYTES = 147456;

__device__ __forceinline__ float bf2f(bf16 v) { return __uint_as_float(((unsigned)v) << 16); }
__device__ __forceinline__ bf16 f2bf(float f) { unsigned u = __float_as_uint(f); u += 0x7fffu + ((u >> 16) & 1u); return (bf16)(u >> 16); }
template <int CTRL> __device__ __forceinline__ float dpp_f(float v) { return __int_as_float(__builtin_amdgcn_update_dpp(0, __float_as_int(v), CTRL, 0xf, 0xf, true)); }
__device__ __forceinline__ float row16_sum(float v) { v += dpp_f<0xB1>(v); v += dpp_f<0x4E>(v); v += dpp_f<0x141>(v); v += dpp_f<0x140>(v); return v; }
__device__ __forceinline__ float wave_sum(float v) { v = row16_sum(v); v += __shfl_xor(v, 16); v += __shfl_xor(v, 32); return v; }
__device__ __forceinline__ float sigmoid_(float x) { return 1.f / (1.f + expf(-x)); }
__device__ __forceinline__ float silu_(float x) { return x / (1.f + expf(-x)); }
__device__ __forceinline__ float gelu_(float x) { const float u = 0.7978845608028654f * (x + 0.044715f * x * x * x); return 0.5f * x * (1.f + tanhf(u)); }
__device__ __forceinline__ float softplus_(float x) { return fmaxf(x, 0.f) + log1pf(expf(-fabsf(x))); }

#define XB_TMO      128
#define XB_XCNT(j)  (256  + 64 * (j))
#define XB_XSUB(j)  (1280 + 64 * (j))
#define XB_XGEN(j)  (2304 + 64 * (j))
#define XB_TOP      3328
#define XB_TOPGEN   3392
#define XCD_BAR_WORDS 3456
#define XB_SPIN_CAP (1u << 22)

__device__ __forceinline__ unsigned xb_ld(unsigned* p)              { return __hip_atomic_load(p, __ATOMIC_RELAXED, __HIP_MEMORY_SCOPE_AGENT); }
__device__ __forceinline__ unsigned xb_add(unsigned* p, unsigned v) { return __hip_atomic_fetch_add(p, v, __ATOMIC_RELAXED, __HIP_MEMORY_SCOPE_AGENT); }
__device__ __forceinline__ unsigned xb_xcc_id() { return (unsigned)__builtin_amdgcn_s_getreg((3 << 11) | 20) & 0xFu; }
#define XB_SPIN(cond, bar) do { unsigned _sp = 0; while (cond) { __builtin_amdgcn_s_sleep(1); \
    if ((++_sp & 255u) == 0u) { if (xb_ld(&(bar)[XB_TMO])) break; if (_sp > XB_SPIN_CAP) { atomicAdd(&(bar)[XB_TMO], 1u); break; } } } } while (0)

struct XcdBarrier { unsigned* bar; unsigned x; volatile LAS unsigned* st; };

__device__ __forceinline__ XcdBarrier xcd_barrier_post(unsigned* bar, volatile LAS unsigned* st) {
    XcdBarrier b; b.bar = bar; b.x = xb_xcc_id(); b.st = st;
    if (threadIdx.x == 0) (void)xb_add(&bar[XB_XCNT(b.x)], 1u);
    return b;
}
__device__ __forceinline__ void xcd_barrier_complete(unsigned* bar, unsigned x, unsigned& nloc, unsigned& nx) {
    const unsigned G = gridDim.x * gridDim.y * gridDim.z;
    unsigned sum, cnt, mine, sp = 0u;
    for (;;) {
        sum = 0u; cnt = 0u; mine = 0u;
#pragma unroll
        for (unsigned j = 0; j < 16; ++j) { const unsigned c = xb_ld(&bar[XB_XCNT(j)]); sum += c; cnt += (c > 0u) ? 1u : 0u; mine = (j == x) ? c : mine; }
        if (sum == G) break;
        __builtin_amdgcn_s_sleep(1);
        if ((++sp & 255u) == 0u) { if (xb_ld(&bar[XB_TMO])) break; if (sp > XB_SPIN_CAP) { atomicAdd(&bar[XB_TMO], 1u); break; } }
    }
    nloc = mine > 0u ? mine : 1u; nx = cnt > 0u ? cnt : 1u;
}
__device__ __forceinline__ void xcd_barrier(const XcdBarrier& b) {
    asm volatile("s_waitcnt vmcnt(0)" ::: "memory");
    __syncthreads();
    if (threadIdx.x == 0) {
        unsigned* bar = b.bar;
        __builtin_amdgcn_s_waitcnt(0);
        unsigned nloc = b.st[0], nx = b.st[1];
        if (nloc == 0u) { xcd_barrier_complete(bar, b.x, nloc, nx); b.st[0] = nloc; b.st[1] = nx; }
        const unsigned old = xb_add(&bar[XB_XSUB(b.x)], 1u);
        const unsigned gen = old / nloc;
        if (old + 1u == (gen + 1u) * nloc) {
            __builtin_amdgcn_fence(__ATOMIC_RELEASE, "agent");
            asm volatile("s_waitcnt vmcnt(0)" ::: "memory");
            const unsigned og = xb_add(&bar[XB_TOP], 1u);
            const unsigned tg = og / nx;
            if (og + 1u == (tg + 1u) * nx) xb_add(&bar[XB_TOPGEN], 1u);
            else XB_SPIN(xb_ld(&bar[XB_TOPGEN]) == tg, bar);
            __builtin_amdgcn_fence(__ATOMIC_ACQUIRE, "agent");
            xb_add(&bar[XB_XGEN(b.x)], 1u);
            asm volatile("s_waitcnt vmcnt(0)" ::: "memory");
        } else {
            XB_SPIN(xb_ld(&bar[XB_XGEN(b.x)]) == gen, bar);
            __builtin_amdgcn_fence(__ATOMIC_ACQUIRE, "agent");
            asm volatile("s_waitcnt vmcnt(0)" ::: "memory");
        }
    }
    __syncthreads();
}

struct Args { const float* in[N_IN]; float* out; unsigned char* ws; int lo, hi; };
struct Ctx {
  float* out; unsigned char* ws; unsigned* ctl;
  unsigned char* lds;
  int tid, lane, wave, bid, G;
};
__device__ __forceinline__ Ctx launder(Ctx c) {
  asm volatile("" : "+v"(c.tid), "+v"(c.lane));
  asm volatile("" : "+s"(c.wave), "+s"(c.bid), "+s"(c.G));
  return c;
}
constexpr int LDS_PTAB = LDS_BYTES - 1024;
constexpr int LDS_BST = LDS_BYTES - 16;
__device__ __forceinline__ const float* inp(const Ctx& c, int k) {
  const LAS unsigned* pt = (const LAS unsigned*)(LAS unsigned char*)(c.lds + LDS_PTAB);
  const unsigned lo = __builtin_amdgcn_readfirstlane(pt[2 * k]), hi = __builtin_amdgcn_readfirstlane(pt[2 * k + 1]);
  return (const float*)(((unsigned long long)hi << 32) | lo);
}


namespace mg {
typedef short bf16x8 __attribute__((ext_vector_type(8)));
typedef unsigned u32x4 __attribute__((ext_vector_type(4)));
constexpr int BM = 256, BK = 64, HALF = 128, HTB = HALF * BK * 2, STAGE_BYTES = 8 * HTB, NXCD = 8, WGM = 8;
constexpr int LDS_IDX = STAGE_BYTES;
__host__ __device__ __forceinline__ int lds_byte(int r, int c) { const int st = (r >> 4) * 2 + (c >> 5), rr = r & 15, cc = c & 31, ob = rr * 64 + cc * 2; return st * 1024 + (ob ^ (((ob >> 9) & 1) << 5)); }
__host__ __device__ __forceinline__ void stage_rc(int b, int& R, int& C) { const int st = b / 1024, sb = b % 1024, swz = sb ^ (((sb >> 9) & 1) << 5); R = (st >> 1) * 16 + swz / 64; C = (st & 1) * 32 + (swz % 64) / 2; }
__host__ __device__ __forceinline__ int perm32(int rho) { const int n = rho >> 4, i = rho & 15; return 8 * (i >> 2) + 4 * n + (i & 3); }
typedef int i32x4_ __attribute__((ext_vector_type(4)));
typedef int i32x8_ __attribute__((ext_vector_type(8)));
__device__ __forceinline__ i32x8_ cat8(bf16x8 a, bf16x8 b) { const i32x4_ x = __builtin_bit_cast(i32x4_, a), y = __builtin_bit_cast(i32x4_, b); return __builtin_shufflevector(x, y, 0, 1, 2, 3, 4, 5, 6, 7); }
struct Unit { int pm, pn; };
struct Gemm { const bf16* A; const bf16* Bt; int lda, ldb, K; };

struct Tiles {
  int nM, nN, nwg, G, c;
  __device__ __forceinline__ void init(int nM_, int nN_, int G_, int c_) { nM = nM_; nN = nN_; nwg = nM * nN; G = G_; c = c_; }
  __device__ __forceinline__ bool next(int i, Unit& u) const {
    const long L = (long)i * G + c; if (L >= nwg) return false;
    int wgid = (int)L; { const int q = nwg / NXCD, r = nwg % NXCD, xcd = wgid % NXCD, off = wgid / NXCD; wgid = (xcd < r ? xcd * (q + 1) : r * (q + 1) + (xcd - r) * q) + off; }
    const int nig = WGM * nN, gid = wgid / nig, fm = gid * WGM, gsz = (nM - fm) < WGM ? (nM - fm) : WGM;
    u.pm = fm + ((wgid % nig) % gsz); u.pn = (wgid % nig) / gsz; return true;
  }
};
struct DenseOrder : Tiles {
  static constexpr bool GATHER = false, FP8 = false;
  const int* rowidx;
  __device__ __forceinline__ const char* a_tile(const Gemm& g, const Unit& u) const { return (const char*)g.A + (size_t)u.pm * BM * g.lda * 2; }
  __device__ __forceinline__ const char* b_tile(const Gemm& g, const Unit& u) const { return (const char*)g.Bt + (size_t)u.pn * BM * g.ldb * 2; }
};
struct S5Order {
  static constexpr bool GATHER = false, FP8 = false;
  int G, c; const int* rowidx;
  __device__ __forceinline__ bool next(int i, Unit& u) const { const int L = i * G + c; if (L >= 128) return false; u.pm = L; u.pn = 0; return true; }
  __device__ __forceinline__ const char* a_tile(const Gemm& g, const Unit& u) const { return (const char*)g.A + (size_t)u.pm * BM * g.lda * 2; }
  __device__ __forceinline__ const char* b_tile(const Gemm& g, const Unit& u) const { return (const char*)g.Bt + (size_t)(u.pm >> 2) * BM * g.ldb * 2; }
};
template <bool GATHER_, bool FP8_> struct MoeOrder : Tiles {
  static constexpr bool GATHER = GATHER_, FP8 = FP8_; static constexpr int ES = FP8_ ? 1 : 2;
  int pend[8]; size_t bstride_e, boff; const int* rowidx;
  __device__ __forceinline__ int expert(int pm) const { int e = 0;
#pragma unroll
    for (int q = 0; q < 7; ++q) e += (pm * BM >= pend[q]) ? 1 : 0;
    return e; }
  __device__ __forceinline__ const char* a_tile(const Gemm& g, const Unit& u) const { return (const char*)g.A + (size_t)u.pm * BM * g.lda * ES; }
  __device__ __forceinline__ const char* b_tile(const Gemm& g, const Unit& u) const { return (const char*)g.Bt + (size_t)expert(u.pm) * bstride_e + boff + (size_t)u.pn * BM * g.ldb * ES; }
};

typedef float f32x2_ __attribute__((ext_vector_type(2)));
typedef __bf16 bfx2_ __attribute__((ext_vector_type(2)));
__device__ __forceinline__ unsigned cvt_pk_bf16(float lo, float hi) { const f32x2_ v = {lo, hi}; const bfx2_ r = __builtin_convertvector(v, bfx2_); return __builtin_bit_cast(unsigned, r); }

struct EpiF32 { static constexpr bool PERM = false; float* C; int ldc;
  __device__ __forceinline__ void operator()(const f32x4 (&acc)[2][2][4][2], const Unit& u, int wr, int wc, int fr, int fq) const {
    const int row0 = u.pm * BM + wr * 64 + fr, col0 = u.pn * BM + wc * 32 + 4 * fq;
#pragma unroll
    for (int ai = 0; ai < 2; ++ai)
#pragma unroll
      for (int m = 0; m < 4; ++m) { float* rowp = C + (size_t)(row0 + ai * HALF + m * 16) * ldc + col0;
#pragma unroll
        for (int bj = 0; bj < 2; ++bj)
#pragma unroll
          for (int n = 0; n < 2; ++n) *(f32x4*)(rowp + bj * HALF + n * 16) = acc[ai][bj][m][n]; }
  } };
template <bool ACCUM> struct EpiBf16 { static constexpr bool PERM = true; bf16* O; int ldc;
  __device__ __forceinline__ void operator()(const f32x4 (&acc)[2][2][4][2], const Unit& u, int wr, int wc, int fr, int fq) const {
    const int row0 = u.pm * BM + wr * 64 + fr, col0 = u.pn * BM + wc * 32 + 8 * fq;
#pragma unroll
    for (int ai = 0; ai < 2; ++ai)
#pragma unroll
      for (int m = 0; m < 4; ++m) { bf16* rowp = O + (size_t)(row0 + ai * HALF + m * 16) * ldc + col0;
#pragma unroll
        for (int bj = 0; bj < 2; ++bj) { f32x4 v0 = acc[ai][bj][m][0], v1 = acc[ai][bj][m][1];
          if (ACCUM) { const u32x4 o = *(const u32x4*)(rowp + bj * HALF);
            v0[0] += __uint_as_float(o.x << 16); v0[1] += __uint_as_float(o.x & 0xffff0000u); v0[2] += __uint_as_float(o.y << 16); v0[3] += __uint_as_float(o.y & 0xffff0000u);
            v1[0] += __uint_as_float(o.z << 16); v1[1] += __uint_as_float(o.z & 0xffff0000u); v1[2] += __uint_as_float(o.w << 16); v1[3] += __uint_as_float(o.w & 0xffff0000u); }
          u32x4 w; w.x = cvt_pk_bf16(v0[0], v0[1]); w.y = cvt_pk_bf16(v0[2], v0[3]); w.z = cvt_pk_bf16(v1[0], v1[1]); w.w = cvt_pk_bf16(v1[2], v1[3]);
          *(u32x4*)(rowp + bj * HALF) = w; } }
  } };
struct EpiP1 { static constexpr bool PERM = true; bf16* P1; bf16* AP;
  __device__ __forceinline__ void operator()(const f32x4 (&acc)[2][2][4][2], const Unit& u, int wr, int wc, int fr, int fq) const {
    const int row0 = u.pm * BM + wr * 64 + fr, col0 = u.pn * BM + wc * 32 + 8 * fq;
#pragma unroll
    for (int ai = 0; ai < 2; ++ai)
#pragma unroll
      for (int m = 0; m < 4; ++m) { const int row = row0 + ai * HALF + m * 16;
#pragma unroll
        for (int bj = 0; bj < 2; ++bj) { const int col = col0 + bj * HALF; const f32x4 v0 = acc[ai][bj][m][0], v1 = acc[ai][bj][m][1];
          u32x4 w; w.x = cvt_pk_bf16(v0[0], v0[1]); w.y = cvt_pk_bf16(v0[2], v0[3]); w.z = cvt_pk_bf16(v1[0], v1[1]); w.w = cvt_pk_bf16(v1[2], v1[3]);
          bf16* dst;
          if (u.pn < 2) { const int g = col >> 4, c0 = col & 15, b = row >> 11, ta = row & 2047; dst = AP + ((size_t)(g * 1024 + b * 128 + (ta >> 4)) * 384 + (ta & 15) * 16 + c0); }
          else dst = P1 + (size_t)row * 2048 + col;
          *(u32x4*)dst = w; } }
  } };
struct EpiS5E { static constexpr bool PERM = false; float* XE;
  __device__ __forceinline__ void operator()(const f32x4 (&acc)[2][2][4][2], const Unit& u, int wr, int wc, int fr, int fq) const {
    const int row0 = u.pm * BM + wr * 64 + fr, col0 = wc * 32 + 4 * fq;
#pragma unroll
    for (int ai = 0; ai < 2; ++ai)
#pragma unroll
      for (int m = 0; m < 4; ++m) { float* rowp = XE + (size_t)(row0 + ai * HALF + m * 16) * 128 + col0;
#pragma unroll
        for (int n = 0; n < 2; ++n) *(f32x4*)(rowp + n * 16) = acc[ai][0][m][n]; }
  } };
struct EpiS5Y { static constexpr bool PERM = true; bf16* YC; const bf16* AP; const float* dsk;
  __device__ __forceinline__ void operator()(const f32x4 (&acc)[2][2][4][2], const Unit& u, int wr, int wc, int fr, int fq) const {
    const int row0 = u.pm * BM + wr * 64 + fr, g = u.pm >> 2;
#pragma unroll
    for (int ai = 0; ai < 2; ++ai)
#pragma unroll
      for (int m = 0; m < 4; ++m) { const int row = row0 + ai * HALF + m * 16, rg = row & 1023, b = rg >> 7, blk = rg & 127;
#pragma unroll
        for (int bj = 0; bj < 2; ++bj) { const int col0 = bj * HALF + wc * 32 + 8 * fq, t = col0 >> 4, ch = g * 16 + (col0 & 15);
          const u32x4 uv = *(const u32x4*)(AP + (size_t)row * 384 + col0);
          const f32x4 d0 = *(const f32x4*)(dsk + ch), d1 = *(const f32x4*)(dsk + ch + 4);
          const float uu[8] = {__uint_as_float(uv.x << 16), __uint_as_float(uv.x & 0xffff0000u), __uint_as_float(uv.y << 16), __uint_as_float(uv.y & 0xffff0000u),
                               __uint_as_float(uv.z << 16), __uint_as_float(uv.z & 0xffff0000u), __uint_as_float(uv.w << 16), __uint_as_float(uv.w & 0xffff0000u)};
          float h[8];
#pragma unroll
          for (int e = 0; e < 4; ++e) { h[e] = gelu_(acc[ai][bj][m][0][e] + d0[e] * uu[e]); h[4 + e] = gelu_(acc[ai][bj][m][1][e] + d1[e] * uu[4 + e]); }
          u32x4 w; w.x = cvt_pk_bf16(h[0], h[1]); w.y = cvt_pk_bf16(h[2], h[3]); w.z = cvt_pk_bf16(h[4], h[5]); w.w = cvt_pk_bf16(h[6], h[7]);
          *(u32x4*)(YC + (size_t)(b * 2048 + blk * 16 + t) * 512 + ch) = w; } }
  } };
struct EpiLora { static constexpr bool PERM = true; bf16* O0; bf16* O1;
  __device__ __forceinline__ void operator()(const f32x4 (&acc)[2][2][4][2], const Unit& u, int wr, int wc, int fr, int fq) const {
    bf16* base = (u.pn < 4) ? O0 : O1; constexpr int ldc = 1024;
    const int row0 = u.pm * BM + wr * 64 + fr, col0 = (u.pn & 3) * BM + wc * 32 + 8 * fq;
#pragma unroll
    for (int ai = 0; ai < 2; ++ai)
#pragma unroll
      for (int m = 0; m < 4; ++m) { bf16* rowp = base + (size_t)(row0 + ai * HALF + m * 16) * ldc + col0;
#pragma unroll
        for (int bj = 0; bj < 2; ++bj) { const f32x4 v0 = acc[ai][bj][m][0], v1 = acc[ai][bj][m][1];
          u32x4 w; w.x = cvt_pk_bf16(v0[0], v0[1]); w.y = cvt_pk_bf16(v0[2], v0[3]); w.z = cvt_pk_bf16(v1[0], v1[1]); w.w = cvt_pk_bf16(v1[2], v1[3]);
          *(u32x4*)(rowp + bj * HALF) = w; } }
  } };
struct EpiSwigluT { static constexpr bool PERM = true; bf16* O; int ldc;
  __device__ __forceinline__ void operator()(const f32x4 (&acc)[2][2][4][2], const Unit& u, int wr, int wc, int fr, int fq) const {
    const int row0 = u.pm * BM + wr * 64 + fr, col0 = u.pn * HALF + wc * 32 + 8 * fq;
#pragma unroll
    for (int ai = 0; ai < 2; ++ai)
#pragma unroll
      for (int m = 0; m < 4; ++m) { bf16* rowp = O + (size_t)(row0 + ai * HALF + m * 16) * ldc + col0;
        float h[8];
#pragma unroll
        for (int n = 0; n < 2; ++n)
#pragma unroll
          for (int e = 0; e < 4; ++e) { const float gte = acc[ai][0][m][n][e], up = acc[ai][1][m][n][e]; h[n * 4 + e] = gte * __builtin_amdgcn_rcpf(1.f + __expf(-gte)) * up; }
        u32x4 w; w.x = cvt_pk_bf16(h[0], h[1]); w.y = cvt_pk_bf16(h[2], h[3]); w.z = cvt_pk_bf16(h[4], h[5]); w.w = cvt_pk_bf16(h[6], h[7]);
        *(u32x4*)rowp = w; }
  } };
__device__ __forceinline__ unsigned pk4_fp8(float a, float b, float c, float d) {
  a = __builtin_amdgcn_fmed3f(a, -448.f, 448.f); b = __builtin_amdgcn_fmed3f(b, -448.f, 448.f); c = __builtin_amdgcn_fmed3f(c, -448.f, 448.f); d = __builtin_amdgcn_fmed3f(d, -448.f, 448.f);
  int w = 0; w = __builtin_amdgcn_cvt_pk_fp8_f32(a, b, w, false); w = __builtin_amdgcn_cvt_pk_fp8_f32(c, d, w, true); return (unsigned)w; }
struct EpiSwigluF8 { static constexpr bool PERM = true; unsigned char* O; int ldc;
  __device__ __forceinline__ void operator()(const f32x4 (&acc)[2][2][4][2], const Unit& u, int wr, int wc, int fr, int fq) const {
    const int row0 = u.pm * BM + wr * 64 + fr, col0 = u.pn * HALF + wc * 32 + 8 * fq;
#pragma unroll
    for (int ai = 0; ai < 2; ++ai)
#pragma unroll
      for (int m = 0; m < 4; ++m) { unsigned char* rowp = O + (size_t)(row0 + ai * HALF + m * 16) * ldc + col0;
        float h[8];
#pragma unroll
        for (int n = 0; n < 2; ++n)
#pragma unroll
          for (int e = 0; e < 4; ++e) { const float gte = acc[ai][0][m][n][e] * (1.f / 4096.f), up = acc[ai][1][m][n][e] * (8.f / 4096.f); h[n * 4 + e] = gte * __builtin_amdgcn_rcpf(1.f + __expf(-gte)) * up; }
        uint2 w; w.x = pk4_fp8(h[0], h[1], h[2], h[3]); w.y = pk4_fp8(h[4], h[5], h[6], h[7]);
        *(uint2*)rowp = w; }
  } };
struct EpiBf16S { static constexpr bool PERM = true; bf16* O; int ldc; float scale;
  __device__ __forceinline__ void operator()(const f32x4 (&acc)[2][2][4][2], const Unit& u, int wr, int wc, int fr, int fq) const {
    const int row0 = u.pm * BM + wr * 64 + fr, col0 = u.pn * BM + wc * 32 + 8 * fq;
#pragma unroll
    for (int ai = 0; ai < 2; ++ai)
#pragma unroll
      for (int m = 0; m < 4; ++m) { bf16* rowp = O + (size_t)(row0 + ai * HALF + m * 16) * ldc + col0;
#pragma unroll
        for (int bj = 0; bj < 2; ++bj) { const f32x4 v0 = acc[ai][bj][m][0] * scale, v1 = acc[ai][bj][m][1] * scale;
          u32x4 w; w.x = cvt_pk_bf16(v0[0], v0[1]); w.y = cvt_pk_bf16(v0[2], v0[3]); w.z = cvt_pk_bf16(v1[0], v1[1]); w.w = cvt_pk_bf16(v1[2], v1[3]);
          *(u32x4*)(rowp + bj * HALF) = w; } }
  } };
struct EpiGluT { static constexpr bool PERM = true; bf16* O; int ldc; const bf16* Yc; const float* bias;
  __device__ __forceinline__ void operator()(const f32x4 (&acc)[2][2][4][2], const Unit& u, int wr, int wc, int fr, int fq) const {
    const int row0 = u.pm * BM + wr * 64 + fr, col0 = u.pn * BM + wc * 32 + 8 * fq;
#pragma unroll
    for (int ai = 0; ai < 2; ++ai)
#pragma unroll
      for (int m = 0; m < 4; ++m) { const int row = row0 + ai * HALF + m * 16;
#pragma unroll
        for (int bj = 0; bj < 2; ++bj) { const int col = col0 + bj * HALF;
          const u32x4 yv = *(const u32x4*)(Yc + (size_t)row * 512 + col);
          const f32x4 b0 = *(const f32x4*)(bias + col), b1 = *(const f32x4*)(bias + col + 4);
          const float y[8] = {__uint_as_float(yv.x << 16), __uint_as_float(yv.x & 0xffff0000u), __uint_as_float(yv.y << 16), __uint_as_float(yv.y & 0xffff0000u),
                              __uint_as_float(yv.z << 16), __uint_as_float(yv.z & 0xffff0000u), __uint_as_float(yv.w << 16), __uint_as_float(yv.w & 0xffff0000u)};
          float h[8];
#pragma unroll
          for (int e = 0; e < 4; ++e) { h[e] = y[e] * __builtin_amdgcn_rcpf(1.f + __expf(-(acc[ai][bj][m][0][e] + b0[e]))); h[4 + e] = y[4 + e] * __builtin_amdgcn_rcpf(1.f + __expf(-(acc[ai][bj][m][1][e] + b1[e]))); }
          u32x4 w; w.x = cvt_pk_bf16(h[0], h[1]); w.y = cvt_pk_bf16(h[2], h[3]); w.z = cvt_pk_bf16(h[4], h[5]); w.w = cvt_pk_bf16(h[6], h[7]);
          *(u32x4*)(O + (size_t)row * ldc + col) = w; } }
  } };

template <class Epi, class Sched>
__device__ __forceinline__ void gemm_phase(LAS unsigned char* lds, const Gemm g, const Sched& S, const Epi& E) {
  const int tid = threadIdx.x, wid = __builtin_amdgcn_readfirstlane(tid >> 6), lane = tid & 63, wr = wid >> 2, wc = wid & 3, fr = lane & 15, fq = lane >> 4;
  constexpr int ES = Sched::FP8 ? 1 : 2;
  const int K = g.K, nt = K * ES / 128;
  unsigned voffA[2], voffB[2]; int gR[2], gC[2];
#pragma unroll
  for (int i = 0; i < 2; ++i) { int R, C; stage_rc(tid * 16 + i * 8192, R, C); const int Rb = Epi::PERM ? ((R & ~31) + perm32(R & 31)) : R;
    voffA[i] = (unsigned)(R * g.lda * ES + C * 2); voffB[i] = (unsigned)(Rb * g.ldb * ES + C * 2); gR[i] = R; gC[i] = C * 2; }
  const size_t kstep = (size_t)(BK * 2);
  const size_t hstepA = (size_t)HALF * g.lda * ES, hstepB = (size_t)HALF * g.ldb * ES;
  const unsigned ldsw = (unsigned)wid * 1024u;
  const unsigned rowb = (unsigned)(g.lda * ES);
  const int aoff = lds_byte(wr * 64 + fr, fq * 8), boff = lds_byte(wc * 32 + fr, fq * 8);
#define PG8_SA(b, h) (((b) * 2 + (h)) * HTB)
#define PG8_SB(b, h) ((4 + (b) * 2 + (h)) * HTB)
#define PG8_STAGE(bufoff, gbase, voff) do { _Pragma("unroll") for (int _i = 0; _i < 2; ++_i) \
    __builtin_amdgcn_global_load_lds((const unsigned*)((const char*)(gbase) + (voff)[_i]), (LAS unsigned*)(lds + (bufoff) + ldsw + _i * 8192), 16, 0, 0); } while (0)
#define PG8_STAGE_A(bufoff, p, h, goff) do { if constexpr (Sched::GATHER) PG8_STAGE(bufoff, p, (goff)[h]); else PG8_STAGE(bufoff, (p) + (h) * hstepA, voffA); } while (0)
#define PG8_LDA(dst, b, h) do { _Pragma("unroll") for (int m = 0; m < 4; ++m) { if constexpr (Sched::FP8) dst##8[m] = __builtin_shufflevector(*(const LAS i32x4_*)(lds + PG8_SA(b, h) + aoff + m * 2048), *(const LAS i32x4_*)(lds + PG8_SA(b, h) + aoff + m * 2048 + 1024), 0, 1, 2, 3, 4, 5, 6, 7); \
    else { _Pragma("unroll") for (int k = 0; k < 2; ++k) dst[m][k] = *(const LAS bf16x8*)(lds + PG8_SA(b, h) + aoff + m * 2048 + k * 1024); } } } while (0)
#define PG8_LDB(dst, b, h) do { _Pragma("unroll") for (int n = 0; n < 2; ++n) { if constexpr (Sched::FP8) dst##8[n] = __builtin_shufflevector(*(const LAS i32x4_*)(lds + PG8_SB(b, h) + boff + n * 2048), *(const LAS i32x4_*)(lds + PG8_SB(b, h) + boff + n * 2048 + 1024), 0, 1, 2, 3, 4, 5, 6, 7); \
    else { _Pragma("unroll") for (int k = 0; k < 2; ++k) dst[n][k] = *(const LAS bf16x8*)(lds + PG8_SB(b, h) + boff + n * 2048 + k * 1024); } } } while (0)
  int sc1 = 0x7f7f7f7f; asm volatile("" : "+v"(sc1));
#define PG8_MMA(ai, bj, At, Bt) do { __builtin_amdgcn_s_setprio(1); _Pragma("unroll") for (int m = 0; m < 4; ++m) _Pragma("unroll") for (int n = 0; n < 2; ++n) { \
    if constexpr (Sched::FP8) asm volatile("v_mfma_scale_f32_16x16x128_f8f6f4 %0, %1, %2, %0, %3, %3 op_sel_hi:[0,0,0]" : "+v"(acc[ai][bj][m][n]) : "v"(Bt##8[n]), "v"(At##8[m]), "v"(sc1)); \
    else { _Pragma("unroll") for (int k = 0; k < 2; ++k) acc[ai][bj][m][n] = __builtin_amdgcn_mfma_f32_16x16x32_bf16(Bt[n][k], At[m][k], acc[ai][bj][m][n], 0, 0, 0); } } \
    __builtin_amdgcn_s_setprio(0); } while (0)
#define PG8_WAIT_V(n) asm volatile("s_waitcnt vmcnt(" #n ")" ::: "memory")
#define PG8_WAIT_L(n) asm volatile("s_waitcnt lgkmcnt(" #n ")" ::: "memory")
#define PG8_BAR __builtin_amdgcn_s_barrier()
#define PG8_SCHED __builtin_amdgcn_sched_barrier(0)
  Unit cur, nxt; int ui = 0;
  if (!S.next(0, cur)) return;
  f32x4 acc[2][2][4][2];
#pragma unroll
  for (int a = 0; a < 2; ++a)
#pragma unroll
    for (int b = 0; b < 2; ++b)
#pragma unroll
      for (int m = 0; m < 4; ++m)
#pragma unroll
        for (int n = 0; n < 2; ++n) acc[a][b][m][n] = (f32x4){0.f, 0.f, 0.f, 0.f};
  bf16x8 At[4][2], B0[2][2], B1[2][2];
  i32x8_ At8[4], B08[2], B18[2];
  unsigned gcu[2][2] = {{0u, 0u}, {0u, 0u}};
  const char* cA = Sched::GATHER ? (const char*)g.A : S.a_tile(g, cur); const char* cB = S.b_tile(g, cur);
  if constexpr (Sched::GATHER) {
#pragma unroll
    for (int h = 0; h < 2; ++h)
#pragma unroll
      for (int i = 0; i < 2; ++i) gcu[h][i] = (unsigned)S.rowidx[cur.pm * BM + h * HALF + gR[i]] * rowb + (unsigned)gC[i];
  }
  PG8_STAGE(PG8_SB(0, 0), cB, voffB); PG8_STAGE(PG8_SB(0, 1), cB + hstepB, voffB); PG8_STAGE_A(PG8_SA(0, 0), cA, 0, gcu); PG8_STAGE_A(PG8_SA(0, 1), cA, 1, gcu);
  if (wr == 1) PG8_BAR;
  PG8_WAIT_V(2); PG8_BAR;
  PG8_STAGE(PG8_SB(1, 0), cB + kstep, voffB); PG8_STAGE_A(PG8_SA(1, 0), cA + kstep, 0, gcu); PG8_STAGE(PG8_SB(1, 1), cB + hstepB + kstep, voffB);
  PG8_WAIT_V(6); PG8_BAR;
  for (;;) {
    const bool has_next = S.next(ui + 1, nxt);
    const char* nA = Sched::GATHER ? (const char*)g.A : (has_next ? S.a_tile(g, nxt) : cA); const char* nB = has_next ? S.b_tile(g, nxt) : cB;
    if constexpr (Sched::GATHER) {
      if (has_next && wid < 4) __builtin_amdgcn_global_load_lds((const unsigned*)(S.rowidx + nxt.pm * BM + wid * 64 + lane), (LAS unsigned*)(lds + LDS_IDX + ((ui + 1) & 1) * 1024 + wid * 256), 4, 0, 0);
    }
#pragma nounroll
    for (int t = 0; t < nt; t += 2) {
      const bool last = (t == nt - 2);
      const char* a1 = cA + (size_t)(t + 1) * kstep;
      const char* a2 = last ? nA : cA + (size_t)(t + 2) * kstep; const char* b2 = last ? nB : cB + (size_t)(t + 2) * kstep;
      const char* a3 = a2 + kstep; const char* b3 = b2 + kstep;
      unsigned g2[2][2];
#pragma unroll
      for (int h = 0; h < 2; ++h)
#pragma unroll
        for (int i = 0; i < 2; ++i) g2[h][i] = gcu[h][i];
      if constexpr (Sched::GATHER) {
        if (last && has_next) {
          const LAS unsigned* ix = (const LAS unsigned*)(lds + LDS_IDX + ((ui + 1) & 1) * 1024);
#pragma unroll
          for (int h = 0; h < 2; ++h)
#pragma unroll
            for (int i = 0; i < 2; ++i) g2[h][i] = ix[h * HALF + gR[i]] * rowb + (unsigned)gC[i];
        }
      }
      PG8_LDB(B0, 0, 0); PG8_LDB(B1, 0, 1); PG8_SCHED; PG8_LDA(At, 0, 0); PG8_STAGE_A(PG8_SA(1, 1), a1, 1, gcu);
      PG8_WAIT_V(8); PG8_WAIT_L(0); PG8_BAR; PG8_MMA(0, 0, At, B0); PG8_MMA(0, 1, At, B1); PG8_BAR; PG8_SCHED;
      PG8_LDA(At, 0, 1); PG8_STAGE(PG8_SB(0, 0), b2, voffB); PG8_STAGE(PG8_SB(0, 1), b2 + hstepB, voffB); PG8_STAGE_A(PG8_SA(0, 0), a2, 0, g2);
      PG8_WAIT_V(8); PG8_WAIT_L(0); PG8_BAR; PG8_MMA(1, 0, At, B0); PG8_MMA(1, 1, At, B1); PG8_BAR; PG8_SCHED;
      PG8_LDB(B0, 1, 0); PG8_LDB(B1, 1, 1); PG8_SCHED; PG8_LDA(At, 1, 0); PG8_STAGE_A(PG8_SA(0, 1), a2, 1, g2);
      PG8_WAIT_V(8); PG8_WAIT_L(0); PG8_BAR; PG8_MMA(0, 0, At, B0); PG8_MMA(0, 1, At, B1); PG8_BAR; PG8_SCHED;
      PG8_LDA(At, 1, 1); PG8_STAGE(PG8_SB(1, 0), b3, voffB); PG8_STAGE(PG8_SB(1, 1), b3 + hstepB, voffB); PG8_STAGE_A(PG8_SA(1, 0), a3, 0, g2);
      PG8_WAIT_V(8); PG8_WAIT_L(0); PG8_BAR; PG8_MMA(1, 0, At, B0); PG8_MMA(1, 1, At, B1); PG8_BAR; PG8_SCHED;
      if constexpr (Sched::GATHER) { if (last) {
#pragma unroll
        for (int h = 0; h < 2; ++h)
#pragma unroll
          for (int i = 0; i < 2; ++i) gcu[h][i] = g2[h][i]; } }
    }
    if (wr == 0) PG8_BAR;
    if constexpr (Sched::FP8) asm volatile("s_nop 15\n\ts_nop 15" ::: "memory");
    E(acc, cur, wr, wc, fr, fq);
    if (!has_next) break;
#pragma unroll
    for (int a = 0; a < 2; ++a)
#pragma unroll
      for (int b = 0; b < 2; ++b)
#pragma unroll
        for (int m = 0; m < 4; ++m)
#pragma unroll
          for (int n = 0; n < 2; ++n) acc[a][b][m][n] = (f32x4){0.f, 0.f, 0.f, 0.f};
    cur = nxt; cA = nA; cB = nB; ++ui;
    if (wr == 1) PG8_BAR;
  }
  PG8_WAIT_V(0);
  PG8_BAR;
#undef PG8_SA
#undef PG8_SB
#undef PG8_STAGE
#undef PG8_STAGE_A
#undef PG8_LDA
#undef PG8_LDB
#undef PG8_MMA
#undef PG8_WAIT_V
#undef PG8_WAIT_L
#undef PG8_BAR
#undef PG8_SCHED
}
}

__device__ __forceinline__ void cvt_item(const float* W, int ldw, bf16* WT, int Kd, int dst_row0, int k0, int n0, int lane) {
  const int kg = lane >> 4, nq = lane & 15;
  const float* src = W + (size_t)(k0 + 16 * kg) * ldw + n0 + 4 * nq;
  f32x4 r[16];
#pragma unroll
  for (int i = 0; i < 16; ++i) r[i] = *(const f32x4*)(src + (size_t)i * ldw);
  bf16* dst = WT + (size_t)(dst_row0 + 4 * nq) * Kd + k0 + 16 * kg;
#pragma unroll
  for (int e = 0; e < 4; ++e) {
    mg::u32x4 o0, o1;
    o0.x = mg::cvt_pk_bf16(r[0][e], r[1][e]); o0.y = mg::cvt_pk_bf16(r[2][e], r[3][e]); o0.z = mg::cvt_pk_bf16(r[4][e], r[5][e]); o0.w = mg::cvt_pk_bf16(r[6][e], r[7][e]);
    o1.x = mg::cvt_pk_bf16(r[8][e], r[9][e]); o1.y = mg::cvt_pk_bf16(r[10][e], r[11][e]); o1.z = mg::cvt_pk_bf16(r[12][e], r[13][e]); o1.w = mg::cvt_pk_bf16(r[14][e], r[15][e]);
    *(mg::u32x4*)(dst + (size_t)e * Kd) = o0; *(mg::u32x4*)(dst + (size_t)e * Kd + 8) = o1;
  }
}
__device__ __forceinline__ void cvt_mat_item(const float* W, int K, int N, int ldw, bf16* WT, int mode, int it, int lane) {
  const int nblk = N / 64, kb = it / nblk, nb = it % nblk, n0 = nb * 64;
  const int dst = mode == 0 ? n0 : ((n0 >> 7) * 256 + (n0 & 127) + (mode == 2 ? 128 : 0));
  cvt_item(W, ldw, WT, K, dst, kb * 64, n0, lane);
}
__device__ __forceinline__ void cvt_dense(const Ctx& c) {
  const float* win0 = inp(c, I0_WIN); const float* wout0 = inp(c, I0_WOUT); const float* fg = inp(c, I0_FG); const float* fu = inp(c, I0_FU); const float* fd = inp(c, I0_FD);
  const float* win1 = inp(c, I1_WIN); const float* glw = inp(c, I1_GLW); const float* wout1 = inp(c, I1_WOUT);
  unsigned char* ws = c.ws;
  for (int it = c.wave * c.G + c.bid; it < 3904; it += NW * c.G) {
    int r = it;
    if (r < 704) { cvt_mat_item(win0, D, EVEN_IN, EVEN_IN, (bf16*)(ws + WS_WIN0), 0, r, c.lane); continue; } r -= 704;
    if (r < 256) { cvt_mat_item(wout0, D, D, D, (bf16*)(ws + WS_WOUT0), 0, r, c.lane); continue; } r -= 256;
    if (r < 704) { cvt_mat_item(fg, D, FFN, FFN, (bf16*)(ws + WS_FGU), 1, r, c.lane); continue; } r -= 704;
    if (r < 704) { cvt_mat_item(fu, D, FFN, FFN, (bf16*)(ws + WS_FGU), 2, r, c.lane); continue; } r -= 704;
    if (r < 704) { cvt_mat_item(fd, FFN, D, D, (bf16*)(ws + WS_FD), 0, r, c.lane); continue; } r -= 704;
    if (r < 512) { cvt_mat_item(win1, D, 2048, ODD_IN, (bf16*)(ws + WS_WIN1), 0, r, c.lane); continue; } r -= 512;
    if (r < 64) { cvt_mat_item(glw, 512, 512, 512, (bf16*)(ws + WS_GLU), 0, r, c.lane); continue; } r -= 64;
    cvt_mat_item(wout1, D, D, D, (bf16*)(ws + WS_WOUT1), 0, r, c.lane);
  }
}
__device__ __forceinline__ void cvt_moe(const Ctx& c, int vb, int vG, int part) {
  const float* mgp = inp(c, I1_MG); const float* mup = inp(c, I1_MU); const float* mdp = inp(c, I1_MDN);
  unsigned char* tile = c.lds;
  const int nitems = part == 0 ? 8 * 224 : 8 * 112;
  for (int it = vb; it < nitems; it += vG) {
    const float* W; unsigned char* WT; int K, N, up = 0, idx;
    if (part == 0) { const int e = it / 224, r = it % 224; up = r / 112; idx = r % 112; W = (up ? mup : mgp) + (size_t)e * D * FE; WT = c.ws + WS_MGU + (size_t)e * 2 * FE * D; K = D; N = FE; }
    else { const int e = it / 112; idx = it % 112; W = mdp + (size_t)e * FE * D; WT = c.ws + WS_MD + (size_t)e * D * FE; K = FE; N = D; }
    const int nblk = N / 256, kb = idx / nblk, nb = idx % nblk, k0 = kb * 128, n0 = nb * 256;
    const float* src = W + (size_t)(k0 + 16 * c.wave) * N + n0 + 4 * c.lane;
    f32x4 r[16];
#pragma unroll
    for (int i = 0; i < 16; ++i) r[i] = *(const f32x4*)(src + (size_t)i * N) * 256.f;
    __syncthreads();
#pragma unroll
    for (int e = 0; e < 4; ++e) {
      mg::u32x4 o; o.x = mg::pk4_fp8(r[0][e], r[1][e], r[2][e], r[3][e]); o.y = mg::pk4_fp8(r[4][e], r[5][e], r[6][e], r[7][e]);
      o.z = mg::pk4_fp8(r[8][e], r[9][e], r[10][e], r[11][e]); o.w = mg::pk4_fp8(r[12][e], r[13][e], r[14][e], r[15][e]);
      *(mg::u32x4*)(tile + (4 * c.lane + e) * 128 + 16 * c.wave) = o;
    }
    __syncthreads();
#pragma unroll
    for (int j = 0; j < 4; ++j) { const int n = (c.tid >> 3) + 64 * j, pc = c.tid & 7, ng = n0 + n;
      const int drow = part == 0 ? ((ng >> 7) * 256 + (ng & 127) + 128 * up) : ng;
      *(mg::u32x4*)(WT + (size_t)drow * K + k0 + 16 * pc) = *(const mg::u32x4*)(tile + n * 128 + 16 * pc); }
  }
  __syncthreads();
}


template <int YMODE, int PROJ>
__device__ __forceinline__ void norm_phase(const Ctx& c, const float* resin, float* resout, const float* Y, const float* gpost, const float* gpre, bf16* XN,
                                           const float* W8, int ldw8, int c0, float* out8) {
  float* w8s = (float*)c.lds;
  LAS unsigned* hist = (LAS unsigned*)(c.lds + 32768);
  if (PROJ) {
    for (int i = c.tid; i < 1024 * 8; i += NT) w8s[i] = W8[(size_t)(i >> 3) * ldw8 + c0 + (i & 7)];
    if (PROJ == 2 && c.tid < 8) hist[c.tid] = 0u;
    __syncthreads();
  }
  int* tok_e = (int*)(c.ws + WS_ROUTE); float* tok_g = (float*)(c.ws + WS_ROUTE + 128 * 1024);
  const int* tok_slot = (const int*)(c.ws + WS_ROUTE + 256 * 1024);
  const bf16* YS = (const bf16*)(c.ws + WS_YS);
  for (int m = c.wave * c.G + c.bid; m < M; m += NW * c.G) {
    f32x4 r[4];
#pragma unroll
    for (int j = 0; j < 4; ++j) r[j] = *(const f32x4*)(resin + (size_t)m * D + j * 256 + c.lane * 4);
    if (YMODE) {
      f32x4 y[4]; float ss = 0.f;
      if (YMODE == 1) {
#pragma unroll
        for (int j = 0; j < 4; ++j) { const uint2 a = *(const uint2*)((const bf16*)Y + (size_t)m * D + j * 256 + c.lane * 4);
          y[j][0] = __uint_as_float(a.x << 16); y[j][1] = __uint_as_float(a.x & 0xffff0000u); y[j][2] = __uint_as_float(a.y << 16); y[j][3] = __uint_as_float(a.y & 0xffff0000u); }
      } else {
        const int s0 = tok_slot[2 * m], s1 = tok_slot[2 * m + 1]; const float g0 = tok_g[2 * m], g1 = tok_g[2 * m + 1];
#pragma unroll
        for (int j = 0; j < 4; ++j) {
          const uint2 a = *(const uint2*)(YS + (size_t)s0 * D + j * 256 + c.lane * 4), b = *(const uint2*)(YS + (size_t)s1 * D + j * 256 + c.lane * 4);
          y[j][0] = g0 * bf2f((bf16)(a.x & 0xffff)) + g1 * bf2f((bf16)(b.x & 0xffff));
          y[j][1] = g0 * bf2f((bf16)(a.x >> 16)) + g1 * bf2f((bf16)(b.x >> 16));
          y[j][2] = g0 * bf2f((bf16)(a.y & 0xffff)) + g1 * bf2f((bf16)(b.y & 0xffff));
          y[j][3] = g0 * bf2f((bf16)(a.y >> 16)) + g1 * bf2f((bf16)(b.y >> 16));
        }
      }
#pragma unroll
      for (int j = 0; j < 4; ++j) ss += y[j][0] * y[j][0] + y[j][1] * y[j][1] + y[j][2] * y[j][2] + y[j][3] * y[j][3];
      const float rs = rsqrtf(wave_sum(ss) * (1.f / D) + 1e-6f);
#pragma unroll
      for (int j = 0; j < 4; ++j) {
        const f32x4 g = *(const f32x4*)(gpost + j * 256 + c.lane * 4);
        r[j] = r[j] + y[j] * rs * g;
        *(f32x4*)(resout + (size_t)m * D + j * 256 + c.lane * 4) = r[j];
      }
    }
    if (gpre) {
      float ss = 0.f;
#pragma unroll
      for (int j = 0; j < 4; ++j) ss += r[j][0] * r[j][0] + r[j][1] * r[j][1] + r[j][2] * r[j][2] + r[j][3] * r[j][3];
      const float rs = rsqrtf(wave_sum(ss) * (1.f / D) + 1e-6f);
      float p8[8];
#pragma unroll
      for (int q = 0; q < 8; ++q) p8[q] = 0.f;
#pragma unroll
      for (int j = 0; j < 4; ++j) {
        const f32x4 g = *(const f32x4*)(gpre + j * 256 + c.lane * 4);
        const f32x4 xn = r[j] * rs * g;
        if (PROJ == 2) { *(unsigned*)(c.ws + WS_XN8 + (size_t)m * D + j * 256 + c.lane * 4) = mg::pk4_fp8(xn[0] * 16.f, xn[1] * 16.f, xn[2] * 16.f, xn[3] * 16.f); }
        else { uint2 o; o.x = (unsigned)f2bf(xn[0]) | ((unsigned)f2bf(xn[1]) << 16); o.y = (unsigned)f2bf(xn[2]) | ((unsigned)f2bf(xn[3]) << 16);
          *(uint2*)(XN + (size_t)m * D + j * 256 + c.lane * 4) = o; }
        if (PROJ) {
#pragma unroll
          for (int e = 0; e < 4; ++e) {
            const float* wr = w8s + (j * 256 + c.lane * 4 + e) * 8;
#pragma unroll
            for (int q = 0; q < 8; ++q) p8[q] += xn[e] * wr[q];
          }
        }
      }
      if (PROJ) {
#pragma unroll
        for (int q = 0; q < 8; ++q) p8[q] = wave_sum(p8[q]);
        if (PROJ == 1) { if (c.lane < 8) { float v = p8[0];
#pragma unroll
            for (int q = 1; q < 8; ++q) v = (c.lane == q) ? p8[q] : v;
            out8[(size_t)m * 8 + c.lane] = v; } }
        if (PROJ == 2 && c.lane == 0) {
          int e0 = 0; float v0 = p8[0];
#pragma unroll
          for (int q = 1; q < 8; ++q) if (p8[q] > v0) { v0 = p8[q]; e0 = q; }
          int e1 = -1; float v1 = -3.0e38f;
#pragma unroll
          for (int q = 0; q < 8; ++q) if (q != e0 && p8[q] > v1) { v1 = p8[q]; e1 = q; }
          const float g1 = 1.f / (1.f + expf(v0 - v1)), g0 = 1.f - g1;
          tok_e[2 * m] = e0; tok_e[2 * m + 1] = e1; tok_g[2 * m] = g0; tok_g[2 * m + 1] = g1;
          atomicAdd((unsigned*)&hist[e0], 1u); atomicAdd((unsigned*)&hist[e1], 1u);
        }
      }
    }
  }
  if (PROJ == 2) { __syncthreads(); if (c.tid < 8) atomicAdd(c.ctl + CW_CNT + 64 * c.tid, hist[c.tid]); }
  __syncthreads();
}

__device__ __forceinline__ void rwkv_prep_a(const Ctx& c) {
  const float* mu = inp(c, I0_MU);
  const bf16* P = (const bf16*)(c.ws + WS_P0); bf16* AL = (bf16*)(c.ws + WS_ALORA);
  const f32x4 mu4 = *(const f32x4*)(mu + 1536 + c.lane * 4);
  for (int m = c.wave * c.G + c.bid; m < M; m += NW * c.G) {
    const int t = m % SEQ;
    const uint2 cu = *(const uint2*)(P + (size_t)m * EVEN_IN + 1536 + c.lane * 4);
    uint2 pv = {0u, 0u}; if (t > 0) pv = *(const uint2*)(P + (size_t)(m - 1) * EVEN_IN + 1536 + c.lane * 4);
    const float cv[4] = {__uint_as_float(cu.x << 16), __uint_as_float(cu.x & 0xffff0000u), __uint_as_float(cu.y << 16), __uint_as_float(cu.y & 0xffff0000u)};
    const float pp[4] = {__uint_as_float(pv.x << 16), __uint_as_float(pv.x & 0xffff0000u), __uint_as_float(pv.y << 16), __uint_as_float(pv.y & 0xffff0000u)};
    float o[4];
#pragma unroll
    for (int e = 0; e < 4; ++e) { float v = cv[e] + (pp[e] - cv[e]) * mu4[e]; if (c.lane < 16) v = tanhf(v); else if (c.lane >= 32) v = sigmoid_(v); o[e] = v; }
    uint2 w; w.x = (unsigned)f2bf(o[0]) | ((unsigned)f2bf(o[1]) << 16); w.y = (unsigned)f2bf(o[2]) | ((unsigned)f2bf(o[3]) << 16);
    *(uint2*)(AL + (size_t)m * 256 + c.lane * 4) = w;
  }
}
__device__ __forceinline__ void build_wlora(const Ctx& c) {
  const float* w2 = inp(c, I0_W2); const float* a2 = inp(c, I0_A2); const float* g2 = inp(c, I0_G2);
  bf16* WL = (bf16*)(c.ws + WS_WLORA);
  for (int i = c.bid * NT + c.tid; i < 1536 * 256; i += c.G * NT) {
    const int n = i >> 8, k = i & 255; float v = 0.f;
    if (n < 512) { if (k < 64) v = w2[k * 512 + n]; }
    else if (n < 1024) { if (k >= 64 && k < 128) v = a2[(k - 64) * 512 + (n - 512)]; }
    else { if (k >= 128) v = g2[(k - 128) * 512 + (n - 1024)]; }
    WL[i] = f2bf(v);
  }
}
constexpr size_t WS_YSC = WS_XN;
typedef short bf16x4 __attribute__((ext_vector_type(4)));
__device__ __forceinline__ bf16x4 pack4(f32x4 v) { union { uint2 u; bf16x4 b; } x; x.u.x = mg::cvt_pk_bf16(v[0], v[1]); x.u.y = mg::cvt_pk_bf16(v[2], v[3]); return x.b; }
__device__ __forceinline__ f32x4 mma16(bf16x4 p, bf16x4 q, f32x4 c) { return __builtin_amdgcn_mfma_f32_16x16x16bf16_1k(p, q, c, 0, 0, 0); }
constexpr int RK_SK = 72;
__device__ __forceinline__ void rwkv_chunk_prep(const Ctx& c) {
  const float* mu = inp(c, I0_MU); const float* w0 = inp(c, I0_W0); const float* a0 = inp(c, I0_A0);
  const float* kkp = inp(c, I0_KK); const float* kap = inp(c, I0_KA); const float* rkp = inp(c, I0_RK);
  const bf16* P = (const bf16*)(c.ws + WS_P0); const bf16* LW = (const bf16*)(c.ws + WS_LOWA);
  float* BON = (float*)(c.ws + WS_BON); unsigned char* CHK = c.ws + WS_CHK;
  bf16* wl = (bf16*)(c.lds + c.wave * 17408);
  bf16* sAt = wl, *sBh = wl + 1152, *sKh = wl + 2304, *sRt = wl + 3456;
  bf16* tAt = wl + 4608, *tRt = tAt + 1024, *tBp = tAt + 2048, *tKp = tAt + 3072;
  const int lane = c.lane, q = lane >> 4, lr = lane & 15;
  for (int unit = c.wave * c.G + c.bid; unit < BATCH * 8 * 128; unit += NW * c.G) {
    const int ck = unit & 127, bh = unit >> 7, h = bh & 7, b = bh >> 3, ch = h * 64 + lane;
    const size_t m0 = (size_t)b * SEQ + ck * 16;
    const float mur = mu[ch], muk = mu[512 + ch], muv = mu[1024 + ch], w0c = w0[ch], a0c = a0[ch], kkc = kkp[ch], kac = kap[ch], rkc = rkp[ch];
    float At[16], Bh[16], Kh[16], Rt[16], Vs[16];
    float rp = 0.f, kp = 0.f, vp = 0.f;
    if (ck > 0) { const bf16* pp = P + (m0 - 1) * EVEN_IN + ch; rp = bf2f(pp[0]); kp = bf2f(pp[512]); vp = bf2f(pp[1024]); }
    float lg = 0.f;
#pragma unroll
    for (int t = 0; t < 16; ++t) {
      const bf16* pc = P + (m0 + t) * EVEN_IN + ch;
      const float rc = bf2f(pc[0]), kc = bf2f(pc[512]), vc = bf2f(pc[1024]);
      const float r = rc + (rp - rc) * mur, k = kc + (kp - kc) * muk, v = vc + (vp - vc) * muv;
      rp = rc; kp = kc; vp = vc;
      const float aw = w0c + bf2f(LW[(m0 + t) * 1024 + ch]), aa = a0c + bf2f(LW[(m0 + t) * 1024 + 512 + ch]);
      const float lw = -__expf(-softplus_(-aw) - 0.5f);
      const float ag = sigmoid_(aa);
      float kk = k * kkc;
      kk = kk / fmaxf(sqrtf(wave_sum(kk * kk)), 1e-12f);
      const float k2 = k * (1.f + (ag - 1.f) * kac);
      const float bon = wave_sum(r * k2 * rkc);
      if (lane == 0) BON[(m0 + t) * 8 + h] = bon;
      const float gprev = __expf(lg); lg += lw; const float g = __expf(lg), gi = __expf(-lg);
      At[t] = -kk * gprev; Bh[t] = kk * ag * gi; Kh[t] = k2 * gi; Rt[t] = r * g; Vs[t] = v;
    }
    const float gL = __expf(lg);
    unsigned char* cb = CHK + (size_t)unit * CHB;
#pragma unroll
    for (int t = 0; t < 16; ++t) { sAt[t * RK_SK + lane] = f2bf(At[t]); sBh[t * RK_SK + lane] = f2bf(Bh[t]); sKh[t * RK_SK + lane] = f2bf(Kh[t]); sRt[t * RK_SK + lane] = f2bf(Rt[t]); }
    { mg::u32x4 o0, o1;
#define PK16(arr, sc) o0.x = mg::cvt_pk_bf16(arr[0] * sc, arr[1] * sc); o0.y = mg::cvt_pk_bf16(arr[2] * sc, arr[3] * sc); o0.z = mg::cvt_pk_bf16(arr[4] * sc, arr[5] * sc); o0.w = mg::cvt_pk_bf16(arr[6] * sc, arr[7] * sc); \
      o1.x = mg::cvt_pk_bf16(arr[8] * sc, arr[9] * sc); o1.y = mg::cvt_pk_bf16(arr[10] * sc, arr[11] * sc); o1.z = mg::cvt_pk_bf16(arr[12] * sc, arr[13] * sc); o1.w = mg::cvt_pk_bf16(arr[14] * sc, arr[15] * sc);
      PK16(At, 1.f) *(mg::u32x4*)(tAt + lane * 16) = o0; *(mg::u32x4*)(tAt + lane * 16 + 8) = o1;
      PK16(Rt, 1.f) *(mg::u32x4*)(tRt + lane * 16) = o0; *(mg::u32x4*)(tRt + lane * 16 + 8) = o1;
      PK16(Bh, gL) *(mg::u32x4*)(tBp + lane * 16) = o0; *(mg::u32x4*)(tBp + lane * 16 + 8) = o1;
      *(mg::u32x4*)(cb + 6656 + lane * 32) = o0; *(mg::u32x4*)(cb + 6656 + lane * 32 + 16) = o1;
      PK16(Kh, gL) *(mg::u32x4*)(tKp + lane * 16) = o0; *(mg::u32x4*)(tKp + lane * 16 + 8) = o1;
      PK16(Vs, 1.f) *(mg::u32x4*)(cb + 8704 + lane * 32) = o0; *(mg::u32x4*)(cb + 8704 + lane * 32 + 16) = o1;
#undef PK16
      *(float*)(cb + 10752 + lane * 4) = gL; }
    __builtin_amdgcn_s_waitcnt(0xc07f); __builtin_amdgcn_wave_barrier();
    mg::bf16x8 fAt[2], fBh[2], fKh[2], fRt[2];
#pragma unroll
    for (int ks = 0; ks < 2; ++ks) { fAt[ks] = *(const mg::bf16x8*)(sAt + lr * RK_SK + 32 * ks + 8 * q); fBh[ks] = *(const mg::bf16x8*)(sBh + lr * RK_SK + 32 * ks + 8 * q);
      fKh[ks] = *(const mg::bf16x8*)(sKh + lr * RK_SK + 32 * ks + 8 * q); fRt[ks] = *(const mg::bf16x8*)(sRt + lr * RK_SK + 32 * ks + 8 * q); }
    const f32x4 z4 = {0.f, 0.f, 0.f, 0.f};
    f32x4 nab = z4, nabT = z4, nak = z4, nakT = z4, mbr = z4, mkr = z4;
#pragma unroll
    for (int ks = 0; ks < 2; ++ks) {
      nab = __builtin_amdgcn_mfma_f32_16x16x32_bf16(fBh[ks], fAt[ks], nab, 0, 0, 0); nabT = __builtin_amdgcn_mfma_f32_16x16x32_bf16(fAt[ks], fBh[ks], nabT, 0, 0, 0);
      nak = __builtin_amdgcn_mfma_f32_16x16x32_bf16(fKh[ks], fAt[ks], nak, 0, 0, 0); nakT = __builtin_amdgcn_mfma_f32_16x16x32_bf16(fAt[ks], fKh[ks], nakT, 0, 0, 0);
      mbr = __builtin_amdgcn_mfma_f32_16x16x32_bf16(fBh[ks], fRt[ks], mbr, 0, 0, 0); mkr = __builtin_amdgcn_mfma_f32_16x16x32_bf16(fKh[ks], fRt[ks], mkr, 0, 0, 0);
    }
    f32x4 eye;
#pragma unroll
    for (int i = 0; i < 4; ++i) { const int row = 4 * q + i;
      eye[i] = (row == lr) ? 1.f : 0.f;
      nab[i] = (row < lr) ? nab[i] : 0.f; nak[i] = (row < lr) ? nak[i] : 0.f; nabT[i] = (lr < row) ? nabT[i] : 0.f; nakT[i] = (lr < row) ? nakT[i] : 0.f;
      mbr[i] = (row <= lr) ? mbr[i] : 0.f; mkr[i] = (row <= lr) ? mkr[i] : 0.f; }
    const bf16x4 dN = pack4(nab), dNT = pack4(nabT);
    const f32x4 n2 = mma16(dNT, dN, z4), nT2 = mma16(dN, dNT, z4);
    const bf16x4 dN2 = pack4(n2), dNT2 = pack4(nT2);
    const f32x4 n4 = mma16(dNT2, dN2, z4), nT4 = mma16(dN2, dNT2, z4);
    const bf16x4 dN4 = pack4(n4), dNT4 = pack4(nT4);
    const f32x4 nT8 = mma16(dN4, dNT4, z4);
    f32x4 Tm = nab + eye;
    Tm = mma16(pack4(nT2 + eye), pack4(Tm), z4);
    Tm = mma16(pack4(nT4 + eye), pack4(Tm), z4);
    Tm = mma16(pack4(nT8 + eye), pack4(Tm), z4);
    const bf16x4 dT = pack4(Tm), dEye = pack4(eye), dMbr = pack4(mbr), dNakT = pack4(nakT);
    const f32x4 w1 = mma16(dNakT, dT, z4);
    const f32x4 w1T = mma16(dT, dNakT, z4);
    const bf16x4 dW1T = pack4(w1T); (void)w1;
    const f32x4 w2 = mma16(dW1T, dMbr, mkr);
    *(bf16x4*)(cb + 4096 + lane * 8) = pack4(w2);
#pragma unroll
    for (int kt = 0; kt < 4; ++kt) {
      const bf16x4 atT = *(const bf16x4*)(tAt + (16 * kt + lr) * 16 + 4 * q);
      const bf16x4 rtT = *(const bf16x4*)(tRt + (16 * kt + lr) * 16 + 4 * q);
      const bf16x4 bpT = *(const bf16x4*)(tBp + (16 * kt + lr) * 16 + 4 * q);
      const bf16x4 kpT = *(const bf16x4*)(tKp + (16 * kt + lr) * 16 + 4 * q);
      const f32x4 ap = mma16(atT, dT, z4);
      const f32x4 apT = mma16(dT, atT, z4);
      f32x4 rpt = mma16(pack4(apT), dMbr, z4);
      rpt = mma16(rtT, dEye, rpt);
      f32x4 ht = mma16(dW1T, bpT, z4);
      ht = mma16(dEye, kpT, ht);
      *(bf16x4*)(cb + kt * 512 + lane * 8) = pack4(ap);
      *(bf16x4*)(cb + 2048 + kt * 512 + lane * 8) = pack4(rpt);
      *(bf16x4*)(cb + 4608 + kt * 512 + lane * 8) = pack4(ht);
    }
    __builtin_amdgcn_s_waitcnt(0xc07f); __builtin_amdgcn_wave_barrier();
  }
}
__device__ __forceinline__ void rwkv_chunk_scan(const Ctx& c) {
  const unsigned char* CHK = c.ws + WS_CHK; float* YO = (float*)(c.ws + WS_YSC);
  if (c.wave >= 4) return;
  const int lane = c.lane, q = lane >> 4, lr = lane & 15, w = c.wave;
  for (int bh = c.bid; bh < BATCH * 8; bh += c.G) {
    const int h = bh & 7, b = bh >> 3;
    f32x4 S[4];
#pragma unroll
    for (int kt = 0; kt < 4; ++kt) S[kt] = (f32x4){0.f, 0.f, 0.f, 0.f};
    bf16x4 nAp[4], nRp[4], nH[4], nBp[4], nW2, nV; f32x4 nG[4];
#define RK2_LOAD(cb_) do { const unsigned char* cb__ = (cb_); \
      _Pragma("unroll") for (int kt = 0; kt < 4; ++kt) { nAp[kt] = *(const bf16x4*)(cb__ + kt * 512 + lane * 8); nRp[kt] = *(const bf16x4*)(cb__ + 2048 + kt * 512 + lane * 8); \
        nH[kt] = *(const bf16x4*)(cb__ + 4608 + kt * 512 + lane * 8); nBp[kt] = *(const bf16x4*)(cb__ + 6656 + (16 * kt + lr) * 32 + 8 * q); nG[kt] = *(const f32x4*)(cb__ + 10752 + (16 * kt + 4 * q) * 4); } \
      nW2 = *(const bf16x4*)(cb__ + 4096 + lane * 8); nV = *(const bf16x4*)(cb__ + 8704 + (16 * w + lr) * 32 + 8 * q); } while (0)
    RK2_LOAD(CHK + (size_t)(bh * 128) * CHB);
    for (int ck = 0; ck < 128; ++ck) {
      bf16x4 Ap[4], Rp[4], Hd[4], Bp[4]; f32x4 G[4];
#pragma unroll
      for (int kt = 0; kt < 4; ++kt) { Ap[kt] = nAp[kt]; Rp[kt] = nRp[kt]; Hd[kt] = nH[kt]; Bp[kt] = nBp[kt]; G[kt] = nG[kt]; }
      const bf16x4 W2 = nW2, Vq = nV;
      if (ck + 1 < 128) RK2_LOAD(CHK + (size_t)(bh * 128 + ck + 1) * CHB);
      bf16x4 Sb[4];
#pragma unroll
      for (int kt = 0; kt < 4; ++kt) Sb[kt] = pack4(S[kt]);
      f32x4 x1 = {0.f, 0.f, 0.f, 0.f}, y = {0.f, 0.f, 0.f, 0.f};
#pragma unroll
      for (int kt = 0; kt < 4; ++kt) { x1 = mma16(Ap[kt], Sb[kt], x1); y = mma16(Rp[kt], Sb[kt], y); }
      y = mma16(W2, Vq, y);
      const bf16x4 X1b = pack4(x1);
#pragma unroll
      for (int kt = 0; kt < 4; ++kt) { S[kt] = S[kt] * G[kt]; S[kt] = mma16(Bp[kt], X1b, S[kt]); S[kt] = mma16(Hd[kt], Vq, S[kt]); }
      float* yo = YO + ((size_t)b * SEQ + ck * 16 + 4 * q) * 512 + h * 64 + 16 * w + lr;
#pragma unroll
      for (int i = 0; i < 4; ++i) yo[i * 512] = y[i];
    }
#undef RK2_LOAD
  }
}

__device__ __forceinline__ void rwkv_post(const Ctx& c) {
  const float* YS = (const float*)(c.ws + WS_YSC); const bf16* P = (const bf16*)(c.ws + WS_P0); const bf16* GG = (const bf16*)(c.ws + WS_LOG);
  const float* BON = (const float*)(c.ws + WS_BON); bf16* YM = (bf16*)(c.ws + WS_YMIX);
  const float* lnw = inp(c, I0_LNW); const float* lnb = inp(c, I0_LNB); const float* mu = inp(c, I0_MU);
  for (int m = c.wave * c.G + c.bid; m < M; m += NW * c.G) {
    const int t = m % SEQ;
#pragma unroll
    for (int j = 0; j < 8; ++j) {
      const int ch = j * 64 + c.lane; const size_t o = (size_t)m * 512 + ch;
      const float y = YS[o];
      const float mean = wave_sum(y) * (1.f / 64.f);
      const float d = y - mean;
      const float var = wave_sum(d * d) * (1.f / 64.f);
      float v = d * rsqrtf(var + 64e-5f) * lnw[ch] + lnb[ch];
      const float vc = bf2f(P[(size_t)m * EVEN_IN + 1024 + ch]), vp = t > 0 ? bf2f(P[(size_t)(m - 1) * EVEN_IN + 1024 + ch]) : 0.f;
      v += BON[(size_t)m * 8 + j] * (vc + (vp - vc) * mu[1024 + ch]);
      YM[(size_t)m * D + ch] = f2bf(v * bf2f(GG[(size_t)m * 1024 + ch]));
    }
  }
}

__device__ __forceinline__ void gmlp_phase(const Ctx& c, int vb, int vG) {
  const bf16* P = (const bf16*)(c.ws + WS_P0); bf16* YM = (bf16*)(c.ws + WS_YMIX);
  const float* lnw = inp(c, I0_GLNW); const float* lnb = inp(c, I0_GLNB); const float* ws = inp(c, I0_GWS); const float* bs = inp(c, I0_GBS);
  bf16* Ws = (bf16*)c.lds; bf16* VT = (bf16*)(c.lds + 34816);
  const int w = c.wave, q = c.lane >> 4, lr = c.lane & 15;
  int gcur = -1;
  for (int it = vb; it < BATCH * 16 * 4; it += vG) {
    const int g = it & 3, ck = (it >> 2) & 15, b = it >> 6;
    const size_t m0 = (size_t)b * SEQ + ck * 128;
    __syncthreads();
    if (g != gcur) { gcur = g;
#pragma unroll
      for (int k = 0; k < 8; ++k) { const int idx = c.tid + NT * k, i = idx >> 5, j4 = (idx & 31) * 4;
        const f32x4 v = *(const f32x4*)(ws + ((size_t)g * 128 + i) * 128 + j4);
        uint2 o; o.x = mg::cvt_pk_bf16(j4 <= i ? v[0] : 0.f, j4 + 1 <= i ? v[1] : 0.f); o.y = mg::cvt_pk_bf16(j4 + 2 <= i ? v[2] : 0.f, j4 + 3 <= i ? v[3] : 0.f);
        *(uint2*)(Ws + i * SPI + j4) = o; } }
    { const float w0 = lnw[g * 128 + c.lane], w1 = lnw[g * 128 + c.lane + 64], b0 = lnb[g * 128 + c.lane], b1 = lnb[g * 128 + c.lane + 64];
      for (int j = w; j < 128; j += NW) {
        const bf16* row = P + (m0 + j) * EVEN_IN + 2304 + g * 128;
        const float v0 = gelu_(bf2f(row[c.lane])), v1 = gelu_(bf2f(row[c.lane + 64]));
        const float mean = wave_sum(v0 + v1) * (1.f / 128.f);
        const float d0 = v0 - mean, d1 = v1 - mean;
        const float rs = rsqrtf(wave_sum(d0 * d0 + d1 * d1) * (1.f / 128.f) + 1e-6f);
        VT[c.lane * SPI + j] = f2bf(d0 * rs * w0 + b0);
        VT[(c.lane + 64) * SPI + j] = f2bf(d1 * rs * w1 + b1);
      } }
    __syncthreads();
    f32x4 acc[8];
#pragma unroll
    for (int dt = 0; dt < 8; ++dt) acc[dt] = (f32x4){0.f, 0.f, 0.f, 0.f};
    const int kmax = (16 * w + 15) >> 5;
    for (int ks = 0; ks <= kmax; ++ks) { const mg::bf16x8 wf = *(const mg::bf16x8*)(Ws + (16 * w + lr) * SPI + 32 * ks + 8 * q);
#pragma unroll
      for (int dt = 0; dt < 8; ++dt) { const mg::bf16x8 vf = *(const mg::bf16x8*)(VT + (16 * dt + lr) * SPI + 32 * ks + 8 * q); acc[dt] = __builtin_amdgcn_mfma_f32_16x16x32_bf16(wf, vf, acc[dt], 0, 0, 0); } }
#pragma unroll
    for (int i = 0; i < 4; ++i) { const int r = 16 * w + 4 * q + i; const float bias = bs[g * 128 + r];
      const bf16* up = P + (m0 + r) * EVEN_IN + 1792 + g * 128 + lr; bf16* op = YM + (m0 + r) * D + 512 + g * 128 + lr;
#pragma unroll
      for (int dt = 0; dt < 8; ++dt) op[16 * dt] = f2bf(gelu_(bf2f(up[16 * dt])) * (acc[dt][i] + bias));
      asm volatile("" ::: "memory"); }
  }
  __syncthreads();
}

__device__ __forceinline__ void s5_tables(const Ctx& c) {
  const float* are = inp(c, I1_ARE); const float* aim = inp(c, I1_AIM); const float* ldt = inp(c, I1_LDT); const float* bre = inp(c, I1_BRE); const float* bim = inp(c, I1_BIM);
  float* POW = (float*)(c.ws + WS_S5POW); float* BB = (float*)(c.ws + WS_S5BB);
  for (int i = c.bid * NT + c.tid; i < 32 * 17 * 64; i += c.G * NT) {
    const int p = i & 63, tau = (i >> 6) % 17, g = i / (17 * 64);
    const float lr = are[g * 64 + p], li = aim[g * 64 + p], dt = expf(ldt[g]);
    const float mag = expf(lr * dt * (float)tau), ang = li * dt * (float)tau;
    POW[2 * i] = mag * cosf(ang); POW[2 * i + 1] = mag * sinf(ang);
  }
  for (int i = c.bid * NT + c.tid; i < 32 * 64 * 16; i += c.G * NT) {
    const int gp = i >> 4, g = gp >> 6;
    const float lr = are[gp], li = aim[gp], dt = expf(ldt[g]);
    const float mag = expf(lr * dt), ar = mag * cosf(li * dt), ai = mag * sinf(li * dt);
    const float nr = ar - 1.f, ni = ai, den = lr * lr + li * li;
    const float fr = (nr * lr + ni * li) / den, fi = (ni * lr - nr * li) / den;
    const float br = bre[i], bi = bim[i];
    BB[2 * i] = fr * br - fi * bi; BB[2 * i + 1] = fr * bi + fi * br;
  }
}
__device__ __forceinline__ void s5_taps(const Ctx& c) {
  const float* cre = inp(c, I1_CRE); const float* cim = inp(c, I1_CIM);
  const float* POW = (const float*)(c.ws + WS_S5POW); const float* BB = (const float*)(c.ws + WS_S5BB); float* KT = (float*)(c.ws + WS_S5KT);
  for (int i = c.bid * NT + c.tid; i < 32 * 16 * 256; i += c.G * NT) {
    const int c2 = i & 15, c1 = (i >> 4) & 15, tau = (i >> 8) & 15, g = i >> 12;
    float acc = 0.f;
    for (int p = 0; p < 64; ++p) {
      const float cr = cre[(g * 16 + c1) * 64 + p], ci = cim[(g * 16 + c1) * 64 + p];
      const float pr = POW[((g * 17 + tau) * 64 + p) * 2], pi = POW[((g * 17 + tau) * 64 + p) * 2 + 1];
      const float br = BB[((g * 64 + p) * 16 + c2) * 2], bi = BB[((g * 64 + p) * 16 + c2) * 2 + 1];
      const float wr = cr * pr - ci * pi, wi = cr * pi + ci * pr;
      acc += wr * br - wi * bi;
    }
    KT[i] = acc;
  }
}
__device__ __forceinline__ void s5_mats(const Ctx& c) {
  const float* cre = inp(c, I1_CRE); const float* cim = inp(c, I1_CIM);
  const float* POW = (const float*)(c.ws + WS_S5POW); const float* BB = (const float*)(c.ws + WS_S5BB); const float* KT = (const float*)(c.ws + WS_S5KT);
  bf16* BE = (bf16*)(c.ws + WS_S5BE); bf16* BTF = (bf16*)(c.ws + WS_S5BTF);
  for (int i = c.bid * NT + c.tid; i < 32 * 256 * 256; i += c.G * NT) {
    const int k = i & 255, n = (i >> 8) & 255, g = i >> 16; float v = 0.f;
    if (n < 128) { const int p = n & 63, s16 = k >> 4, c2 = k & 15;
      const float pr = POW[((g * 17 + 15 - s16) * 64 + p) * 2], pi = POW[((g * 17 + 15 - s16) * 64 + p) * 2 + 1];
      const float br = BB[((g * 64 + p) * 16 + c2) * 2], bi = BB[((g * 64 + p) * 16 + c2) * 2 + 1];
      v = (n < 64) ? (pr * br - pi * bi) : (pr * bi + pi * br); }
    BE[i] = f2bf(v);
  }
  for (int i = c.bid * NT + c.tid; i < 32 * 256 * 384; i += c.G * NT) {
    const int k = i % 384, n = (i / 384) & 255, g = i / (384 * 256), t = n >> 4, c1 = n & 15; float v = 0.f;
    if (k < 256) { const int s16 = k >> 4, c2 = k & 15; if (s16 <= t) v = KT[((g * 16 + (t - s16)) * 16 + c1) * 16 + c2]; }
    else { const int kk = k - 256, p = kk & 63;
      const float cr = cre[(g * 16 + c1) * 64 + p], ci = cim[(g * 16 + c1) * 64 + p];
      const float pr = POW[((g * 17 + t + 1) * 64 + p) * 2], pi = POW[((g * 17 + t + 1) * 64 + p) * 2 + 1];
      v = (kk < 64) ? (cr * pr - ci * pi) : -(cr * pi + ci * pr); }
    BTF[i] = f2bf(v);
  }
}
__device__ __forceinline__ void s5_carry(const Ctx& c) {
  const float* XE = (const float*)(c.ws + WS_S5XE); bf16* AP = (bf16*)(c.ws + WS_S5A); const float* POW = (const float*)(c.ws + WS_S5POW);
  for (int it = c.wave * c.G + c.bid; it < BATCH * 32; it += NW * c.G) {
    const int b = it >> 5, g = it & 31, p = c.lane;
    const float ar = POW[((g * 17 + 16) * 64 + p) * 2], ai = POW[((g * 17 + 16) * 64 + p) * 2 + 1];
    float xr = 0.f, xi = 0.f;
    const size_t row0 = (size_t)g * 1024 + b * 128;
    for (int blk0 = 0; blk0 < 128; blk0 += 8) {
      float er[8], ei[8];
#pragma unroll
      for (int j = 0; j < 8; ++j) { er[j] = XE[(row0 + blk0 + j) * 128 + p]; ei[j] = XE[(row0 + blk0 + j) * 128 + 64 + p]; }
#pragma unroll
      for (int j = 0; j < 8; ++j) {
        bf16* ap = AP + (row0 + blk0 + j) * 384 + 256;
        ap[p] = f2bf(xr); ap[64 + p] = f2bf(xi);
        const float nr = ar * xr - ai * xi + er[j], ni = ar * xi + ai * xr + ei[j];
        xr = nr; xi = ni;
      }
    }
  }
}

__device__ __forceinline__ void ssd_conv(const Ctx& c) {
  const bf16* P1 = (const bf16*)(c.ws + WS_P1); bf16* CV = (bf16*)(c.ws + WS_CONV);
  const float* cw = inp(c, I1_CW); const float* cb = inp(c, I1_CB);
  for (size_t i = (size_t)c.bid * NT + c.tid; i < (size_t)M * 128; i += (size_t)c.G * NT) {
    const int ch = (int)(i & 127) * 8; const size_t m = i >> 7; const int t = (int)(m % SEQ);
    float acc[8];
#pragma unroll
    for (int e = 0; e < 8; ++e) acc[e] = cb[ch + e];
#pragma unroll
    for (int j = 0; j < 4; ++j) { const int tt = t - 3 + j; if (tt >= 0) {
        const uint4 v = *(const uint4*)(P1 + (m - 3 + j) * 2048 + 1024 + ch); const unsigned vw[4] = {v.x, v.y, v.z, v.w};
#pragma unroll
        for (int e = 0; e < 4; ++e) { acc[2 * e] += cw[j * 1024 + ch + 2 * e] * __uint_as_float(vw[e] << 16); acc[2 * e + 1] += cw[j * 1024 + ch + 2 * e + 1] * __uint_as_float(vw[e] & 0xffff0000u); } } }
    uint4 o; o.x = mg::cvt_pk_bf16(silu_(acc[0]), silu_(acc[1])); o.y = mg::cvt_pk_bf16(silu_(acc[2]), silu_(acc[3])); o.z = mg::cvt_pk_bf16(silu_(acc[4]), silu_(acc[5])); o.w = mg::cvt_pk_bf16(silu_(acc[6]), silu_(acc[7]));
    *(uint4*)(CV + m * 1024 + ch) = o;
  }
}

constexpr int SL_C = 0, SL_B = 34816, SL_BT = 69632, SL_XT = 104448, SL_DT = 121856, SL_ACS = 123904;
__device__ __forceinline__ void ssd_dt_acs(const Ctx& c, size_t m0, int g, const float* DT, const float* dtb, const float* alog, float* sdt, float* sacs) {
  if (c.wave < 4) {
    const int h = g * 4 + c.wave; const float av = -expf(alog[h]), bias = dtb[h];
    const float d0 = softplus_(DT[(m0 + 2 * c.lane) * 8 + h] + bias), d1 = softplus_(DT[(m0 + 2 * c.lane + 1) * 8 + h] + bias);
    const float a0 = av * d0, a1 = av * d1;
    float sc = a0 + a1;
#pragma unroll
    for (int o = 1; o < 64; o <<= 1) { const float t = __shfl_up(sc, o); if (c.lane >= o) sc += t; }
    sdt[c.wave * 128 + 2 * c.lane] = d0; sdt[c.wave * 128 + 2 * c.lane + 1] = d1;
    sacs[c.wave * 128 + 2 * c.lane] = sc - a1; sacs[c.wave * 128 + 2 * c.lane + 1] = sc;
  }
}
__device__ __forceinline__ void ssd_pass1(const Ctx& c) {
  const bf16* CV = (const bf16*)(c.ws + WS_CONV); const float* DT = (const float*)(c.ws + WS_DT);
  float* YD = (float*)(c.ws + WS_YD); float* SE = (float*)(c.ws + WS_SE); float* ATOT = (float*)(c.ws + WS_ATOT);
  const float* dtb = inp(c, I1_DTB); const float* alog = inp(c, I1_ALOG);
  bf16* Cs = (bf16*)(c.lds + SL_C); bf16* Bs = (bf16*)(c.lds + SL_B); bf16* BTs = (bf16*)(c.lds + SL_BT); bf16* XT = (bf16*)(c.lds + SL_XT);
  float* sdt = (float*)(c.lds + SL_DT); float* sacs = (float*)(c.lds + SL_ACS);
  const int w = c.wave, q = c.lane >> 4, lr = c.lane & 15;
  for (int unit = c.bid; unit < BATCH * 16 * 2; unit += c.G) {
    const int g = unit & 1, ck = (unit >> 1) & 15, b = unit >> 5;
    const size_t m0 = (size_t)b * SEQ + ck * 128;
    __syncthreads();
#pragma unroll
    for (int i = 0; i < 8; ++i) { const int idx = c.tid + NT * i, mat = idx >> 11, r = (idx >> 4) & 127, qq = idx & 15;
      const uint4 v = *(const uint4*)(CV + (m0 + r) * 1024 + 512 + mat * 256 + g * 128 + qq * 8);
      *(uint4*)((mat ? Cs : Bs) + r * SPI + qq * 8) = v; }
#pragma unroll
    for (int i = 0; i < 4; ++i) { const int task = c.tid + NT * i, n = task & 127, l0 = (task >> 7) * 8;
      unsigned short e[8];
#pragma unroll
      for (int j = 0; j < 8; ++j) e[j] = CV[(m0 + l0 + j) * 1024 + 512 + g * 128 + n];
      uint4 o; o.x = e[0] | ((unsigned)e[1] << 16); o.y = e[2] | ((unsigned)e[3] << 16); o.z = e[4] | ((unsigned)e[5] << 16); o.w = e[6] | ((unsigned)e[7] << 16);
      *(uint4*)(BTs + n * SPI + l0) = o; }
    ssd_dt_acs(c, m0, g, DT, dtb, alog, sdt, sacs);
    __syncthreads();
    mg::bf16x8 cf[4];
#pragma unroll
    for (int ks = 0; ks < 4; ++ks) cf[ks] = *(const mg::bf16x8*)(Cs + (16 * w + lr) * SPI + 32 * ks + 8 * q);
    f32x4 cb[8];
#pragma unroll
    for (int j = 0; j < 8; ++j) { cb[j] = (f32x4){0.f, 0.f, 0.f, 0.f};
#pragma unroll
      for (int ks = 0; ks < 4; ++ks) { const mg::bf16x8 bf = *(const mg::bf16x8*)(Bs + (16 * j + lr) * SPI + 32 * ks + 8 * q); cb[j] = __builtin_amdgcn_mfma_f32_16x16x32_bf16(cf[ks], bf, cb[j], 0, 0, 0); } }
    __syncthreads();
    bf16* Ms = Bs;
    for (int r = 0; r < 4; ++r) {
      const int h = g * 4 + r;
#pragma unroll
      for (int i = 0; i < 2; ++i) { const int task = c.tid + NT * i, p = task & 63, l0 = (task >> 6) * 8;
        unsigned short e[8];
#pragma unroll
        for (int j = 0; j < 8; ++j) e[j] = CV[(m0 + l0 + j) * 1024 + h * 64 + p];
        uint4 o; o.x = e[0] | ((unsigned)e[1] << 16); o.y = e[2] | ((unsigned)e[3] << 16); o.z = e[4] | ((unsigned)e[5] << 16); o.w = e[6] | ((unsigned)e[7] << 16);
        *(uint4*)(XT + p * SPI + l0) = o; }
      const float* ac = sacs + r * 128; const float* dl = sdt + r * 128;
#pragma unroll
      for (int j = 0; j < 8; ++j) { const int sidx = 16 * j + lr; const float as = ac[sidx], ds = dl[sidx];
#pragma unroll
        for (int i = 0; i < 4; ++i) { const int l = 16 * w + 4 * q + i;
          const float v = (sidx <= l) ? cb[j][i] * __expf(fminf(ac[l] - as, 0.f)) * ds : 0.f;
          Ms[l * SPI + sidx] = f2bf(v); } }
      __syncthreads();
      { f32x4 ya[4];
#pragma unroll
        for (int pt = 0; pt < 4; ++pt) ya[pt] = (f32x4){0.f, 0.f, 0.f, 0.f};
        const int kmax = (16 * w + 15) >> 5;
        for (int ks = 0; ks <= kmax; ++ks) { const mg::bf16x8 mf = *(const mg::bf16x8*)(Ms + (16 * w + lr) * SPI + 32 * ks + 8 * q);
#pragma unroll
          for (int pt = 0; pt < 4; ++pt) { const mg::bf16x8 xf = *(const mg::bf16x8*)(XT + (16 * pt + lr) * SPI + 32 * ks + 8 * q); ya[pt] = __builtin_amdgcn_mfma_f32_16x16x32_bf16(mf, xf, ya[pt], 0, 0, 0); } }
#pragma unroll
        for (int pt = 0; pt < 4; ++pt)
#pragma unroll
          for (int i = 0; i < 4; ++i) YD[(m0 + 16 * w + 4 * q + i) * 512 + h * 64 + 16 * pt + lr] = ya[pt][i]; }
      { const int pt = w & 3, ntb = (w >> 2) * 4; const float aend = ac[127];
        f32x4 sa[4];
#pragma unroll
        for (int nt = 0; nt < 4; ++nt) sa[nt] = (f32x4){0.f, 0.f, 0.f, 0.f};
#pragma unroll
        for (int ks = 0; ks < 4; ++ks) { const uint4 xr = *(const uint4*)(XT + (16 * pt + lr) * SPI + 32 * ks + 8 * q); const unsigned xw[4] = {xr.x, xr.y, xr.z, xr.w};
          float xv[8];
#pragma unroll
          for (int e = 0; e < 4; ++e) { const int l = 32 * ks + 8 * q + 2 * e;
            xv[2 * e] = __uint_as_float(xw[e] << 16) * dl[l] * __expf(aend - ac[l]); xv[2 * e + 1] = __uint_as_float(xw[e] & 0xffff0000u) * dl[l + 1] * __expf(aend - ac[l + 1]); }
          union { uint4 u; mg::bf16x8 v; } xs; xs.u.x = mg::cvt_pk_bf16(xv[0], xv[1]); xs.u.y = mg::cvt_pk_bf16(xv[2], xv[3]); xs.u.z = mg::cvt_pk_bf16(xv[4], xv[5]); xs.u.w = mg::cvt_pk_bf16(xv[6], xv[7]);
#pragma unroll
          for (int nt = 0; nt < 4; ++nt) { const mg::bf16x8 bt = *(const mg::bf16x8*)(BTs + (16 * (ntb + nt) + lr) * SPI + 32 * ks + 8 * q); sa[nt] = __builtin_amdgcn_mfma_f32_16x16x32_bf16(xs.v, bt, sa[nt], 0, 0, 0); } }
        float* Eo = SE + ((size_t)(b * 8 + h) * 16 + ck) * 8192;
#pragma unroll
        for (int nt = 0; nt < 4; ++nt)
#pragma unroll
          for (int i = 0; i < 4; ++i) Eo[(16 * pt + 4 * q + i) * 128 + 16 * (ntb + nt) + lr] = sa[nt][i];
        if (c.tid == 0) ATOT[(b * 8 + h) * 16 + ck] = aend; }
      __syncthreads();
    }
  }
  __syncthreads();
}
__device__ __forceinline__ void ssd_carry(const Ctx& c) {
  const float* SE = (const float*)(c.ws + WS_SE); const float* ATOT = (const float*)(c.ws + WS_ATOT); bf16* SPV = (bf16*)(c.ws + WS_SPV);
  for (int i = c.bid * NT + c.tid; i < BATCH * 8 * 2048; i += c.G * NT) {
    const int bh = i >> 11, e4 = (i & 2047) * 4;
    f32x4 S = {0.f, 0.f, 0.f, 0.f};
    for (int ck = 0; ck < 16; ++ck) {
      const size_t o = ((size_t)bh * 16 + ck) * 8192 + e4;
      uint2 pk; pk.x = mg::cvt_pk_bf16(S[0], S[1]); pk.y = mg::cvt_pk_bf16(S[2], S[3]);
      *(uint2*)(SPV + o) = pk;
      const float d = __expf(ATOT[bh * 16 + ck]); const f32x4 e = *(const f32x4*)(SE + o);
      S = S * d + e;
    }
  }
}
__device__ __forceinline__ void ssd_pass2(const Ctx& c) {
  const bf16* CV = (const bf16*)(c.ws + WS_CONV); const float* DT = (const float*)(c.ws + WS_DT); const bf16* P1 = (const bf16*)(c.ws + WS_P1);
  const float* YD = (const float*)(c.ws + WS_YD); const bf16* SPV = (const bf16*)(c.ws + WS_SPV); bf16* YM = (bf16*)(c.ws + WS_YMIX);
  const float* dtb = inp(c, I1_DTB); const float* alog = inp(c, I1_ALOG); const float* dsk = inp(c, I1_MD); const float* nw = inp(c, I1_MNW);
  bf16* Cs = (bf16*)(c.lds + SL_C); bf16* SPs = (bf16*)(c.lds + SL_B);
  float* sdt = (float*)(c.lds + SL_DT); float* sacs = (float*)(c.lds + SL_ACS);
  const int w = c.wave, q = c.lane >> 4, lr = c.lane & 15;
  for (int unit = c.bid; unit < BATCH * 16 * 2; unit += c.G) {
    const int g = unit & 1, ck = (unit >> 1) & 15, b = unit >> 5;
    const size_t m0 = (size_t)b * SEQ + ck * 128;
    __syncthreads();
#pragma unroll
    for (int i = 0; i < 4; ++i) { const int idx = c.tid + NT * i, r = idx >> 4, qq = idx & 15;
      *(uint4*)(Cs + r * SPI + qq * 8) = *(const uint4*)(CV + (m0 + r) * 1024 + 768 + g * 128 + qq * 8); }
#pragma unroll
    for (int i = 0; i < 8; ++i) { const int idx = c.tid + NT * i, r = idx >> 10, p = (idx >> 4) & 63, qq = idx & 15;
      *(uint4*)(SPs + (r * 64 + p) * SPI + qq * 8) = *(const uint4*)(SPV + ((size_t)(b * 8 + g * 4 + r) * 16 + ck) * 8192 + p * 128 + qq * 8); }
    ssd_dt_acs(c, m0, g, DT, dtb, alog, sdt, sacs);
    __syncthreads();
    mg::bf16x8 cf[4];
#pragma unroll
    for (int ks = 0; ks < 4; ++ks) cf[ks] = *(const mg::bf16x8*)(Cs + (16 * w + lr) * SPI + 32 * ks + 8 * q);
    f32x4 yo[4][4];
#pragma unroll
    for (int r = 0; r < 4; ++r)
#pragma unroll
      for (int pt = 0; pt < 4; ++pt) { yo[r][pt] = (f32x4){0.f, 0.f, 0.f, 0.f};
#pragma unroll
        for (int ks = 0; ks < 4; ++ks) { const mg::bf16x8 sf = *(const mg::bf16x8*)(SPs + (r * 64 + 16 * pt + lr) * SPI + 32 * ks + 8 * q); yo[r][pt] = __builtin_amdgcn_mfma_f32_16x16x32_bf16(cf[ks], sf, yo[r][pt], 0, 0, 0); } }
    float dh[4];
#pragma unroll
    for (int r = 0; r < 4; ++r) dh[r] = dsk[g * 4 + r];
    float ss[4];
#pragma unroll
    for (int i = 0; i < 4; ++i) {
      const int l = 16 * w + 4 * q + i; const size_t m = m0 + l;
      const float* ydp = YD + m * 512 + g * 256 + lr; const bf16* cvp = CV + m * 1024 + g * 256 + lr; const bf16* zp = P1 + m * 2048 + 512 + g * 256 + lr;
      float sq = 0.f;
#pragma unroll
      for (int r = 0; r < 4; ++r) { const float ea = __expf(sacs[r * 128 + l]);
#pragma unroll
        for (int pt = 0; pt < 4; ++pt) { const int o = r * 64 + 16 * pt;
          const float y = ydp[o] + ea * yo[r][pt][i] + dh[r] * bf2f(cvp[o]);
          const float vv = y * silu_(bf2f(zp[o]));
          yo[r][pt][i] = vv; sq += vv * vv; } }
      ss[i] = rsqrtf(row16_sum(sq) * (1.f / 256.f) + 1e-6f);
      asm volatile("" ::: "memory");
    }
#pragma unroll
    for (int i = 0; i < 4; ++i) { const int l = 16 * w + 4 * q + i;
      bf16* ymp = YM + (m0 + l) * D + 512 + g * 256 + lr; const float* nwp = nw + g * 256 + lr;
#pragma unroll
      for (int r = 0; r < 4; ++r)
#pragma unroll
        for (int pt = 0; pt < 4; ++pt) { const int o = r * 64 + 16 * pt; ymp[o] = f2bf(yo[r][pt][i] * ss[i] * nwp[o]); }
      asm volatile("" ::: "memory");
    }
  }
  __syncthreads();
}

__device__ __forceinline__ void moe_assign(const Ctx& c) {
  LAS unsigned* lcnt = (LAS unsigned*)c.lds; LAS unsigned* lbase = lcnt + 8;
  const int* tok_e = (const int*)(c.ws + WS_ROUTE); int* tok_slot = (int*)(c.ws + WS_ROUTE + 256 * 1024); int* slot_tok = (int*)(c.ctl + CW_SLOTTOK);
  int pstart[8]; { int acc = 0;
#pragma unroll
    for (int e = 0; e < 8; ++e) { pstart[e] = acc; acc += ((int)c.ctl[CW_CNT + 64 * e] + 255) / 256 * 256; } }
  for (int tb = c.bid; tb < M / 64; tb += c.G) {
    __syncthreads();
    if (c.tid < 8) lcnt[c.tid] = 0u;
    __syncthreads();
    int e = 0; unsigned rank = 0; const int pair = tb * 128 + c.tid;
    if (c.tid < 128) { e = tok_e[pair]; rank = atomicAdd((unsigned*)&lcnt[e], 1u); }
    __syncthreads();
    if (c.tid < 8) lbase[c.tid] = atomicAdd(c.ctl + CW_CUR + 64 * c.tid, lcnt[c.tid]);
    __syncthreads();
    if (c.tid < 128) {
      int ps = 0;
#pragma unroll
      for (int q = 0; q < 8; ++q) ps = (e == q) ? pstart[q] : ps;
      const int slot = ps + (int)lbase[e] + (int)rank;
      slot_tok[slot] = pair >> 1; tok_slot[pair] = slot;
    }
  }
  __syncthreads();
}


enum { PH_PRO, PH_WIN0, PH_PREPA, PH_LORA, PH_PREPC, PH_SCAN, PH_POST, PH_WOUT0, PH_NORM0, PH_FGU, PH_FD, PH_NORM1, PH_WIN1, PH_L1A, PH_L1B, PH_L1C, PH_L1D, PH_WOUT1, PH_NORM2, PH_ASSIGN, PH_MGU, PH_MD, PH_FINAL, PH_COUNT };
constexpr int LAST_PHASE = PH_COUNT;
template <int LO, int HI, int BREG = 0>
__global__ void __launch_bounds__(NT, 2) fwd_kernel(Args args) {
  extern __shared__ __attribute__((aligned(16))) unsigned char lds[];
  Ctx c0; c0.out = args.out; c0.ws = args.ws; c0.ctl = (unsigned*)(args.ws + WS_CTL); c0.lds = lds;
  c0.tid = threadIdx.x; c0.lane = c0.tid & 63; c0.wave = __builtin_amdgcn_readfirstlane(c0.tid >> 6); c0.bid = blockIdx.x; c0.G = gridDim.x;
  volatile LAS unsigned* bst = (volatile LAS unsigned*)(LAS unsigned char*)(lds + LDS_BST);
  if (c0.tid == 0) { LAS unsigned long long* pt = (LAS unsigned long long*)(LAS unsigned char*)(lds + LDS_PTAB);
#pragma unroll
    for (int i = 0; i < N_IN; ++i) pt[i] = (unsigned long long)args.in[i];
    bst[0] = 0u; bst[1] = 0u; }
  __syncthreads();
  constexpr int lo = LO, hi = HI;
  if constexpr (hi - lo > 1) (void)xcd_barrier_post(c0.ctl + CW_BAR + BREG * 4096, bst);
#define IN(k) (lo <= (k) && (k) < hi)
#define SEAM(k) do { if constexpr (IN(k) && IN((k) + 1)) { XcdBarrier bar_; bar_.bar = (unsigned*)(args.ws + WS_CTL) + CW_BAR + BREG * 4096; bar_.x = xb_xcc_id(); \
    bar_.st = (volatile LAS unsigned*)(LAS unsigned char*)(lds + LDS_BST); xcd_barrier(bar_); } } while (0)

  LAS unsigned char* const ldsl = (LAS unsigned char*)lds;
  if constexpr (IN(PH_PRO)) { const Ctx c = launder(c0); cvt_dense(c); build_wlora(c); s5_tables(c); norm_phase<0, 0>(c, inp(c, I_X), nullptr, nullptr, nullptr, inp(c, I0_NPM), ((bf16*)(c.ws + WS_XN)), nullptr, 0, 0, nullptr); } SEAM(PH_PRO);
  if constexpr (IN(PH_WIN0)) { const Ctx c = launder(c0); s5_taps(c); mg::Gemm g{((bf16*)(c.ws + WS_XN)), (const bf16*)(c.ws + WS_WIN0), D, D, D}; mg::DenseOrder S; S.init(M / 256, EVEN_IN / 256, c.G, c.bid);
    mg::EpiBf16<false> E{(bf16*)(c.ws + WS_P0), EVEN_IN}; mg::gemm_phase(ldsl, g, S, E); } SEAM(PH_WIN0);
  if constexpr (IN(PH_PREPA)) { const Ctx c = launder(c0); rwkv_prep_a(c); } SEAM(PH_PREPA);
  if constexpr (IN(PH_LORA)) { const Ctx c = launder(c0); mg::Gemm g{(const bf16*)(c.ws + WS_ALORA), (const bf16*)(c.ws + WS_WLORA), 256, 256, 256}; mg::DenseOrder S; S.init(M / 256, 1536 / 256, c.G, c.bid);
    mg::EpiLora E{(bf16*)(c.ws + WS_LOWA), (bf16*)(c.ws + WS_LOG)}; mg::gemm_phase(ldsl, g, S, E); } SEAM(PH_LORA);
  if constexpr (IN(PH_PREPC)) { const Ctx c = launder(c0); rwkv_chunk_prep(c); } SEAM(PH_PREPC);
  if constexpr (IN(PH_SCAN)) { const Ctx c = launder(c0); if (c.G >= 256) { if (c.bid < 64) rwkv_chunk_scan(c); else gmlp_phase(c, c.bid - 64, c.G - 64); } else { rwkv_chunk_scan(c); gmlp_phase(c, c.bid, c.G); } } SEAM(PH_SCAN);
  if constexpr (IN(PH_POST)) { const Ctx c = launder(c0); rwkv_post(c); } SEAM(PH_POST);
  if constexpr (IN(PH_WOUT0)) { const Ctx c = launder(c0); mg::Gemm g{((bf16*)(c.ws + WS_YMIX)), (const bf16*)(c.ws + WS_WOUT0), D, D, D}; mg::DenseOrder S; S.init(M / 256, D / 256, c.G, c.bid);
    mg::EpiBf16<false> E{(bf16*)(c.ws + WS_Y), D}; mg::gemm_phase(ldsl, g, S, E); } SEAM(PH_WOUT0);
  if constexpr (IN(PH_NORM0)) { const Ctx c = launder(c0); norm_phase<1, 0>(c, inp(c, I_X), args.out, ((float*)(c.ws + WS_Y)), inp(c, I0_NPOM), inp(c, I0_NPF), ((bf16*)(c.ws + WS_XN)), nullptr, 0, 0, nullptr); } SEAM(PH_NORM0);
  if constexpr (IN(PH_FGU)) { const Ctx c = launder(c0); mg::Gemm g{((bf16*)(c.ws + WS_XN)), (const bf16*)(c.ws + WS_FGU), D, D, D}; mg::DenseOrder S; S.init(M / 256, 2 * FFN / 256, c.G, c.bid);
    mg::EpiSwigluT E{(bf16*)(c.ws + WS_H), FFN}; mg::gemm_phase(ldsl, g, S, E); } SEAM(PH_FGU);
  if constexpr (IN(PH_FD)) { const Ctx c = launder(c0); mg::Gemm g{(const bf16*)(c.ws + WS_H), (const bf16*)(c.ws + WS_FD), FFN, FFN, FFN}; mg::DenseOrder S; S.init(M / 256, D / 256, c.G, c.bid);
    mg::EpiBf16<false> E{(bf16*)(c.ws + WS_Y), D}; mg::gemm_phase(ldsl, g, S, E); } SEAM(PH_FD);
  if constexpr (IN(PH_NORM1)) { const Ctx c = launder(c0); s5_mats(c); norm_phase<1, 1>(c, args.out, args.out, ((float*)(c.ws + WS_Y)), inp(c, I0_NPOF), inp(c, I1_NPM), ((bf16*)(c.ws + WS_XN)), inp(c, I1_WIN), ODD_IN, 2048, (float*)(c.ws + WS_DT)); } SEAM(PH_NORM1);
  if constexpr (IN(PH_WIN1)) { const Ctx c = launder(c0); mg::Gemm g{((bf16*)(c.ws + WS_XN)), (const bf16*)(c.ws + WS_WIN1), D, D, D}; mg::DenseOrder S; S.init(M / 256, 2048 / 256, c.G, c.bid);
    mg::EpiP1 E{(bf16*)(c.ws + WS_P1), (bf16*)(c.ws + WS_S5A)}; mg::gemm_phase(ldsl, g, S, E); } SEAM(PH_WIN1);
  if constexpr (IN(PH_L1A)) { const Ctx c = launder(c0);
    { mg::Gemm g{(const bf16*)(c.ws + WS_S5A), (const bf16*)(c.ws + WS_S5BE), 384, 256, 256}; mg::S5Order S; S.G = c.G; S.c = c.bid; mg::EpiS5E E{(float*)(c.ws + WS_S5XE)}; mg::gemm_phase(ldsl, g, S, E); }
    ssd_conv(c); cvt_moe(c, c.bid, c.G, 0); } SEAM(PH_L1A);
  if constexpr (IN(PH_L1B)) { const Ctx c = launder(c0); s5_carry(c); ssd_pass1(c); } SEAM(PH_L1B);
  if constexpr (IN(PH_L1C)) { const Ctx c = launder(c0);
    { mg::Gemm g{(const bf16*)(c.ws + WS_S5A), (const bf16*)(c.ws + WS_S5BTF), 384, 384, 384}; mg::S5Order S; S.G = c.G; S.c = c.bid; mg::EpiS5Y E{(bf16*)(c.ws + WS_YC), (const bf16*)(c.ws + WS_S5A), inp(c, I1_SD)}; mg::gemm_phase(ldsl, g, S, E); }
    ssd_carry(c); } SEAM(PH_L1C);
  if constexpr (IN(PH_L1D)) { const Ctx c = launder(c0);
    { mg::Gemm g{(const bf16*)(c.ws + WS_YC), (const bf16*)(c.ws + WS_GLU), 512, 512, 512}; mg::DenseOrder S; S.init(M / 256, 512 / 256, c.G, c.bid);
      mg::EpiGluT E{((bf16*)(c.ws + WS_YMIX)), D, (const bf16*)(c.ws + WS_YC), inp(c, I1_GLB)}; mg::gemm_phase(ldsl, g, S, E); }
    ssd_pass2(c); cvt_moe(c, c.bid, c.G, 1); } SEAM(PH_L1D);
  if constexpr (IN(PH_WOUT1)) { const Ctx c = launder(c0); mg::Gemm g{((bf16*)(c.ws + WS_YMIX)), (const bf16*)(c.ws + WS_WOUT1), D, D, D}; mg::DenseOrder S; S.init(M / 256, D / 256, c.G, c.bid);
    mg::EpiBf16<false> E{(bf16*)(c.ws + WS_Y), D}; mg::gemm_phase(ldsl, g, S, E); } SEAM(PH_WOUT1);
  if constexpr (IN(PH_NORM2)) { const Ctx c = launder(c0); norm_phase<1, 2>(c, args.out, args.out, ((float*)(c.ws + WS_Y)), inp(c, I1_NPOM), inp(c, I1_NPF), ((bf16*)(c.ws + WS_XN)), inp(c, I1_RT), 8, 0, nullptr); } SEAM(PH_NORM2);
  if constexpr (IN(PH_ASSIGN)) { const Ctx c = launder(c0); moe_assign(c); } SEAM(PH_ASSIGN);
#define MOE_SCHED(S, nn, bse, bof) do { int acc_ = 0; \
    _Pragma("unroll") for (int e = 0; e < 8; ++e) { acc_ += ((int)c.ctl[CW_CNT + 64 * e] + 255) / 256 * 256; S.pend[e] = acc_; } \
    S.init(acc_ / 256, nn, c.G, c.bid); S.bstride_e = (bse); S.boff = (bof); S.rowidx = (const int*)(c.ctl + CW_SLOTTOK); } while (0)
  if constexpr (IN(PH_MGU)) { const Ctx c = launder(c0); mg::Gemm g{(const bf16*)(c.ws + WS_XN8), (const bf16*)(c.ws + WS_MGU), D, D, D}; mg::MoeOrder<true, true> S; MOE_SCHED(S, FE / 128, (size_t)2 * FE * D, 0);
    mg::EpiSwigluF8 E{c.ws + WS_HID, FE}; mg::gemm_phase(ldsl, g, S, E); } SEAM(PH_MGU);
  if constexpr (IN(PH_MD)) { const Ctx c = launder(c0); mg::Gemm g{(const bf16*)(c.ws + WS_HID), (const bf16*)(c.ws + WS_MD), FE, FE, FE}; mg::MoeOrder<false, true> S; MOE_SCHED(S, D / 256, (size_t)D * FE, 0);
    mg::EpiBf16S E{(bf16*)(c.ws + WS_YS), D, 1.f / 2048.f}; mg::gemm_phase(ldsl, g, S, E); } SEAM(PH_MD);
  if constexpr (IN(PH_FINAL)) { const Ctx c = launder(c0); norm_phase<2, 0>(c, args.out, args.out, nullptr, inp(c, I1_NPOF), nullptr, nullptr, nullptr, 0, 0, nullptr); }
#undef MOE_SCHED
#undef IN
#undef SEAM
}

template <int P> static void launch_one(const Args& a, hipStream_t stream) { hipLaunchKernelGGL((fwd_kernel<P, P + 1>), dim3(256), dim3(NT), LDS_BYTES, stream, a); }
template <int P> static bool set_attr_one() { return hipFuncSetAttribute((const void*)fwd_kernel<P, P + 1>, hipFuncAttributeMaxDynamicSharedMemorySize, LDS_BYTES) == hipSuccess; }
template <int... Ps> static void launch_all(const Args& a, hipStream_t stream, std::integer_sequence<int, Ps...>) { (launch_one<Ps>(a, stream), ...); }
template <int... Ps> static bool set_attr_all(std::integer_sequence<int, Ps...>) { return (set_attr_one<Ps>() && ...); }

extern "C" void kernel_launch(void* const* d_in, const int* in_sizes, int n_in, void* d_out, int out_size, void* d_ws, size_t ws_size, hipStream_t stream) {
  static int ready = 0;
  if (!ready) {
    bool ok = true;
    if (n_in != N_IN || out_size != M * D || ws_size < WS_END) { fprintf(stderr, "kernel_launch: unexpected problem: n_in %d out %d ws %zu (need %zu)\n", n_in, out_size, ws_size, (size_t)WS_END); ok = false; }
#if PROBE_PHASE >= 0
    if (ok && (hipFuncSetAttribute((const void*)fwd_kernel<0, PROBE_PHASE + 1, 0>, hipFuncAttributeMaxDynamicSharedMemorySize, LDS_BYTES) != hipSuccess ||
               hipFuncSetAttribute((const void*)fwd_kernel<PROBE_PHASE, PROBE_PHASE + 1, 1>, hipFuncAttributeMaxDynamicSharedMemorySize, LDS_BYTES) != hipSuccess ||
               hipFuncSetAttribute((const void*)fwd_kernel<PROBE_PHASE + 1, LAST_PHASE, 2>, hipFuncAttributeMaxDynamicSharedMemorySize, LDS_BYTES) != hipSuccess)) ok = false;
#elif ONE_LAUNCH
    if (ok && hipFuncSetAttribute((const void*)fwd_kernel<0, LAST_PHASE>, hipFuncAttributeMaxDynamicSharedMemorySize, LDS_BYTES) != hipSuccess) ok = false;
#else
    if (ok && !set_attr_all(std::make_integer_sequence<int, LAST_PHASE>{})) ok = false;
#endif
    if (!ok) fprintf(stderr, "kernel_launch: setup failed\n");
    ready = ok ? 1 : -1;
  }
  if (ready < 0) return;
  (void)hipMemsetAsync((char*)d_ws + WS_CTL, 0, CTL_BYTES, stream);
  Args a{};
  for (int i = 0; i < N_IN; ++i) a.in[i] = (const float*)d_in[i];
  a.out = (float*)d_out; a.ws = (unsigned char*)d_ws;
#if PROBE_PHASE >= 0
  hipLaunchKernelGGL((fwd_kernel<0, PROBE_PHASE + 1, 0>), dim3(256), dim3(NT), LDS_BYTES, stream, a);
  hipLaunchKernelGGL((fwd_kernel<PROBE_PHASE, PROBE_PHASE + 1, 1>), dim3(256), dim3(NT), LDS_BYTES, stream, a);
  hipLaunchKernelGGL((fwd_kernel<PROBE_PHASE + 1, LAST_PHASE, 2>), dim3(256), dim3(NT), LDS_BYTES, stream, a);
#elif ONE_LAUNCH
  hipLaunchKernelGGL((fwd_kernel<0, LAST_PHASE>), dim3(256), dim3(NT), LDS_BYTES, stream, a);
#else
  launch_all(a, stream, std::make_integer_sequence<int, LAST_PHASE>{});
#endif
}
```

```cpp
#include <hip/hip_runtime.h>
#include <stdint.h>
#include <stdio.h>
#include <utility>

#ifndef PROBE_PHASE
#define PROBE_PHASE -1
#endif
#ifndef ONE_LAUNCH
#define ONE_LAUNCH 1
#endif

constexpr int D = 1024, BATCH = 8, SEQ = 2048, M = BATCH * SEQ;
constexpr int A_W = 512, A_IN = 1792, EVEN_IN = 2816, FFN = 2816;
constexpr int ODD_IN = 2056, NE = 8, FE = 3584;
constexpr int MAXSLOT = 2 * M + NE * 256;
constexpr int NT = 512, NW = 8;

typedef unsigned short bf16;
typedef float f32x4 __attribute__((ext_vector_type(4)));
#define LAS __attribute__((address_space(3)))

enum {
  I_X = 0,
  I0_NPM, I0_WIN, I0_MU, I0_W0, I0_W2, I0_A0, I0_A2, I0_G2, I0_KK, I0_KA, I0_RK, I0_LNW, I0_LNB,
  I0_GLNW, I0_GLNB, I0_GWS, I0_GBS, I0_WOUT, I0_NPOM, I0_NPF, I0_FG, I0_FU, I0_FD, I0_NPOF,
  I1_NPM, I1_WIN, I1_ARE, I1_AIM, I1_LDT, I1_BRE, I1_BIM, I1_CRE, I1_CIM, I1_SD, I1_GLW, I1_GLB,
  I1_CW, I1_CB, I1_DTB, I1_ALOG, I1_MD, I1_MNW, I1_WOUT, I1_NPOM, I1_NPF, I1_RT, I1_MG, I1_MU, I1_MDN, I1_NPOF,
  N_IN
};
static_assert(N_IN == 51, "input count");

constexpr size_t MiB = 1ull << 20;
constexpr size_t WS_CTL = 0, CTL_BYTES = 1 * MiB;
constexpr size_t KiB = 1024;
constexpr size_t WS_WIN0 = 1 * MiB;
constexpr size_t WS_WOUT0 = WS_WIN0 + 5632 * KiB;
constexpr size_t WS_FGU = WS_WOUT0 + 2048 * KiB;
constexpr size_t WS_FD = WS_FGU + 11264 * KiB;
constexpr size_t WS_WIN1 = WS_FD + 5632 * KiB;
constexpr size_t WS_GLU = WS_WIN1 + 4096 * KiB;
constexpr size_t WS_WOUT1 = WS_GLU + 512 * KiB;
constexpr size_t WS_WLORA = WS_WOUT1 + 2048 * KiB;
constexpr size_t WS_DENSE_END = WS_WLORA + 768 * KiB;
constexpr size_t WS_MGU = 33 * MiB;
constexpr size_t WS_MD = 145 * MiB;
constexpr size_t WS_XN = 201 * MiB;
constexpr size_t WS_YMIX = 233 * MiB;
constexpr size_t WS_Y = 265 * MiB;
constexpr size_t WS_BIG = 329 * MiB;
constexpr size_t WS_P0 = WS_BIG;
constexpr size_t WS_SR = WS_MGU;
constexpr size_t WS_SW = WS_SR + 32 * MiB, WS_SK = WS_SW + 32 * MiB, WS_SV = WS_SK + 32 * MiB, WS_SA = WS_SV + 32 * MiB, WS_SB = WS_Y;
constexpr size_t WS_LOG = WS_P0 + 88 * MiB;
constexpr size_t WS_BON = WS_LOG + 32 * MiB;
constexpr size_t WS_L0END = WS_BON + 1 * MiB;
constexpr size_t WS_CHK = WS_MGU;
constexpr int CHB = 11264;
constexpr size_t WS_ALORA = WS_MGU + 160 * MiB;
constexpr size_t WS_LOWA = WS_XN;
static_assert(WS_DENSE_END <= WS_MGU && WS_ALORA + 8 * MiB <= WS_XN, "lora buffers");
static_assert(WS_SA + 32 * MiB <= WS_XN && WS_CHK + (size_t)BATCH * 8 * 128 * CHB <= WS_ALORA, "streams / chunk operators inside the MoE weight region");
constexpr size_t WS_H = WS_BIG;
constexpr size_t WS_P1 = WS_BIG;
constexpr size_t WS_DT = WS_P1 + 64 * MiB;
constexpr size_t WS_S5A = WS_YMIX;
constexpr size_t WS_S5XE = WS_XN;
constexpr size_t WS_S5BE = 176 * MiB;
constexpr size_t WS_S5BTF = 180 * MiB;
constexpr size_t WS_S5POW = WS_BIG + 129 * MiB;
constexpr size_t WS_S5BB = WS_S5POW + 320 * KiB;
constexpr size_t WS_S5KT = WS_S5BB + 320 * KiB;
constexpr size_t WS_ATOT = WS_DT + 768 * KiB;
constexpr size_t WS_CONV = WS_DT + 1 * MiB;
constexpr size_t WS_YD = WS_CONV + 32 * MiB;
constexpr size_t WS_YC = WS_Y;
constexpr size_t WS_SE = WS_Y + 16 * MiB;
constexpr size_t WS_SPV = WS_SE + 32 * MiB;
constexpr size_t WS_HID = WS_BIG;
constexpr size_t WS_XN8 = 176 * MiB;
constexpr size_t WS_YS = WS_YMIX;
constexpr size_t WS_ROUTE = WS_BIG + 120 * MiB;
constexpr size_t WS_END = 462 * MiB;
static_assert(WS_S5KT + 512 * KiB <= WS_END && WS_L0END <= WS_S5POW && WS_L0END <= WS_END && WS_YD + 32 * MiB <= WS_END && WS_ROUTE + 1 * MiB <= WS_END && WS_SPV + 16 * MiB <= WS_BIG, "workspace map");
static_assert((size_t)MAXSLOT * FE <= 120 * MiB && (size_t)MAXSLOT * D * 2 <= 96 * MiB && WS_MD + (size_t)8 * D * FE <= WS_XN8 && WS_MGU + (size_t)8 * 2 * FE * D <= WS_MD, "moe buffers");
constexpr int CW_BAR = 16384;
constexpr int CW_CNT = 8192;
constexpr int CW_CUR = 8192 + 64 * 8;
constexpr int CW_SLOTTOK = 65536;
static_assert((CW_SLOTTOK + MAXSLOT) * 4 <= (int)CTL_BYTES, "ctl");

constexpr int SPI = 136;
constexpr int LDS_BYTES = 147456;

__device__ __forceinline__ float bf2f(bf16 v) { return __uint_as_float(((unsigned)v) << 16); }
__device__ __forceinline__ bf16 f2bf(float f) { unsigned u = __float_as_uint(f); u += 0x7fffu + ((u >> 16) & 1u); return (bf16)(u >> 16); }
template <int CTRL> __device__ __forceinline__ float dpp_f(float v) { return __int_as_float(__builtin_amdgcn_update_dpp(0, __float_as_int(v), CTRL, 0xf, 0xf, true)); }
__device__ __forceinline__ float row16_sum(float v) { v += dpp_f<0xB1>(v); v += dpp_f<0x4E>(v); v += dpp_f<0x141>(v); v += dpp_f<0x140>(v); return v; }
__device__ __forceinline__ float wave_sum(float v) { v = row16_sum(v); v += __shfl_xor(v, 16); v += __shfl_xor(v, 32); return v; }
__device__ __forceinline__ float sigmoid_(float x) { return 1.f / (1.f + expf(-x)); }
__device__ __forceinline__ float silu_(float x) { return x / (1.f + expf(-x)); }
__device__ __forceinline__ float gelu_(float x) { const float u = 0.7978845608028654f * (x + 0.044715f * x * x * x); return 0.5f * x * (1.f + tanhf(u)); }
__device__ __forceinline__ float softplus_(float x) { return fmaxf(x, 0.f) + log1pf(expf(-fabsf(x))); }

#define XB_TMO      128
#define XB_XCNT(j)  (256  + 64 * (j))
#define XB_XSUB(j)  (1280 + 64 * (j))
#define XB_XGEN(j)  (2304 + 64 * (j))
#define XB_TOP      3328
#define XB_TOPGEN   3392
#define XCD_BAR_WORDS 3456
#define XB_SPIN_CAP (1u << 22)

__device__ __forceinline__ unsigned xb_ld(unsigned* p)              { return __hip_atomic_load(p, __ATOMIC_RELAXED, __HIP_MEMORY_SCOPE_AGENT); }
__device__ __forceinline__ unsigned xb_add(unsigned* p, unsigned v) { return __hip_atomic_fetch_add(p, v, __ATOMIC_RELAXED, __HIP_MEMORY_SCOPE_AGENT); }
__device__ __forceinline__ unsigned xb_xcc_id() { return (unsigned)__builtin_amdgcn_s_getreg((3 << 11) | 20) & 0xFu; }
#define XB_SPIN(cond, bar) do { unsigned _sp = 0; while (cond) { __builtin_amdgcn_s_sleep(1); \
    if ((++_sp & 255u) == 0u) { if (xb_ld(&(bar)[XB_TMO])) break; if (_sp > XB_SPIN_CAP) { atomicAdd(&(bar)[XB_TMO], 1u); break; } } } } while (0)

struct XcdBarrier { unsigned* bar; unsigned x; volatile LAS unsigned* st; };

__device__ __forceinline__ XcdBarrier xcd_barrier_post(unsigned* bar, volatile LAS unsigned* st) {
    XcdBarrier b; b.bar = bar; b.x = xb_xcc_id(); b.st = st;
    if (threadIdx.x == 0) (void)xb_add(&bar[XB_XCNT(b.x)], 1u);
    return b;
}
__device__ __forceinline__ void xcd_barrier_complete(unsigned* bar, unsigned x, unsigned& nloc, unsigned& nx) {
    const unsigned G = gridDim.x * gridDim.y * gridDim.z;
    unsigned sum, cnt, mine, sp = 0u;
    for (;;) {
        sum = 0u; cnt = 0u; mine = 0u;
#pragma unroll
        for (unsigned j = 0; j < 16; ++j) { const unsigned c = xb_ld(&bar[XB_XCNT(j)]); sum += c; cnt += (c > 0u) ? 1u : 0u; mine = (j == x) ? c : mine; }
        if (sum == G) break;
        __builtin_amdgcn_s_sleep(1);
        if ((++sp & 255u) == 0u) { if (xb_ld(&bar[XB_TMO])) break; if (sp > XB_SPIN_CAP) { atomicAdd(&bar[XB_TMO], 1u); break; } }
    }
    nloc = mine > 0u ? mine : 1u; nx = cnt > 0u ? cnt : 1u;
}
__device__ __forceinline__ void xcd_barrier(const XcdBarrier& b) {
    asm volatile("s_waitcnt vmcnt(0)" ::: "memory");
    __syncthreads();
    if (threadIdx.x == 0) {
        unsigned* bar = b.bar;
        __builtin_amdgcn_s_waitcnt(0);
        unsigned nloc = b.st[0], nx = b.st[1];
        if (nloc == 0u) { xcd_barrier_complete(bar, b.x, nloc, nx); b.st[0] = nloc; b.st[1] = nx; }
        const unsigned old = xb_add(&bar[XB_XSUB(b.x)], 1u);
        const unsigned gen = old / nloc;
        if (old + 1u == (gen + 1u) * nloc) {
            __builtin_amdgcn_fence(__ATOMIC_RELEASE, "agent");
            asm volatile("s_waitcnt vmcnt(0)" ::: "memory");
            const unsigned og = xb_add(&bar[XB_TOP], 1u);
            const unsigned tg = og / nx;
            if (og + 1u == (tg + 1u) * nx) xb_add(&bar[XB_TOPGEN], 1u);
            else XB_SPIN(xb_ld(&bar[XB_TOPGEN]) == tg, bar);
            __builtin_amdgcn_fence(__ATOMIC_ACQUIRE, "agent");
            xb_add(&bar[XB_XGEN(b.x)], 1u);
            asm volatile("s_waitcnt vmcnt(0)" ::: "memory");
        } else {
            XB_SPIN(xb_ld(&bar[XB_XGEN(b.x)]) == gen, bar);
            __builtin_amdgcn_fence(__ATOMIC_ACQUIRE, "agent");
            asm volatile("s_waitcnt vmcnt(0)" ::: "memory");
        }
    }
    __syncthreads();
}

struct Args { const float* in[N_IN]; float* out; unsigned char* ws; int lo, hi; };
struct Ctx {
  float* out; unsigned char* ws; unsigned* ctl;
  unsigned char* lds;
  int tid, lane, wave, bid, G;
};
__device__ __forceinline__ Ctx launder(Ctx c) {
  asm volatile("" : "+v"(c.tid), "+v"(c.lane));
  asm volatile("" : "+s"(c.wave), "+s"(c.bid), "+s"(c.G));
  return c;
}
constexpr int LDS_PTAB = LDS_BYTES - 1024;
constexpr int LDS_BST = LDS_BYTES - 16;
__device__ __forceinline__ const float* inp(const Ctx& c, int k) {
  const LAS unsigned* pt = (const LAS unsigned*)(LAS unsigned char*)(c.lds + LDS_PTAB);
  const unsigned lo = __builtin_amdgcn_readfirstlane(pt[2 * k]), hi = __builtin_amdgcn_readfirstlane(pt[2 * k + 1]);
  return (const float*)(((unsigned long long)hi << 32) | lo);
}


namespace mg {
typedef short bf16x8 __attribute__((ext_vector_type(8)));
typedef unsigned u32x4 __attribute__((ext_vector_type(4)));
constexpr int BM = 256, BK = 64, HALF = 128, HTB = HALF * BK * 2, STAGE_BYTES = 8 * HTB, NXCD = 8, WGM = 8;
constexpr int LDS_IDX = STAGE_BYTES;
__host__ __device__ __forceinline__ int lds_byte(int r, int c) { const int st = (r >> 4) * 2 + (c >> 5), rr = r & 15, cc = c & 31, ob = rr * 64 + cc * 2; return st * 1024 + (ob ^ (((ob >> 9) & 1) << 5)); }
__host__ __device__ __forceinline__ void stage_rc(int b, int& R, int& C) { const int st = b / 1024, sb = b % 1024, swz = sb ^ (((sb >> 9) & 1) << 5); R = (st >> 1) * 16 + swz / 64; C = (st & 1) * 32 + (swz % 64) / 2; }
__host__ __device__ __forceinline__ int perm32(int rho) { const int n = rho >> 4, i = rho & 15; return 8 * (i >> 2) + 4 * n + (i & 3); }
typedef int i32x4_ __attribute__((ext_vector_type(4)));
typedef int i32x8_ __attribute__((ext_vector_type(8)));
__device__ __forceinline__ i32x8_ cat8(bf16x8 a, bf16x8 b) { const i32x4_ x = __builtin_bit_cast(i32x4_, a), y = __builtin_bit_cast(i32x4_, b); return __builtin_shufflevector(x, y, 0, 1, 2, 3, 4, 5, 6, 7); }
struct Unit { int pm, pn; };
struct Gemm { const bf16* A; const bf16* Bt; int lda, ldb, K; };

struct Tiles {
  int nM, nN, nwg, G, c;
  __device__ __forceinline__ void init(int nM_, int nN_, int G_, int c_) { nM = nM_; nN = nN_; nwg = nM * nN; G = G_; c = c_; }
  __device__ __forceinline__ bool next(int i, Unit& u) const {
    const long L = (long)i * G + c; if (L >= nwg) return false;
    int wgid = (int)L; { const int q = nwg / NXCD, r = nwg % NXCD, xcd = wgid % NXCD, off = wgid / NXCD; wgid = (xcd < r ? xcd * (q + 1) : r * (q + 1) + (xcd - r) * q) + off; }
    const int nig = WGM * nN, gid = wgid / nig, fm = gid * WGM, gsz = (nM - fm) < WGM ? (nM - fm) : WGM;
    u.pm = fm + ((wgid % nig) % gsz); u.pn = (wgid % nig) / gsz; return true;
  }
};
struct DenseOrder : Tiles {
  static constexpr bool GATHER = false, FP8 = false;
  const int* rowidx;
  __device__ __forceinline__ const char* a_tile(const Gemm& g, const Unit& u) const { return (const char*)g.A + (size_t)u.pm * BM * g.lda * 2; }
  __device__ __forceinline__ const char* b_tile(const Gemm& g, const Unit& u) const { return (const char*)g.Bt + (size_t)u.pn * BM * g.ldb * 2; }
};
struct S5Order {
  static constexpr bool GATHER = false, FP8 = false;
  int G, c; const int* rowidx;
  __device__ __forceinline__ bool next(int i, Unit& u) const { const int L = i * G + c; if (L >= 128) return false; u.pm = L; u.pn = 0; return true; }
  __device__ __forceinline__ const char* a_tile(const Gemm& g, const Unit& u) const { return (const char*)g.A + (size_t)u.pm * BM * g.lda * 2; }
  __device__ __forceinline__ const char* b_tile(const Gemm& g, const Unit& u) const { return (const char*)g.Bt + (size_t)(u.pm >> 2) * BM * g.ldb * 2; }
};
template <bool GATHER_, bool FP8_> struct MoeOrder : Tiles {
  static constexpr bool GATHER = GATHER_, FP8 = FP8_; static constexpr int ES = FP8_ ? 1 : 2;
  int pend[8]; size_t bstride_e, boff; const int* rowidx;
  __device__ __forceinline__ int expert(int pm) const { int e = 0;
#pragma unroll
    for (int q = 0; q < 7; ++q) e += (pm * BM >= pend[q]) ? 1 : 0;
    return e; }
  __device__ __forceinline__ const char* a_tile(const Gemm& g, const Unit& u) const { return (const char*)g.A + (size_t)u.pm * BM * g.lda * ES; }
  __device__ __forceinline__ const char* b_tile(const Gemm& g, const Unit& u) const { return (const char*)g.Bt + (size_t)expert(u.pm) * bstride_e + boff + (size_t)u.pn * BM * g.ldb * ES; }
};

typedef float f32x2_ __attribute__((ext_vector_type(2)));
typedef __bf16 bfx2_ __attribute__((ext_vector_type(2)));
__device__ __forceinline__ unsigned cvt_pk_bf16(float lo, float hi) { const f32x2_ v = {lo, hi}; const bfx2_ r = __builtin_convertvector(v, bfx2_); return __builtin_bit_cast(unsigned, r); }

struct EpiF32 { static constexpr bool PERM = false; float* C; int ldc;
  __device__ __forceinline__ void operator()(const f32x4 (&acc)[2][2][4][2], const Unit& u, int wr, int wc, int fr, int fq) const {
    const int row0 = u.pm * BM + wr * 64 + fr, col0 = u.pn * BM + wc * 32 + 4 * fq;
#pragma unroll
    for (int ai = 0; ai < 2; ++ai)
#pragma unroll
      for (int m = 0; m < 4; ++m) { float* rowp = C + (size_t)(row0 + ai * HALF + m * 16) * ldc + col0;
#pragma unroll
        for (int bj = 0; bj < 2; ++bj)
#pragma unroll
          for (int n = 0; n < 2; ++n) *(f32x4*)(rowp + bj * HALF + n * 16) = acc[ai][bj][m][n]; }
  } };
template <bool ACCUM> struct EpiBf16 { static constexpr bool PERM = true; bf16* O; int ldc;
  __device__ __forceinline__ void operator()(const f32x4 (&acc)[2][2][4][2], const Unit& u, int wr, int wc, int fr, int fq) const {
    const int row0 = u.pm * BM + wr * 64 + fr, col0 = u.pn * BM + wc * 32 + 8 * fq;
#pragma unroll
    for (int ai = 0; ai < 2; ++ai)
#pragma unroll
      for (int m = 0; m < 4; ++m) { bf16* rowp = O + (size_t)(row0 + ai * HALF + m * 16) * ldc + col0;
#pragma unroll
        for (int bj = 0; bj < 2; ++bj) { f32x4 v0 = acc[ai][bj][m][0], v1 = acc[ai][bj][m][1];
          if (ACCUM) { const u32x4 o = *(const u32x4*)(rowp + bj * HALF);
            v0[0] += __uint_as_float(o.x << 16); v0[1] += __uint_as_float(o.x & 0xffff0000u); v0[2] += __uint_as_float(o.y << 16); v0[3] += __uint_as_float(o.y & 0xffff0000u);
            v1[0] += __uint_as_float(o.z << 16); v1[1] += __uint_as_float(o.z & 0xffff0000u); v1[2] += __uint_as_float(o.w << 16); v1[3] += __uint_as_float(o.w & 0xffff0000u); }
          u32x4 w; w.x = cvt_pk_bf16(v0[0], v0[1]); w.y = cvt_pk_bf16(v0[2], v0[3]); w.z = cvt_pk_bf16(v1[0], v1[1]); w.w = cvt_pk_bf16(v1[2], v1[3]);
          *(u32x4*)(rowp + bj * HALF) = w; } }
  } };
struct EpiP1 { static constexpr bool PERM = true; bf16* P1; bf16* AP;
  __device__ __forceinline__ void operator()(const f32x4 (&acc)[2][2][4][2], const Unit& u, int wr, int wc, int fr, int fq) const {
    const int row0 = u.pm * BM + wr * 64 + fr, col0 = u.pn * BM + wc * 32 + 8 * fq;
#pragma unroll
    for (int ai = 0; ai < 2; ++ai)
#pragma unroll
      for (int m = 0; m < 4; ++m) { const int row = row0 + ai * HALF + m * 16;
#pragma unroll
        for (int bj = 0; bj < 2; ++bj) { const int col = col0 + bj * HALF; const f32x4 v0 = acc[ai][bj][m][0], v1 = acc[ai][bj][m][1];
          u32x4 w; w.x = cvt_pk_bf16(v0[0], v0[1]); w.y = cvt_pk_bf16(v0[2], v0[3]); w.z = cvt_pk_bf16(v1[0], v1[1]); w.w = cvt_pk_bf16(v1[2], v1[3]);
          bf16* dst;
          if (u.pn < 2) { const int g = col >> 4, c0 = col & 15, b = row >> 11, ta = row & 2047; dst = AP + ((size_t)(g * 1024 + b * 128 + (ta >> 4)) * 384 + (ta & 15) * 16 + c0); }
          else dst = P1 + (size_t)row * 2048 + col;
          *(u32x4*)dst = w; } }
  } };
struct EpiS5E { static constexpr bool PERM = false; float* XE;
  __device__ __forceinline__ void operator()(const f32x4 (&acc)[2][2][4][2], const Unit& u, int wr, int wc, int fr, int fq) const {
    const int row0 = u.pm * BM + wr * 64 + fr, col0 = wc * 32 + 4 * fq;
#pragma unroll
    for (int ai = 0; ai < 2; ++ai)
#pragma unroll
      for (int m = 0; m < 4; ++m) { float* rowp = XE + (size_t)(row0 + ai * HALF + m * 16) * 128 + col0;
#pragma unroll
        for (int n = 0; n < 2; ++n) *(f32x4*)(rowp + n * 16) = acc[ai][0][m][n]; }
  } };
struct EpiS5Y { static constexpr bool PERM = true; bf16* YC; const bf16* AP; const float* dsk;
  __device__ __forceinline__ void operator()(const f32x4 (&acc)[2][2][4][2], const Unit& u, int wr, int wc, int fr, int fq) const {
    const int row0 = u.pm * BM + wr * 64 + fr, g = u.pm >> 2;
#pragma unroll
    for (int ai = 0; ai < 2; ++ai)
#pragma unroll
      for (int m = 0; m < 4; ++m) { const int row = row0 + ai * HALF + m * 16, rg = row & 1023, b = rg >> 7, blk = rg & 127;
#pragma unroll
        for (int bj = 0; bj < 2; ++bj) { const int col0 = bj * HALF + wc * 32 + 8 * fq, t = col0 >> 4, ch = g * 16 + (col0 & 15);
          const u32x4 uv = *(const u32x4*)(AP + (size_t)row * 384 + col0);
          const f32x4 d0 = *(const f32x4*)(dsk + ch), d1 = *(const f32x4*)(dsk + ch + 4);
          const float uu[8] = {__uint_as_float(uv.x << 16), __uint_as_float(uv.x & 0xffff0000u), __uint_as_float(uv.y << 16), __uint_as_float(uv.y & 0xffff0000u),
                               __uint_as_float(uv.z << 16), __uint_as_float(uv.z & 0xffff0000u), __uint_as_float(uv.w << 16), __uint_as_float(uv.w & 0xffff0000u)};
          float h[8];
#pragma unroll
          for (int e = 0; e < 4; ++e) { h[e] = gelu_(acc[ai][bj][m][0][e] + d0[e] * uu[e]); h[4 + e] = gelu_(acc[ai][bj][m][1][e] + d1[e] * uu[4 + e]); }
          u32x4 w; w.x = cvt_pk_bf16(h[0], h[1]); w.y = cvt_pk_bf16(h[2], h[3]); w.z = cvt_pk_bf16(h[4], h[5]); w.w = cvt_pk_bf16(h[6], h[7]);
          *(u32x4*)(YC + (size_t)(b * 2048 + blk * 16 + t) * 512 + ch) = w; } }
  } };
struct EpiLora { static constexpr bool PERM = true; bf16* O0; bf16* O1;
  __device__ __forceinline__ void operator()(const f32x4 (&acc)[2][2][4][2], const Unit& u, int wr, int wc, int fr, int fq) const {
    bf16* base = (u.pn < 4) ? O0 : O1; constexpr int ldc = 1024;
    const int row0 = u.pm * BM + wr * 64 + fr, col0 = (u.pn & 3) * BM + wc * 32 + 8 * fq;
#pragma unroll
    for (int ai = 0; ai < 2; ++ai)
#pragma unroll
      for (int m = 0; m < 4; ++m) { bf16* rowp = base + (size_t)(row0 + ai * HALF + m * 16) * ldc + col0;
#pragma unroll
        for (int bj = 0; bj < 2; ++bj) { const f32x4 v0 = acc[ai][bj][m][0], v1 = acc[ai][bj][m][1];
          u32x4 w; w.x = cvt_pk_bf16(v0[0], v0[1]); w.y = cvt_pk_bf16(v0[2], v0[3]); w.z = cvt_pk_bf16(v1[0], v1[1]); w.w = cvt_pk_bf16(v1[2], v1[3]);
          *(u32x4*)(rowp + bj * HALF) = w; } }
  } };
struct EpiSwigluT { static constexpr bool PERM = true; bf16* O; int ldc;
  __device__ __forceinline__ void operator()(const f32x4 (&acc)[2][2][4][2], const Unit& u, int wr, int wc, int fr, int fq) const {
    const int row0 = u.pm * BM + wr * 64 + fr, col0 = u.pn * HALF + wc * 32 + 8 * fq;
#pragma unroll
    for (int ai = 0; ai < 2; ++ai)
#pragma unroll
      for (int m = 0; m < 4; ++m) { bf16* rowp = O + (size_t)(row0 + ai * HALF + m * 16) * ldc + col0;
        float h[8];
#pragma unroll
        for (int n = 0; n < 2; ++n)
#pragma unroll
          for (int e = 0; e < 4; ++e) { const float gte = acc[ai][0][m][n][e], up = acc[ai][1][m][n][e]; h[n * 4 + e] = gte * __builtin_amdgcn_rcpf(1.f + __expf(-gte)) * up; }
        u32x4 w; w.x = cvt_pk_bf16(h[0], h[1]); w.y = cvt_pk_bf16(h[2], h[3]); w.z = cvt_pk_bf16(h[4], h[5]); w.w = cvt_pk_bf16(h[6], h[7]);
        *(u32x4*)rowp = w; }
  } };
__device__ __forceinline__ unsigned pk4_fp8(float a, float b, float c, float d) {
  a = __builtin_amdgcn_fmed3f(a, -448.f, 448.f); b = __builtin_amdgcn_fmed3f(b, -448.f, 448.f); c = __builtin_amdgcn_fmed3f(c, -448.f, 448.f); d = __builtin_amdgcn_fmed3f(d, -448.f, 448.f);
  int w = 0; w = __builtin_amdgcn_cvt_pk_fp8_f32(a, b, w, false); w = __builtin_amdgcn_cvt_pk_fp8_f32(c, d, w, true); return (unsigned)w; }
struct EpiSwigluF8 { static constexpr bool PERM = true; unsigned char* O; int ldc;
  __device__ __forceinline__ void operator()(const f32x4 (&acc)[2][2][4][2], const Unit& u, int wr, int wc, int fr, int fq) const {
    const int row0 = u.pm * BM + wr * 64 + fr, col0 = u.pn * HALF + wc * 32 + 8 * fq;
#pragma unroll
    for (int ai = 0; ai < 2; ++ai)
#pragma unroll
      for (int m = 0; m < 4; ++m) { unsigned char* rowp = O + (size_t)(row0 + ai * HALF + m * 16) * ldc + col0;
        float h[8];
#pragma unroll
        for (int n = 0; n < 2; ++n)
#pragma unroll
          for (int e = 0; e < 4; ++e) { const float gte = acc[ai][0][m][n][e] * (1.f / 4096.f), up = acc[ai][1][m][n][e] * (8.f / 4096.f); h[n * 4 + e] = gte * __builtin_amdgcn_rcpf(1.f + __expf(-gte)) * up; }
        uint2 w; w.x = pk4_fp8(h[0], h[1], h[2], h[3]); w.y = pk4_fp8(h[4], h[5], h[6], h[7]);
        *(uint2*)rowp = w; }
  } };
struct EpiBf16S { static constexpr bool PERM = true; bf16* O; int ldc; float scale;
  __device__ __forceinline__ void operator()(const f32x4 (&acc)[2][2][4][2], const Unit& u, int wr, int wc, int fr, int fq) const {
    const int row0 = u.pm * BM + wr * 64 + fr, col0 = u.pn * BM + wc * 32 + 8 * fq;
#pragma unroll
    for (int ai = 0; ai < 2; ++ai)
#pragma unroll
      for (int m = 0; m < 4; ++m) { bf16* rowp = O + (size_t)(row0 + ai * HALF + m * 16) * ldc + col0;
#pragma unroll
        for (int bj = 0; bj < 2; ++bj) { const f32x4 v0 = acc[ai][bj][m][0] * scale, v1 = acc[ai][bj][m][1] * scale;
          u32x4 w; w.x = cvt_pk_bf16(v0[0], v0[1]); w.y = cvt_pk_bf16(v0[2], v0[3]); w.z = cvt_pk_bf16(v1[0], v1[1]); w.w = cvt_pk_bf16(v1[2], v1[3]);
          *(u32x4*)(rowp + bj * HALF) = w; } }
  } };
struct EpiGluT { static constexpr bool PERM = true; bf16* O; int ldc; const bf16* Yc; const float* bias;
  __device__ __forceinline__ void operator()(const f32x4 (&acc)[2][2][4][2], const Unit& u, int wr, int wc, int fr, int fq) const {
    const int row0 = u.pm * BM + wr * 64 + fr, col0 = u.pn * BM + wc * 32 + 8 * fq;
#pragma unroll
    for (int ai = 0; ai < 2; ++ai)
#pragma unroll
      for (int m = 0; m < 4; ++m) { const int row = row0 + ai * HALF + m * 16;
#pragma unroll
        for (int bj = 0; bj < 2; ++bj) { const int col = col0 + bj * HALF;
          const u32x4 yv = *(const u32x4*)(Yc + (size_t)row * 512 + col);
          const f32x4 b0 = *(const f32x4*)(bias + col), b1 = *(const f32x4*)(bias + col + 4);
          const float y[8] = {__uint_as_float(yv.x << 16), __uint_as_float(yv.x & 0xffff0000u), __uint_as_float(yv.y << 16), __uint_as_float(yv.y & 0xffff0000u),
                              __uint_as_float(yv.z << 16), __uint_as_float(yv.z & 0xffff0000u), __uint_as_float(yv.w << 16), __uint_as_float(yv.w & 0xffff0000u)};
          float h[8];
#pragma unroll
          for (int e = 0; e < 4; ++e) { h[e] = y[e] * __builtin_amdgcn_rcpf(1.f + __expf(-(acc[ai][bj][m][0][e] + b0[e]))); h[4 + e] = y[4 + e] * __builtin_amdgcn_rcpf(1.f + __expf(-(acc[ai][bj][m][1][e] + b1[e]))); }
          u32x4 w; w.x = cvt_pk_bf16(h[0], h[1]); w.y = cvt_pk_bf16(h[2], h[3]); w.z = cvt_pk_bf16(h[4], h[5]); w.w = cvt_pk_bf16(h[6], h[7]);
          *(u32x4*)(O + (size_t)row * ldc + col) = w; } }
  } };

template <class Epi, class Sched>
__device__ __forceinline__ void gemm_phase(LAS unsigned char* lds, const Gemm g, const Sched& S, const Epi& E) {
  const int tid = threadIdx.x, wid = __builtin_amdgcn_readfirstlane(tid >> 6), lane = tid & 63, wr = wid >> 2, wc = wid & 3, fr = lane & 15, fq = lane >> 4;
  constexpr int ES = Sched::FP8 ? 1 : 2;
  const int K = g.K, nt = K * ES / 128;
  unsigned voffA[2], voffB[2]; int gR[2], gC[2];
#pragma unroll
  for (int i = 0; i < 2; ++i) { int R, C; stage_rc(tid * 16 + i * 8192, R, C); const int Rb = Epi::PERM ? ((R & ~31) + perm32(R & 31)) : R;
    voffA[i] = (unsigned)(R * g.lda * ES + C * 2); voffB[i] = (unsigned)(Rb * g.ldb * ES + C * 2); gR[i] = R; gC[i] = C * 2; }
  const size_t kstep = (size_t)(BK * 2);
  const size_t hstepA = (size_t)HALF * g.lda * ES, hstepB = (size_t)HALF * g.ldb * ES;
  const unsigned ldsw = (unsigned)wid * 1024u;
  const unsigned rowb = (unsigned)(g.lda * ES);
  const int aoff = lds_byte(wr * 64 + fr, fq * 8), boff = lds_byte(wc * 32 + fr, fq * 8);
#define PG8_SA(b, h) (((b) * 2 + (h)) * HTB)
#define PG8_SB(b, h) ((4 + (b) * 2 + (h)) * HTB)
#define PG8_STAGE(bufoff, gbase, voff) do { _Pragma("unroll") for (int _i = 0; _i < 2; ++_i) \
    __builtin_amdgcn_global_load_lds((const unsigned*)((const char*)(gbase) + (voff)[_i]), (LAS unsigned*)(lds + (bufoff) + ldsw + _i * 8192), 16, 0, 0); } while (0)
#define PG8_STAGE_A(bufoff, p, h, goff) do { if constexpr (Sched::GATHER) PG8_STAGE(bufoff, p, (goff)[h]); else PG8_STAGE(bufoff, (p) + (h) * hstepA, voffA); } while (0)
#define PG8_LDA(dst, b, h) do { _Pragma("unroll") for (int m = 0; m < 4; ++m) { if constexpr (Sched::FP8) dst##8[m] = __builtin_shufflevector(*(const LAS i32x4_*)(lds + PG8_SA(b, h) + aoff + m * 2048), *(const LAS i32x4_*)(lds + PG8_SA(b, h) + aoff + m * 2048 + 1024), 0, 1, 2, 3, 4, 5, 6, 7); \
    else { _Pragma("unroll") for (int k = 0; k < 2; ++k) dst[m][k] = *(const LAS bf16x8*)(lds + PG8_SA(b, h) + aoff + m * 2048 + k * 1024); } } } while (0)
#define PG8_LDB(dst, b, h) do { _Pragma("unroll") for (int n = 0; n < 2; ++n) { if constexpr (Sched::FP8) dst##8[n] = __builtin_shufflevector(*(const LAS i32x4_*)(lds + PG8_SB(b, h) + boff + n * 2048), *(const LAS i32x4_*)(lds + PG8_SB(b, h) + boff + n * 2048 + 1024), 0, 1, 2, 3, 4, 5, 6, 7); \
    else { _Pragma("unroll") for (int k = 0; k < 2; ++k) dst[n][k] = *(const LAS bf16x8*)(lds + PG8_SB(b, h) + boff + n * 2048 + k * 1024); } } } while (0)
  int sc1 = 0x7f7f7f7f; asm volatile("" : "+v"(sc1));
#define PG8_MMA(ai, bj, At, Bt) do { __builtin_amdgcn_s_setprio(1); _Pragma("unroll") for (int m = 0; m < 4; ++m) _Pragma("unroll") for (int n = 0; n < 2; ++n) { \
    if constexpr (Sched::FP8) asm volatile("v_mfma_scale_f32_16x16x128_f8f6f4 %0, %1, %2, %0, %3, %3 op_sel_hi:[0,0,0]" : "+v"(acc[ai][bj][m][n]) : "v"(Bt##8[n]), "v"(At##8[m]), "v"(sc1)); \
    else { _Pragma("unroll") for (int k = 0; k < 2; ++k) acc[ai][bj][m][n] = __builtin_amdgcn_mfma_f32_16x16x32_bf16(Bt[n][k], At[m][k], acc[ai][bj][m][n], 0, 0, 0); } } \
    __builtin_amdgcn_s_setprio(0); } while (0)
#define PG8_WAIT_V(n) asm volatile("s_waitcnt vmcnt(" #n ")" ::: "memory")
#define PG8_WAIT_L(n) asm volatile("s_waitcnt lgkmcnt(" #n ")" ::: "memory")
#define PG8_BAR __builtin_amdgcn_s_barrier()
#define PG8_SCHED __builtin_amdgcn_sched_barrier(0)
  Unit cur, nxt; int ui = 0;
  if (!S.next(0, cur)) return;
  f32x4 acc[2][2][4][2];
#pragma unroll
  for (int a = 0; a < 2; ++a)
#pragma unroll
    for (int b = 0; b < 2; ++b)
#pragma unroll
      for (int m = 0; m < 4; ++m)
#pragma unroll
        for (int n = 0; n < 2; ++n) acc[a][b][m][n] = (f32x4){0.f, 0.f, 0.f, 0.f};
  bf16x8 At[4][2], B0[2][2], B1[2][2];
  i32x8_ At8[4], B08[2], B18[2];
  unsigned gcu[2][2] = {{0u, 0u}, {0u, 0u}};
  const char* cA = Sched::GATHER ? (const char*)g.A : S.a_tile(g, cur); const char* cB = S.b_tile(g, cur);
  if constexpr (Sched::GATHER) {
#pragma unroll
    for (int h = 0; h < 2; ++h)
#pragma unroll
      for (int i = 0; i < 2; ++i) gcu[h][i] = (unsigned)S.rowidx[cur.pm * BM + h * HALF + gR[i]] * rowb + (unsigned)gC[i];
  }
  PG8_STAGE(PG8_SB(0, 0), cB, voffB); PG8_STAGE(PG8_SB(0, 1), cB + hstepB, voffB); PG8_STAGE_A(PG8_SA(0, 0), cA, 0, gcu); PG8_STAGE_A(PG8_SA(0, 1), cA, 1, gcu);
  if (wr == 1) PG8_BAR;
  PG8_WAIT_V(2); PG8_BAR;
  PG8_STAGE(PG8_SB(1, 0), cB + kstep, voffB); PG8_STAGE_A(PG8_SA(1, 0), cA + kstep, 0, gcu); PG8_STAGE(PG8_SB(1, 1), cB + hstepB + kstep, voffB);
  PG8_WAIT_V(6); PG8_BAR;
  for (;;) {
    const bool has_next = S.next(ui + 1, nxt);
    const char* nA = Sched::GATHER ? (const char*)g.A : (has_next ? S.a_tile(g, nxt) : cA); const char* nB = has_next ? S.b_tile(g, nxt) : cB;
    if constexpr (Sched::GATHER) {
      if (has_next && wid < 4) __builtin_amdgcn_global_load_lds((const unsigned*)(S.rowidx + nxt.pm * BM + wid * 64 + lane), (LAS unsigned*)(lds + LDS_IDX + ((ui + 1) & 1) * 1024 + wid * 256), 4, 0, 0);
    }
#pragma nounroll
    for (int t = 0; t < nt; t += 2) {
      const bool last = (t == nt - 2);
      const char* a1 = cA + (size_t)(t + 1) * kstep;
      const char* a2 = last ? nA : cA + (size_t)(t + 2) * kstep; const char* b2 = last ? nB : cB + (size_t)(t + 2) * kstep;
      const char* a3 = a2 + kstep; const char* b3 = b2 + kstep;
      unsigned g2[2][2];
#pragma unroll
      for (int h = 0; h < 2; ++h)
#pragma unroll
        for (int i = 0; i < 2; ++i) g2[h][i] = gcu[h][i];
      if constexpr (Sched::GATHER) {
        if (last && has_next) {
          const LAS unsigned* ix = (const LAS unsigned*)(lds + LDS_IDX + ((ui + 1) & 1) * 1024);
#pragma unroll
          for (int h = 0; h < 2; ++h)
#pragma unroll
            for (int i = 0; i < 2; ++i) g2[h][i] = ix[h * HALF + gR[i]] * rowb + (unsigned)gC[i];
        }
      }
      PG8_LDB(B0, 0, 0); PG8_LDB(B1, 0, 1); PG8_SCHED; PG8_LDA(At, 0, 0); PG8_STAGE_A(PG8_SA(1, 1), a1, 1, gcu);
      PG8_WAIT_V(8); PG8_WAIT_L(0); PG8_BAR; PG8_MMA(0, 0, At, B0); PG8_MMA(0, 1, At, B1); PG8_BAR; PG8_SCHED;
      PG8_LDA(At, 0, 1); PG8_STAGE(PG8_SB(0, 0), b2, voffB); PG8_STAGE(PG8_SB(0, 1), b2 + hstepB, voffB); PG8_STAGE_A(PG8_SA(0, 0), a2, 0, g2);
      PG8_WAIT_V(8); PG8_WAIT_L(0); PG8_BAR; PG8_MMA(1, 0, At, B0); PG8_MMA(1, 1, At, B1); PG8_BAR; PG8_SCHED;
      PG8_LDB(B0, 1, 0); PG8_LDB(B1, 1, 1); PG8_SCHED; PG8_LDA(At, 1, 0); PG8_STAGE_A(PG8_SA(0, 1), a2, 1, g2);
      PG8_WAIT_V(8); PG8_WAIT_L(0); PG8_BAR; PG8_MMA(0, 0, At, B0); PG8_MMA(0, 1, At, B1); PG8_BAR; PG8_SCHED;
      PG8_LDA(At, 1, 1); PG8_STAGE(PG8_SB(1, 0), b3, voffB); PG8_STAGE(PG8_SB(1, 1), b3 + hstepB, voffB); PG8_STAGE_A(PG8_SA(1, 0), a3, 0, g2);
      PG8_WAIT_V(8); PG8_WAIT_L(0); PG8_BAR; PG8_MMA(1, 0, At, B0); PG8_MMA(1, 1, At, B1); PG8_BAR; PG8_SCHED;
      if constexpr (Sched::GATHER) { if (last) {
#pragma unroll
        for (int h = 0; h < 2; ++h)
#pragma unroll
          for (int i = 0; i < 2; ++i) gcu[h][i] = g2[h][i]; } }
    }
    if (wr == 0) PG8_BAR;
    if constexpr (Sched::FP8) asm volatile("s_nop 15\n\ts_nop 15" ::: "memory");
    E(acc, cur, wr, wc, fr, fq);
    if (!has_next) break;
#pragma unroll
    for (int a = 0; a < 2; ++a)
#pragma unroll
      for (int b = 0; b < 2; ++b)
#pragma unroll
        for (int m = 0; m < 4; ++m)
#pragma unroll
          for (int n = 0; n < 2; ++n) acc[a][b][m][n] = (f32x4){0.f, 0.f, 0.f, 0.f};
    cur = nxt; cA = nA; cB = nB; ++ui;
    if (wr == 1) PG8_BAR;
  }
  PG8_WAIT_V(0);
  PG8_BAR;
#undef PG8_SA
#undef PG8_SB
#undef PG8_STAGE
#undef PG8_STAGE_A
#undef PG8_LDA
#undef PG8_LDB
#undef PG8_MMA
#undef PG8_WAIT_V
#undef PG8_WAIT_L
#undef PG8_BAR
#undef PG8_SCHED
}
}

__device__ __forceinline__ void cvt_item(const float* W, int ldw, bf16* WT, int Kd, int dst_row0, int k0, int n0, int lane) {
  const int kg = lane >> 4, nq = lane & 15;
  const float* src = W + (size_t)(k0 + 16 * kg) * ldw + n0 + 4 * nq;
  f32x4 r[16];
#pragma unroll
  for (int i = 0; i < 16; ++i) r[i] = *(const f32x4*)(src + (size_t)i * ldw);
  bf16* dst = WT + (size_t)(dst_row0 + 4 * nq) * Kd + k0 + 16 * kg;
#pragma unroll
  for (int e = 0; e < 4; ++e) {
    mg::u32x4 o0, o1;
    o0.x = mg::cvt_pk_bf16(r[0][e], r[1][e]); o0.y = mg::cvt_pk_bf16(r[2][e], r[3][e]); o0.z = mg::cvt_pk_bf16(r[4][e], r[5][e]); o0.w = mg::cvt_pk_bf16(r[6][e], r[7][e]);
    o1.x = mg::cvt_pk_bf16(r[8][e], r[9][e]); o1.y = mg::cvt_pk_bf16(r[10][e], r[11][e]); o1.z = mg::cvt_pk_bf16(r[12][e], r[13][e]); o1.w = mg::cvt_pk_bf16(r[14][e], r[15][e]);
    *(mg::u32x4*)(dst + (size_t)e * Kd) = o0; *(mg::u32x4*)(dst + (size_t)e * Kd + 8) = o1;
  }
}
__device__ __forceinline__ void cvt_mat_item(const float* W, int K, int N, int ldw, bf16* WT, int mode, int it, int lane) {
  const int nblk = N / 64, kb = it / nblk, nb = it % nblk, n0 = nb * 64;
  const int dst = mode == 0 ? n0 : ((n0 >> 7) * 256 + (n0 & 127) + (mode == 2 ? 128 : 0));
  cvt_item(W, ldw, WT, K, dst, kb * 64, n0, lane);
}
__device__ __forceinline__ void cvt_dense(const Ctx& c) {
  const float* win0 = inp(c, I0_WIN); const float* wout0 = inp(c, I0_WOUT); const float* fg = inp(c, I0_FG); const float* fu = inp(c, I0_FU); const float* fd = inp(c, I0_FD);
  const float* win1 = inp(c, I1_WIN); const float* glw = inp(c, I1_GLW); const float* wout1 = inp(c, I1_WOUT);
  unsigned char* ws = c.ws;
  for (int it = c.wave * c.G + c.bid; it < 3904; it += NW * c.G) {
    int r = it;
    if (r < 704) { cvt_mat_item(win0, D, EVEN_IN, EVEN_IN, (bf16*)(ws + WS_WIN0), 0, r, c.lane); continue; } r -= 704;
    if (r < 256) { cvt_mat_item(wout0, D, D, D, (bf16*)(ws + WS_WOUT0), 0, r, c.lane); continue; } r -= 256;
    if (r < 704) { cvt_mat_item(fg, D, FFN, FFN, (bf16*)(ws + WS_FGU), 1, r, c.lane); continue; } r -= 704;
    if (r < 704) { cvt_mat_item(fu, D, FFN, FFN, (bf16*)(ws + WS_FGU), 2, r, c.lane); continue; } r -= 704;
    if (r < 704) { cvt_mat_item(fd, FFN, D, D, (bf16*)(ws + WS_FD), 0, r, c.lane); continue; } r -= 704;
    if (r < 512) { cvt_mat_item(win1, D, 2048, ODD_IN, (bf16*)(ws + WS_WIN1), 0, r, c.lane); continue; } r -= 512;
    if (r < 64) { cvt_mat_item(glw, 512, 512, 512, (bf16*)(ws + WS_GLU), 0, r, c.lane); continue; } r -= 64;
    cvt_mat_item(wout1, D, D, D, (bf16*)(ws + WS_WOUT1), 0, r, c.lane);
  }
}
__device__ __forceinline__ void cvt_moe(const Ctx& c, int vb, int vG, int part) {
  const float* mgp = inp(c, I1_MG); const float* mup = inp(c, I1_MU); const float* mdp = inp(c, I1_MDN);
  unsigned char* tile = c.lds;
  const int nitems = part == 0 ? 8 * 224 : 8 * 112;
  for (int it = vb; it < nitems; it += vG) {
    const float* W; unsigned char* WT; int K, N, up = 0, idx;
    if (part == 0) { const int e = it / 224, r = it % 224; up = r / 112; idx = r % 112; W = (up ? mup : mgp) + (size_t)e * D * FE; WT = c.ws + WS_MGU + (size_t)e * 2 * FE * D; K = D; N = FE; }
    else { const int e = it / 112; idx = it % 112; W = mdp + (size_t)e * FE * D; WT = c.ws + WS_MD + (size_t)e * D * FE; K = FE; N = D; }
    const int nblk = N / 256, kb = idx / nblk, nb = idx % nblk, k0 = kb * 128, n0 = nb * 256;
    const float* src = W + (size_t)(k0 + 16 * c.wave) * N + n0 + 4 * c.lane;
    f32x4 r[16];
#pragma unroll
    for (int i = 0; i < 16; ++i) r[i] = *(const f32x4*)(src + (size_t)i * N) * 256.f;
    __syncthreads();
#pragma unroll
    for (int e = 0; e < 4; ++e) {
      mg::u32x4 o; o.x = mg::pk4_fp8(r[0][e], r[1][e], r[2][e], r[3][e]); o.y = mg::pk4_fp8(r[4][e], r[5][e], r[6][e], r[7][e]);
      o.z = mg::pk4_fp8(r[8][e], r[9][e], r[10][e], r[11][e]); o.w = mg::pk4_fp8(r[12][e], r[13][e], r[14][e], r[15][e]);
      *(mg::u32x4*)(tile + (4 * c.lane + e) * 128 + 16 * c.wave) = o;
    }
    __syncthreads();
#pragma unroll
    for (int j = 0; j < 4; ++j) { const int n = (c.tid >> 3) + 64 * j, pc = c.tid & 7, ng = n0 + n;
      const int drow = part == 0 ? ((ng >> 7) * 256 + (ng & 127) + 128 * up) : ng;
      *(mg::u32x4*)(WT + (size_t)drow * K + k0 + 16 * pc) = *(const mg::u32x4*)(tile + n * 128 + 16 * pc); }
  }
  __syncthreads();
}


template <int YMODE, int PROJ>
__device__ __forceinline__ void norm_phase(const Ctx& c, const float* resin, float* resout, const float* Y, const float* gpost, const float* gpre, bf16* XN,
                                           const float* W8, int ldw8, int c0, float* out8) {
  float* w8s = (float*)c.lds;
  LAS unsigned* hist = (LAS unsigned*)(c.lds + 32768);
  if (PROJ) {
    for (int i = c.tid; i < 1024 * 8; i += NT) w8s[i] = W8[(size_t)(i >> 3) * ldw8 + c0 + (i & 7)];
    if (PROJ == 2 && c.tid < 8) hist[c.tid] = 0u;
    __syncthreads();
  }
  int* tok_e = (int*)(c.ws + WS_ROUTE); float* tok_g = (float*)(c.ws + WS_ROUTE + 128 * 1024);
  const int* tok_slot = (const int*)(c.ws + WS_ROUTE + 256 * 1024);
  const bf16* YS = (const bf16*)(c.ws + WS_YS);
  for (int m = c.wave * c.G + c.bid; m < M; m += NW * c.G) {
    f32x4 r[4];
#pragma unroll
    for (int j = 0; j < 4; ++j) r[j] = *(const f32x4*)(resin + (size_t)m * D + j * 256 + c.lane * 4);
    if (YMODE) {
      f32x4 y[4]; float ss = 0.f;
      if (YMODE == 1) {
#pragma unroll
        for (int j = 0; j < 4; ++j) { const uint2 a = *(const uint2*)((const bf16*)Y + (size_t)m * D + j * 256 + c.lane * 4);
          y[j][0] = __uint_as_float(a.x << 16); y[j][1] = __uint_as_float(a.x & 0xffff0000u); y[j][2] = __uint_as_float(a.y << 16); y[j][3] = __uint_as_float(a.y & 0xffff0000u); }
      } else {
        const int s0 = tok_slot[2 * m], s1 = tok_slot[2 * m + 1]; const float g0 = tok_g[2 * m], g1 = tok_g[2 * m + 1];
#pragma unroll
        for (int j = 0; j < 4; ++j) {
          const uint2 a = *(const uint2*)(YS + (size_t)s0 * D + j * 256 + c.lane * 4), b = *(const uint2*)(YS + (size_t)s1 * D + j * 256 + c.lane * 4);
          y[j][0] = g0 * bf2f((bf16)(a.x & 0xffff)) + g1 * bf2f((bf16)(b.x & 0xffff));
          y[j][1] = g0 * bf2f((bf16)(a.x >> 16)) + g1 * bf2f((bf16)(b.x >> 16));
          y[j][2] = g0 * bf2f((bf16)(a.y & 0xffff)) + g1 * bf2f((bf16)(b.y & 0xffff));
          y[j][3] = g0 * bf2f((bf16)(a.y >> 16)) + g1 * bf2f((bf16)(b.y >> 16));
        }
      }
#pragma unroll
      for (int j = 0; j < 4; ++j) ss += y[j][0] * y[j][0] + y[j][1] * y[j][1] + y[j][2] * y[j][2] + y[j][3] * y[j][3];
      const float rs = rsqrtf(wave_sum(ss) * (1.f / D) + 1e-6f);
#pragma unroll
      for (int j = 0; j < 4; ++j) {
        const f32x4 g = *(const f32x4*)(gpost + j * 256 + c.lane * 4);
        r[j] = r[j] + y[j] * rs * g;
        *(f32x4*)(resout + (size_t)m * D + j * 256 + c.lane * 4) = r[j];
      }
    }
    if (gpre) {
      float ss = 0.f;
#pragma unroll
      for (int j = 0; j < 4; ++j) ss += r[j][0] * r[j][0] + r[j][1] * r[j][1] + r[j][2] * r[j][2] + r[j][3] * r[j][3];
      const float rs = rsqrtf(wave_sum(ss) * (1.f / D) + 1e-6f);
      float p8[8];
#pragma unroll
      for (int q = 0; q < 8; ++q) p8[q] = 0.f;
#pragma unroll
      for (int j = 0; j < 4; ++j) {
        const f32x4 g = *(const f32x4*)(gpre + j * 256 + c.lane * 4);
        const f32x4 xn = r[j] * rs * g;
        if (PROJ == 2) { *(unsigned*)(c.ws + WS_XN8 + (size_t)m * D + j * 256 + c.lane * 4) = mg::pk4_fp8(xn[0] * 16.f, xn[1] * 16.f, xn[2] * 16.f, xn[3] * 16.f); }
        else { uint2 o; o.x = (unsigned)f2bf(xn[0]) | ((unsigned)f2bf(xn[1]) << 16); o.y = (unsigned)f2bf(xn[2]) | ((unsigned)f2bf(xn[3]) << 16);
          *(uint2*)(XN + (size_t)m * D + j * 256 + c.lane * 4) = o; }
        if (PROJ) {
#pragma unroll
          for (int e = 0; e < 4; ++e) {
            const float* wr = w8s + (j * 256 + c.lane * 4 + e) * 8;
#pragma unroll
            for (int q = 0; q < 8; ++q) p8[q] += xn[e] * wr[q];
          }
        }
      }
      if (PROJ) {
#pragma unroll
        for (int q = 0; q < 8; ++q) p8[q] = wave_sum(p8[q]);
        if (PROJ == 1) { if (c.lane < 8) { float v = p8[0];
#pragma unroll
            for (int q = 1; q < 8; ++q) v = (c.lane == q) ? p8[q] : v;
            out8[(size_t)m * 8 + c.lane] = v; } }
        if (PROJ == 2 && c.lane == 0) {
          int e0 = 0; float v0 = p8[0];
#pragma unroll
          for (int q = 1; q < 8; ++q) if (p8[q] > v0) { v0 = p8[q]; e0 = q; }
          int e1 = -1; float v1 = -3.0e38f;
#pragma unroll
          for (int q = 0; q < 8; ++q) if (q != e0 && p8[q] > v1) { v1 = p8[q]; e1 = q; }
          const float g1 = 1.f / (1.f + expf(v0 - v1)), g0 = 1.f - g1;
          tok_e[2 * m] = e0; tok_e[2 * m + 1] = e1; tok_g[2 * m] = g0; tok_g[2 * m + 1] = g1;
          atomicAdd((unsigned*)&hist[e0], 1u); atomicAdd((unsigned*)&hist[e1], 1u);
        }
      }
    }
  }
  if (PROJ == 2) { __syncthreads(); if (c.tid < 8) atomicAdd(c.ctl + CW_CNT + 64 * c.tid, hist[c.tid]); }
  __syncthreads();
}

__device__ __forceinline__ void rwkv_prep_a(const Ctx& c) {
  const float* mu = inp(c, I0_MU);
  const bf16* P = (const bf16*)(c.ws + WS_P0); bf16* AL = (bf16*)(c.ws + WS_ALORA);
  const f32x4 mu4 = *(const f32x4*)(mu + 1536 + c.lane * 4);
  for (int m = c.wave * c.G + c.bid; m < M; m += NW * c.G) {
    const int t = m % SEQ;
    const uint2 cu = *(const uint2*)(P + (size_t)m * EVEN_IN + 1536 + c.lane * 4);
    uint2 pv = {0u, 0u}; if (t > 0) pv = *(const uint2*)(P + (size_t)(m - 1) * EVEN_IN + 1536 + c.lane * 4);
    const float cv[4] = {__uint_as_float(cu.x << 16), __uint_as_float(cu.x & 0xffff0000u), __uint_as_float(cu.y << 16), __uint_as_float(cu.y & 0xffff0000u)};
    const float pp[4] = {__uint_as_float(pv.x << 16), __uint_as_float(pv.x & 0xffff0000u), __uint_as_float(pv.y << 16), __uint_as_float(pv.y & 0xffff0000u)};
    float o[4];
#pragma unroll
    for (int e = 0; e < 4; ++e) { float v = cv[e] + (pp[e] - cv[e]) * mu4[e]; if (c.lane < 16) v = tanhf(v); else if (c.lane >= 32) v = sigmoid_(v); o[e] = v; }
    uint2 w; w.x = (unsigned)f2bf(o[0]) | ((unsigned)f2bf(o[1]) << 16); w.y = (unsigned)f2bf(o[2]) | ((unsigned)f2bf(o[3]) << 16);
    *(uint2*)(AL + (size_t)m * 256 + c.lane * 4) = w;
  }
}
__device__ __forceinline__ void build_wlora(const Ctx& c) {
  const float* w2 = inp(c, I0_W2); const float* a2 = inp(c, I0_A2); const float* g2 = inp(c, I0_G2);
  bf16* WL = (bf16*)(c.ws + WS_WLORA);
  for (int i = c.bid * NT + c.tid; i < 1536 * 256; i += c.G * NT) {
    const int n = i >> 8, k = i & 255; float v = 0.f;
    if (n < 512) { if (k < 64) v = w2[k * 512 + n]; }
    else if (n < 1024) { if (k >= 64 && k < 128) v = a2[(k - 64) * 512 + (n - 512)]; }
    else { if (k >= 128) v = g2[(k - 128) * 512 + (n - 1024)]; }
    WL[i] = f2bf(v);
  }
}
constexpr size_t WS_YSC = WS_XN;
typedef short bf16x4 __attribute__((ext_vector_type(4)));
__device__ __forceinline__ bf16x4 pack4(f32x4 v) { union { uint2 u; bf16x4 b; } x; x.u.x = mg::cvt_pk_bf16(v[0], v[1]); x.u.y = mg::cvt_pk_bf16(v[2], v[3]); return x.b; }
__device__ __forceinline__ f32x4 mma16(bf16x4 p, bf16x4 q, f32x4 c) { return __builtin_amdgcn_mfma_f32_16x16x16bf16_1k(p, q, c, 0, 0, 0); }
constexpr int RK_SK = 72;
__device__ __forceinline__ void rwkv_chunk_prep(const Ctx& c) {
  const float* mu = inp(c, I0_MU); const float* w0 = inp(c, I0_W0); const float* a0 = inp(c, I0_A0);
  const float* kkp = inp(c, I0_KK); const float* kap = inp(c, I0_KA); const float* rkp = inp(c, I0_RK);
  const bf16* P = (const bf16*)(c.ws + WS_P0); const bf16* LW = (const bf16*)(c.ws + WS_LOWA);
  float* BON = (float*)(c.ws + WS_BON); unsigned char* CHK = c.ws + WS_CHK;
  bf16* wl = (bf16*)(c.lds + c.wave * 17408);
  bf16* sAt = wl, *sBh = wl + 1152, *sKh = wl + 2304, *sRt = wl + 3456;
  bf16* tAt = wl + 4608, *tRt = tAt + 1024, *tBp = tAt + 2048, *tKp = tAt + 3072;
  const int lane = c.lane, q = lane >> 4, lr = lane & 15;
  for (int unit = c.wave * c.G + c.bid; unit < BATCH * 8 * 128; unit += NW * c.G) {
    const int ck = unit & 127, bh = unit >> 7, h = bh & 7, b = bh >> 3, ch = h * 64 + lane;
    const size_t m0 = (size_t)b * SEQ + ck * 16;
    const float mur = mu[ch], muk = mu[512 + ch], muv = mu[1024 + ch], w0c = w0[ch], a0c = a0[ch], kkc = kkp[ch], kac = kap[ch], rkc = rkp[ch];
    float At[16], Bh[16], Kh[16], Rt[16], Vs[16];
    float rp = 0.f, kp = 0.f, vp = 0.f;
    if (ck > 0) { const bf16* pp = P + (m0 - 1) * EVEN_IN + ch; rp = bf2f(pp[0]); kp = bf2f(pp[512]); vp = bf2f(pp[1024]); }
    float g = 1.f;
#pragma unroll
    for (int t = 0; t < 16; ++t) {
      const bf16* pc = P + (m0 + t) * EVEN_IN + ch;
      const float rc = bf2f(pc[0]), kc = bf2f(pc[512]), vc = bf2f(pc[1024]);
      const float r = rc + (rp - rc) * mur, k = kc + (kp - kc) * muk, v = vc + (vp - vc) * muv;
      rp = rc; kp = kc; vp = vc;
      const float aw = w0c + bf2f(LW[(m0 + t) * 1024 + ch]), aa = a0c + bf2f(LW[(m0 + t) * 1024 + 512 + ch]);
      const float lw = -__expf(-softplus_(-aw) - 0.5f);
      const float ag = sigmoid_(aa);
      float kk = k * kkc;
      kk = kk / fmaxf(sqrtf(wave_sum(kk * kk)), 1e-12f);
      const float k2 = k * (1.f + (ag - 1.f) * kac);
      const float bon = wave_sum(r * k2 * rkc);
      if (lane == 0) BON[(m0 + t) * 8 + h] = bon;
      const float gprev = g; g *= __expf(lw); const float gi = __builtin_amdgcn_rcpf(g);
      At[t] = -kk * gprev; Bh[t] = kk * ag * gi; Kh[t] = k2 * gi; Rt[t] = r * g; Vs[t] = v;
    }
    const float gL = g;
    unsigned char* cb = CHK + (size_t)unit * CHB;
#pragma unroll
    for (int t = 0; t < 16; ++t) { sAt[t * RK_SK + lane] = f2bf(At[t]); sBh[t * RK_SK + lane] = f2bf(Bh[t]); sKh[t * RK_SK + lane] = f2bf(Kh[t]); sRt[t * RK_SK + lane] = f2bf(Rt[t]); }
    { mg::u32x4 o0, o1;
#define PK16(arr, sc) o0.x = mg::cvt_pk_bf16(arr[0] * sc, arr[1] * sc); o0.y = mg::cvt_pk_bf16(arr[2] * sc, arr[3] * sc); o0.z = mg::cvt_pk_bf16(arr[4] * sc, arr[5] * sc); o0.w = mg::cvt_pk_bf16(arr[6] * sc, arr[7] * sc); \
      o1.x = mg::cvt_pk_bf16(arr[8] * sc, arr[9] * sc); o1.y = mg::cvt_pk_bf16(arr[10] * sc, arr[11] * sc); o1.z = mg::cvt_pk_bf16(arr[12] * sc, arr[13] * sc); o1.w = mg::cvt_pk_bf16(arr[14] * sc, arr[15] * sc);
      PK16(At, 1.f) *(mg::u32x4*)(tAt + lane * 16) = o0; *(mg::u32x4*)(tAt + lane * 16 + 8) = o1;
      PK16(Rt, 1.f) *(mg::u32x4*)(tRt + lane * 16) = o0; *(mg::u32x4*)(tRt + lane * 16 + 8) = o1;
      PK16(Bh, gL) *(mg::u32x4*)(tBp + lane * 16) = o0; *(mg::u32x4*)(tBp + lane * 16 + 8) = o1;
      *(mg::u32x4*)(cb + 6656 + lane * 32) = o0; *(mg::u32x4*)(cb + 6656 + lane * 32 + 16) = o1;
      PK16(Kh, gL) *(mg::u32x4*)(tKp + lane * 16) = o0; *(mg::u32x4*)(tKp + lane * 16 + 8) = o1;
      PK16(Vs, 1.f) *(mg::u32x4*)(cb + 8704 + lane * 32) = o0; *(mg::u32x4*)(cb + 8704 + lane * 32 + 16) = o1;
#undef PK16
      *(float*)(cb + 10752 + lane * 4) = gL; }
    __builtin_amdgcn_s_waitcnt(0xc07f); __builtin_amdgcn_wave_barrier();
    mg::bf16x8 fAt[2], fBh[2], fKh[2], fRt[2];
#pragma unroll
    for (int ks = 0; ks < 2; ++ks) { fAt[ks] = *(const mg::bf16x8*)(sAt + lr * RK_SK + 32 * ks + 8 * q); fBh[ks] = *(const mg::bf16x8*)(sBh + lr * RK_SK + 32 * ks + 8 * q);
      fKh[ks] = *(const mg::bf16x8*)(sKh + lr * RK_SK + 32 * ks + 8 * q); fRt[ks] = *(const mg::bf16x8*)(sRt + lr * RK_SK + 32 * ks + 8 * q); }
    const f32x4 z4 = {0.f, 0.f, 0.f, 0.f};
    f32x4 nab = z4, nabT = z4, nak = z4, nakT = z4, mbr = z4, mkr = z4;
#pragma unroll
    for (int ks = 0; ks < 2; ++ks) {
      nab = __builtin_amdgcn_mfma_f32_16x16x32_bf16(fBh[ks], fAt[ks], nab, 0, 0, 0); nabT = __builtin_amdgcn_mfma_f32_16x16x32_bf16(fAt[ks], fBh[ks], nabT, 0, 0, 0);
      nak = __builtin_amdgcn_mfma_f32_16x16x32_bf16(fKh[ks], fAt[ks], nak, 0, 0, 0); nakT = __builtin_amdgcn_mfma_f32_16x16x32_bf16(fAt[ks], fKh[ks], nakT, 0, 0, 0);
      mbr = __builtin_amdgcn_mfma_f32_16x16x32_bf16(fBh[ks], fRt[ks], mbr, 0, 0, 0); mkr = __builtin_amdgcn_mfma_f32_16x16x32_bf16(fKh[ks], fRt[ks], mkr, 0, 0, 0);
    }
    f32x4 eye;
#pragma unroll
    for (int i = 0; i < 4; ++i) { const int row = 4 * q + i;
      eye[i] = (row == lr) ? 1.f : 0.f;
      nab[i] = (row < lr) ? nab[i] : 0.f; nak[i] = (row < lr) ? nak[i] : 0.f; nabT[i] = (lr < row) ? nabT[i] : 0.f; nakT[i] = (lr < row) ? nakT[i] : 0.f;
      mbr[i] = (row <= lr) ? mbr[i] : 0.f; mkr[i] = (row <= lr) ? mkr[i] : 0.f; }
    const bf16x4 dN = pack4(nab), dNT = pack4(nabT);
    const f32x4 n2 = mma16(dNT, dN, z4), nT2 = mma16(dN, dNT, z4);
    const bf16x4 dN2 = pack4(n2), dNT2 = pack4(nT2);
    const f32x4 n4 = mma16(dNT2, dN2, z4), nT4 = mma16(dN2, dNT2, z4);
    const bf16x4 dN4 = pack4(n4), dNT4 = pack4(nT4);
    const f32x4 nT8 = mma16(dN4, dNT4, z4);
    f32x4 Tm = nab + eye;
    Tm = mma16(pack4(nT2 + eye), pack4(Tm), z4);
    Tm = mma16(pack4(nT4 + eye), pack4(Tm), z4);
    Tm = mma16(pack4(nT8 + eye), pack4(Tm), z4);
    const bf16x4 dT = pack4(Tm), dEye = pack4(eye), dMbr = pack4(mbr), dNakT = pack4(nakT);
    const f32x4 w1 = mma16(dNakT, dT, z4);
    const f32x4 w1T = mma16(dT, dNakT, z4);
    const bf16x4 dW1T = pack4(w1T); (void)w1;
    const f32x4 w2 = mma16(dW1T, dMbr, mkr);
    *(bf16x4*)(cb + 4096 + lane * 8) = pack4(w2);
#pragma unroll
    for (int kt = 0; kt < 4; ++kt) {
      const bf16x4 atT = *(const bf16x4*)(tAt + (16 * kt + lr) * 16 + 4 * q);
      const bf16x4 rtT = *(const bf16x4*)(tRt + (16 * kt + lr) * 16 + 4 * q);
      const bf16x4 bpT = *(const bf16x4*)(tBp + (16 * kt + lr) * 16 + 4 * q);
      const bf16x4 kpT = *(const bf16x4*)(tKp + (16 * kt + lr) * 16 + 4 * q);
      const f32x4 ap = mma16(atT, dT, z4);
      const f32x4 apT = mma16(dT, atT, z4);
      f32x4 rpt = mma16(pack4(apT), dMbr, z4);
      rpt = mma16(rtT, dEye, rpt);
      f32x4 ht = mma16(dW1T, bpT, z4);
      ht = mma16(dEye, kpT, ht);
      *(bf16x4*)(cb + kt * 512 + lane * 8) = pack4(ap);
      *(bf16x4*)(cb + 2048 + kt * 512 + lane * 8) = pack4(rpt);
      *(bf16x4*)(cb + 4608 + kt * 512 + lane * 8) = pack4(ht);
    }
    __builtin_amdgcn_s_waitcnt(0xc07f); __builtin_amdgcn_wave_barrier();
  }
}
constexpr int RK2_NS = 12, RK2_D = 8;
__device__ __forceinline__ void rwkv_chunk_scan(const Ctx& c) {
  const unsigned char* CHK = c.ws + WS_CHK; float* YO = (float*)(c.ws + WS_YSC);
  LAS unsigned char* ring = (LAS unsigned char*)c.lds;
  const int lane = c.lane, q = lane >> 4, lr = lane & 15, w = c.wave;
  for (int bh = c.bid; bh < BATCH * 8; bh += c.G) {
    const int h = bh & 7, b = bh >> 3;
    const unsigned char* rec0 = CHK + (size_t)(bh * 128) * CHB;
#define RK2_ISSUE(cidx) do { const unsigned char* src_ = rec0 + (size_t)(cidx) * CHB + lane * 16; LAS unsigned char* dst_ = ring + ((cidx) % RK2_NS) * CHB; \
      _Pragma("unroll") for (int i_ = 0; i_ < 11; ++i_) __builtin_amdgcn_global_load_lds((const unsigned*)(src_ + i_ * 1024), (LAS unsigned*)(dst_ + i_ * 1024), 16, 0, 0); } while (0)
    __syncthreads();
    if (w >= 4) {
      RK2_ISSUE(w - 4); RK2_ISSUE(w);
      if (w < 6) asm volatile("s_waitcnt vmcnt(11)" ::: "memory");
    }
    asm volatile("" ::: "memory"); __builtin_amdgcn_s_barrier(); asm volatile("" ::: "memory");
    f32x4 S[4];
#pragma unroll
    for (int kt = 0; kt < 4; ++kt) S[kt] = (f32x4){0.f, 0.f, 0.f, 0.f};
    bf16x4 nAp[4], nRp[4], nH[4], nBp[4], nW2, nV; f32x4 nG[4];
#define RK2_FETCH(cidx) do { const LAS unsigned char* cb__ = ring + ((cidx) % RK2_NS) * CHB; \
      _Pragma("unroll") for (int kt = 0; kt < 4; ++kt) { nAp[kt] = *(const LAS bf16x4*)(cb__ + kt * 512 + lane * 8); nRp[kt] = *(const LAS bf16x4*)(cb__ + 2048 + kt * 512 + lane * 8); \
        nH[kt] = *(const LAS bf16x4*)(cb__ + 4608 + kt * 512 + lane * 8); nBp[kt] = *(const LAS bf16x4*)(cb__ + 6656 + (16 * kt + lr) * 32 + 8 * q); nG[kt] = *(const LAS f32x4*)(cb__ + 10752 + (16 * kt + 4 * q) * 4); } \
      nW2 = *(const LAS bf16x4*)(cb__ + 4096 + lane * 8); nV = *(const LAS bf16x4*)(cb__ + 8704 + (16 * w + lr) * 32 + 8 * q); } while (0)
    if (w < 4) RK2_FETCH(0);
    for (int ck = 0; ck < 128; ++ck) {
      if (w >= 4) {
        if ((ck & 3) == w - 4 && ck + RK2_D < 128) RK2_ISSUE(ck + RK2_D);
        if (((ck + 2) & 3) == w - 4 && ck + 2 < 128) {
          if (ck + 6 < 128) asm volatile("s_waitcnt vmcnt(11)" ::: "memory"); else asm volatile("s_waitcnt vmcnt(0)" ::: "memory"); }
      } else {
        bf16x4 Ap[4], Rp[4], Hd[4], Bp[4]; f32x4 G[4];
#pragma unroll
        for (int kt = 0; kt < 4; ++kt) { Ap[kt] = nAp[kt]; Rp[kt] = nRp[kt]; Hd[kt] = nH[kt]; Bp[kt] = nBp[kt]; G[kt] = nG[kt]; }
        const bf16x4 W2 = nW2, Vq = nV;
        if (ck + 1 < 128) RK2_FETCH(ck + 1);
        bf16x4 Sb[4];
#pragma unroll
        for (int kt = 0; kt < 4; ++kt) Sb[kt] = pack4(S[kt]);
        f32x4 x1 = {0.f, 0.f, 0.f, 0.f}, y = {0.f, 0.f, 0.f, 0.f};
#pragma unroll
        for (int kt = 0; kt < 4; ++kt) { x1 = mma16(Ap[kt], Sb[kt], x1); y = mma16(Rp[kt], Sb[kt], y); }
        y = mma16(W2, Vq, y);
        const bf16x4 X1b = pack4(x1);
#pragma unroll
        for (int kt = 0; kt < 4; ++kt) { S[kt] = S[kt] * G[kt]; S[kt] = mma16(Bp[kt], X1b, S[kt]); S[kt] = mma16(Hd[kt], Vq, S[kt]); }
        float* yo = YO + ((size_t)b * SEQ + ck * 16 + 4 * q) * 512 + h * 64 + 16 * w + lr;
#pragma unroll
        for (int i = 0; i < 4; ++i) yo[i * 512] = y[i];
      }
      asm volatile("s_waitcnt lgkmcnt(0)" ::: "memory"); __builtin_amdgcn_s_barrier(); asm volatile("" ::: "memory");
    }
#undef RK2_ISSUE
#undef RK2_FETCH
  }
  __syncthreads();
}

__device__ __forceinline__ void rwkv_post(const Ctx& c) {
  const float* YS = (const float*)(c.ws + WS_YSC); const bf16* P = (const bf16*)(c.ws + WS_P0); const bf16* GG = (const bf16*)(c.ws + WS_LOG);
  const float* BON = (const float*)(c.ws + WS_BON); bf16* YM = (bf16*)(c.ws + WS_YMIX);
  const float* lnw = inp(c, I0_LNW); const float* lnb = inp(c, I0_LNB); const float* mu = inp(c, I0_MU);
  for (int m = c.wave * c.G + c.bid; m < M; m += NW * c.G) {
    const int t = m % SEQ;
#pragma unroll
    for (int j = 0; j < 8; ++j) {
      const int ch = j * 64 + c.lane; const size_t o = (size_t)m * 512 + ch;
      const float y = YS[o];
      const float mean = wave_sum(y) * (1.f / 64.f);
      const float d = y - mean;
      const float var = wave_sum(d * d) * (1.f / 64.f);
      float v = d * rsqrtf(var + 64e-5f) * lnw[ch] + lnb[ch];
      const float vc = bf2f(P[(size_t)m * EVEN_IN + 1024 + ch]), vp = t > 0 ? bf2f(P[(size_t)(m - 1) * EVEN_IN + 1024 + ch]) : 0.f;
      v += BON[(size_t)m * 8 + j] * (vc + (vp - vc) * mu[1024 + ch]);
      YM[(size_t)m * D + ch] = f2bf(v * bf2f(GG[(size_t)m * 1024 + ch]));
    }
  }
}

__device__ __forceinline__ void gmlp_phase(const Ctx& c, int vb, int vG) {
  const bf16* P = (const bf16*)(c.ws + WS_P0); bf16* YM = (bf16*)(c.ws + WS_YMIX);
  const float* lnw = inp(c, I0_GLNW); const float* lnb = inp(c, I0_GLNB); const float* ws = inp(c, I0_GWS); const float* bs = inp(c, I0_GBS);
  bf16* Ws = (bf16*)c.lds; bf16* VT = (bf16*)(c.lds + 34816);
  const int w = c.wave, q = c.lane >> 4, lr = c.lane & 15;
  int gcur = -1;
  for (int it = vb; it < BATCH * 16 * 4; it += vG) {
    const int g = it & 3, ck = (it >> 2) & 15, b = it >> 6;
    const size_t m0 = (size_t)b * SEQ + ck * 128;
    __syncthreads();
    if (g != gcur) { gcur = g;
#pragma unroll
      for (int k = 0; k < 8; ++k) { const int idx = c.tid + NT * k, i = idx >> 5, j4 = (idx & 31) * 4;
        const f32x4 v = *(const f32x4*)(ws + ((size_t)g * 128 + i) * 128 + j4);
        uint2 o; o.x = mg::cvt_pk_bf16(j4 <= i ? v[0] : 0.f, j4 + 1 <= i ? v[1] : 0.f); o.y = mg::cvt_pk_bf16(j4 + 2 <= i ? v[2] : 0.f, j4 + 3 <= i ? v[3] : 0.f);
        *(uint2*)(Ws + i * SPI + j4) = o; } }
    { const float w0 = lnw[g * 128 + c.lane], w1 = lnw[g * 128 + c.lane + 64], b0 = lnb[g * 128 + c.lane], b1 = lnb[g * 128 + c.lane + 64];
      unsigned short ra[16], rb[16];
#pragma unroll
      for (int jj = 0; jj < 16; ++jj) { const bf16* row = P + (m0 + w + 8 * jj) * EVEN_IN + 2304 + g * 128; ra[jj] = row[c.lane]; rb[jj] = row[c.lane + 64]; }
#pragma unroll
      for (int jj = 0; jj < 16; ++jj) { const int j = w + 8 * jj;
        const float v0 = gelu_(bf2f(ra[jj])), v1 = gelu_(bf2f(rb[jj]));
        const float mean = wave_sum(v0 + v1) * (1.f / 128.f);
        const float d0 = v0 - mean, d1 = v1 - mean;
        const float rs = rsqrtf(wave_sum(d0 * d0 + d1 * d1) * (1.f / 128.f) + 1e-6f);
        VT[c.lane * SPI + j] = f2bf(d0 * rs * w0 + b0);
        VT[(c.lane + 64) * SPI + j] = f2bf(d1 * rs * w1 + b1);
      } }
    __syncthreads();
    f32x4 acc[8];
#pragma unroll
    for (int dt = 0; dt < 8; ++dt) acc[dt] = (f32x4){0.f, 0.f, 0.f, 0.f};
    const int kmax = (16 * w + 15) >> 5;
    for (int ks = 0; ks <= kmax; ++ks) { const mg::bf16x8 wf = *(const mg::bf16x8*)(Ws + (16 * w + lr) * SPI + 32 * ks + 8 * q);
#pragma unroll
      for (int dt = 0; dt < 8; ++dt) { const mg::bf16x8 vf = *(const mg::bf16x8*)(VT + (16 * dt + lr) * SPI + 32 * ks + 8 * q); acc[dt] = __builtin_amdgcn_mfma_f32_16x16x32_bf16(wf, vf, acc[dt], 0, 0, 0); } }
    unsigned short uu[4][8];
#pragma unroll
    for (int i = 0; i < 4; ++i) { const bf16* up = P + (m0 + 16 * w + 4 * q + i) * EVEN_IN + 1792 + g * 128 + lr;
#pragma unroll
      for (int dt = 0; dt < 8; ++dt) uu[i][dt] = up[16 * dt]; }
#pragma unroll
    for (int i = 0; i < 4; ++i) { const int r = 16 * w + 4 * q + i; const float bias = bs[g * 128 + r];
      bf16* op = YM + (m0 + r) * D + 512 + g * 128 + lr;
#pragma unroll
      for (int dt = 0; dt < 8; ++dt) op[16 * dt] = f2bf(gelu_(bf2f(uu[i][dt])) * (acc[dt][i] + bias)); }
  }
  __syncthreads();
}

__device__ __forceinline__ void s5_tables(const Ctx& c) {
  const float* are = inp(c, I1_ARE); const float* aim = inp(c, I1_AIM); const float* ldt = inp(c, I1_LDT); const float* bre = inp(c, I1_BRE); const float* bim = inp(c, I1_BIM);
  float* POW = (float*)(c.ws + WS_S5POW); float* BB = (float*)(c.ws + WS_S5BB);
  for (int i = c.bid * NT + c.tid; i < 32 * 17 * 64; i += c.G * NT) {
    const int p = i & 63, tau = (i >> 6) % 17, g = i / (17 * 64);
    const float lr = are[g * 64 + p], li = aim[g * 64 + p], dt = expf(ldt[g]);
    const float mag = expf(lr * dt * (float)tau), ang = li * dt * (float)tau;
    POW[2 * i] = mag * cosf(ang); POW[2 * i + 1] = mag * sinf(ang);
  }
  for (int i = c.bid * NT + c.tid; i < 32 * 64 * 16; i += c.G * NT) {
    const int gp = i >> 4, g = gp >> 6;
    const float lr = are[gp], li = aim[gp], dt = expf(ldt[g]);
    const float mag = expf(lr * dt), ar = mag * cosf(li * dt), ai = mag * sinf(li * dt);
    const float nr = ar - 1.f, ni = ai, den = lr * lr + li * li;
    const float fr = (nr * lr + ni * li) / den, fi = (ni * lr - nr * li) / den;
    const float br = bre[i], bi = bim[i];
    BB[2 * i] = fr * br - fi * bi; BB[2 * i + 1] = fr * bi + fi * br;
  }
}
__device__ __forceinline__ void s5_taps(const Ctx& c) {
  const float* cre = inp(c, I1_CRE); const float* cim = inp(c, I1_CIM);
  const float* POW = (const float*)(c.ws + WS_S5POW); const float* BB = (const float*)(c.ws + WS_S5BB); float* KT = (float*)(c.ws + WS_S5KT);
  for (int i = c.bid * NT + c.tid; i < 32 * 16 * 256; i += c.G * NT) {
    const int c2 = i & 15, c1 = (i >> 4) & 15, tau = (i >> 8) & 15, g = i >> 12;
    float acc = 0.f;
    for (int p = 0; p < 64; ++p) {
      const float cr = cre[(g * 16 + c1) * 64 + p], ci = cim[(g * 16 + c1) * 64 + p];
      const float pr = POW[((g * 17 + tau) * 64 + p) * 2], pi = POW[((g * 17 + tau) * 64 + p) * 2 + 1];
      const float br = BB[((g * 64 + p) * 16 + c2) * 2], bi = BB[((g * 64 + p) * 16 + c2) * 2 + 1];
      const float wr = cr * pr - ci * pi, wi = cr * pi + ci * pr;
      acc += wr * br - wi * bi;
    }
    KT[i] = acc;
  }
}
__device__ __forceinline__ void s5_mats(const Ctx& c) {
  const float* cre = inp(c, I1_CRE); const float* cim = inp(c, I1_CIM);
  const float* POW = (const float*)(c.ws + WS_S5POW); const float* BB = (const float*)(c.ws + WS_S5BB); const float* KT = (const float*)(c.ws + WS_S5KT);
  bf16* BE = (bf16*)(c.ws + WS_S5BE); bf16* BTF = (bf16*)(c.ws + WS_S5BTF);
  for (int i = c.bid * NT + c.tid; i < 32 * 256 * 256; i += c.G * NT) {
    const int k = i & 255, n = (i >> 8) & 255, g = i >> 16; float v = 0.f;
    if (n < 128) { const int p = n & 63, s16 = k >> 4, c2 = k & 15;
      const float pr = POW[((g * 17 + 15 - s16) * 64 + p) * 2], pi = POW[((g * 17 + 15 - s16) * 64 + p) * 2 + 1];
      const float br = BB[((g * 64 + p) * 16 + c2) * 2], bi = BB[((g * 64 + p) * 16 + c2) * 2 + 1];
      v = (n < 64) ? (pr * br - pi * bi) : (pr * bi + pi * br); }
    BE[i] = f2bf(v);
  }
  for (int i = c.bid * NT + c.tid; i < 32 * 256 * 384; i += c.G * NT) {
    const int k = i % 384, n = (i / 384) & 255, g = i / (384 * 256), t = n >> 4, c1 = n & 15; float v = 0.f;
    if (k < 256) { const int s16 = k >> 4, c2 = k & 15; if (s16 <= t) v = KT[((g * 16 + (t - s16)) * 16 + c1) * 16 + c2]; }
    else { const int kk = k - 256, p = kk & 63;
      const float cr = cre[(g * 16 + c1) * 64 + p], ci = cim[(g * 16 + c1) * 64 + p];
      const float pr = POW[((g * 17 + t + 1) * 64 + p) * 2], pi = POW[((g * 17 + t + 1) * 64 + p) * 2 + 1];
      v = (kk < 64) ? (cr * pr - ci * pi) : -(cr * pi + ci * pr); }
    BTF[i] = f2bf(v);
  }
}
__device__ __forceinline__ void s5_carry(const Ctx& c) {
  const float* XE = (const float*)(c.ws + WS_S5XE); bf16* AP = (bf16*)(c.ws + WS_S5A); const float* POW = (const float*)(c.ws + WS_S5POW);
  for (int it = c.wave * c.G + c.bid; it < BATCH * 32; it += NW * c.G) {
    const int b = it >> 5, g = it & 31, p = c.lane;
    const float ar = POW[((g * 17 + 16) * 64 + p) * 2], ai = POW[((g * 17 + 16) * 64 + p) * 2 + 1];
    float xr = 0.f, xi = 0.f;
    const size_t row0 = (size_t)g * 1024 + b * 128;
    for (int blk0 = 0; blk0 < 128; blk0 += 8) {
      float er[8], ei[8];
#pragma unroll
      for (int j = 0; j < 8; ++j) { er[j] = XE[(row0 + blk0 + j) * 128 + p]; ei[j] = XE[(row0 + blk0 + j) * 128 + 64 + p]; }
#pragma unroll
      for (int j = 0; j < 8; ++j) {
        bf16* ap = AP + (row0 + blk0 + j) * 384 + 256;
        ap[p] = f2bf(xr); ap[64 + p] = f2bf(xi);
        const float nr = ar * xr - ai * xi + er[j], ni = ar * xi + ai * xr + ei[j];
        xr = nr; xi = ni;
      }
    }
  }
}

__device__ __forceinline__ void ssd_conv(const Ctx& c) {
  const bf16* P1 = (const bf16*)(c.ws + WS_P1); bf16* CV = (bf16*)(c.ws + WS_CONV);
  const float* cw = inp(c, I1_CW); const float* cb = inp(c, I1_CB);
  for (size_t i = (size_t)c.bid * NT + c.tid; i < (size_t)M * 128; i += (size_t)c.G * NT) {
    const int ch = (int)(i & 127) * 8; const size_t m = i >> 7; const int t = (int)(m % SEQ);
    float acc[8];
#pragma unroll
    for (int e = 0; e < 8; ++e) acc[e] = cb[ch + e];
#pragma unroll
    for (int j = 0; j < 4; ++j) { const int tt = t - 3 + j; if (tt >= 0) {
        const uint4 v = *(const uint4*)(P1 + (m - 3 + j) * 2048 + 1024 + ch); const unsigned vw[4] = {v.x, v.y, v.z, v.w};
#pragma unroll
        for (int e = 0; e < 4; ++e) { acc[2 * e] += cw[j * 1024 + ch + 2 * e] * __uint_as_float(vw[e] << 16); acc[2 * e + 1] += cw[j * 1024 + ch + 2 * e + 1] * __uint_as_float(vw[e] & 0xffff0000u); } } }
    uint4 o; o.x = mg::cvt_pk_bf16(silu_(acc[0]), silu_(acc[1])); o.y = mg::cvt_pk_bf16(silu_(acc[2]), silu_(acc[3])); o.z = mg::cvt_pk_bf16(silu_(acc[4]), silu_(acc[5])); o.w = mg::cvt_pk_bf16(silu_(acc[6]), silu_(acc[7]));
    *(uint4*)(CV + m * 1024 + ch) = o;
  }
}

constexpr int SL_C = 0, SL_B = 34816, SL_BT = 69632, SL_XT = 104448, SL_DT = 121856, SL_ACS = 123904;
__device__ __forceinline__ void ssd_dt_acs(const Ctx& c, size_t m0, int g, const float* DT, const float* dtb, const float* alog, float* sdt, float* sacs) {
  if (c.wave < 4) {
    const int h = g * 4 + c.wave; const float av = -expf(alog[h]), bias = dtb[h];
    const float d0 = softplus_(DT[(m0 + 2 * c.lane) * 8 + h] + bias), d1 = softplus_(DT[(m0 + 2 * c.lane + 1) * 8 + h] + bias);
    const float a0 = av * d0, a1 = av * d1;
    float sc = a0 + a1;
#pragma unroll
    for (int o = 1; o < 64; o <<= 1) { const float t = __shfl_up(sc, o); if (c.lane >= o) sc += t; }
    sdt[c.wave * 128 + 2 * c.lane] = d0; sdt[c.wave * 128 + 2 * c.lane + 1] = d1;
    sacs[c.wave * 128 + 2 * c.lane] = sc - a1; sacs[c.wave * 128 + 2 * c.lane + 1] = sc;
  }
}
__device__ __forceinline__ void ssd_pass1(const Ctx& c) {
  const bf16* CV = (const bf16*)(c.ws + WS_CONV); const float* DT = (const float*)(c.ws + WS_DT);
  float* YD = (float*)(c.ws + WS_YD); float* SE = (float*)(c.ws + WS_SE); float* ATOT = (float*)(c.ws + WS_ATOT);
  const float* dtb = inp(c, I1_DTB); const float* alog = inp(c, I1_ALOG);
  bf16* Cs = (bf16*)(c.lds + SL_C); bf16* Bs = (bf16*)(c.lds + SL_B); bf16* BTs = (bf16*)(c.lds + SL_BT); bf16* XT = (bf16*)(c.lds + SL_XT);
  float* sdt = (float*)(c.lds + SL_DT); float* sacs = (float*)(c.lds + SL_ACS);
  const int w = c.wave, q = c.lane >> 4, lr = c.lane & 15;
  for (int unit = c.bid; unit < BATCH * 16 * 2; unit += c.G) {
    const int g = unit & 1, ck = (unit >> 1) & 15, b = unit >> 5;
    const size_t m0 = (size_t)b * SEQ + ck * 128;
    __syncthreads();
#pragma unroll
    for (int i = 0; i < 8; ++i) { const int idx = c.tid + NT * i, mat = idx >> 11, r = (idx >> 4) & 127, qq = idx & 15;
      const uint4 v = *(const uint4*)(CV + (m0 + r) * 1024 + 512 + mat * 256 + g * 128 + qq * 8);
      *(uint4*)((mat ? Cs : Bs) + r * SPI + qq * 8) = v; }
#pragma unroll
    for (int i = 0; i < 4; ++i) { const int task = c.tid + NT * i, n = task & 127, l0 = (task >> 7) * 8;
      unsigned short e[8];
#pragma unroll
      for (int j = 0; j < 8; ++j) e[j] = CV[(m0 + l0 + j) * 1024 + 512 + g * 128 + n];
      uint4 o; o.x = e[0] | ((unsigned)e[1] << 16); o.y = e[2] | ((unsigned)e[3] << 16); o.z = e[4] | ((unsigned)e[5] << 16); o.w = e[6] | ((unsigned)e[7] << 16);
      *(uint4*)(BTs + n * SPI + l0) = o; }
    ssd_dt_acs(c, m0, g, DT, dtb, alog, sdt, sacs);
    __syncthreads();
    mg::bf16x8 cf[4];
#pragma unroll
    for (int ks = 0; ks < 4; ++ks) cf[ks] = *(const mg::bf16x8*)(Cs + (16 * w + lr) * SPI + 32 * ks + 8 * q);
    f32x4 cb[8];
#pragma unroll
    for (int j = 0; j < 8; ++j) { cb[j] = (f32x4){0.f, 0.f, 0.f, 0.f};
#pragma unroll
      for (int ks = 0; ks < 4; ++ks) { const mg::bf16x8 bf = *(const mg::bf16x8*)(Bs + (16 * j + lr) * SPI + 32 * ks + 8 * q); cb[j] = __builtin_amdgcn_mfma_f32_16x16x32_bf16(cf[ks], bf, cb[j], 0, 0, 0); } }
    __syncthreads();
    bf16* Ms = Bs;
    for (int r = 0; r < 4; ++r) {
      const int h = g * 4 + r;
#pragma unroll
      for (int i = 0; i < 2; ++i) { const int task = c.tid + NT * i, p = task & 63, l0 = (task >> 6) * 8;
        unsigned short e[8];
#pragma unroll
        for (int j = 0; j < 8; ++j) e[j] = CV[(m0 + l0 + j) * 1024 + h * 64 + p];
        uint4 o; o.x = e[0] | ((unsigned)e[1] << 16); o.y = e[2] | ((unsigned)e[3] << 16); o.z = e[4] | ((unsigned)e[5] << 16); o.w = e[6] | ((unsigned)e[7] << 16);
        *(uint4*)(XT + p * SPI + l0) = o; }
      const float* ac = sacs + r * 128; const float* dl = sdt + r * 128;
#pragma unroll
      for (int j = 0; j < 8; ++j) { const int sidx = 16 * j + lr; const float as = ac[sidx], ds = dl[sidx];
#pragma unroll
        for (int i = 0; i < 4; ++i) { const int l = 16 * w + 4 * q + i;
          const float v = (sidx <= l) ? cb[j][i] * __expf(fminf(ac[l] - as, 0.f)) * ds : 0.f;
          Ms[l * SPI + sidx] = f2bf(v); } }
      __syncthreads();
      { f32x4 ya[4];
#pragma unroll
        for (int pt = 0; pt < 4; ++pt) ya[pt] = (f32x4){0.f, 0.f, 0.f, 0.f};
        const int kmax = (16 * w + 15) >> 5;
        for (int ks = 0; ks <= kmax; ++ks) { const mg::bf16x8 mf = *(const mg::bf16x8*)(Ms + (16 * w + lr) * SPI + 32 * ks + 8 * q);
#pragma unroll
          for (int pt = 0; pt < 4; ++pt) { const mg::bf16x8 xf = *(const mg::bf16x8*)(XT + (16 * pt + lr) * SPI + 32 * ks + 8 * q); ya[pt] = __builtin_amdgcn_mfma_f32_16x16x32_bf16(mf, xf, ya[pt], 0, 0, 0); } }
#pragma unroll
        for (int pt = 0; pt < 4; ++pt)
#pragma unroll
          for (int i = 0; i < 4; ++i) YD[(m0 + 16 * w + 4 * q + i) * 512 + h * 64 + 16 * pt + lr] = ya[pt][i]; }
      { const int pt = w & 3, ntb = (w >> 2) * 4; const float aend = ac[127];
        f32x4 sa[4];
#pragma unroll
        for (int nt = 0; nt < 4; ++nt) sa[nt] = (f32x4){0.f, 0.f, 0.f, 0.f};
#pragma unroll
        for (int ks = 0; ks < 4; ++ks) { const uint4 xr = *(const uint4*)(XT + (16 * pt + lr) * SPI + 32 * ks + 8 * q); const unsigned xw[4] = {xr.x, xr.y, xr.z, xr.w};
          float xv[8];
#pragma unroll
          for (int e = 0; e < 4; ++e) { const int l = 32 * ks + 8 * q + 2 * e;
            xv[2 * e] = __uint_as_float(xw[e] << 16) * dl[l] * __expf(aend - ac[l]); xv[2 * e + 1] = __uint_as_float(xw[e] & 0xffff0000u) * dl[l + 1] * __expf(aend - ac[l + 1]); }
          union { uint4 u; mg::bf16x8 v; } xs; xs.u.x = mg::cvt_pk_bf16(xv[0], xv[1]); xs.u.y = mg::cvt_pk_bf16(xv[2], xv[3]); xs.u.z = mg::cvt_pk_bf16(xv[4], xv[5]); xs.u.w = mg::cvt_pk_bf16(xv[6], xv[7]);
#pragma unroll
          for (int nt = 0; nt < 4; ++nt) { const mg::bf16x8 bt = *(const mg::bf16x8*)(BTs + (16 * (ntb + nt) + lr) * SPI + 32 * ks + 8 * q); sa[nt] = __builtin_amdgcn_mfma_f32_16x16x32_bf16(xs.v, bt, sa[nt], 0, 0, 0); } }
        float* Eo = SE + ((size_t)(b * 8 + h) * 16 + ck) * 8192;
#pragma unroll
        for (int nt = 0; nt < 4; ++nt)
#pragma unroll
          for (int i = 0; i < 4; ++i) Eo[(16 * pt + 4 * q + i) * 128 + 16 * (ntb + nt) + lr] = sa[nt][i];
        if (c.tid == 0) ATOT[(b * 8 + h) * 16 + ck] = aend; }
      __syncthreads();
    }
  }
  __syncthreads();
}
__device__ __forceinline__ void ssd_carry(const Ctx& c) {
  const float* SE = (const float*)(c.ws + WS_SE); const float* ATOT = (const float*)(c.ws + WS_ATOT); bf16* SPV = (bf16*)(c.ws + WS_SPV);
  for (int i = c.bid * NT + c.tid; i < BATCH * 8 * 2048; i += c.G * NT) {
    const int bh = i >> 11, e4 = (i & 2047) * 4;
    f32x4 S = {0.f, 0.f, 0.f, 0.f};
    for (int ck = 0; ck < 16; ++ck) {
      const size_t o = ((size_t)bh * 16 + ck) * 8192 + e4;
      uint2 pk; pk.x = mg::cvt_pk_bf16(S[0], S[1]); pk.y = mg::cvt_pk_bf16(S[2], S[3]);
      *(uint2*)(SPV + o) = pk;
      const float d = __expf(ATOT[bh * 16 + ck]); const f32x4 e = *(const f32x4*)(SE + o);
      S = S * d + e;
    }
  }
}
__device__ __forceinline__ void ssd_pass2(const Ctx& c) {
  const bf16* CV = (const bf16*)(c.ws + WS_CONV); const float* DT = (const float*)(c.ws + WS_DT); const bf16* P1 = (const bf16*)(c.ws + WS_P1);
  const float* YD = (const float*)(c.ws + WS_YD); const bf16* SPV = (const bf16*)(c.ws + WS_SPV); bf16* YM = (bf16*)(c.ws + WS_YMIX);
  const float* dtb = inp(c, I1_DTB); const float* alog = inp(c, I1_ALOG); const float* dsk = inp(c, I1_MD); const float* nw = inp(c, I1_MNW);
  bf16* Cs = (bf16*)(c.lds + SL_C); bf16* SPs = (bf16*)(c.lds + SL_B);
  float* sdt = (float*)(c.lds + SL_DT); float* sacs = (float*)(c.lds + SL_ACS);
  const int w = c.wave, q = c.lane >> 4, lr = c.lane & 15;
  for (int unit = c.bid; unit < BATCH * 16 * 2; unit += c.G) {
    const int g = unit & 1, ck = (unit >> 1) & 15, b = unit >> 5;
    const size_t m0 = (size_t)b * SEQ + ck * 128;
    __syncthreads();
#pragma unroll
    for (int i = 0; i < 4; ++i) { const int idx = c.tid + NT * i, r = idx >> 4, qq = idx & 15;
      *(uint4*)(Cs + r * SPI + qq * 8) = *(const uint4*)(CV + (m0 + r) * 1024 + 768 + g * 128 + qq * 8); }
#pragma unroll
    for (int i = 0; i < 8; ++i) { const int idx = c.tid + NT * i, r = idx >> 10, p = (idx >> 4) & 63, qq = idx & 15;
      *(uint4*)(SPs + (r * 64 + p) * SPI + qq * 8) = *(const uint4*)(SPV + ((size_t)(b * 8 + g * 4 + r) * 16 + ck) * 8192 + p * 128 + qq * 8); }
    ssd_dt_acs(c, m0, g, DT, dtb, alog, sdt, sacs);
    __syncthreads();
    mg::bf16x8 cf[4];
#pragma unroll
    for (int ks = 0; ks < 4; ++ks) cf[ks] = *(const mg::bf16x8*)(Cs + (16 * w + lr) * SPI + 32 * ks + 8 * q);
    f32x4 yo[4][4];
#pragma unroll
    for (int r = 0; r < 4; ++r)
#pragma unroll
      for (int pt = 0; pt < 4; ++pt) { yo[r][pt] = (f32x4){0.f, 0.f, 0.f, 0.f};
#pragma unroll
        for (int ks = 0; ks < 4; ++ks) { const mg::bf16x8 sf = *(const mg::bf16x8*)(SPs + (r * 64 + 16 * pt + lr) * SPI + 32 * ks + 8 * q); yo[r][pt] = __builtin_amdgcn_mfma_f32_16x16x32_bf16(cf[ks], sf, yo[r][pt], 0, 0, 0); } }
    float dh[4];
#pragma unroll
    for (int r = 0; r < 4; ++r) dh[r] = dsk[g * 4 + r];
    float ss[4];
#pragma unroll
    for (int i = 0; i < 4; ++i) {
      const int l = 16 * w + 4 * q + i; const size_t m = m0 + l;
      const float* ydp = YD + m * 512 + g * 256 + lr; const bf16* cvp = CV + m * 1024 + g * 256 + lr; const bf16* zp = P1 + m * 2048 + 512 + g * 256 + lr;
      float sq = 0.f;
#pragma unroll
      for (int r = 0; r < 4; ++r) { const float ea = __expf(sacs[r * 128 + l]);
#pragma unroll
        for (int pt = 0; pt < 4; ++pt) { const int o = r * 64 + 16 * pt;
          const float y = ydp[o] + ea * yo[r][pt][i] + dh[r] * bf2f(cvp[o]);
          const float vv = y * silu_(bf2f(zp[o]));
          yo[r][pt][i] = vv; sq += vv * vv; } }
      ss[i] = rsqrtf(row16_sum(sq) * (1.f / 256.f) + 1e-6f);
      asm volatile("" ::: "memory");
    }
#pragma unroll
    for (int i = 0; i < 4; ++i) { const int l = 16 * w + 4 * q + i;
      bf16* ymp = YM + (m0 + l) * D + 512 + g * 256 + lr; const float* nwp = nw + g * 256 + lr;
#pragma unroll
      for (int r = 0; r < 4; ++r)
#pragma unroll
        for (int pt = 0; pt < 4; ++pt) { const int o = r * 64 + 16 * pt; ymp[o] = f2bf(yo[r][pt][i] * ss[i] * nwp[o]); }
      asm volatile("" ::: "memory");
    }
  }
  __syncthreads();
}

__device__ __forceinline__ void moe_assign(const Ctx& c) {
  LAS unsigned* lcnt = (LAS unsigned*)c.lds; LAS unsigned* lbase = lcnt + 8;
  const int* tok_e = (const int*)(c.ws + WS_ROUTE); int* tok_slot = (int*)(c.ws + WS_ROUTE + 256 * 1024); int* slot_tok = (int*)(c.ctl + CW_SLOTTOK);
  int pstart[8]; { int acc = 0;
#pragma unroll
    for (int e = 0; e < 8; ++e) { pstart[e] = acc; acc += ((int)c.ctl[CW_CNT + 64 * e] + 255) / 256 * 256; } }
  for (int tb = c.bid; tb < M / 64; tb += c.G) {
    __syncthreads();
    if (c.tid < 8) lcnt[c.tid] = 0u;
    __syncthreads();
    int e = 0; unsigned rank = 0; const int pair = tb * 128 + c.tid;
    if (c.tid < 128) { e = tok_e[pair]; rank = atomicAdd((unsigned*)&lcnt[e], 1u); }
    __syncthreads();
    if (c.tid < 8) lbase[c.tid] = atomicAdd(c.ctl + CW_CUR + 64 * c.tid, lcnt[c.tid]);
    __syncthreads();
    if (c.tid < 128) {
      int ps = 0;
#pragma unroll
      for (int q = 0; q < 8; ++q) ps = (e == q) ? pstart[q] : ps;
      const int slot = ps + (int)lbase[e] + (int)rank;
      slot_tok[slot] = pair >> 1; tok_slot[pair] = slot;
    }
  }
  __syncthreads();
}


enum { PH_PRO, PH_WIN0, PH_PREPA, PH_LORA, PH_PREPC, PH_SCAN, PH_POST, PH_WOUT0, PH_NORM0, PH_FGU, PH_FD, PH_NORM1, PH_WIN1, PH_L1A, PH_L1B, PH_L1C, PH_L1D, PH_WOUT1, PH_NORM2, PH_ASSIGN, PH_MGU, PH_MD, PH_FINAL, PH_COUNT };
constexpr int LAST_PHASE = PH_COUNT;
template <int LO, int HI, int BREG = 0>
__global__ void __launch_bounds__(NT, 2) fwd_kernel(Args args) {
  extern __shared__ __attribute__((aligned(16))) unsigned char lds[];
  Ctx c0; c0.out = args.out; c0.ws = args.ws; c0.ctl = (unsigned*)(args.ws + WS_CTL); c0.lds = lds;
  c0.tid = threadIdx.x; c0.lane = c0.tid & 63; c0.wave = __builtin_amdgcn_readfirstlane(c0.tid >> 6); c0.bid = blockIdx.x; c0.G = gridDim.x;
  volatile LAS unsigned* bst = (volatile LAS unsigned*)(LAS unsigned char*)(lds + LDS_BST);
  if (c0.tid == 0) { LAS unsigned long long* pt = (LAS unsigned long long*)(LAS unsigned char*)(lds + LDS_PTAB);
#pragma unroll
    for (int i = 0; i < N_IN; ++i) pt[i] = (unsigned long long)args.in[i];
    bst[0] = 0u; bst[1] = 0u; }
  __syncthreads();
  constexpr int lo = LO, hi = HI;
  if constexpr (hi - lo > 1) (void)xcd_barrier_post(c0.ctl + CW_BAR + BREG * 4096, bst);
#define IN(k) (lo <= (k) && (k) < hi)
#define SEAM(k) do { if constexpr (IN(k) && IN((k) + 1)) { XcdBarrier bar_; bar_.bar = (unsigned*)(args.ws + WS_CTL) + CW_BAR + BREG * 4096; bar_.x = xb_xcc_id(); \
    bar_.st = (volatile LAS unsigned*)(LAS unsigned char*)(lds + LDS_BST); xcd_barrier(bar_); } } while (0)

  LAS unsigned char* const ldsl = (LAS unsigned char*)lds;
  if constexpr (IN(PH_PRO)) { const Ctx c = launder(c0); cvt_dense(c); build_wlora(c); s5_tables(c); norm_phase<0, 0>(c, inp(c, I_X), nullptr, nullptr, nullptr, inp(c, I0_NPM), ((bf16*)(c.ws + WS_XN)), nullptr, 0, 0, nullptr); } SEAM(PH_PRO);
  if constexpr (IN(PH_WIN0)) { const Ctx c = launder(c0); s5_taps(c); mg::Gemm g{((bf16*)(c.ws + WS_XN)), (const bf16*)(c.ws + WS_WIN0), D, D, D}; mg::DenseOrder S; S.init(M / 256, EVEN_IN / 256, c.G, c.bid);
    mg::EpiBf16<false> E{(bf16*)(c.ws + WS_P0), EVEN_IN}; mg::gemm_phase(ldsl, g, S, E); } SEAM(PH_WIN0);
  if constexpr (IN(PH_PREPA)) { const Ctx c = launder(c0); rwkv_prep_a(c); s5_mats(c); } SEAM(PH_PREPA);
  if constexpr (IN(PH_LORA)) { const Ctx c = launder(c0); mg::Gemm g{(const bf16*)(c.ws + WS_ALORA), (const bf16*)(c.ws + WS_WLORA), 256, 256, 256}; mg::DenseOrder S; S.init(M / 256, 1536 / 256, c.G, c.bid);
    mg::EpiLora E{(bf16*)(c.ws + WS_LOWA), (bf16*)(c.ws + WS_LOG)}; mg::gemm_phase(ldsl, g, S, E); } SEAM(PH_LORA);
  if constexpr (IN(PH_PREPC)) { const Ctx c = launder(c0); rwkv_chunk_prep(c); } SEAM(PH_PREPC);
  if constexpr (IN(PH_SCAN)) { const Ctx c = launder(c0); if (c.G >= 256) { if (c.bid < 64) rwkv_chunk_scan(c); else gmlp_phase(c, c.bid - 64, c.G - 64); } else { rwkv_chunk_scan(c); gmlp_phase(c, c.bid, c.G); } } SEAM(PH_SCAN);
  if constexpr (IN(PH_POST)) { const Ctx c = launder(c0); rwkv_post(c); } SEAM(PH_POST);
  if constexpr (IN(PH_WOUT0)) { const Ctx c = launder(c0); mg::Gemm g{((bf16*)(c.ws + WS_YMIX)), (const bf16*)(c.ws + WS_WOUT0), D, D, D}; mg::DenseOrder S; S.init(M / 256, D / 256, c.G, c.bid);
    mg::EpiBf16<false> E{(bf16*)(c.ws + WS_Y), D}; mg::gemm_phase(ldsl, g, S, E); } SEAM(PH_WOUT0);
  if constexpr (IN(PH_NORM0)) { const Ctx c = launder(c0); norm_phase<1, 0>(c, inp(c, I_X), args.out, ((float*)(c.ws + WS_Y)), inp(c, I0_NPOM), inp(c, I0_NPF), ((bf16*)(c.ws + WS_XN)), nullptr, 0, 0, nullptr); } SEAM(PH_NORM0);
  if constexpr (IN(PH_FGU)) { const Ctx c = launder(c0); mg::Gemm g{((bf16*)(c.ws + WS_XN)), (const bf16*)(c.ws + WS_FGU), D, D, D}; mg::DenseOrder S; S.init(M / 256, 2 * FFN / 256, c.G, c.bid);
    mg::EpiSwigluT E{(bf16*)(c.ws + WS_H), FFN}; mg::gemm_phase(ldsl, g, S, E); } SEAM(PH_FGU);
  if constexpr (IN(PH_FD)) { const Ctx c = launder(c0); mg::Gemm g{(const bf16*)(c.ws + WS_H), (const bf16*)(c.ws + WS_FD), FFN, FFN, FFN}; mg::DenseOrder S; S.init(M / 256, D / 256, c.G, c.bid);
    mg::EpiBf16<false> E{(bf16*)(c.ws + WS_Y), D}; mg::gemm_phase(ldsl, g, S, E); } SEAM(PH_FD);
  if constexpr (IN(PH_NORM1)) { const Ctx c = launder(c0); norm_phase<1, 1>(c, args.out, args.out, ((float*)(c.ws + WS_Y)), inp(c, I0_NPOF), inp(c, I1_NPM), ((bf16*)(c.ws + WS_XN)), inp(c, I1_WIN), ODD_IN, 2048, (float*)(c.ws + WS_DT)); } SEAM(PH_NORM1);
  if constexpr (IN(PH_WIN1)) { const Ctx c = launder(c0); mg::Gemm g{((bf16*)(c.ws + WS_XN)), (const bf16*)(c.ws + WS_WIN1), D, D, D}; mg::DenseOrder S; S.init(M / 256, 2048 / 256, c.G, c.bid);
    mg::EpiP1 E{(bf16*)(c.ws + WS_P1), (bf16*)(c.ws + WS_S5A)}; mg::gemm_phase(ldsl, g, S, E); } SEAM(PH_WIN1);
  if constexpr (IN(PH_L1A)) { const Ctx c = launder(c0);
    { mg::Gemm g{(const bf16*)(c.ws + WS_S5A), (const bf16*)(c.ws + WS_S5BE), 384, 256, 256}; mg::S5Order S; S.G = c.G; S.c = c.bid; mg::EpiS5E E{(float*)(c.ws + WS_S5XE)}; mg::gemm_phase(ldsl, g, S, E); }
    ssd_conv(c); cvt_moe(c, c.bid, c.G, 0); } SEAM(PH_L1A);
  if constexpr (IN(PH_L1B)) { const Ctx c = launder(c0); s5_carry(c); ssd_pass1(c); } SEAM(PH_L1B);
  if constexpr (IN(PH_L1C)) { const Ctx c = launder(c0);
    { mg::Gemm g{(const bf16*)(c.ws + WS_S5A), (const bf16*)(c.ws + WS_S5BTF), 384, 384, 384}; mg::S5Order S; S.G = c.G; S.c = c.bid; mg::EpiS5Y E{(bf16*)(c.ws + WS_YC), (const bf16*)(c.ws + WS_S5A), inp(c, I1_SD)}; mg::gemm_phase(ldsl, g, S, E); }
    ssd_carry(c); cvt_moe(c, c.bid, c.G, 1); } SEAM(PH_L1C);
  if constexpr (IN(PH_L1D)) { const Ctx c = launder(c0);
    { mg::Gemm g{(const bf16*)(c.ws + WS_YC), (const bf16*)(c.ws + WS_GLU), 512, 512, 512}; mg::DenseOrder S; S.init(M / 256, 512 / 256, c.G, c.bid);
      mg::EpiGluT E{((bf16*)(c.ws + WS_YMIX)), D, (const bf16*)(c.ws + WS_YC), inp(c, I1_GLB)}; mg::gemm_phase(ldsl, g, S, E); }
    ssd_pass2(c); } SEAM(PH_L1D);
  if constexpr (IN(PH_WOUT1)) { const Ctx c = launder(c0); mg::Gemm g{((bf16*)(c.ws + WS_YMIX)), (const bf16*)(c.ws + WS_WOUT1), D, D, D}; mg::DenseOrder S; S.init(M / 256, D / 256, c.G, c.bid);
    mg::EpiBf16<false> E{(bf16*)(c.ws + WS_Y), D}; mg::gemm_phase(ldsl, g, S, E); } SEAM(PH_WOUT1);
  if constexpr (IN(PH_NORM2)) { const Ctx c = launder(c0); norm_phase<1, 2>(c, args.out, args.out, ((float*)(c.ws + WS_Y)), inp(c, I1_NPOM), inp(c, I1_NPF), ((bf16*)(c.ws + WS_XN)), inp(c, I1_RT), 8, 0, nullptr); } SEAM(PH_NORM2);
  if constexpr (IN(PH_ASSIGN)) { const Ctx c = launder(c0); moe_assign(c); } SEAM(PH_ASSIGN);
#define MOE_SCHED(S, nn, bse, bof) do { int acc_ = 0; \
    _Pragma("unroll") for (int e = 0; e < 8; ++e) { acc_ += ((int)c.ctl[CW_CNT + 64 * e] + 255) / 256 * 256; S.pend[e] = acc_; } \
    S.init(acc_ / 256, nn, c.G, c.bid); S.bstride_e = (bse); S.boff = (bof); S.rowidx = (const int*)(c.ctl + CW_SLOTTOK); } while (0)
  if constexpr (IN(PH_MGU)) { const Ctx c = launder(c0); mg::Gemm g{(const bf16*)(c.ws + WS_XN8), (const bf16*)(c.ws + WS_MGU), D, D, D}; mg::MoeOrder<true, true> S; MOE_SCHED(S, FE / 128, (size_t)2 * FE * D, 0);
    mg::EpiSwigluF8 E{c.ws + WS_HID, FE}; mg::gemm_phase(ldsl, g, S, E); } SEAM(PH_MGU);
  if constexpr (IN(PH_MD)) { const Ctx c = launder(c0); mg::Gemm g{(const bf16*)(c.ws + WS_HID), (const bf16*)(c.ws + WS_MD), FE, FE, FE}; mg::MoeOrder<false, true> S; MOE_SCHED(S, D / 256, (size_t)D * FE, 0);
    mg::EpiBf16S E{(bf16*)(c.ws + WS_YS), D, 1.f / 2048.f}; mg::gemm_phase(ldsl, g, S, E); } SEAM(PH_MD);
  if constexpr (IN(PH_FINAL)) { const Ctx c = launder(c0); norm_phase<2, 0>(c, args.out, args.out, nullptr, inp(c, I1_NPOF), nullptr, nullptr, nullptr, 0, 0, nullptr); }
#undef MOE_SCHED
#undef IN
#undef SEAM
}

template <int P> static void launch_one(const Args& a, hipStream_t stream) { hipLaunchKernelGGL((fwd_kernel<P, P + 1>), dim3(256), dim3(NT), LDS_BYTES, stream, a); }
template <int P> static bool set_attr_one() { return hipFuncSetAttribute((const void*)fwd_kernel<P, P + 1>, hipFuncAttributeMaxDynamicSharedMemorySize, LDS_BYTES) == hipSuccess; }
template <int... Ps> static void launch_all(const Args& a, hipStream_t stream, std::integer_sequence<int, Ps...>) { (launch_one<Ps>(a, stream), ...); }
template <int... Ps> static bool set_attr_all(std::integer_sequence<int, Ps...>) { return (set_attr_one<Ps>() && ...); }

extern "C" void kernel_launch(void* const* d_in, const int* in_sizes, int n_in, void* d_out, int out_size, void* d_ws, size_t ws_size, hipStream_t stream) {
  static int ready = 0;
  if (!ready) {
    bool ok = true;
    if (n_in != N_IN || out_size != M * D || ws_size < WS_END) { fprintf(stderr, "kernel_launch: unexpected problem: n_in %d out %d ws %zu (need %zu)\n", n_in, out_size, ws_size, (size_t)WS_END); ok = false; }
#if PROBE_PHASE >= 0
    if (ok && (hipFuncSetAttribute((const void*)fwd_kernel<0, PROBE_PHASE + 1, 0>, hipFuncAttributeMaxDynamicSharedMemorySize, LDS_BYTES) != hipSuccess ||
               hipFuncSetAttribute((const void*)fwd_kernel<PROBE_PHASE, PROBE_PHASE + 1, 1>, hipFuncAttributeMaxDynamicSharedMemorySize, LDS_BYTES) != hipSuccess ||
               hipFuncSetAttribute((const void*)fwd_kernel<PROBE_PHASE + 1, LAST_PHASE, 2>, hipFuncAttributeMaxDynamicSharedMemorySize, LDS_BYTES) != hipSuccess)) ok = false;
#elif ONE_LAUNCH
    if (ok && hipFuncSetAttribute((const void*)fwd_kernel<0, LAST_PHASE>, hipFuncAttributeMaxDynamicSharedMemorySize, LDS_BYTES) != hipSuccess) ok = false;
#else
    if (ok && !set_attr_all(std::make_integer_sequence<int, LAST_PHASE>{})) ok = false;
#endif
    if (!ok) fprintf(stderr, "kernel_launch: setup failed\n");
    ready = ok ? 1 : -1;
  }
  if (ready < 0) return;
  (void)hipMemsetAsync((char*)d_ws + WS_CTL, 0, CTL_BYTES, stream);
  Args a{};
  for (int i = 0; i < N_IN; ++i) a.in[i] = (const float*)d_in[i];
  a.out = (float*)d_out; a.ws = (unsigned char*)d_ws;
#if PROBE_PHASE >= 0
  hipLaunchKernelGGL((fwd_kernel<0, PROBE_PHASE + 1, 0>), dim3(256), dim3(NT), LDS_BYTES, stream, a);
  hipLaunchKernelGGL((fwd_kernel<PROBE_PHASE, PROBE_PHASE + 1, 1>), dim3(256), dim3(NT), LDS_BYTES, stream, a);
  hipLaunchKernelGGL((fwd_kernel<PROBE_PHASE + 1, LAST_PHASE, 2>), dim3(256), dim3(NT), LDS_BYTES, stream, a);
#elif ONE_LAUNCH
  hipLaunchKernelGGL((fwd_kernel<0, LAST_PHASE>), dim3(256), dim3(NT), LDS_BYTES, stream, a);
#else
  launch_all(a, stream, std::make_integer_sequence<int, LAST_PHASE>{});
#endif
}
```

```cpp
#include <hip/hip_runtime.h>
#include <stdint.h>
#include <stdio.h>
#include <utility>

#ifndef PROBE_PHASE
#define PROBE_PHASE -1
#endif
#ifndef ONE_LAUNCH
#define ONE_LAUNCH 1
#endif

constexpr int D = 1024, BATCH = 8, SEQ = 2048, M = BATCH * SEQ;
constexpr int A_W = 512, A_IN = 1792, EVEN_IN = 2816, FFN = 2816;
constexpr int ODD_IN = 2056, NE = 8, FE = 3584;
constexpr int MAXSLOT = 2 * M + NE * 256;
constexpr int NT = 512, NW = 8;

typedef unsigned short bf16;
typedef float f32x4 __attribute__((ext_vector_type(4)));
#define LAS __attribute__((address_space(3)))

enum {
  I_X = 0,
  I0_NPM, I0_WIN, I0_MU, I0_W0, I0_W2, I0_A0, I0_A2, I0_G2, I0_KK, I0_KA, I0_RK, I0_LNW, I0_LNB,
  I0_GLNW, I0_GLNB, I0_GWS, I0_GBS, I0_WOUT, I0_NPOM, I0_NPF, I0_FG, I0_FU, I0_FD, I0_NPOF,
  I1_NPM, I1_WIN, I1_ARE, I1_AIM, I1_LDT, I1_BRE, I1_BIM, I1_CRE, I1_CIM, I1_SD, I1_GLW, I1_GLB,
  I1_CW, I1_CB, I1_DTB, I1_ALOG, I1_MD, I1_MNW, I1_WOUT, I1_NPOM, I1_NPF, I1_RT, I1_MG, I1_MU, I1_MDN, I1_NPOF,
  N_IN
};
static_assert(N_IN == 51, "input count");

constexpr size_t MiB = 1ull << 20;
constexpr size_t WS_CTL = 0, CTL_BYTES = 1 * MiB;
constexpr size_t KiB = 1024;
constexpr size_t WS_WIN0 = 1 * MiB;
constexpr size_t WS_WOUT0 = WS_WIN0 + 5632 * KiB;
constexpr size_t WS_FGU = WS_WOUT0 + 2048 * KiB;
constexpr size_t WS_FD = WS_FGU + 11264 * KiB;
constexpr size_t WS_WIN1 = WS_FD + 5632 * KiB;
constexpr size_t WS_GLU = WS_WIN1 + 4096 * KiB;
constexpr size_t WS_WOUT1 = WS_GLU + 512 * KiB;
constexpr size_t WS_WLORA = WS_WOUT1 + 2048 * KiB;
constexpr size_t WS_DENSE_END = WS_WLORA + 768 * KiB;
constexpr size_t WS_MGU = 33 * MiB;
constexpr size_t WS_MD = 145 * MiB;
constexpr size_t WS_XN = 201 * MiB;
constexpr size_t WS_YMIX = 233 * MiB;
constexpr size_t WS_Y = 265 * MiB;
constexpr size_t WS_BIG = 329 * MiB;
constexpr size_t WS_P0 = WS_BIG;
constexpr size_t WS_SR = WS_MGU;
constexpr size_t WS_SW = WS_SR + 32 * MiB, WS_SK = WS_SW + 32 * MiB, WS_SV = WS_SK + 32 * MiB, WS_SA = WS_SV + 32 * MiB, WS_SB = WS_Y;
constexpr size_t WS_LOG = WS_P0 + 88 * MiB;
constexpr size_t WS_BON = WS_LOG + 32 * MiB;
constexpr size_t WS_L0END = WS_BON + 1 * MiB;
constexpr size_t WS_CHK = WS_MGU;
constexpr int CHB = 11264;
constexpr size_t WS_ALORA = WS_MGU + 160 * MiB;
constexpr size_t WS_LOWA = WS_XN;
static_assert(WS_DENSE_END <= WS_MGU && WS_ALORA + 8 * MiB <= WS_XN, "lora buffers");
static_assert(WS_SA + 32 * MiB <= WS_XN && WS_CHK + (size_t)BATCH * 8 * 128 * CHB <= WS_ALORA, "streams / chunk operators inside the MoE weight region");
constexpr size_t WS_H = WS_BIG;
constexpr size_t WS_P1 = WS_BIG;
constexpr size_t WS_DT = WS_P1 + 64 * MiB;
constexpr size_t WS_S5A = WS_YMIX;
constexpr size_t WS_S5XE = WS_XN;
constexpr size_t WS_S5BE = 176 * MiB;
constexpr size_t WS_S5BTF = 180 * MiB;
constexpr size_t WS_S5POW = WS_BIG + 129 * MiB;
constexpr size_t WS_S5BB = WS_S5POW + 320 * KiB;
constexpr size_t WS_S5KT = WS_S5BB + 320 * KiB;
constexpr size_t WS_ATOT = WS_DT + 768 * KiB;
constexpr size_t WS_CONV = WS_DT + 1 * MiB;
constexpr size_t WS_YD = WS_CONV + 32 * MiB;
constexpr size_t WS_YC = WS_Y;
constexpr size_t WS_SE = WS_Y + 16 * MiB;
constexpr size_t WS_SPV = WS_SE + 32 * MiB;
constexpr size_t WS_HID = WS_BIG;
constexpr size_t WS_XN8 = 176 * MiB;
constexpr size_t WS_YS = WS_YMIX;
constexpr size_t WS_ROUTE = WS_BIG + 120 * MiB;
constexpr size_t WS_END = 462 * MiB;
static_assert(WS_S5KT + 512 * KiB <= WS_END && WS_L0END <= WS_S5POW && WS_L0END <= WS_END && WS_YD + 32 * MiB <= WS_END && WS_ROUTE + 1 * MiB <= WS_END && WS_SPV + 16 * MiB <= WS_BIG, "workspace map");
static_assert((size_t)MAXSLOT * FE <= 120 * MiB && (size_t)MAXSLOT * D * 2 <= 96 * MiB && WS_MD + (size_t)8 * D * FE <= WS_XN8 && WS_MGU + (size_t)8 * 2 * FE * D <= WS_MD, "moe buffers");
constexpr int CW_BAR = 16384;
constexpr int CW_CNT = 8192;
constexpr int CW_TOKE = 65536;
static_assert((CW_TOKE + 8 * M) * 4 <= (int)CTL_BYTES, "ctl");

constexpr int SPI = 136;
constexpr int LDS_BYTES = 147456;

__device__ __forceinline__ float bf2f(bf16 v) { return __uint_as_float(((unsigned)v) << 16); }
__device__ __forceinline__ bf16 f2bf(float f) { unsigned u = __float_as_uint(f); u += 0x7fffu + ((u >> 16) & 1u); return (bf16)(u >> 16); }
template <int CTRL> __device__ __forceinline__ float dpp_f(float v) { return __int_as_float(__builtin_amdgcn_update_dpp(0, __float_as_int(v), CTRL, 0xf, 0xf, true)); }
__device__ __forceinline__ float row16_sum(float v) { v += dpp_f<0xB1>(v); v += dpp_f<0x4E>(v); v += dpp_f<0x141>(v); v += dpp_f<0x140>(v); return v; }
__device__ __forceinline__ float wave_sum(float v) { v = row16_sum(v); v += __shfl_xor(v, 16); v += __shfl_xor(v, 32); return v; }
__device__ __forceinline__ float sigmoid_(float x) { return 1.f / (1.f + expf(-x)); }
__device__ __forceinline__ float silu_(float x) { return x / (1.f + expf(-x)); }
__device__ __forceinline__ float gelu_(float x) { const float u = 0.7978845608028654f * (x + 0.044715f * x * x * x); return 0.5f * x * (1.f + tanhf(u)); }
__device__ __forceinline__ float softplus_(float x) { return fmaxf(x, 0.f) + log1pf(expf(-fabsf(x))); }

#define XB_TMO      128
#define XB_XCNT(j)  (256  + 64 * (j))
#define XB_XSUB(j)  (1280 + 64 * (j))
#define XB_XGEN(j)  (2304 + 64 * (j))
#define XB_TOP      3328
#define XB_TOPGEN   3392
#define XCD_BAR_WORDS 3456
#define XB_SPIN_CAP (1u << 22)

__device__ __forceinline__ unsigned xb_ld(unsigned* p)              { return __hip_atomic_load(p, __ATOMIC_RELAXED, __HIP_MEMORY_SCOPE_AGENT); }
__device__ __forceinline__ unsigned xb_add(unsigned* p, unsigned v) { return __hip_atomic_fetch_add(p, v, __ATOMIC_RELAXED, __HIP_MEMORY_SCOPE_AGENT); }
__device__ __forceinline__ unsigned xb_xcc_id() { return (unsigned)__builtin_amdgcn_s_getreg((3 << 11) | 20) & 0xFu; }
#define XB_SPIN(cond, bar) do { unsigned _sp = 0; while (cond) { __builtin_amdgcn_s_sleep(1); \
    if ((++_sp & 255u) == 0u) { if (xb_ld(&(bar)[XB_TMO])) break; if (_sp > XB_SPIN_CAP) { atomicAdd(&(bar)[XB_TMO], 1u); break; } } } } while (0)

struct XcdBarrier { unsigned* bar; unsigned x; volatile LAS unsigned* st; };

__device__ __forceinline__ XcdBarrier xcd_barrier_post(unsigned* bar, volatile LAS unsigned* st) {
    XcdBarrier b; b.bar = bar; b.x = xb_xcc_id(); b.st = st;
    if (threadIdx.x == 0) (void)xb_add(&bar[XB_XCNT(b.x)], 1u);
    return b;
}
__device__ __forceinline__ void xcd_barrier_complete(unsigned* bar, unsigned x, unsigned& nloc, unsigned& nx) {
    const unsigned G = gridDim.x * gridDim.y * gridDim.z;
    unsigned sum, cnt, mine, sp = 0u;
    for (;;) {
        sum = 0u; cnt = 0u; mine = 0u;
#pragma unroll
        for (unsigned j = 0; j < 16; ++j) { const unsigned c = xb_ld(&bar[XB_XCNT(j)]); sum += c; cnt += (c > 0u) ? 1u : 0u; mine = (j == x) ? c : mine; }
        if (sum == G) break;
        __builtin_amdgcn_s_sleep(1);
        if ((++sp & 255u) == 0u) { if (xb_ld(&bar[XB_TMO])) break; if (sp > XB_SPIN_CAP) { atomicAdd(&bar[XB_TMO], 1u); break; } }
    }
    nloc = mine > 0u ? mine : 1u; nx = cnt > 0u ? cnt : 1u;
}
__device__ __forceinline__ void xcd_barrier(const XcdBarrier& b) {
    asm volatile("s_waitcnt vmcnt(0)" ::: "memory");
    __syncthreads();
    if (threadIdx.x == 0) {
        unsigned* bar = b.bar;
        __builtin_amdgcn_s_waitcnt(0);
        unsigned nloc = b.st[0], nx = b.st[1];
        if (nloc == 0u) { xcd_barrier_complete(bar, b.x, nloc, nx); b.st[0] = nloc; b.st[1] = nx; }
        const unsigned old = xb_add(&bar[XB_XSUB(b.x)], 1u);
        const unsigned gen = old / nloc;
        if (old + 1u == (gen + 1u) * nloc) {
            __builtin_amdgcn_fence(__ATOMIC_RELEASE, "agent");
            asm volatile("s_waitcnt vmcnt(0)" ::: "memory");
            const unsigned og = xb_add(&bar[XB_TOP], 1u);
            const unsigned tg = og / nx;
            if (og + 1u == (tg + 1u) * nx) xb_add(&bar[XB_TOPGEN], 1u);
            else XB_SPIN(xb_ld(&bar[XB_TOPGEN]) == tg, bar);
            __builtin_amdgcn_fence(__ATOMIC_ACQUIRE, "agent");
            xb_add(&bar[XB_XGEN(b.x)], 1u);
            asm volatile("s_waitcnt vmcnt(0)" ::: "memory");
        } else {
            XB_SPIN(xb_ld(&bar[XB_XGEN(b.x)]) == gen, bar);
            __builtin_amdgcn_fence(__ATOMIC_ACQUIRE, "agent");
            asm volatile("s_waitcnt vmcnt(0)" ::: "memory");
        }
    }
    __syncthreads();
}

struct Args { const float* in[N_IN]; float* out; unsigned char* ws; int lo, hi; };
struct Ctx {
  float* out; unsigned char* ws; unsigned* ctl;
  unsigned char* lds;
  int tid, lane, wave, bid, G;
};
__device__ __forceinline__ Ctx launder(Ctx c) {
  asm volatile("" : "+v"(c.tid), "+v"(c.lane));
  asm volatile("" : "+s"(c.wave), "+s"(c.bid), "+s"(c.G));
  return c;
}
constexpr int LDS_PTAB = LDS_BYTES - 1024;
constexpr int LDS_BST = LDS_BYTES - 16;
__device__ __forceinline__ const float* inp(const Ctx& c, int k) {
  const LAS unsigned* pt = (const LAS unsigned*)(LAS unsigned char*)(c.lds + LDS_PTAB);
  const unsigned lo = __builtin_amdgcn_readfirstlane(pt[2 * k]), hi = __builtin_amdgcn_readfirstlane(pt[2 * k + 1]);
  return (const float*)(((unsigned long long)hi << 32) | lo);
}


namespace mg {
typedef short bf16x8 __attribute__((ext_vector_type(8)));
typedef unsigned u32x4 __attribute__((ext_vector_type(4)));
constexpr int BM = 256, BK = 64, HALF = 128, HTB = HALF * BK * 2, STAGE_BYTES = 8 * HTB, NXCD = 8, WGM = 8;
constexpr int LDS_IDX = STAGE_BYTES;
__host__ __device__ __forceinline__ int lds_byte(int r, int c) { const int st = (r >> 4) * 2 + (c >> 5), rr = r & 15, cc = c & 31, ob = rr * 64 + cc * 2; return st * 1024 + (ob ^ (((ob >> 9) & 1) << 5)); }
__host__ __device__ __forceinline__ void stage_rc(int b, int& R, int& C) { const int st = b / 1024, sb = b % 1024, swz = sb ^ (((sb >> 9) & 1) << 5); R = (st >> 1) * 16 + swz / 64; C = (st & 1) * 32 + (swz % 64) / 2; }
__host__ __device__ __forceinline__ int perm32(int rho) { const int n = rho >> 4, i = rho & 15; return 8 * (i >> 2) + 4 * n + (i & 3); }
typedef int i32x4_ __attribute__((ext_vector_type(4)));
typedef int i32x8_ __attribute__((ext_vector_type(8)));
__device__ __forceinline__ i32x8_ cat8(bf16x8 a, bf16x8 b) { const i32x4_ x = __builtin_bit_cast(i32x4_, a), y = __builtin_bit_cast(i32x4_, b); return __builtin_shufflevector(x, y, 0, 1, 2, 3, 4, 5, 6, 7); }
struct Unit { int pm, pn; };
struct Gemm { const bf16* A; const bf16* Bt; int lda, ldb, K; };

struct Tiles {
  int nM, nN, nwg, G, c;
  __device__ __forceinline__ void init(int nM_, int nN_, int G_, int c_) { nM = nM_; nN = nN_; nwg = nM * nN; G = G_; c = c_; }
  __device__ __forceinline__ bool next(int i, Unit& u) const {
    const long L = (long)i * G + c; if (L >= nwg) return false;
    int wgid = (int)L; { const int q = nwg / NXCD, r = nwg % NXCD, xcd = wgid % NXCD, off = wgid / NXCD; wgid = (xcd < r ? xcd * (q + 1) : r * (q + 1) + (xcd - r) * q) + off; }
    const int nig = WGM * nN, gid = wgid / nig, fm = gid * WGM, gsz = (nM - fm) < WGM ? (nM - fm) : WGM;
    u.pm = fm + ((wgid % nig) % gsz); u.pn = (wgid % nig) / gsz; return true;
  }
};
struct DenseOrder : Tiles {
  static constexpr bool GATHER = false, FP8 = false;
  const int* rowidx;
  __device__ __forceinline__ const char* a_tile(const Gemm& g, const Unit& u) const { return (const char*)g.A + (size_t)u.pm * BM * g.lda * 2; }
  __device__ __forceinline__ const char* b_tile(const Gemm& g, const Unit& u) const { return (const char*)g.Bt + (size_t)u.pn * BM * g.ldb * 2; }
};
struct S5Order {
  static constexpr bool GATHER = false, FP8 = false;
  int G, c; const int* rowidx;
  __device__ __forceinline__ bool next(int i, Unit& u) const { const int L = i * G + c; if (L >= 128) return false; u.pm = L; u.pn = 0; return true; }
  __device__ __forceinline__ const char* a_tile(const Gemm& g, const Unit& u) const { return (const char*)g.A + (size_t)u.pm * BM * g.lda * 2; }
  __device__ __forceinline__ const char* b_tile(const Gemm& g, const Unit& u) const { return (const char*)g.Bt + (size_t)(u.pm >> 2) * BM * g.ldb * 2; }
};
template <bool GATHER_, bool FP8_> struct MoeOrder : Tiles {
  static constexpr bool GATHER = GATHER_, FP8 = FP8_; static constexpr int ES = FP8_ ? 1 : 2;
  int pend[8]; size_t bstride_e, boff; const int* rowidx;
  __device__ __forceinline__ const int* rows(const Unit& u) const { const int e = expert(u.pm); int ps = 0;
#pragma unroll
    for (int q = 0; q < 7; ++q) ps = (e == q + 1) ? pend[q] : ps;
    return rowidx + e * M + (u.pm * BM - ps); }
  __device__ __forceinline__ int expert(int pm) const { int e = 0;
#pragma unroll
    for (int q = 0; q < 7; ++q) e += (pm * BM >= pend[q]) ? 1 : 0;
    return e; }
  __device__ __forceinline__ const char* a_tile(const Gemm& g, const Unit& u) const { return (const char*)g.A + (size_t)u.pm * BM * g.lda * ES; }
  __device__ __forceinline__ const char* b_tile(const Gemm& g, const Unit& u) const { return (const char*)g.Bt + (size_t)expert(u.pm) * bstride_e + boff + (size_t)u.pn * BM * g.ldb * ES; }
};

typedef float f32x2_ __attribute__((ext_vector_type(2)));
typedef __bf16 bfx2_ __attribute__((ext_vector_type(2)));
__device__ __forceinline__ unsigned cvt_pk_bf16(float lo, float hi) { const f32x2_ v = {lo, hi}; const bfx2_ r = __builtin_convertvector(v, bfx2_); return __builtin_bit_cast(unsigned, r); }

struct EpiF32 { static constexpr bool PERM = false; float* C; int ldc;
  __device__ __forceinline__ void operator()(const f32x4 (&acc)[2][2][4][2], const Unit& u, int wr, int wc, int fr, int fq) const {
    const int row0 = u.pm * BM + wr * 64 + fr, col0 = u.pn * BM + wc * 32 + 4 * fq;
#pragma unroll
    for (int ai = 0; ai < 2; ++ai)
#pragma unroll
      for (int m = 0; m < 4; ++m) { float* rowp = C + (size_t)(row0 + ai * HALF + m * 16) * ldc + col0;
#pragma unroll
        for (int bj = 0; bj < 2; ++bj)
#pragma unroll
          for (int n = 0; n < 2; ++n) *(f32x4*)(rowp + bj * HALF + n * 16) = acc[ai][bj][m][n]; }
  } };
template <bool ACCUM> struct EpiBf16 { static constexpr bool PERM = true; bf16* O; int ldc;
  __device__ __forceinline__ void operator()(const f32x4 (&acc)[2][2][4][2], const Unit& u, int wr, int wc, int fr, int fq) const {
    const int row0 = u.pm * BM + wr * 64 + fr, col0 = u.pn * BM + wc * 32 + 8 * fq;
#pragma unroll
    for (int ai = 0; ai < 2; ++ai)
#pragma unroll
      for (int m = 0; m < 4; ++m) { bf16* rowp = O + (size_t)(row0 + ai * HALF + m * 16) * ldc + col0;
#pragma unroll
        for (int bj = 0; bj < 2; ++bj) { f32x4 v0 = acc[ai][bj][m][0], v1 = acc[ai][bj][m][1];
          if (ACCUM) { const u32x4 o = *(const u32x4*)(rowp + bj * HALF);
            v0[0] += __uint_as_float(o.x << 16); v0[1] += __uint_as_float(o.x & 0xffff0000u); v0[2] += __uint_as_float(o.y << 16); v0[3] += __uint_as_float(o.y & 0xffff0000u);
            v1[0] += __uint_as_float(o.z << 16); v1[1] += __uint_as_float(o.z & 0xffff0000u); v1[2] += __uint_as_float(o.w << 16); v1[3] += __uint_as_float(o.w & 0xffff0000u); }
          u32x4 w; w.x = cvt_pk_bf16(v0[0], v0[1]); w.y = cvt_pk_bf16(v0[2], v0[3]); w.z = cvt_pk_bf16(v1[0], v1[1]); w.w = cvt_pk_bf16(v1[2], v1[3]);
          *(u32x4*)(rowp + bj * HALF) = w; } }
  } };
struct EpiP1 { static constexpr bool PERM = true; bf16* P1; bf16* AP;
  __device__ __forceinline__ void operator()(const f32x4 (&acc)[2][2][4][2], const Unit& u, int wr, int wc, int fr, int fq) const {
    const int row0 = u.pm * BM + wr * 64 + fr, col0 = u.pn * BM + wc * 32 + 8 * fq;
#pragma unroll
    for (int ai = 0; ai < 2; ++ai)
#pragma unroll
      for (int m = 0; m < 4; ++m) { const int row = row0 + ai * HALF + m * 16;
#pragma unroll
        for (int bj = 0; bj < 2; ++bj) { const int col = col0 + bj * HALF; const f32x4 v0 = acc[ai][bj][m][0], v1 = acc[ai][bj][m][1];
          u32x4 w; w.x = cvt_pk_bf16(v0[0], v0[1]); w.y = cvt_pk_bf16(v0[2], v0[3]); w.z = cvt_pk_bf16(v1[0], v1[1]); w.w = cvt_pk_bf16(v1[2], v1[3]);
          bf16* dst;
          if (u.pn < 2) { const int g = col >> 4, c0 = col & 15, b = row >> 11, ta = row & 2047; dst = AP + ((size_t)(g * 1024 + b * 128 + (ta >> 4)) * 384 + (ta & 15) * 16 + c0); }
          else dst = P1 + (size_t)row * 2048 + col;
          *(u32x4*)dst = w; } }
  } };
struct EpiS5E { static constexpr bool PERM = false; float* XE;
  __device__ __forceinline__ void operator()(const f32x4 (&acc)[2][2][4][2], const Unit& u, int wr, int wc, int fr, int fq) const {
    const int row0 = u.pm * BM + wr * 64 + fr, col0 = wc * 32 + 4 * fq;
#pragma unroll
    for (int ai = 0; ai < 2; ++ai)
#pragma unroll
      for (int m = 0; m < 4; ++m) { float* rowp = XE + (size_t)(row0 + ai * HALF + m * 16) * 128 + col0;
#pragma unroll
        for (int n = 0; n < 2; ++n) *(f32x4*)(rowp + n * 16) = acc[ai][0][m][n]; }
  } };
struct EpiS5Y { static constexpr bool PERM = true; bf16* YC; const bf16* AP; const float* dsk;
  __device__ __forceinline__ void operator()(const f32x4 (&acc)[2][2][4][2], const Unit& u, int wr, int wc, int fr, int fq) const {
    const int row0 = u.pm * BM + wr * 64 + fr, g = u.pm >> 2;
#pragma unroll
    for (int ai = 0; ai < 2; ++ai)
#pragma unroll
      for (int m = 0; m < 4; ++m) { const int row = row0 + ai * HALF + m * 16, rg = row & 1023, b = rg >> 7, blk = rg & 127;
#pragma unroll
        for (int bj = 0; bj < 2; ++bj) { const int col0 = bj * HALF + wc * 32 + 8 * fq, t = col0 >> 4, ch = g * 16 + (col0 & 15);
          const u32x4 uv = *(const u32x4*)(AP + (size_t)row * 384 + col0);
          const f32x4 d0 = *(const f32x4*)(dsk + ch), d1 = *(const f32x4*)(dsk + ch + 4);
          const float uu[8] = {__uint_as_float(uv.x << 16), __uint_as_float(uv.x & 0xffff0000u), __uint_as_float(uv.y << 16), __uint_as_float(uv.y & 0xffff0000u),
                               __uint_as_float(uv.z << 16), __uint_as_float(uv.z & 0xffff0000u), __uint_as_float(uv.w << 16), __uint_as_float(uv.w & 0xffff0000u)};
          float h[8];
#pragma unroll
          for (int e = 0; e < 4; ++e) { h[e] = gelu_(acc[ai][bj][m][0][e] + d0[e] * uu[e]); h[4 + e] = gelu_(acc[ai][bj][m][1][e] + d1[e] * uu[4 + e]); }
          u32x4 w; w.x = cvt_pk_bf16(h[0], h[1]); w.y = cvt_pk_bf16(h[2], h[3]); w.z = cvt_pk_bf16(h[4], h[5]); w.w = cvt_pk_bf16(h[6], h[7]);
          *(u32x4*)(YC + (size_t)(b * 2048 + blk * 16 + t) * 512 + ch) = w; } }
  } };
struct EpiLora { static constexpr bool PERM = true; bf16* O0; bf16* O1;
  __device__ __forceinline__ void operator()(const f32x4 (&acc)[2][2][4][2], const Unit& u, int wr, int wc, int fr, int fq) const {
    bf16* base = (u.pn < 4) ? O0 : O1; constexpr int ldc = 1024;
    const int row0 = u.pm * BM + wr * 64 + fr, col0 = (u.pn & 3) * BM + wc * 32 + 8 * fq;
#pragma unroll
    for (int ai = 0; ai < 2; ++ai)
#pragma unroll
      for (int m = 0; m < 4; ++m) { bf16* rowp = base + (size_t)(row0 + ai * HALF + m * 16) * ldc + col0;
#pragma unroll
        for (int bj = 0; bj < 2; ++bj) { const f32x4 v0 = acc[ai][bj][m][0], v1 = acc[ai][bj][m][1];
          u32x4 w; w.x = cvt_pk_bf16(v0[0], v0[1]); w.y = cvt_pk_bf16(v0[2], v0[3]); w.z = cvt_pk_bf16(v1[0], v1[1]); w.w = cvt_pk_bf16(v1[2], v1[3]);
          *(u32x4*)(rowp + bj * HALF) = w; } }
  } };
struct EpiSwigluT { static constexpr bool PERM = true; bf16* O; int ldc;
  __device__ __forceinline__ void operator()(const f32x4 (&acc)[2][2][4][2], const Unit& u, int wr, int wc, int fr, int fq) const {
    const int row0 = u.pm * BM + wr * 64 + fr, col0 = u.pn * HALF + wc * 32 + 8 * fq;
#pragma unroll
    for (int ai = 0; ai < 2; ++ai)
#pragma unroll
      for (int m = 0; m < 4; ++m) { bf16* rowp = O + (size_t)(row0 + ai * HALF + m * 16) * ldc + col0;
        float h[8];
#pragma unroll
        for (int n = 0; n < 2; ++n)
#pragma unroll
          for (int e = 0; e < 4; ++e) { const float gte = acc[ai][0][m][n][e], up = acc[ai][1][m][n][e]; h[n * 4 + e] = gte * __builtin_amdgcn_rcpf(1.f + __expf(-gte)) * up; }
        u32x4 w; w.x = cvt_pk_bf16(h[0], h[1]); w.y = cvt_pk_bf16(h[2], h[3]); w.z = cvt_pk_bf16(h[4], h[5]); w.w = cvt_pk_bf16(h[6], h[7]);
        *(u32x4*)rowp = w; }
  } };
__device__ __forceinline__ unsigned pk4_fp8(float a, float b, float c, float d) {
  a = __builtin_amdgcn_fmed3f(a, -448.f, 448.f); b = __builtin_amdgcn_fmed3f(b, -448.f, 448.f); c = __builtin_amdgcn_fmed3f(c, -448.f, 448.f); d = __builtin_amdgcn_fmed3f(d, -448.f, 448.f);
  int w = 0; w = __builtin_amdgcn_cvt_pk_fp8_f32(a, b, w, false); w = __builtin_amdgcn_cvt_pk_fp8_f32(c, d, w, true); return (unsigned)w; }
struct EpiSwigluF8 { static constexpr bool PERM = true; unsigned char* O; int ldc;
  __device__ __forceinline__ void operator()(const f32x4 (&acc)[2][2][4][2], const Unit& u, int wr, int wc, int fr, int fq) const {
    const int row0 = u.pm * BM + wr * 64 + fr, col0 = u.pn * HALF + wc * 32 + 8 * fq;
#pragma unroll
    for (int ai = 0; ai < 2; ++ai)
#pragma unroll
      for (int m = 0; m < 4; ++m) { unsigned char* rowp = O + (size_t)(row0 + ai * HALF + m * 16) * ldc + col0;
        float h[8];
#pragma unroll
        for (int n = 0; n < 2; ++n)
#pragma unroll
          for (int e = 0; e < 4; ++e) { const float gte = acc[ai][0][m][n][e] * (1.f / 4096.f), up = acc[ai][1][m][n][e] * (8.f / 4096.f); h[n * 4 + e] = gte * __builtin_amdgcn_rcpf(1.f + __expf(-gte)) * up; }
        uint2 w; w.x = pk4_fp8(h[0], h[1], h[2], h[3]); w.y = pk4_fp8(h[4], h[5], h[6], h[7]);
        *(uint2*)rowp = w; }
  } };
struct EpiBf16S { static constexpr bool PERM = true; bf16* O; int ldc; float scale;
  __device__ __forceinline__ void operator()(const f32x4 (&acc)[2][2][4][2], const Unit& u, int wr, int wc, int fr, int fq) const {
    const int row0 = u.pm * BM + wr * 64 + fr, col0 = u.pn * BM + wc * 32 + 8 * fq;
#pragma unroll
    for (int ai = 0; ai < 2; ++ai)
#pragma unroll
      for (int m = 0; m < 4; ++m) { bf16* rowp = O + (size_t)(row0 + ai * HALF + m * 16) * ldc + col0;
#pragma unroll
        for (int bj = 0; bj < 2; ++bj) { const f32x4 v0 = acc[ai][bj][m][0] * scale, v1 = acc[ai][bj][m][1] * scale;
          u32x4 w; w.x = cvt_pk_bf16(v0[0], v0[1]); w.y = cvt_pk_bf16(v0[2], v0[3]); w.z = cvt_pk_bf16(v1[0], v1[1]); w.w = cvt_pk_bf16(v1[2], v1[3]);
          *(u32x4*)(rowp + bj * HALF) = w; } }
  } };
struct EpiGluT { static constexpr bool PERM = true; bf16* O; int ldc; const bf16* Yc; const float* bias;
  __device__ __forceinline__ void operator()(const f32x4 (&acc)[2][2][4][2], const Unit& u, int wr, int wc, int fr, int fq) const {
    const int row0 = u.pm * BM + wr * 64 + fr, col0 = u.pn * BM + wc * 32 + 8 * fq;
#pragma unroll
    for (int ai = 0; ai < 2; ++ai)
#pragma unroll
      for (int m = 0; m < 4; ++m) { const int row = row0 + ai * HALF + m * 16;
#pragma unroll
        for (int bj = 0; bj < 2; ++bj) { const int col = col0 + bj * HALF;
          const u32x4 yv = *(const u32x4*)(Yc + (size_t)row * 512 + col);
          const f32x4 b0 = *(const f32x4*)(bias + col), b1 = *(const f32x4*)(bias + col + 4);
          const float y[8] = {__uint_as_float(yv.x << 16), __uint_as_float(yv.x & 0xffff0000u), __uint_as_float(yv.y << 16), __uint_as_float(yv.y & 0xffff0000u),
                              __uint_as_float(yv.z << 16), __uint_as_float(yv.z & 0xffff0000u), __uint_as_float(yv.w << 16), __uint_as_float(yv.w & 0xffff0000u)};
          float h[8];
#pragma unroll
          for (int e = 0; e < 4; ++e) { h[e] = y[e] * __builtin_amdgcn_rcpf(1.f + __expf(-(acc[ai][bj][m][0][e] + b0[e]))); h[4 + e] = y[4 + e] * __builtin_amdgcn_rcpf(1.f + __expf(-(acc[ai][bj][m][1][e] + b1[e]))); }
          u32x4 w; w.x = cvt_pk_bf16(h[0], h[1]); w.y = cvt_pk_bf16(h[2], h[3]); w.z = cvt_pk_bf16(h[4], h[5]); w.w = cvt_pk_bf16(h[6], h[7]);
          *(u32x4*)(O + (size_t)row * ldc + col) = w; } }
  } };

template <class Epi, class Sched>
__device__ __forceinline__ void gemm_phase(LAS unsigned char* lds, const Gemm g, const Sched& S, const Epi& E) {
  const int tid = threadIdx.x, wid = __builtin_amdgcn_readfirstlane(tid >> 6), lane = tid & 63, wr = wid >> 2, wc = wid & 3, fr = lane & 15, fq = lane >> 4;
  constexpr int ES = Sched::FP8 ? 1 : 2;
  const int K = g.K, nt = K * ES / 128;
  unsigned voffA[2], voffB[2]; int gR[2], gC[2];
#pragma unroll
  for (int i = 0; i < 2; ++i) { int R, C; stage_rc(tid * 16 + i * 8192, R, C); const int Rb = Epi::PERM ? ((R & ~31) + perm32(R & 31)) : R;
    voffA[i] = (unsigned)(R * g.lda * ES + C * 2); voffB[i] = (unsigned)(Rb * g.ldb * ES + C * 2); gR[i] = R; gC[i] = C * 2; }
  const size_t kstep = (size_t)(BK * 2);
  const size_t hstepA = (size_t)HALF * g.lda * ES, hstepB = (size_t)HALF * g.ldb * ES;
  const unsigned ldsw = (unsigned)wid * 1024u;
  const unsigned rowb = (unsigned)(g.lda * ES);
  const int aoff = lds_byte(wr * 64 + fr, fq * 8), boff = lds_byte(wc * 32 + fr, fq * 8);
#define PG8_SA(b, h) (((b) * 2 + (h)) * HTB)
#define PG8_SB(b, h) ((4 + (b) * 2 + (h)) * HTB)
#define PG8_STAGE(bufoff, gbase, voff) do { _Pragma("unroll") for (int _i = 0; _i < 2; ++_i) \
    __builtin_amdgcn_global_load_lds((const unsigned*)((const char*)(gbase) + (voff)[_i]), (LAS unsigned*)(lds + (bufoff) + ldsw + _i * 8192), 16, 0, 0); } while (0)
#define PG8_STAGE_A(bufoff, p, h, goff) do { if constexpr (Sched::GATHER) PG8_STAGE(bufoff, p, (goff)[h]); else PG8_STAGE(bufoff, (p) + (h) * hstepA, voffA); } while (0)
#define PG8_LDA(dst, b, h) do { _Pragma("unroll") for (int m = 0; m < 4; ++m) { if constexpr (Sched::FP8) dst##8[m] = __builtin_shufflevector(*(const LAS i32x4_*)(lds + PG8_SA(b, h) + aoff + m * 2048), *(const LAS i32x4_*)(lds + PG8_SA(b, h) + aoff + m * 2048 + 1024), 0, 1, 2, 3, 4, 5, 6, 7); \
    else { _Pragma("unroll") for (int k = 0; k < 2; ++k) dst[m][k] = *(const LAS bf16x8*)(lds + PG8_SA(b, h) + aoff + m * 2048 + k * 1024); } } } while (0)
#define PG8_LDB(dst, b, h) do { _Pragma("unroll") for (int n = 0; n < 2; ++n) { if constexpr (Sched::FP8) dst##8[n] = __builtin_shufflevector(*(const LAS i32x4_*)(lds + PG8_SB(b, h) + boff + n * 2048), *(const LAS i32x4_*)(lds + PG8_SB(b, h) + boff + n * 2048 + 1024), 0, 1, 2, 3, 4, 5, 6, 7); \
    else { _Pragma("unroll") for (int k = 0; k < 2; ++k) dst[n][k] = *(const LAS bf16x8*)(lds + PG8_SB(b, h) + boff + n * 2048 + k * 1024); } } } while (0)
  int sc1 = 0x7f7f7f7f; asm volatile("" : "+v"(sc1));
#define PG8_MMA(ai, bj, At, Bt) do { __builtin_amdgcn_s_setprio(1); _Pragma("unroll") for (int m = 0; m < 4; ++m) _Pragma("unroll") for (int n = 0; n < 2; ++n) { \
    if constexpr (Sched::FP8) asm volatile("v_mfma_scale_f32_16x16x128_f8f6f4 %0, %1, %2, %0, %3, %3 op_sel_hi:[0,0,0]" : "+v"(acc[ai][bj][m][n]) : "v"(Bt##8[n]), "v"(At##8[m]), "v"(sc1)); \
    else { _Pragma("unroll") for (int k = 0; k < 2; ++k) acc[ai][bj][m][n] = __builtin_amdgcn_mfma_f32_16x16x32_bf16(Bt[n][k], At[m][k], acc[ai][bj][m][n], 0, 0, 0); } } \
    __builtin_amdgcn_s_setprio(0); } while (0)
#define PG8_WAIT_V(n) asm volatile("s_waitcnt vmcnt(" #n ")" ::: "memory")
#define PG8_WAIT_L(n) asm volatile("s_waitcnt lgkmcnt(" #n ")" ::: "memory")
#define PG8_BAR __builtin_amdgcn_s_barrier()
#define PG8_SCHED __builtin_amdgcn_sched_barrier(0)
  Unit cur, nxt; int ui = 0;
  if (!S.next(0, cur)) return;
  f32x4 acc[2][2][4][2];
#pragma unroll
  for (int a = 0; a < 2; ++a)
#pragma unroll
    for (int b = 0; b < 2; ++b)
#pragma unroll
      for (int m = 0; m < 4; ++m)
#pragma unroll
        for (int n = 0; n < 2; ++n) acc[a][b][m][n] = (f32x4){0.f, 0.f, 0.f, 0.f};
  bf16x8 At[4][2], B0[2][2], B1[2][2];
  i32x8_ At8[4], B08[2], B18[2];
  unsigned gcu[2][2] = {{0u, 0u}, {0u, 0u}};
  const char* cA = Sched::GATHER ? (const char*)g.A : S.a_tile(g, cur); const char* cB = S.b_tile(g, cur);
  if constexpr (Sched::GATHER) {
#pragma unroll
    for (int h = 0; h < 2; ++h)
#pragma unroll
      for (int i = 0; i < 2; ++i) gcu[h][i] = (unsigned)S.rows(cur)[h * HALF + gR[i]] * rowb + (unsigned)gC[i];
  }
  PG8_STAGE(PG8_SB(0, 0), cB, voffB); PG8_STAGE(PG8_SB(0, 1), cB + hstepB, voffB); PG8_STAGE_A(PG8_SA(0, 0), cA, 0, gcu); PG8_STAGE_A(PG8_SA(0, 1), cA, 1, gcu);
  if (wr == 1) PG8_BAR;
  PG8_WAIT_V(2); PG8_BAR;
  PG8_STAGE(PG8_SB(1, 0), cB + kstep, voffB); PG8_STAGE_A(PG8_SA(1, 0), cA + kstep, 0, gcu); PG8_STAGE(PG8_SB(1, 1), cB + hstepB + kstep, voffB);
  PG8_WAIT_V(6); PG8_BAR;
  for (;;) {
    const bool has_next = S.next(ui + 1, nxt);
    const char* nA = Sched::GATHER ? (const char*)g.A : (has_next ? S.a_tile(g, nxt) : cA); const char* nB = has_next ? S.b_tile(g, nxt) : cB;
    if constexpr (Sched::GATHER) {
      if (has_next && wid < 4) __builtin_amdgcn_global_load_lds((const unsigned*)(S.rows(nxt) + wid * 64 + lane), (LAS unsigned*)(lds + LDS_IDX + ((ui + 1) & 1) * 1024 + wid * 256), 4, 0, 0);
    }
#pragma nounroll
    for (int t = 0; t < nt; t += 2) {
      const bool last = (t == nt - 2);
      const char* a1 = cA + (size_t)(t + 1) * kstep;
      const char* a2 = last ? nA : cA + (size_t)(t + 2) * kstep; const char* b2 = last ? nB : cB + (size_t)(t + 2) * kstep;
      const char* a3 = a2 + kstep; const char* b3 = b2 + kstep;
      unsigned g2[2][2];
#pragma unroll
      for (int h = 0; h < 2; ++h)
#pragma unroll
        for (int i = 0; i < 2; ++i) g2[h][i] = gcu[h][i];
      if constexpr (Sched::GATHER) {
        if (last && has_next) {
          const LAS unsigned* ix = (const LAS unsigned*)(lds + LDS_IDX + ((ui + 1) & 1) * 1024);
#pragma unroll
          for (int h = 0; h < 2; ++h)
#pragma unroll
            for (int i = 0; i < 2; ++i) g2[h][i] = ix[h * HALF + gR[i]] * rowb + (unsigned)gC[i];
        }
      }
      PG8_LDB(B0, 0, 0); PG8_LDB(B1, 0, 1); PG8_SCHED; PG8_LDA(At, 0, 0); PG8_STAGE_A(PG8_SA(1, 1), a1, 1, gcu);
      PG8_WAIT_V(8); PG8_WAIT_L(0); PG8_BAR; PG8_MMA(0, 0, At, B0); PG8_MMA(0, 1, At, B1); PG8_BAR; PG8_SCHED;
      PG8_LDA(At, 0, 1); PG8_STAGE(PG8_SB(0, 0), b2, voffB); PG8_STAGE(PG8_SB(0, 1), b2 + hstepB, voffB); PG8_STAGE_A(PG8_SA(0, 0), a2, 0, g2);
      PG8_WAIT_V(8); PG8_WAIT_L(0); PG8_BAR; PG8_MMA(1, 0, At, B0); PG8_MMA(1, 1, At, B1); PG8_BAR; PG8_SCHED;
      PG8_LDB(B0, 1, 0); PG8_LDB(B1, 1, 1); PG8_SCHED; PG8_LDA(At, 1, 0); PG8_STAGE_A(PG8_SA(0, 1), a2, 1, g2);
      PG8_WAIT_V(8); PG8_WAIT_L(0); PG8_BAR; PG8_MMA(0, 0, At, B0); PG8_MMA(0, 1, At, B1); PG8_BAR; PG8_SCHED;
      PG8_LDA(At, 1, 1); PG8_STAGE(PG8_SB(1, 0), b3, voffB); PG8_STAGE(PG8_SB(1, 1), b3 + hstepB, voffB); PG8_STAGE_A(PG8_SA(1, 0), a3, 0, g2);
      PG8_WAIT_V(8); PG8_WAIT_L(0); PG8_BAR; PG8_MMA(1, 0, At, B0); PG8_MMA(1, 1, At, B1); PG8_BAR; PG8_SCHED;
      if constexpr (Sched::GATHER) { if (last) {
#pragma unroll
        for (int h = 0; h < 2; ++h)
#pragma unroll
          for (int i = 0; i < 2; ++i) gcu[h][i] = g2[h][i]; } }
    }
    if (wr == 0) PG8_BAR;
    if constexpr (Sched::FP8) asm volatile("s_nop 15\n\ts_nop 15" ::: "memory");
    E(acc, cur, wr, wc, fr, fq);
    if (!has_next) break;
#pragma unroll
    for (int a = 0; a < 2; ++a)
#pragma unroll
      for (int b = 0; b < 2; ++b)
#pragma unroll
        for (int m = 0; m < 4; ++m)
#pragma unroll
          for (int n = 0; n < 2; ++n) acc[a][b][m][n] = (f32x4){0.f, 0.f, 0.f, 0.f};
    cur = nxt; cA = nA; cB = nB; ++ui;
    if (wr == 1) PG8_BAR;
  }
  PG8_WAIT_V(0);
  PG8_BAR;
#undef PG8_SA
#undef PG8_SB
#undef PG8_STAGE
#undef PG8_STAGE_A
#undef PG8_LDA
#undef PG8_LDB
#undef PG8_MMA
#undef PG8_WAIT_V
#undef PG8_WAIT_L
#undef PG8_BAR
#undef PG8_SCHED
}
}

__device__ __forceinline__ void cvt_item(const float* W, int ldw, bf16* WT, int Kd, int dst_row0, int k0, int n0, int lane) {
  const int kg = lane >> 4, nq = lane & 15;
  const float* src = W + (size_t)(k0 + 16 * kg) * ldw + n0 + 4 * nq;
  f32x4 r[16];
#pragma unroll
  for (int i = 0; i < 16; ++i) r[i] = *(const f32x4*)(src + (size_t)i * ldw);
  bf16* dst = WT + (size_t)(dst_row0 + 4 * nq) * Kd + k0 + 16 * kg;
#pragma unroll
  for (int e = 0; e < 4; ++e) {
    mg::u32x4 o0, o1;
    o0.x = mg::cvt_pk_bf16(r[0][e], r[1][e]); o0.y = mg::cvt_pk_bf16(r[2][e], r[3][e]); o0.z = mg::cvt_pk_bf16(r[4][e], r[5][e]); o0.w = mg::cvt_pk_bf16(r[6][e], r[7][e]);
    o1.x = mg::cvt_pk_bf16(r[8][e], r[9][e]); o1.y = mg::cvt_pk_bf16(r[10][e], r[11][e]); o1.z = mg::cvt_pk_bf16(r[12][e], r[13][e]); o1.w = mg::cvt_pk_bf16(r[14][e], r[15][e]);
    *(mg::u32x4*)(dst + (size_t)e * Kd) = o0; *(mg::u32x4*)(dst + (size_t)e * Kd + 8) = o1;
  }
}
__device__ __forceinline__ void cvt_mat_item(const float* W, int K, int N, int ldw, bf16* WT, int mode, int it, int lane) {
  const int nblk = N / 64, kb = it / nblk, nb = it % nblk, n0 = nb * 64;
  const int dst = mode == 0 ? n0 : ((n0 >> 7) * 256 + (n0 & 127) + (mode == 2 ? 128 : 0));
  cvt_item(W, ldw, WT, K, dst, kb * 64, n0, lane);
}
__device__ __forceinline__ void cvt_dense(const Ctx& c) {
  const float* win0 = inp(c, I0_WIN); const float* wout0 = inp(c, I0_WOUT); const float* fg = inp(c, I0_FG); const float* fu = inp(c, I0_FU); const float* fd = inp(c, I0_FD);
  const float* win1 = inp(c, I1_WIN); const float* glw = inp(c, I1_GLW); const float* wout1 = inp(c, I1_WOUT);
  unsigned char* ws = c.ws;
  for (int it = c.wave * c.G + c.bid; it < 3904; it += NW * c.G) {
    int r = it;
    if (r < 704) { cvt_mat_item(win0, D, EVEN_IN, EVEN_IN, (bf16*)(ws + WS_WIN0), 0, r, c.lane); continue; } r -= 704;
    if (r < 256) { cvt_mat_item(wout0, D, D, D, (bf16*)(ws + WS_WOUT0), 0, r, c.lane); continue; } r -= 256;
    if (r < 704) { cvt_mat_item(fg, D, FFN, FFN, (bf16*)(ws + WS_FGU), 1, r, c.lane); continue; } r -= 704;
    if (r < 704) { cvt_mat_item(fu, D, FFN, FFN, (bf16*)(ws + WS_FGU), 2, r, c.lane); continue; } r -= 704;
    if (r < 704) { cvt_mat_item(fd, FFN, D, D, (bf16*)(ws + WS_FD), 0, r, c.lane); continue; } r -= 704;
    if (r < 512) { cvt_mat_item(win1, D, 2048, ODD_IN, (bf16*)(ws + WS_WIN1), 0, r, c.lane); continue; } r -= 512;
    if (r < 64) { cvt_mat_item(glw, 512, 512, 512, (bf16*)(ws + WS_GLU), 0, r, c.lane); continue; } r -= 64;
    cvt_mat_item(wout1, D, D, D, (bf16*)(ws + WS_WOUT1), 0, r, c.lane);
  }
}
__device__ __forceinline__ void cvt_moe(const Ctx& c, int vb, int vG, int part) {
  const float* mgp = inp(c, I1_MG); const float* mup = inp(c, I1_MU); const float* mdp = inp(c, I1_MDN);
  unsigned char* tile = c.lds;
  const int nitems = part == 0 ? 8 * 224 : 8 * 112;
  for (int it = vb; it < nitems; it += vG) {
    const float* W; unsigned char* WT; int K, N, up = 0, idx;
    if (part == 0) { const int e = it / 224, r = it % 224; up = r / 112; idx = r % 112; W = (up ? mup : mgp) + (size_t)e * D * FE; WT = c.ws + WS_MGU + (size_t)e * 2 * FE * D; K = D; N = FE; }
    else { const int e = it / 112; idx = it % 112; W = mdp + (size_t)e * FE * D; WT = c.ws + WS_MD + (size_t)e * D * FE; K = FE; N = D; }
    const int nblk = N / 256, kb = idx / nblk, nb = idx % nblk, k0 = kb * 128, n0 = nb * 256;
    const float* src = W + (size_t)(k0 + 16 * c.wave) * N + n0 + 4 * c.lane;
    f32x4 r[16];
#pragma unroll
    for (int i = 0; i < 16; ++i) r[i] = *(const f32x4*)(src + (size_t)i * N) * 256.f;
    __syncthreads();
#pragma unroll
    for (int e = 0; e < 4; ++e) {
      mg::u32x4 o; o.x = mg::pk4_fp8(r[0][e], r[1][e], r[2][e], r[3][e]); o.y = mg::pk4_fp8(r[4][e], r[5][e], r[6][e], r[7][e]);
      o.z = mg::pk4_fp8(r[8][e], r[9][e], r[10][e], r[11][e]); o.w = mg::pk4_fp8(r[12][e], r[13][e], r[14][e], r[15][e]);
      *(mg::u32x4*)(tile + (4 * c.lane + e) * 128 + 16 * c.wave) = o;
    }
    __syncthreads();
#pragma unroll
    for (int j = 0; j < 4; ++j) { const int n = (c.tid >> 3) + 64 * j, pc = c.tid & 7, ng = n0 + n;
      const int drow = part == 0 ? ((ng >> 7) * 256 + (ng & 127) + 128 * up) : ng;
      *(mg::u32x4*)(WT + (size_t)drow * K + k0 + 16 * pc) = *(const mg::u32x4*)(tile + n * 128 + 16 * pc); }
  }
  __syncthreads();
}


template <int YMODE, int PROJ>
__device__ __forceinline__ void norm_phase(const Ctx& c, const float* resin, float* resout, const float* Y, const float* gpost, const float* gpre, bf16* XN,
                                           const float* W8, int ldw8, int c0, float* out8) {
  float* w8s = (float*)c.lds;
  LAS unsigned* hist = (LAS unsigned*)(c.lds + 32768);
  if (PROJ) {
    for (int i = c.tid; i < 1024 * 8; i += NT) w8s[i] = W8[(size_t)(i >> 3) * ldw8 + c0 + (i & 7)];
    if (PROJ == 2 && c.tid < 8) hist[c.tid] = 0u;
    __syncthreads();
  }
  int* tok_e = (int*)(c.ws + WS_ROUTE); float* tok_g = (float*)(c.ws + WS_ROUTE + 128 * 1024);
  int* tok_pos = (int*)(c.ws + WS_ROUTE + 256 * 1024);
  const bf16* YS = (const bf16*)(c.ws + WS_YS);
  f32x4 rn[4]; uint2 yn[4] = {}, zn[4] = {}; float gn0 = 0.f, gn1 = 0.f;
  int te0 = 0, te1 = 0, tp0 = 0, tp1 = 0; float tg0 = 0.f, tg1 = 0.f;
  int pst[8] = {0, 0, 0, 0, 0, 0, 0, 0};
  if (YMODE == 2) { int acc_ = 0;
#pragma unroll
    for (int e = 0; e < 8; ++e) { pst[e] = acc_; acc_ += ((int)c.ctl[CW_CNT + 64 * e] + 255) / 256 * 256; } }
#define NP_TOK(mm) do { te0 = tok_e[2 * (mm)]; te1 = tok_e[2 * (mm) + 1]; tp0 = tok_pos[2 * (mm)]; tp1 = tok_pos[2 * (mm) + 1]; tg0 = tok_g[2 * (mm)]; tg1 = tok_g[2 * (mm) + 1]; } while (0)
#define NP_LOAD(mm) do { _Pragma("unroll") for (int j = 0; j < 4; ++j) { rn[j] = *(const f32x4*)(resin + (size_t)(mm) * D + j * 256 + c.lane * 4); \
      if (YMODE == 1) yn[j] = *(const uint2*)((const bf16*)Y + (size_t)(mm) * D + j * 256 + c.lane * 4); } \
    if (YMODE == 2) { int s0_ = tp0, s1_ = tp1; _Pragma("unroll") for (int e = 0; e < 8; ++e) { s0_ += (te0 == e) ? pst[e] : 0; s1_ += (te1 == e) ? pst[e] : 0; } gn0 = tg0; gn1 = tg1; \
      _Pragma("unroll") for (int j = 0; j < 4; ++j) { yn[j] = *(const uint2*)(YS + (size_t)s0_ * D + j * 256 + c.lane * 4); zn[j] = *(const uint2*)(YS + (size_t)s1_ * D + j * 256 + c.lane * 4); } } } while (0)
  { const int m_first = c.wave * c.G + c.bid;
    if (m_first < M) { if (YMODE == 2) NP_TOK(m_first); NP_LOAD(m_first); if (YMODE == 2 && m_first + NW * c.G < M) NP_TOK(m_first + NW * c.G); } }
  for (int m = c.wave * c.G + c.bid; m < M; m += NW * c.G) {
    f32x4 r[4]; uint2 ya[4], za[4]; const float g0 = gn0, g1 = gn1;
#pragma unroll
    for (int j = 0; j < 4; ++j) { r[j] = rn[j]; ya[j] = yn[j]; za[j] = zn[j]; }
    if (m + NW * c.G < M) { NP_LOAD(m + NW * c.G); if (YMODE == 2 && m + 2 * NW * c.G < M) NP_TOK(m + 2 * NW * c.G); }
    if (YMODE) {
      f32x4 y[4]; float ss = 0.f;
      if (YMODE == 1) {
#pragma unroll
        for (int j = 0; j < 4; ++j) { const uint2 a = ya[j];
          y[j][0] = __uint_as_float(a.x << 16); y[j][1] = __uint_as_float(a.x & 0xffff0000u); y[j][2] = __uint_as_float(a.y << 16); y[j][3] = __uint_as_float(a.y & 0xffff0000u); }
      } else {
#pragma unroll
        for (int j = 0; j < 4; ++j) { const uint2 a = ya[j], b = za[j];
          y[j][0] = g0 * bf2f((bf16)(a.x & 0xffff)) + g1 * bf2f((bf16)(b.x & 0xffff));
          y[j][1] = g0 * bf2f((bf16)(a.x >> 16)) + g1 * bf2f((bf16)(b.x >> 16));
          y[j][2] = g0 * bf2f((bf16)(a.y & 0xffff)) + g1 * bf2f((bf16)(b.y & 0xffff));
          y[j][3] = g0 * bf2f((bf16)(a.y >> 16)) + g1 * bf2f((bf16)(b.y >> 16));
        }
      }
#pragma unroll
      for (int j = 0; j < 4; ++j) ss += y[j][0] * y[j][0] + y[j][1] * y[j][1] + y[j][2] * y[j][2] + y[j][3] * y[j][3];
      const float rs = rsqrtf(wave_sum(ss) * (1.f / D) + 1e-6f);
#pragma unroll
      for (int j = 0; j < 4; ++j) {
        const f32x4 g = *(const f32x4*)(gpost + j * 256 + c.lane * 4);
        r[j] = r[j] + y[j] * rs * g;
        *(f32x4*)(resout + (size_t)m * D + j * 256 + c.lane * 4) = r[j];
      }
    }
    if (gpre) {
      float ss = 0.f;
#pragma unroll
      for (int j = 0; j < 4; ++j) ss += r[j][0] * r[j][0] + r[j][1] * r[j][1] + r[j][2] * r[j][2] + r[j][3] * r[j][3];
      const float rs = rsqrtf(wave_sum(ss) * (1.f / D) + 1e-6f);
      float p8[8];
#pragma unroll
      for (int q = 0; q < 8; ++q) p8[q] = 0.f;
#pragma unroll
      for (int j = 0; j < 4; ++j) {
        const f32x4 g = *(const f32x4*)(gpre + j * 256 + c.lane * 4);
        const f32x4 xn = r[j] * rs * g;
        if (PROJ == 2) { *(unsigned*)(c.ws + WS_XN8 + (size_t)m * D + j * 256 + c.lane * 4) = mg::pk4_fp8(xn[0] * 16.f, xn[1] * 16.f, xn[2] * 16.f, xn[3] * 16.f); }
        else { uint2 o; o.x = (unsigned)f2bf(xn[0]) | ((unsigned)f2bf(xn[1]) << 16); o.y = (unsigned)f2bf(xn[2]) | ((unsigned)f2bf(xn[3]) << 16);
          *(uint2*)(XN + (size_t)m * D + j * 256 + c.lane * 4) = o; }
        if (PROJ) {
#pragma unroll
          for (int e = 0; e < 4; ++e) {
            const float* wr = w8s + (j * 256 + c.lane * 4 + e) * 8;
#pragma unroll
            for (int q = 0; q < 8; ++q) p8[q] += xn[e] * wr[q];
          }
        }
      }
      if (PROJ) {
#pragma unroll
        for (int q = 0; q < 8; ++q) p8[q] = wave_sum(p8[q]);
        if (PROJ == 1) { if (c.lane < 8) { float v = p8[0];
#pragma unroll
            for (int q = 1; q < 8; ++q) v = (c.lane == q) ? p8[q] : v;
            out8[(size_t)m * 8 + c.lane] = v; } }
        if (PROJ == 2 && c.lane == 0) {
          int e0 = 0; float v0 = p8[0];
#pragma unroll
          for (int q = 1; q < 8; ++q) if (p8[q] > v0) { v0 = p8[q]; e0 = q; }
          int e1 = -1; float v1 = -3.0e38f;
#pragma unroll
          for (int q = 0; q < 8; ++q) if (q != e0 && p8[q] > v1) { v1 = p8[q]; e1 = q; }
          const float g1 = 1.f / (1.f + expf(v0 - v1)), g0 = 1.f - g1;
          tok_e[2 * m] = e0; tok_e[2 * m + 1] = e1; tok_g[2 * m] = g0; tok_g[2 * m + 1] = g1;
          tok_pos[2 * m] = (int)atomicAdd((unsigned*)&hist[e0], 1u); tok_pos[2 * m + 1] = (int)atomicAdd((unsigned*)&hist[e1], 1u);
        }
      }
    }
  }
#undef NP_LOAD
#undef NP_TOK
  if (PROJ == 2) {
    __syncthreads();
    if (c.tid < 8) hist[8 + c.tid] = atomicAdd(c.ctl + CW_CNT + 64 * c.tid, hist[c.tid]);
    __syncthreads();
    int* toke = (int*)(c.ctl + CW_TOKE);
    if (c.lane == 0) for (int m = c.wave * c.G + c.bid; m < M; m += NW * c.G) {
#pragma unroll
      for (int k = 0; k < 2; ++k) { const int e = tok_e[2 * m + k], pos = (int)hist[8 + e] + tok_pos[2 * m + k]; tok_pos[2 * m + k] = pos; toke[e * M + pos] = m; } }
  }
  __syncthreads();
}

__device__ __forceinline__ void rwkv_prep_a(const Ctx& c) {
  const float* mu = inp(c, I0_MU);
  const bf16* P = (const bf16*)(c.ws + WS_P0); bf16* AL = (bf16*)(c.ws + WS_ALORA);
  const f32x4 mu4 = *(const f32x4*)(mu + 1536 + c.lane * 4);
  for (int m = c.wave * c.G + c.bid; m < M; m += NW * c.G) {
    const int t = m % SEQ;
    const uint2 cu = *(const uint2*)(P + (size_t)m * EVEN_IN + 1536 + c.lane * 4);
    uint2 pv = {0u, 0u}; if (t > 0) pv = *(const uint2*)(P + (size_t)(m - 1) * EVEN_IN + 1536 + c.lane * 4);
    const float cv[4] = {__uint_as_float(cu.x << 16), __uint_as_float(cu.x & 0xffff0000u), __uint_as_float(cu.y << 16), __uint_as_float(cu.y & 0xffff0000u)};
    const float pp[4] = {__uint_as_float(pv.x << 16), __uint_as_float(pv.x & 0xffff0000u), __uint_as_float(pv.y << 16), __uint_as_float(pv.y & 0xffff0000u)};
    float o[4];
#pragma unroll
    for (int e = 0; e < 4; ++e) { float v = cv[e] + (pp[e] - cv[e]) * mu4[e]; if (c.lane < 16) v = tanhf(v); else if (c.lane >= 32) v = sigmoid_(v); o[e] = v; }
    uint2 w; w.x = (unsigned)f2bf(o[0]) | ((unsigned)f2bf(o[1]) << 16); w.y = (unsigned)f2bf(o[2]) | ((unsigned)f2bf(o[3]) << 16);
    *(uint2*)(AL + (size_t)m * 256 + c.lane * 4) = w;
  }
}
__device__ __forceinline__ void build_wlora(const Ctx& c) {
  const float* w2 = inp(c, I0_W2); const float* a2 = inp(c, I0_A2); const float* g2 = inp(c, I0_G2);
  bf16* WL = (bf16*)(c.ws + WS_WLORA);
  for (int i = c.bid * NT + c.tid; i < 1536 * 256; i += c.G * NT) {
    const int n = i >> 8, k = i & 255; float v = 0.f;
    if (n < 512) { if (k < 64) v = w2[k * 512 + n]; }
    else if (n < 1024) { if (k >= 64 && k < 128) v = a2[(k - 64) * 512 + (n - 512)]; }
    else { if (k >= 128) v = g2[(k - 128) * 512 + (n - 1024)]; }
    WL[i] = f2bf(v);
  }
}
constexpr size_t WS_YSC = WS_XN;
typedef short bf16x4 __attribute__((ext_vector_type(4)));
__device__ __forceinline__ bf16x4 pack4(f32x4 v) { union { uint2 u; bf16x4 b; } x; x.u.x = mg::cvt_pk_bf16(v[0], v[1]); x.u.y = mg::cvt_pk_bf16(v[2], v[3]); return x.b; }
__device__ __forceinline__ f32x4 mma16(bf16x4 p, bf16x4 q, f32x4 c) { return __builtin_amdgcn_mfma_f32_16x16x16bf16_1k(p, q, c, 0, 0, 0); }
constexpr int RK_SK = 72;
__device__ __forceinline__ void rwkv_chunk_prep(const Ctx& c) {
  const float* mu = inp(c, I0_MU); const float* w0 = inp(c, I0_W0); const float* a0 = inp(c, I0_A0);
  const float* kkp = inp(c, I0_KK); const float* kap = inp(c, I0_KA); const float* rkp = inp(c, I0_RK);
  const bf16* P = (const bf16*)(c.ws + WS_P0); const bf16* LW = (const bf16*)(c.ws + WS_LOWA);
  float* BON = (float*)(c.ws + WS_BON); unsigned char* CHK = c.ws + WS_CHK;
  bf16* wl = (bf16*)(c.lds + c.wave * 17408);
  bf16* sAt = wl, *sBh = wl + 1152, *sKh = wl + 2304, *sRt = wl + 3456;
  bf16* tAt = wl + 4608, *tRt = tAt + 1024, *tBp = tAt + 2048, *tKp = tAt + 3072;
  const int lane = c.lane, q = lane >> 4, lr = lane & 15;
  for (int unit = c.wave * c.G + c.bid; unit < BATCH * 8 * 128; unit += NW * c.G) {
    const int ck = unit & 127, bh = unit >> 7, h = bh & 7, b = bh >> 3, ch = h * 64 + lane;
    const size_t m0 = (size_t)b * SEQ + ck * 16;
    const float mur = mu[ch], muk = mu[512 + ch], muv = mu[1024 + ch], w0c = w0[ch], a0c = a0[ch], kkc = kkp[ch], kac = kap[ch], rkc = rkp[ch];
    float At[16], Bh[16], Kh[16], Rt[16], Vs[16];
    float rp = 0.f, kp = 0.f, vp = 0.f;
    if (ck > 0) { const bf16* pp = P + (m0 - 1) * EVEN_IN + ch; rp = bf2f(pp[0]); kp = bf2f(pp[512]); vp = bf2f(pp[1024]); }
    float g = 1.f;
#pragma unroll
    for (int t = 0; t < 16; ++t) {
      const bf16* pc = P + (m0 + t) * EVEN_IN + ch;
      const float rc = bf2f(pc[0]), kc = bf2f(pc[512]), vc = bf2f(pc[1024]);
      const float r = rc + (rp - rc) * mur, k = kc + (kp - kc) * muk, v = vc + (vp - vc) * muv;
      rp = rc; kp = kc; vp = vc;
      const float aw = w0c + bf2f(LW[(m0 + t) * 1024 + ch]), aa = a0c + bf2f(LW[(m0 + t) * 1024 + 512 + ch]);
      const float lw = -__expf(-softplus_(-aw) - 0.5f);
      const float ag = sigmoid_(aa);
      float kk = k * kkc;
      kk = kk / fmaxf(sqrtf(wave_sum(kk * kk)), 1e-12f);
      const float k2 = k * (1.f + (ag - 1.f) * kac);
      const float bon = wave_sum(r * k2 * rkc);
      if (lane == 0) BON[(m0 + t) * 8 + h] = bon;
      const float gprev = g; g *= __expf(lw); const float gi = __builtin_amdgcn_rcpf(g);
      At[t] = -kk * gprev; Bh[t] = kk * ag * gi; Kh[t] = k2 * gi; Rt[t] = r * g; Vs[t] = v;
    }
    const float gL = g;
    unsigned char* cb = CHK + (size_t)unit * CHB;
#pragma unroll
    for (int t = 0; t < 16; ++t) { sAt[t * RK_SK + lane] = f2bf(At[t]); sBh[t * RK_SK + lane] = f2bf(Bh[t]); sKh[t * RK_SK + lane] = f2bf(Kh[t]); sRt[t * RK_SK + lane] = f2bf(Rt[t]); }
    { mg::u32x4 o0, o1;
#define PK16(arr, sc) o0.x = mg::cvt_pk_bf16(arr[0] * sc, arr[1] * sc); o0.y = mg::cvt_pk_bf16(arr[2] * sc, arr[3] * sc); o0.z = mg::cvt_pk_bf16(arr[4] * sc, arr[5] * sc); o0.w = mg::cvt_pk_bf16(arr[6] * sc, arr[7] * sc); \
      o1.x = mg::cvt_pk_bf16(arr[8] * sc, arr[9] * sc); o1.y = mg::cvt_pk_bf16(arr[10] * sc, arr[11] * sc); o1.z = mg::cvt_pk_bf16(arr[12] * sc, arr[13] * sc); o1.w = mg::cvt_pk_bf16(arr[14] * sc, arr[15] * sc);
      PK16(At, 1.f) *(mg::u32x4*)(tAt + lane * 16) = o0; *(mg::u32x4*)(tAt + lane * 16 + 8) = o1;
      PK16(Rt, 1.f) *(mg::u32x4*)(tRt + lane * 16) = o0; *(mg::u32x4*)(tRt + lane * 16 + 8) = o1;
      PK16(Bh, gL) *(mg::u32x4*)(tBp + lane * 16) = o0; *(mg::u32x4*)(tBp + lane * 16 + 8) = o1;
      *(mg::u32x4*)(cb + 6656 + lane * 32) = o0; *(mg::u32x4*)(cb + 6656 + lane * 32 + 16) = o1;
      PK16(Kh, gL) *(mg::u32x4*)(tKp + lane * 16) = o0; *(mg::u32x4*)(tKp + lane * 16 + 8) = o1;
      PK16(Vs, 1.f) *(mg::u32x4*)(cb + 8704 + lane * 32) = o0; *(mg::u32x4*)(cb + 8704 + lane * 32 + 16) = o1;
#undef PK16
      *(float*)(cb + 10752 + lane * 4) = gL; }
    __builtin_amdgcn_s_waitcnt(0xc07f); __builtin_amdgcn_wave_barrier();
    mg::bf16x8 fAt[2], fBh[2], fKh[2], fRt[2];
#pragma unroll
    for (int ks = 0; ks < 2; ++ks) { fAt[ks] = *(const mg::bf16x8*)(sAt + lr * RK_SK + 32 * ks + 8 * q); fBh[ks] = *(const mg::bf16x8*)(sBh + lr * RK_SK + 32 * ks + 8 * q);
      fKh[ks] = *(const mg::bf16x8*)(sKh + lr * RK_SK + 32 * ks + 8 * q); fRt[ks] = *(const mg::bf16x8*)(sRt + lr * RK_SK + 32 * ks + 8 * q); }
    const f32x4 z4 = {0.f, 0.f, 0.f, 0.f};
    f32x4 nab = z4, nabT = z4, nak = z4, nakT = z4, mbr = z4, mkr = z4;
#pragma unroll
    for (int ks = 0; ks < 2; ++ks) {
      nab = __builtin_amdgcn_mfma_f32_16x16x32_bf16(fBh[ks], fAt[ks], nab, 0, 0, 0); nabT = __builtin_amdgcn_mfma_f32_16x16x32_bf16(fAt[ks], fBh[ks], nabT, 0, 0, 0);
      nak = __builtin_amdgcn_mfma_f32_16x16x32_bf16(fKh[ks], fAt[ks], nak, 0, 0, 0); nakT = __builtin_amdgcn_mfma_f32_16x16x32_bf16(fAt[ks], fKh[ks], nakT, 0, 0, 0);
      mbr = __builtin_amdgcn_mfma_f32_16x16x32_bf16(fBh[ks], fRt[ks], mbr, 0, 0, 0); mkr = __builtin_amdgcn_mfma_f32_16x16x32_bf16(fKh[ks], fRt[ks], mkr, 0, 0, 0);
    }
    f32x4 eye;
#pragma unroll
    for (int i = 0; i < 4; ++i) { const int row = 4 * q + i;
      eye[i] = (row == lr) ? 1.f : 0.f;
      nab[i] = (row < lr) ? nab[i] : 0.f; nak[i] = (row < lr) ? nak[i] : 0.f; nabT[i] = (lr < row) ? nabT[i] : 0.f; nakT[i] = (lr < row) ? nakT[i] : 0.f;
      mbr[i] = (row <= lr) ? mbr[i] : 0.f; mkr[i] = (row <= lr) ? mkr[i] : 0.f; }
    const bf16x4 dN = pack4(nab), dNT = pack4(nabT);
    const f32x4 n2 = mma16(dNT, dN, z4), nT2 = mma16(dN, dNT, z4);
    const bf16x4 dN2 = pack4(n2), dNT2 = pack4(nT2);
    const f32x4 n4 = mma16(dNT2, dN2, z4), nT4 = mma16(dN2, dNT2, z4);
    const bf16x4 dN4 = pack4(n4), dNT4 = pack4(nT4);
    const f32x4 nT8 = mma16(dN4, dNT4, z4);
    f32x4 Tm = nab + eye;
    Tm = mma16(pack4(nT2 + eye), pack4(Tm), z4);
    Tm = mma16(pack4(nT4 + eye), pack4(Tm), z4);
    Tm = mma16(pack4(nT8 + eye), pack4(Tm), z4);
    const bf16x4 dT = pack4(Tm), dEye = pack4(eye), dMbr = pack4(mbr), dNakT = pack4(nakT);
    const f32x4 w1 = mma16(dNakT, dT, z4);
    const f32x4 w1T = mma16(dT, dNakT, z4);
    const bf16x4 dW1T = pack4(w1T); (void)w1;
    const f32x4 w2 = mma16(dW1T, dMbr, mkr);
    *(bf16x4*)(cb + 4096 + lane * 8) = pack4(w2);
#pragma unroll
    for (int kt = 0; kt < 4; ++kt) {
      const bf16x4 atT = *(const bf16x4*)(tAt + (16 * kt + lr) * 16 + 4 * q);
      const bf16x4 rtT = *(const bf16x4*)(tRt + (16 * kt + lr) * 16 + 4 * q);
      const bf16x4 bpT = *(const bf16x4*)(tBp + (16 * kt + lr) * 16 + 4 * q);
      const bf16x4 kpT = *(const bf16x4*)(tKp + (16 * kt + lr) * 16 + 4 * q);
      const f32x4 ap = mma16(atT, dT, z4);
      const f32x4 apT = mma16(dT, atT, z4);
      f32x4 rpt = mma16(pack4(apT), dMbr, z4);
      rpt = mma16(rtT, dEye, rpt);
      f32x4 ht = mma16(dW1T, bpT, z4);
      ht = mma16(dEye, kpT, ht);
      *(bf16x4*)(cb + kt * 512 + lane * 8) = pack4(ap);
      *(bf16x4*)(cb + 2048 + kt * 512 + lane * 8) = pack4(rpt);
      *(bf16x4*)(cb + 4608 + kt * 512 + lane * 8) = pack4(ht);
    }
    __builtin_amdgcn_s_waitcnt(0xc07f); __builtin_amdgcn_wave_barrier();
  }
}
constexpr int RK2_NS = 12, RK2_D = 8;
__device__ __forceinline__ void rwkv_chunk_scan(const Ctx& c) {
  const unsigned char* CHK = c.ws + WS_CHK; float* YO = (float*)(c.ws + WS_YSC);
  LAS unsigned char* ring = (LAS unsigned char*)c.lds;
  const int lane = c.lane, q = lane >> 4, lr = lane & 15, w = c.wave;
  for (int bh = c.bid; bh < BATCH * 8; bh += c.G) {
    const int h = bh & 7, b = bh >> 3;
    const unsigned char* rec0 = CHK + (size_t)(bh * 128) * CHB;
#define RK2_ISSUE(cidx) do { const unsigned char* src_ = rec0 + (size_t)(cidx) * CHB + lane * 16; LAS unsigned char* dst_ = ring + ((cidx) % RK2_NS) * CHB; \
      _Pragma("unroll") for (int i_ = 0; i_ < 11; ++i_) __builtin_amdgcn_global_load_lds((const unsigned*)(src_ + i_ * 1024), (LAS unsigned*)(dst_ + i_ * 1024), 16, 0, 0); } while (0)
    __syncthreads();
    if (w >= 4) {
      RK2_ISSUE(w - 4); RK2_ISSUE(w);
      if (w < 6) asm volatile("s_waitcnt vmcnt(11)" ::: "memory");
    }
    asm volatile("" ::: "memory"); __builtin_amdgcn_s_barrier(); asm volatile("" ::: "memory");
    f32x4 S[4];
#pragma unroll
    for (int kt = 0; kt < 4; ++kt) S[kt] = (f32x4){0.f, 0.f, 0.f, 0.f};
    bf16x4 nAp[4], nRp[4], nH[4], nBp[4], nW2, nV; f32x4 nG[4];
#define RK2_FETCH(cidx) do { const LAS unsigned char* cb__ = ring + ((cidx) % RK2_NS) * CHB; \
      _Pragma("unroll") for (int kt = 0; kt < 4; ++kt) { nAp[kt] = *(const LAS bf16x4*)(cb__ + kt * 512 + lane * 8); nRp[kt] = *(const LAS bf16x4*)(cb__ + 2048 + kt * 512 + lane * 8); \
        nH[kt] = *(const LAS bf16x4*)(cb__ + 4608 + kt * 512 + lane * 8); nBp[kt] = *(const LAS bf16x4*)(cb__ + 6656 + (16 * kt + lr) * 32 + 8 * q); nG[kt] = *(const LAS f32x4*)(cb__ + 10752 + (16 * kt + 4 * q) * 4); } \
      nW2 = *(const LAS bf16x4*)(cb__ + 4096 + lane * 8); nV = *(const LAS bf16x4*)(cb__ + 8704 + (16 * w + lr) * 32 + 8 * q); } while (0)
    if (w < 4) RK2_FETCH(0);
    for (int ck = 0; ck < 128; ++ck) {
      if (w >= 4) {
        if ((ck & 3) == w - 4 && ck + RK2_D < 128) RK2_ISSUE(ck + RK2_D);
        if (((ck + 2) & 3) == w - 4 && ck + 2 < 128) {
          if (ck + 6 < 128) asm volatile("s_waitcnt vmcnt(11)" ::: "memory"); else asm volatile("s_waitcnt vmcnt(0)" ::: "memory"); }
      } else {
        bf16x4 Ap[4], Rp[4], Hd[4], Bp[4]; f32x4 G[4];
#pragma unroll
        for (int kt = 0; kt < 4; ++kt) { Ap[kt] = nAp[kt]; Rp[kt] = nRp[kt]; Hd[kt] = nH[kt]; Bp[kt] = nBp[kt]; G[kt] = nG[kt]; }
        const bf16x4 W2 = nW2, Vq = nV;
        if (ck + 1 < 128) RK2_FETCH(ck + 1);
        bf16x4 Sb[4];
#pragma unroll
        for (int kt = 0; kt < 4; ++kt) Sb[kt] = pack4(S[kt]);
        f32x4 x1 = {0.f, 0.f, 0.f, 0.f}, y = {0.f, 0.f, 0.f, 0.f};
#pragma unroll
        for (int kt = 0; kt < 4; ++kt) { x1 = mma16(Ap[kt], Sb[kt], x1); y = mma16(Rp[kt], Sb[kt], y); }
        y = mma16(W2, Vq, y);
        const bf16x4 X1b = pack4(x1);
#pragma unroll
        for (int kt = 0; kt < 4; ++kt) { S[kt] = S[kt] * G[kt]; S[kt] = mma16(Bp[kt], X1b, S[kt]); S[kt] = mma16(Hd[kt], Vq, S[kt]); }
        float* yo = YO + ((size_t)b * SEQ + ck * 16 + 4 * q) * 512 + h * 64 + 16 * w + lr;
#pragma unroll
        for (int i = 0; i < 4; ++i) yo[i * 512] = y[i];
      }
      asm volatile("s_waitcnt lgkmcnt(0)" ::: "memory"); __builtin_amdgcn_s_barrier(); asm volatile("" ::: "memory");
    }
#undef RK2_ISSUE
#undef RK2_FETCH
  }
  __syncthreads();
}

__device__ __forceinline__ void rwkv_post(const Ctx& c) {
  const float* YS = (const float*)(c.ws + WS_YSC); const bf16* P = (const bf16*)(c.ws + WS_P0); const bf16* GG = (const bf16*)(c.ws + WS_LOG);
  const float* BON = (const float*)(c.ws + WS_BON); bf16* YM = (bf16*)(c.ws + WS_YMIX);
  const float* lnw = inp(c, I0_LNW); const float* lnb = inp(c, I0_LNB); const float* mu = inp(c, I0_MU);
  for (int m = c.wave * c.G + c.bid; m < M; m += NW * c.G) {
    const int t = m % SEQ;
    float y[8], bon[8]; unsigned short vc[8], vp[8], gg[8];
#pragma unroll
    for (int j = 0; j < 8; ++j) { const int ch = j * 64 + c.lane;
      y[j] = YS[(size_t)m * 512 + ch]; vc[j] = P[(size_t)m * EVEN_IN + 1024 + ch]; vp[j] = t > 0 ? P[(size_t)(m - 1) * EVEN_IN + 1024 + ch] : (unsigned short)0;
      gg[j] = GG[(size_t)m * 1024 + ch]; bon[j] = BON[(size_t)m * 8 + j]; }
#pragma unroll
    for (int j = 0; j < 8; ++j) {
      const int ch = j * 64 + c.lane;
      const float mean = wave_sum(y[j]) * (1.f / 64.f);
      const float d = y[j] - mean;
      const float var = wave_sum(d * d) * (1.f / 64.f);
      float v = d * rsqrtf(var + 64e-5f) * lnw[ch] + lnb[ch];
      const float vcf = bf2f(vc[j]), vpf = bf2f(vp[j]);
      v += bon[j] * (vcf + (vpf - vcf) * mu[1024 + ch]);
      YM[(size_t)m * D + ch] = f2bf(v * bf2f(gg[j]));
    }
  }
}

__device__ __forceinline__ void gmlp_phase(const Ctx& c, int vb, int vG) {
  const bf16* P = (const bf16*)(c.ws + WS_P0); bf16* YM = (bf16*)(c.ws + WS_YMIX);
  const float* lnw = inp(c, I0_GLNW); const float* lnb = inp(c, I0_GLNB); const float* ws = inp(c, I0_GWS); const float* bs = inp(c, I0_GBS);
  bf16* Ws = (bf16*)c.lds; bf16* VT = (bf16*)(c.lds + 34816);
  const int w = c.wave, q = c.lane >> 4, lr = c.lane & 15;
  int gcur = -1;
  for (int it = vb; it < BATCH * 16 * 4; it += vG) {
    const int g = it & 3, ck = (it >> 2) & 15, b = it >> 6;
    const size_t m0 = (size_t)b * SEQ + ck * 128;
    __syncthreads();
    if (g != gcur) { gcur = g;
#pragma unroll
      for (int k = 0; k < 8; ++k) { const int idx = c.tid + NT * k, i = idx >> 5, j4 = (idx & 31) * 4;
        const f32x4 v = *(const f32x4*)(ws + ((size_t)g * 128 + i) * 128 + j4);
        uint2 o; o.x = mg::cvt_pk_bf16(j4 <= i ? v[0] : 0.f, j4 + 1 <= i ? v[1] : 0.f); o.y = mg::cvt_pk_bf16(j4 + 2 <= i ? v[2] : 0.f, j4 + 3 <= i ? v[3] : 0.f);
        *(uint2*)(Ws + i * SPI + j4) = o; } }
    { const float w0 = lnw[g * 128 + c.lane], w1 = lnw[g * 128 + c.lane + 64], b0 = lnb[g * 128 + c.lane], b1 = lnb[g * 128 + c.lane + 64];
      unsigned short ra[16], rb[16];
#pragma unroll
      for (int jj = 0; jj < 16; ++jj) { const bf16* row = P + (m0 + w + 8 * jj) * EVEN_IN + 2304 + g * 128; ra[jj] = row[c.lane]; rb[jj] = row[c.lane + 64]; }
#pragma unroll
      for (int jj = 0; jj < 16; ++jj) { const int j = w + 8 * jj;
        const float v0 = gelu_(bf2f(ra[jj])), v1 = gelu_(bf2f(rb[jj]));
        const float mean = wave_sum(v0 + v1) * (1.f / 128.f);
        const float d0 = v0 - mean, d1 = v1 - mean;
        const float rs = rsqrtf(wave_sum(d0 * d0 + d1 * d1) * (1.f / 128.f) + 1e-6f);
        VT[c.lane * SPI + j] = f2bf(d0 * rs * w0 + b0);
        VT[(c.lane + 64) * SPI + j] = f2bf(d1 * rs * w1 + b1);
      } }
    __syncthreads();
    f32x4 acc[8];
#pragma unroll
    for (int dt = 0; dt < 8; ++dt) acc[dt] = (f32x4){0.f, 0.f, 0.f, 0.f};
    const int kmax = (16 * w + 15) >> 5;
    for (int ks = 0; ks <= kmax; ++ks) { const mg::bf16x8 wf = *(const mg::bf16x8*)(Ws + (16 * w + lr) * SPI + 32 * ks + 8 * q);
#pragma unroll
      for (int dt = 0; dt < 8; ++dt) { const mg::bf16x8 vf = *(const mg::bf16x8*)(VT + (16 * dt + lr) * SPI + 32 * ks + 8 * q); acc[dt] = __builtin_amdgcn_mfma_f32_16x16x32_bf16(wf, vf, acc[dt], 0, 0, 0); } }
    unsigned short uu[4][8];
#pragma unroll
    for (int i = 0; i < 4; ++i) { const bf16* up = P + (m0 + 16 * w + 4 * q + i) * EVEN_IN + 1792 + g * 128 + lr;
#pragma unroll
      for (int dt = 0; dt < 8; ++dt) uu[i][dt] = up[16 * dt]; }
#pragma unroll
    for (int i = 0; i < 4; ++i) { const int r = 16 * w + 4 * q + i; const float bias = bs[g * 128 + r];
      bf16* op = YM + (m0 + r) * D + 512 + g * 128 + lr;
#pragma unroll
      for (int dt = 0; dt < 8; ++dt) op[16 * dt] = f2bf(gelu_(bf2f(uu[i][dt])) * (acc[dt][i] + bias)); }
  }
  __syncthreads();
}

__device__ __forceinline__ void s5_tables(const Ctx& c) {
  const float* are = inp(c, I1_ARE); const float* aim = inp(c, I1_AIM); const float* ldt = inp(c, I1_LDT); const float* bre = inp(c, I1_BRE); const float* bim = inp(c, I1_BIM);
  float* POW = (float*)(c.ws + WS_S5POW); float* BB = (float*)(c.ws + WS_S5BB);
  for (int i = c.bid * NT + c.tid; i < 32 * 17 * 64; i += c.G * NT) {
    const int p = i & 63, tau = (i >> 6) % 17, g = i / (17 * 64);
    const float lr = are[g * 64 + p], li = aim[g * 64 + p], dt = expf(ldt[g]);
    const float mag = expf(lr * dt * (float)tau), ang = li * dt * (float)tau;
    POW[2 * i] = mag * cosf(ang); POW[2 * i + 1] = mag * sinf(ang);
  }
  for (int i = c.bid * NT + c.tid; i < 32 * 64 * 16; i += c.G * NT) {
    const int gp = i >> 4, g = gp >> 6;
    const float lr = are[gp], li = aim[gp], dt = expf(ldt[g]);
    const float mag = expf(lr * dt), ar = mag * cosf(li * dt), ai = mag * sinf(li * dt);
    const float nr = ar - 1.f, ni = ai, den = lr * lr + li * li;
    const float fr = (nr * lr + ni * li) / den, fi = (ni * lr - nr * li) / den;
    const float br = bre[i], bi = bim[i];
    BB[2 * i] = fr * br - fi * bi; BB[2 * i + 1] = fr * bi + fi * br;
  }
}
__device__ __forceinline__ void s5_taps(const Ctx& c) {
  const float* cre = inp(c, I1_CRE); const float* cim = inp(c, I1_CIM);
  const float* POW = (const float*)(c.ws + WS_S5POW); const float* BB = (const float*)(c.ws + WS_S5BB); float* KT = (float*)(c.ws + WS_S5KT);
  for (int i = c.bid * NT + c.tid; i < 32 * 16 * 256; i += c.G * NT) {
    const int c2 = i & 15, c1 = (i >> 4) & 15, tau = (i >> 8) & 15, g = i >> 12;
    float acc = 0.f;
    for (int p = 0; p < 64; ++p) {
      const float cr = cre[(g * 16 + c1) * 64 + p], ci = cim[(g * 16 + c1) * 64 + p];
      const float pr = POW[((g * 17 + tau) * 64 + p) * 2], pi = POW[((g * 17 + tau) * 64 + p) * 2 + 1];
      const float br = BB[((g * 64 + p) * 16 + c2) * 2], bi = BB[((g * 64 + p) * 16 + c2) * 2 + 1];
      const float wr = cr * pr - ci * pi, wi = cr * pi + ci * pr;
      acc += wr * br - wi * bi;
    }
    KT[i] = acc;
  }
}
__device__ __forceinline__ void s5_mats(const Ctx& c) {
  const float* cre = inp(c, I1_CRE); const float* cim = inp(c, I1_CIM);
  const float* POW = (const float*)(c.ws + WS_S5POW); const float* BB = (const float*)(c.ws + WS_S5BB); const float* KT = (const float*)(c.ws + WS_S5KT);
  bf16* BE = (bf16*)(c.ws + WS_S5BE); bf16* BTF = (bf16*)(c.ws + WS_S5BTF);
  for (int i = c.bid * NT + c.tid; i < 32 * 256 * 256; i += c.G * NT) {
    const int k = i & 255, n = (i >> 8) & 255, g = i >> 16; float v = 0.f;
    if (n < 128) { const int p = n & 63, s16 = k >> 4, c2 = k & 15;
      const float pr = POW[((g * 17 + 15 - s16) * 64 + p) * 2], pi = POW[((g * 17 + 15 - s16) * 64 + p) * 2 + 1];
      const float br = BB[((g * 64 + p) * 16 + c2) * 2], bi = BB[((g * 64 + p) * 16 + c2) * 2 + 1];
      v = (n < 64) ? (pr * br - pi * bi) : (pr * bi + pi * br); }
    BE[i] = f2bf(v);
  }
  for (int i = c.bid * NT + c.tid; i < 32 * 256 * 384; i += c.G * NT) {
    const int k = i % 384, n = (i / 384) & 255, g = i / (384 * 256), t = n >> 4, c1 = n & 15; float v = 0.f;
    if (k < 256) { const int s16 = k >> 4, c2 = k & 15; if (s16 <= t) v = KT[((g * 16 + (t - s16)) * 16 + c1) * 16 + c2]; }
    else { const int kk = k - 256, p = kk & 63;
      const float cr = cre[(g * 16 + c1) * 64 + p], ci = cim[(g * 16 + c1) * 64 + p];
      const float pr = POW[((g * 17 + t + 1) * 64 + p) * 2], pi = POW[((g * 17 + t + 1) * 64 + p) * 2 + 1];
      v = (kk < 64) ? (cr * pr - ci * pi) : -(cr * pi + ci * pr); }
    BTF[i] = f2bf(v);
  }
}
__device__ __forceinline__ void s5_carry(const Ctx& c) {
  const float* XE = (const float*)(c.ws + WS_S5XE); bf16* AP = (bf16*)(c.ws + WS_S5A); const float* POW = (const float*)(c.ws + WS_S5POW);
  for (int it = c.wave * c.G + c.bid; it < BATCH * 32; it += NW * c.G) {
    const int b = it >> 5, g = it & 31, p = c.lane;
    const float ar = POW[((g * 17 + 16) * 64 + p) * 2], ai = POW[((g * 17 + 16) * 64 + p) * 2 + 1];
    float xr = 0.f, xi = 0.f;
    const size_t row0 = (size_t)g * 1024 + b * 128;
    for (int blk0 = 0; blk0 < 128; blk0 += 8) {
      float er[8], ei[8];
#pragma unroll
      for (int j = 0; j < 8; ++j) { er[j] = XE[(row0 + blk0 + j) * 128 + p]; ei[j] = XE[(row0 + blk0 + j) * 128 + 64 + p]; }
#pragma unroll
      for (int j = 0; j < 8; ++j) {
        bf16* ap = AP + (row0 + blk0 + j) * 384 + 256;
        ap[p] = f2bf(xr); ap[64 + p] = f2bf(xi);
        const float nr = ar * xr - ai * xi + er[j], ni = ar * xi + ai * xr + ei[j];
        xr = nr; xi = ni;
      }
    }
  }
}

__device__ __forceinline__ void ssd_conv(const Ctx& c) {
  const bf16* P1 = (const bf16*)(c.ws + WS_P1); bf16* CV = (bf16*)(c.ws + WS_CONV);
  const float* cw = inp(c, I1_CW); const float* cb = inp(c, I1_CB);
  for (size_t i = (size_t)c.bid * NT + c.tid; i < (size_t)M * 128; i += (size_t)c.G * NT) {
    const int ch = (int)(i & 127) * 8; const size_t m = i >> 7; const int t = (int)(m % SEQ);
    float acc[8];
#pragma unroll
    for (int e = 0; e < 8; ++e) acc[e] = cb[ch + e];
#pragma unroll
    for (int j = 0; j < 4; ++j) { const int tt = t - 3 + j; if (tt >= 0) {
        const uint4 v = *(const uint4*)(P1 + (m - 3 + j) * 2048 + 1024 + ch); const unsigned vw[4] = {v.x, v.y, v.z, v.w};
#pragma unroll
        for (int e = 0; e < 4; ++e) { acc[2 * e] += cw[j * 1024 + ch + 2 * e] * __uint_as_float(vw[e] << 16); acc[2 * e + 1] += cw[j * 1024 + ch + 2 * e + 1] * __uint_as_float(vw[e] & 0xffff0000u); } } }
    uint4 o; o.x = mg::cvt_pk_bf16(silu_(acc[0]), silu_(acc[1])); o.y = mg::cvt_pk_bf16(silu_(acc[2]), silu_(acc[3])); o.z = mg::cvt_pk_bf16(silu_(acc[4]), silu_(acc[5])); o.w = mg::cvt_pk_bf16(silu_(acc[6]), silu_(acc[7]));
    *(uint4*)(CV + m * 1024 + ch) = o;
  }
}

constexpr int SL_C = 0, SL_B = 34816, SL_BT = 69632, SL_XT = 104448, SL_DT = 121856, SL_ACS = 123904;
__device__ __forceinline__ void ssd_dt_acs(const Ctx& c, size_t m0, int g, const float* DT, const float* dtb, const float* alog, float* sdt, float* sacs) {
  if (c.wave < 4) {
    const int h = g * 4 + c.wave; const float av = -expf(alog[h]), bias = dtb[h];
    const float d0 = softplus_(DT[(m0 + 2 * c.lane) * 8 + h] + bias), d1 = softplus_(DT[(m0 + 2 * c.lane + 1) * 8 + h] + bias);
    const float a0 = av * d0, a1 = av * d1;
    float sc = a0 + a1;
#pragma unroll
    for (int o = 1; o < 64; o <<= 1) { const float t = __shfl_up(sc, o); if (c.lane >= o) sc += t; }
    sdt[c.wave * 128 + 2 * c.lane] = d0; sdt[c.wave * 128 + 2 * c.lane + 1] = d1;
    sacs[c.wave * 128 + 2 * c.lane] = sc - a1; sacs[c.wave * 128 + 2 * c.lane + 1] = sc;
  }
}
__device__ __forceinline__ void ssd_pass1(const Ctx& c) {
  const bf16* CV = (const bf16*)(c.ws + WS_CONV); const float* DT = (const float*)(c.ws + WS_DT);
  float* YD = (float*)(c.ws + WS_YD); float* SE = (float*)(c.ws + WS_SE); float* ATOT = (float*)(c.ws + WS_ATOT);
  const float* dtb = inp(c, I1_DTB); const float* alog = inp(c, I1_ALOG);
  bf16* Cs = (bf16*)(c.lds + SL_C); bf16* Bs = (bf16*)(c.lds + SL_B); bf16* BTs = (bf16*)(c.lds + SL_BT); bf16* XT = (bf16*)(c.lds + SL_XT);
  float* sdt = (float*)(c.lds + SL_DT); float* sacs = (float*)(c.lds + SL_ACS);
  const int w = c.wave, q = c.lane >> 4, lr = c.lane & 15;
  for (int unit = c.bid; unit < BATCH * 16 * 2; unit += c.G) {
    const int g = unit & 1, ck = (unit >> 1) & 15, b = unit >> 5;
    const size_t m0 = (size_t)b * SEQ + ck * 128;
    __syncthreads();
#pragma unroll
    for (int i = 0; i < 8; ++i) { const int idx = c.tid + NT * i, mat = idx >> 11, r = (idx >> 4) & 127, qq = idx & 15;
      const uint4 v = *(const uint4*)(CV + (m0 + r) * 1024 + 512 + mat * 256 + g * 128 + qq * 8);
      *(uint4*)((mat ? Cs : Bs) + r * SPI + qq * 8) = v; }
#pragma unroll
    for (int i = 0; i < 4; ++i) { const int task = c.tid + NT * i, n = task & 127, l0 = (task >> 7) * 8;
      unsigned short e[8];
#pragma unroll
      for (int j = 0; j < 8; ++j) e[j] = CV[(m0 + l0 + j) * 1024 + 512 + g * 128 + n];
      uint4 o; o.x = e[0] | ((unsigned)e[1] << 16); o.y = e[2] | ((unsigned)e[3] << 16); o.z = e[4] | ((unsigned)e[5] << 16); o.w = e[6] | ((unsigned)e[7] << 16);
      *(uint4*)(BTs + n * SPI + l0) = o; }
    ssd_dt_acs(c, m0, g, DT, dtb, alog, sdt, sacs);
    __syncthreads();
    mg::bf16x8 cf[4];
#pragma unroll
    for (int ks = 0; ks < 4; ++ks) cf[ks] = *(const mg::bf16x8*)(Cs + (16 * w + lr) * SPI + 32 * ks + 8 * q);
    f32x4 cb[8];
#pragma unroll
    for (int j = 0; j < 8; ++j) { cb[j] = (f32x4){0.f, 0.f, 0.f, 0.f};
#pragma unroll
      for (int ks = 0; ks < 4; ++ks) { const mg::bf16x8 bf = *(const mg::bf16x8*)(Bs + (16 * j + lr) * SPI + 32 * ks + 8 * q); cb[j] = __builtin_amdgcn_mfma_f32_16x16x32_bf16(cf[ks], bf, cb[j], 0, 0, 0); } }
    __syncthreads();
    bf16* Ms = Bs;
    for (int r = 0; r < 4; ++r) {
      const int h = g * 4 + r;
#pragma unroll
      for (int i = 0; i < 2; ++i) { const int task = c.tid + NT * i, p = task & 63, l0 = (task >> 6) * 8;
        unsigned short e[8];
#pragma unroll
        for (int j = 0; j < 8; ++j) e[j] = CV[(m0 + l0 + j) * 1024 + h * 64 + p];
        uint4 o; o.x = e[0] | ((unsigned)e[1] << 16); o.y = e[2] | ((unsigned)e[3] << 16); o.z = e[4] | ((unsigned)e[5] << 16); o.w = e[6] | ((unsigned)e[7] << 16);
        *(uint4*)(XT + p * SPI + l0) = o; }
      const float* ac = sacs + r * 128; const float* dl = sdt + r * 128;
#pragma unroll
      for (int j = 0; j < 8; ++j) { const int sidx = 16 * j + lr; const float as = ac[sidx], ds = dl[sidx];
#pragma unroll
        for (int i = 0; i < 4; ++i) { const int l = 16 * w + 4 * q + i;
          const float v = (sidx <= l) ? cb[j][i] * __expf(fminf(ac[l] - as, 0.f)) * ds : 0.f;
          Ms[l * SPI + sidx] = f2bf(v); } }
      __syncthreads();
      { f32x4 ya[4];
#pragma unroll
        for (int pt = 0; pt < 4; ++pt) ya[pt] = (f32x4){0.f, 0.f, 0.f, 0.f};
        const int kmax = (16 * w + 15) >> 5;
        for (int ks = 0; ks <= kmax; ++ks) { const mg::bf16x8 mf = *(const mg::bf16x8*)(Ms + (16 * w + lr) * SPI + 32 * ks + 8 * q);
#pragma unroll
          for (int pt = 0; pt < 4; ++pt) { const mg::bf16x8 xf = *(const mg::bf16x8*)(XT + (16 * pt + lr) * SPI + 32 * ks + 8 * q); ya[pt] = __builtin_amdgcn_mfma_f32_16x16x32_bf16(mf, xf, ya[pt], 0, 0, 0); } }
#pragma unroll
        for (int pt = 0; pt < 4; ++pt)
#pragma unroll
          for (int i = 0; i < 4; ++i) YD[(m0 + 16 * w + 4 * q + i) * 512 + h * 64 + 16 * pt + lr] = ya[pt][i]; }
      { const int pt = w & 3, ntb = (w >> 2) * 4; const float aend = ac[127];
        f32x4 sa[4];
#pragma unroll
        for (int nt = 0; nt < 4; ++nt) sa[nt] = (f32x4){0.f, 0.f, 0.f, 0.f};
#pragma unroll
        for (int ks = 0; ks < 4; ++ks) { const uint4 xr = *(const uint4*)(XT + (16 * pt + lr) * SPI + 32 * ks + 8 * q); const unsigned xw[4] = {xr.x, xr.y, xr.z, xr.w};
          float xv[8];
#pragma unroll
          for (int e = 0; e < 4; ++e) { const int l = 32 * ks + 8 * q + 2 * e;
            xv[2 * e] = __uint_as_float(xw[e] << 16) * dl[l] * __expf(aend - ac[l]); xv[2 * e + 1] = __uint_as_float(xw[e] & 0xffff0000u) * dl[l + 1] * __expf(aend - ac[l + 1]); }
          union { uint4 u; mg::bf16x8 v; } xs; xs.u.x = mg::cvt_pk_bf16(xv[0], xv[1]); xs.u.y = mg::cvt_pk_bf16(xv[2], xv[3]); xs.u.z = mg::cvt_pk_bf16(xv[4], xv[5]); xs.u.w = mg::cvt_pk_bf16(xv[6], xv[7]);
#pragma unroll
          for (int nt = 0; nt < 4; ++nt) { const mg::bf16x8 bt = *(const mg::bf16x8*)(BTs + (16 * (ntb + nt) + lr) * SPI + 32 * ks + 8 * q); sa[nt] = __builtin_amdgcn_mfma_f32_16x16x32_bf16(xs.v, bt, sa[nt], 0, 0, 0); } }
        float* Eo = SE + ((size_t)(b * 8 + h) * 16 + ck) * 8192;
#pragma unroll
        for (int nt = 0; nt < 4; ++nt)
#pragma unroll
          for (int i = 0; i < 4; ++i) Eo[(16 * pt + 4 * q + i) * 128 + 16 * (ntb + nt) + lr] = sa[nt][i];
        if (c.tid == 0) ATOT[(b * 8 + h) * 16 + ck] = aend; }
      __syncthreads();
    }
  }
  __syncthreads();
}
__device__ __forceinline__ void ssd_carry(const Ctx& c) {
  const float* SE = (const float*)(c.ws + WS_SE); const float* ATOT = (const float*)(c.ws + WS_ATOT); bf16* SPV = (bf16*)(c.ws + WS_SPV);
  for (int i = c.bid * NT + c.tid; i < BATCH * 8 * 2048; i += c.G * NT) {
    const int bh = i >> 11, e4 = (i & 2047) * 4;
    f32x4 S = {0.f, 0.f, 0.f, 0.f};
    for (int ck = 0; ck < 16; ++ck) {
      const size_t o = ((size_t)bh * 16 + ck) * 8192 + e4;
      uint2 pk; pk.x = mg::cvt_pk_bf16(S[0], S[1]); pk.y = mg::cvt_pk_bf16(S[2], S[3]);
      *(uint2*)(SPV + o) = pk;
      const float d = __expf(ATOT[bh * 16 + ck]); const f32x4 e = *(const f32x4*)(SE + o);
      S = S * d + e;
    }
  }
}
__device__ __forceinline__ void ssd_pass2(const Ctx& c) {
  const bf16* CV = (const bf16*)(c.ws + WS_CONV); const float* DT = (const float*)(c.ws + WS_DT); const bf16* P1 = (const bf16*)(c.ws + WS_P1);
  const float* YD = (const float*)(c.ws + WS_YD); const bf16* SPV = (const bf16*)(c.ws + WS_SPV); bf16* YM = (bf16*)(c.ws + WS_YMIX);
  const float* dtb = inp(c, I1_DTB); const float* alog = inp(c, I1_ALOG); const float* dsk = inp(c, I1_MD); const float* nw = inp(c, I1_MNW);
  bf16* Cs = (bf16*)(c.lds + SL_C); bf16* SPs = (bf16*)(c.lds + SL_B);
  float* sdt = (float*)(c.lds + SL_DT); float* sacs = (float*)(c.lds + SL_ACS);
  const int w = c.wave, q = c.lane >> 4, lr = c.lane & 15;
  for (int unit = c.bid; unit < BATCH * 16 * 2; unit += c.G) {
    const int g = unit & 1, ck = (unit >> 1) & 15, b = unit >> 5;
    const size_t m0 = (size_t)b * SEQ + ck * 128;
    __syncthreads();
#pragma unroll
    for (int i = 0; i < 4; ++i) { const int idx = c.tid + NT * i, r = idx >> 4, qq = idx & 15;
      *(uint4*)(Cs + r * SPI + qq * 8) = *(const uint4*)(CV + (m0 + r) * 1024 + 768 + g * 128 + qq * 8); }
#pragma unroll
    for (int i = 0; i < 8; ++i) { const int idx = c.tid + NT * i, r = idx >> 10, p = (idx >> 4) & 63, qq = idx & 15;
      *(uint4*)(SPs + (r * 64 + p) * SPI + qq * 8) = *(const uint4*)(SPV + ((size_t)(b * 8 + g * 4 + r) * 16 + ck) * 8192 + p * 128 + qq * 8); }
    ssd_dt_acs(c, m0, g, DT, dtb, alog, sdt, sacs);
    __syncthreads();
    mg::bf16x8 cf[4];
#pragma unroll
    for (int ks = 0; ks < 4; ++ks) cf[ks] = *(const mg::bf16x8*)(Cs + (16 * w + lr) * SPI + 32 * ks + 8 * q);
    f32x4 yo[4][4];
#pragma unroll
    for (int r = 0; r < 4; ++r)
#pragma unroll
      for (int pt = 0; pt < 4; ++pt) { yo[r][pt] = (f32x4){0.f, 0.f, 0.f, 0.f};
#pragma unroll
        for (int ks = 0; ks < 4; ++ks) { const mg::bf16x8 sf = *(const mg::bf16x8*)(SPs + (r * 64 + 16 * pt + lr) * SPI + 32 * ks + 8 * q); yo[r][pt] = __builtin_amdgcn_mfma_f32_16x16x32_bf16(cf[ks], sf, yo[r][pt], 0, 0, 0); } }
    float dh[4];
#pragma unroll
    for (int r = 0; r < 4; ++r) dh[r] = dsk[g * 4 + r];
    float ss[4];
#pragma unroll
    for (int i = 0; i < 4; ++i) {
      const int l = 16 * w + 4 * q + i; const size_t m = m0 + l;
      const float* ydp = YD + m * 512 + g * 256 + lr; const bf16* cvp = CV + m * 1024 + g * 256 + lr; const bf16* zp = P1 + m * 2048 + 512 + g * 256 + lr;
      float sq = 0.f;
#pragma unroll
      for (int r = 0; r < 4; ++r) { const float ea = __expf(sacs[r * 128 + l]);
#pragma unroll
        for (int pt = 0; pt < 4; ++pt) { const int o = r * 64 + 16 * pt;
          const float y = ydp[o] + ea * yo[r][pt][i] + dh[r] * bf2f(cvp[o]);
          const float vv = y * silu_(bf2f(zp[o]));
          yo[r][pt][i] = vv; sq += vv * vv; } }
      ss[i] = rsqrtf(row16_sum(sq) * (1.f / 256.f) + 1e-6f);
      asm volatile("" ::: "memory");
    }
#pragma unroll
    for (int i = 0; i < 4; ++i) { const int l = 16 * w + 4 * q + i;
      bf16* ymp = YM + (m0 + l) * D + 512 + g * 256 + lr; const float* nwp = nw + g * 256 + lr;
#pragma unroll
      for (int r = 0; r < 4; ++r)
#pragma unroll
        for (int pt = 0; pt < 4; ++pt) { const int o = r * 64 + 16 * pt; ymp[o] = f2bf(yo[r][pt][i] * ss[i] * nwp[o]); }
      asm volatile("" ::: "memory");
    }
  }
  __syncthreads();
}


enum { PH_PRO, PH_WIN0, PH_PREPA, PH_LORA, PH_PREPC, PH_SCAN, PH_POST, PH_WOUT0, PH_NORM0, PH_FGU, PH_FD, PH_NORM1, PH_WIN1, PH_L1A, PH_L1B, PH_L1C, PH_L1D, PH_WOUT1, PH_NORM2, PH_MGU, PH_MD, PH_FINAL, PH_COUNT };
constexpr int LAST_PHASE = PH_COUNT;
template <int LO, int HI, int BREG = 0>
__global__ void __launch_bounds__(NT, 2) fwd_kernel(Args args) {
  extern __shared__ __attribute__((aligned(16))) unsigned char lds[];
  Ctx c0; c0.out = args.out; c0.ws = args.ws; c0.ctl = (unsigned*)(args.ws + WS_CTL); c0.lds = lds;
  c0.tid = threadIdx.x; c0.lane = c0.tid & 63; c0.wave = __builtin_amdgcn_readfirstlane(c0.tid >> 6); c0.bid = blockIdx.x; c0.G = gridDim.x;
  volatile LAS unsigned* bst = (volatile LAS unsigned*)(LAS unsigned char*)(lds + LDS_BST);
  if (c0.tid == 0) { LAS unsigned long long* pt = (LAS unsigned long long*)(LAS unsigned char*)(lds + LDS_PTAB);
#pragma unroll
    for (int i = 0; i < N_IN; ++i) pt[i] = (unsigned long long)args.in[i];
    bst[0] = 0u; bst[1] = 0u; }
  __syncthreads();
  constexpr int lo = LO, hi = HI;
  if constexpr (hi - lo > 1) (void)xcd_barrier_post(c0.ctl + CW_BAR + BREG * 4096, bst);
#define IN(k) (lo <= (k) && (k) < hi)
#define SEAM(k) do { if constexpr (IN(k) && IN((k) + 1)) { XcdBarrier bar_; bar_.bar = (unsigned*)(args.ws + WS_CTL) + CW_BAR + BREG * 4096; bar_.x = xb_xcc_id(); \
    bar_.st = (volatile LAS unsigned*)(LAS unsigned char*)(lds + LDS_BST); xcd_barrier(bar_); } } while (0)

  LAS unsigned char* const ldsl = (LAS unsigned char*)lds;
  if constexpr (IN(PH_PRO)) { const Ctx c = launder(c0); cvt_dense(c); build_wlora(c); s5_tables(c); norm_phase<0, 0>(c, inp(c, I_X), nullptr, nullptr, nullptr, inp(c, I0_NPM), ((bf16*)(c.ws + WS_XN)), nullptr, 0, 0, nullptr); } SEAM(PH_PRO);
  if constexpr (IN(PH_WIN0)) { const Ctx c = launder(c0); s5_taps(c); mg::Gemm g{((bf16*)(c.ws + WS_XN)), (const bf16*)(c.ws + WS_WIN0), D, D, D}; mg::DenseOrder S; S.init(M / 256, EVEN_IN / 256, c.G, c.bid);
    mg::EpiBf16<false> E{(bf16*)(c.ws + WS_P0), EVEN_IN}; mg::gemm_phase(ldsl, g, S, E); } SEAM(PH_WIN0);
  if constexpr (IN(PH_PREPA)) { const Ctx c = launder(c0); rwkv_prep_a(c); s5_mats(c); } SEAM(PH_PREPA);
  if constexpr (IN(PH_LORA)) { const Ctx c = launder(c0); mg::Gemm g{(const bf16*)(c.ws + WS_ALORA), (const bf16*)(c.ws + WS_WLORA), 256, 256, 256}; mg::DenseOrder S; S.init(M / 256, 1536 / 256, c.G, c.bid);
    mg::EpiLora E{(bf16*)(c.ws + WS_LOWA), (bf16*)(c.ws + WS_LOG)}; mg::gemm_phase(ldsl, g, S, E); } SEAM(PH_LORA);
  if constexpr (IN(PH_PREPC)) { const Ctx c = launder(c0); rwkv_chunk_prep(c); } SEAM(PH_PREPC);
  if constexpr (IN(PH_SCAN)) { const Ctx c = launder(c0); if (c.G >= 256) { if (c.bid < 64) rwkv_chunk_scan(c); else gmlp_phase(c, c.bid - 64, c.G - 64); } else { rwkv_chunk_scan(c); gmlp_phase(c, c.bid, c.G); } } SEAM(PH_SCAN);
  if constexpr (IN(PH_POST)) { const Ctx c = launder(c0); rwkv_post(c); } SEAM(PH_POST);
  if constexpr (IN(PH_WOUT0)) { const Ctx c = launder(c0); mg::Gemm g{((bf16*)(c.ws + WS_YMIX)), (const bf16*)(c.ws + WS_WOUT0), D, D, D}; mg::DenseOrder S; S.init(M / 256, D / 256, c.G, c.bid);
    mg::EpiBf16<false> E{(bf16*)(c.ws + WS_Y), D}; mg::gemm_phase(ldsl, g, S, E); } SEAM(PH_WOUT0);
  if constexpr (IN(PH_NORM0)) { const Ctx c = launder(c0); norm_phase<1, 0>(c, inp(c, I_X), args.out, ((float*)(c.ws + WS_Y)), inp(c, I0_NPOM), inp(c, I0_NPF), ((bf16*)(c.ws + WS_XN)), nullptr, 0, 0, nullptr); } SEAM(PH_NORM0);
  if constexpr (IN(PH_FGU)) { const Ctx c = launder(c0); mg::Gemm g{((bf16*)(c.ws + WS_XN)), (const bf16*)(c.ws + WS_FGU), D, D, D}; mg::DenseOrder S; S.init(M / 256, 2 * FFN / 256, c.G, c.bid);
    mg::EpiSwigluT E{(bf16*)(c.ws + WS_H), FFN}; mg::gemm_phase(ldsl, g, S, E); } SEAM(PH_FGU);
  if constexpr (IN(PH_FD)) { const Ctx c = launder(c0); mg::Gemm g{(const bf16*)(c.ws + WS_H), (const bf16*)(c.ws + WS_FD), FFN, FFN, FFN}; mg::DenseOrder S; S.init(M / 256, D / 256, c.G, c.bid);
    mg::EpiBf16<false> E{(bf16*)(c.ws + WS_Y), D}; mg::gemm_phase(ldsl, g, S, E); } SEAM(PH_FD);
  if constexpr (IN(PH_NORM1)) { const Ctx c = launder(c0); norm_phase<1, 1>(c, args.out, args.out, ((float*)(c.ws + WS_Y)), inp(c, I0_NPOF), inp(c, I1_NPM), ((bf16*)(c.ws + WS_XN)), inp(c, I1_WIN), ODD_IN, 2048, (float*)(c.ws + WS_DT)); } SEAM(PH_NORM1);
  if constexpr (IN(PH_WIN1)) { const Ctx c = launder(c0); mg::Gemm g{((bf16*)(c.ws + WS_XN)), (const bf16*)(c.ws + WS_WIN1), D, D, D}; mg::DenseOrder S; S.init(M / 256, 2048 / 256, c.G, c.bid);
    mg::EpiP1 E{(bf16*)(c.ws + WS_P1), (bf16*)(c.ws + WS_S5A)}; mg::gemm_phase(ldsl, g, S, E); } SEAM(PH_WIN1);
  if constexpr (IN(PH_L1A)) { const Ctx c = launder(c0);
    { mg::Gemm g{(const bf16*)(c.ws + WS_S5A), (const bf16*)(c.ws + WS_S5BE), 384, 256, 256}; mg::S5Order S; S.G = c.G; S.c = c.bid; mg::EpiS5E E{(float*)(c.ws + WS_S5XE)}; mg::gemm_phase(ldsl, g, S, E); }
    ssd_conv(c); cvt_moe(c, c.bid, c.G, 0); } SEAM(PH_L1A);
  if constexpr (IN(PH_L1B)) { const Ctx c = launder(c0); s5_carry(c); ssd_pass1(c); } SEAM(PH_L1B);
  if constexpr (IN(PH_L1C)) { const Ctx c = launder(c0);
    { mg::Gemm g{(const bf16*)(c.ws + WS_S5A), (const bf16*)(c.ws + WS_S5BTF), 384, 384, 384}; mg::S5Order S; S.G = c.G; S.c = c.bid; mg::EpiS5Y E{(bf16*)(c.ws + WS_YC), (const bf16*)(c.ws + WS_S5A), inp(c, I1_SD)}; mg::gemm_phase(ldsl, g, S, E); }
    ssd_carry(c); cvt_moe(c, c.bid, c.G, 1); } SEAM(PH_L1C);
  if constexpr (IN(PH_L1D)) { const Ctx c = launder(c0);
    { mg::Gemm g{(const bf16*)(c.ws + WS_YC), (const bf16*)(c.ws + WS_GLU), 512, 512, 512}; mg::DenseOrder S; S.init(M / 256, 512 / 256, c.G, c.bid);
      mg::EpiGluT E{((bf16*)(c.ws + WS_YMIX)), D, (const bf16*)(c.ws + WS_YC), inp(c, I1_GLB)}; mg::gemm_phase(ldsl, g, S, E); }
    ssd_pass2(c); } SEAM(PH_L1D);
  if constexpr (IN(PH_WOUT1)) { const Ctx c = launder(c0); mg::Gemm g{((bf16*)(c.ws + WS_YMIX)), (const bf16*)(c.ws + WS_WOUT1), D, D, D}; mg::DenseOrder S; S.init(M / 256, D / 256, c.G, c.bid);
    mg::EpiBf16<false> E{(bf16*)(c.ws + WS_Y), D}; mg::gemm_phase(ldsl, g, S, E); } SEAM(PH_WOUT1);
  if constexpr (IN(PH_NORM2)) { const Ctx c = launder(c0); norm_phase<1, 2>(c, args.out, args.out, ((float*)(c.ws + WS_Y)), inp(c, I1_NPOM), inp(c, I1_NPF), ((bf16*)(c.ws + WS_XN)), inp(c, I1_RT), 8, 0, nullptr); } SEAM(PH_NORM2);
#define MOE_SCHED(S, nn, bse, bof) do { int acc_ = 0; \
    _Pragma("unroll") for (int e = 0; e < 8; ++e) { acc_ += ((int)c.ctl[CW_CNT + 64 * e] + 255) / 256 * 256; S.pend[e] = acc_; } \
    S.init(acc_ / 256, nn, c.G, c.bid); S.bstride_e = (bse); S.boff = (bof); S.rowidx = (const int*)(c.ctl + CW_TOKE); } while (0)
  if constexpr (IN(PH_MGU)) { const Ctx c = launder(c0); mg::Gemm g{(const bf16*)(c.ws + WS_XN8), (const bf16*)(c.ws + WS_MGU), D, D, D}; mg::MoeOrder<true, true> S; MOE_SCHED(S, FE / 128, (size_t)2 * FE * D, 0);
    mg::EpiSwigluF8 E{c.ws + WS_HID, FE}; mg::gemm_phase(ldsl, g, S, E); } SEAM(PH_MGU);
  if constexpr (IN(PH_MD)) { const Ctx c = launder(c0); mg::Gemm g{(const bf16*)(c.ws + WS_HID), (const bf16*)(c.ws + WS_MD), FE, FE, FE}; mg::MoeOrder<false, true> S; MOE_SCHED(S, D / 256, (size_t)D * FE, 0);
    mg::EpiBf16S E{(bf16*)(c.ws + WS_YS), D, 1.f / 2048.f}; mg::gemm_phase(ldsl, g, S, E); } SEAM(PH_MD);
  if constexpr (IN(PH_FINAL)) { const Ctx c = launder(c0); norm_phase<2, 0>(c, args.out, args.out, nullptr, inp(c, I1_NPOF), nullptr, nullptr, nullptr, 0, 0, nullptr); }
#undef MOE_SCHED
#undef IN
#undef SEAM
}

template <int P> static void launch_one(const Args& a, hipStream_t stream) { hipLaunchKernelGGL((fwd_kernel<P, P + 1>), dim3(256), dim3(NT), LDS_BYTES, stream, a); }
template <int P> static bool set_attr_one() { return hipFuncSetAttribute((const void*)fwd_kernel<P, P + 1>, hipFuncAttributeMaxDynamicSharedMemorySize, LDS_BYTES) == hipSuccess; }
template <int... Ps> static void launch_all(const Args& a, hipStream_t stream, std::integer_sequence<int, Ps...>) { (launch_one<Ps>(a, stream), ...); }
template <int... Ps> static bool set_attr_all(std::integer_sequence<int, Ps...>) { return (set_attr_one<Ps>() && ...); }

extern "C" void kernel_launch(void* const* d_in, const int* in_sizes, int n_in, void* d_out, int out_size, void* d_ws, size_t ws_size, hipStream_t stream) {
  static int ready = 0;
  if (!ready) {
    bool ok = true;
    if (n_in != N_IN || out_size != M * D || ws_size < WS_END) { fprintf(stderr, "kernel_launch: unexpected problem: n_in %d out %d ws %zu (need %zu)\n", n_in, out_size, ws_size, (size_t)WS_END); ok = false; }
#if PROBE_PHASE >= 0
    if (ok && (hipFuncSetAttribute((const void*)fwd_kernel<0, PROBE_PHASE + 1, 0>, hipFuncAttributeMaxDynamicSharedMemorySize, LDS_BYTES) != hipSuccess ||
               hipFuncSetAttribute((const void*)fwd_kernel<PROBE_PHASE, PROBE_PHASE + 1, 1>, hipFuncAttributeMaxDynamicSharedMemorySize, LDS_BYTES) != hipSuccess ||
               hipFuncSetAttribute((const void*)fwd_kernel<PROBE_PHASE + 1, LAST_PHASE, 2>, hipFuncAttributeMaxDynamicSharedMemorySize, LDS_BYTES) != hipSuccess)) ok = false;
#elif ONE_LAUNCH
    if (ok && hipFuncSetAttribute((const void*)fwd_kernel<0, LAST_PHASE>, hipFuncAttributeMaxDynamicSharedMemorySize, LDS_BYTES) != hipSuccess) ok = false;
#else
    if (ok && !set_attr_all(std::make_integer_sequence<int, LAST_PHASE>{})) ok = false;
#endif
    if (!ok) fprintf(stderr, "kernel_launch: setup failed\n");
    ready = ok ? 1 : -1;
  }
  if (ready < 0) return;
  (void)hipMemsetAsync((char*)d_ws + WS_CTL, 0, CTL_BYTES, stream);
  Args a{};
  for (int i = 0; i < N_IN; ++i) a.in[i] = (const float*)d_in[i];
  a.out = (float*)d_out; a.ws = (unsigned char*)d_ws;
#if PROBE_PHASE >= 0
  hipLaunchKernelGGL((fwd_kernel<0, PROBE_PHASE + 1, 0>), dim3(256), dim3(NT), LDS_BYTES, stream, a);
  hipLaunchKernelGGL((fwd_kernel<PROBE_PHASE, PROBE_PHASE + 1, 1>), dim3(256), dim3(NT), LDS_BYTES, stream, a);
  hipLaunchKernelGGL((fwd_kernel<PROBE_PHASE + 1, LAST_PHASE, 2>), dim3(256), dim3(NT), LDS_BYTES, stream, a);
#elif ONE_LAUNCH
  hipLaunchKernelGGL((fwd_kernel<0, LAST_PHASE>), dim3(256), dim3(NT), LDS_BYTES, stream, a);
#else
  launch_all(a, stream, std::make_integer_sequence<int, LAST_PHASE>{});
#endif
}
```
